# Optimizing an MI355X kernel written in HIP

```python
import math
import jax, jax.numpy as jnp
from jax import lax
import numpy as np

D_MODEL = 2048
BATCH = 1
SEQ = 8192
DEPTH = 1

POOL_WINDOWS = (2, 4, 8, 16)
N_POOL_GROUPS = len(POOL_WINDOWS)
POOL_WIDTH = D_MODEL // 2
POOL_GROUP_WIDTH = POOL_WIDTH // N_POOL_GROUPS
POOL_OUT_GROUP = D_MODEL // N_POOL_GROUPS
GMLP_HEADS = 8
GMLP_HEAD_DIM = 128
GMLP_WIDTH = GMLP_HEADS * GMLP_HEAD_DIM
CHUNK = 128
IN_WIDTH = POOL_WIDTH + 2 * GMLP_WIDTH + 2 * D_MODEL
PEER_HEADS = 8
N_KEYS = 128
N_EXPERTS = N_KEYS * N_KEYS
QUERY_DIM = 256
HALF_DIM = QUERY_DIM // 2
TOPK = 16
TOKEN_BLOCK = 128
EPS = 1e-6

kernel_name = "hybrid_pool_sgu_peer_block"


def rms_norm(x, g):
    xf = x.astype(jnp.float32)
    y = xf * lax.rsqrt(jnp.mean(xf * xf, axis=-1, keepdims=True) + EPS)
    return (y * g.astype(jnp.float32)).astype(x.dtype)


def layer_norm(x, g, b):
    xf = x.astype(jnp.float32)
    mu = jnp.mean(xf, axis=-1, keepdims=True)
    var = jnp.mean(jnp.square(xf - mu), axis=-1, keepdims=True)
    y = (xf - mu) * lax.rsqrt(var + EPS)
    return (y * g.astype(jnp.float32) + b.astype(jnp.float32)).astype(x.dtype)


def pool_mixer(a, pool_scale, w_pool):
    B, S, _ = a.shape
    af = a.astype(jnp.float32)
    csum = jnp.cumsum(af, axis=1)
    pos1 = jnp.arange(1, S + 1, dtype=jnp.float32)
    groups = []
    for gi, w in enumerate(POOL_WINDOWS):
        sl = slice(gi * POOL_GROUP_WIDTH, (gi + 1) * POOL_GROUP_WIDTH)
        cg = csum[..., sl]
        prev = jnp.pad(cg, ((0, 0), (w, 0), (0, 0)))[:, :S]
        cnt = jnp.minimum(pos1, float(w))[None, :, None]
        groups.append((cg - prev) / cnt - af[..., sl])
    pooled = jnp.concatenate(groups, axis=-1) * pool_scale.astype(jnp.float32)
    pooled = pooled.astype(a.dtype).reshape(B, S, N_POOL_GROUPS, POOL_GROUP_WIDTH)
    y = jnp.einsum('bsgc,gcd->bsgd', pooled, w_pool)
    return y.reshape(B, S, D_MODEL)


def sgu_mixer(u, v, ln_v_g, ln_v_b, w_s, b_s, w_gproj):
    B, S, _ = u.shape
    u = jax.nn.gelu(u)
    v = layer_norm(jax.nn.gelu(v), ln_v_g, ln_v_b)
    nc = S // CHUNK
    v = v.reshape(B, nc, CHUNK, GMLP_HEADS, GMLP_HEAD_DIM)
    mask = jnp.tril(jnp.ones((CHUNK, CHUNK), dtype=w_s.dtype))
    sv = jnp.einsum('hts,bnshd->bnthd', w_s * mask[None], v)
    sv = sv + jnp.transpose(b_s)[None, None, :, :, None]
    y = u.reshape(B, nc, CHUNK, GMLP_HEADS, GMLP_HEAD_DIM) * sv
    return y.reshape(B, S, GMLP_WIDTH) @ w_gproj


def peer_ffn(h, w_q, sub_keys, expert_u, expert_v):
    B, S, D = h.shape
    q = (h @ w_q).astype(jnp.float32).reshape(B, S, PEER_HEADS, 2, HALF_DIM)
    kf = sub_keys.astype(jnp.float32)
    s1 = jnp.einsum('bshk,hnk->bshn', q[..., 0, :], kf[:, 0])
    s2 = jnp.einsum('bshk,hnk->bshn', q[..., 1, :], kf[:, 1])
    t1, i1 = lax.top_k(s1, TOPK)
    t2, i2 = lax.top_k(s2, TOPK)
    cand = (t1[..., :, None] + t2[..., None, :]).reshape(B, S, PEER_HEADS, TOPK * TOPK)
    cand_idx = (i1[..., :, None] * N_KEYS + i2[..., None, :]).reshape(B, S, PEER_HEADS, TOPK * TOPK)
    ts, ti = lax.top_k(cand, TOPK)
    idx = jnp.take_along_axis(cand_idx, ti, axis=-1)
    gate = jax.nn.softmax(ts, axis=-1)
    T = B * S
    E = PEER_HEADS * TOPK
    nb = T // TOKEN_BLOCK
    xb = h.reshape(nb, TOKEN_BLOCK, D)
    ib = idx.reshape(nb, TOKEN_BLOCK, E)
    gb = gate.reshape(nb, TOKEN_BLOCK, E).astype(h.dtype)

    def block(args):
        xt, it, gt = args
        ue = expert_u[it]
        ve = expert_v[it]
        act = jax.nn.gelu(jnp.einsum('td,ted->te', xt, ue))
        return jnp.einsum('te,ted->td', gt * act, ve)

    y = lax.map(block, (xb, ib, gb))
    return y.reshape(B, S, D)


def setup_inputs(seed: int = 0) -> dict:
    key = jax.random.key(seed)
    ks = jax.random.split(key, 20)
    f32 = jnp.float32
    nrm = lambda k, shape, s: jax.random.normal(k, shape, f32) * s
    x = nrm(ks[0], (BATCH, SEQ, D_MODEL), 1.0)
    norm1_g = 1.0 + nrm(ks[1], (D_MODEL,), 0.02)
    w_in = nrm(ks[2], (D_MODEL, IN_WIDTH), D_MODEL ** -0.5)
    b_gate = nrm(ks[3], (2 * D_MODEL,), 0.02)
    pool_scale = 1.0 + nrm(ks[4], (POOL_WIDTH,), 0.02)
    w_pool = nrm(ks[5], (N_POOL_GROUPS, POOL_GROUP_WIDTH, POOL_OUT_GROUP), POOL_GROUP_WIDTH ** -0.5)
    ln_v_g = 1.0 + nrm(ks[6], (GMLP_WIDTH,), 0.02)
    ln_v_b = nrm(ks[7], (GMLP_WIDTH,), 0.02)
    w_s = nrm(ks[8], (GMLP_HEADS, CHUNK, CHUNK), 0.5 * CHUNK ** -0.5)
    b_s = 1.0 + nrm(ks[9], (GMLP_HEADS, CHUNK), 0.02)
    w_gproj = nrm(ks[10], (GMLP_WIDTH, D_MODEL), GMLP_WIDTH ** -0.5)
    w_out = nrm(ks[11], (D_MODEL, D_MODEL), D_MODEL ** -0.5)
    norm2_g = 1.0 + nrm(ks[12], (D_MODEL,), 0.02)
    w_q = nrm(ks[13], (D_MODEL, PEER_HEADS * QUERY_DIM), D_MODEL ** -0.5)
    sub_keys = nrm(ks[14], (PEER_HEADS, 2, N_KEYS, HALF_DIM), HALF_DIM ** -0.5)
    expert_u = nrm(ks[15], (N_EXPERTS, D_MODEL), D_MODEL ** -0.5)
    expert_v = nrm(ks[16], (N_EXPERTS, D_MODEL), PEER_HEADS ** -0.5)
    final_g = 1.0 + nrm(ks[17], (D_MODEL,), 0.02)
    return {"x": x, "norm1_g": norm1_g, "w_in": w_in, "b_gate": b_gate,
            "pool_scale": pool_scale, "w_pool": w_pool, "ln_v_g": ln_v_g, "ln_v_b": ln_v_b,
            "w_s": w_s, "b_s": b_s, "w_gproj": w_gproj, "w_out": w_out,
            "norm2_g": norm2_g, "w_q": w_q, "sub_keys": sub_keys,
            "expert_u": expert_u, "expert_v": expert_v, "final_g": final_g}


def reference(x, norm1_g, w_in, b_gate, pool_scale, w_pool, ln_v_g, ln_v_b,
              w_s, b_s, w_gproj, w_out, norm2_g, w_q, sub_keys,
              expert_u, expert_v, final_g):
    P, G, D = POOL_WIDTH, GMLP_WIDTH, D_MODEL
    for _ in range(DEPTH):
        h = rms_norm(x, norm1_g)
        z = h @ w_in
        y_pool = pool_mixer(z[..., :P], pool_scale, w_pool)
        y_sgu = sgu_mixer(z[..., P:P + G], z[..., P + G:P + 2 * G],
                          ln_v_g, ln_v_b, w_s, b_s, w_gproj)
        gates = jax.nn.sigmoid(z[..., P + 2 * G:] + b_gate)
        merged = gates[..., :D] * y_pool + gates[..., D:] * y_sgu
        x = x + merged @ w_out
        x = x + peer_ffn(rms_norm(x, norm2_g), w_q, sub_keys, expert_u, expert_v)
    return rms_norm(x, final_g)
```

```cpp
#include <hip/hip_runtime.h>
#include <hip/hip_cooperative_groups.h>
#include <cstdio>
#include <cstdint>
namespace cg = cooperative_groups;

#ifndef MK_N_LAUNCHES
#define MK_N_LAUNCHES 9
#endif

#define LAS __attribute__((address_space(3)))
typedef unsigned short bf16_t;
typedef short bf16x8 __attribute__((ext_vector_type(8)));
typedef float f32x4 __attribute__((ext_vector_type(4)));
typedef unsigned u32x4 __attribute__((ext_vector_type(4)));
typedef unsigned u32x2 __attribute__((ext_vector_type(2)));

constexpr int S = 8192, D = 2048, INW = 7168, PW = 1024, GWD = 1024;
constexpr int NEXP = 16384;
constexpr float EPS = 1e-6f;
constexpr int NWAVES = 8, NTHR = 512;

constexpr size_t MiB = 1u << 20;
constexpr size_t WS_CTL = 0;
constexpr size_t WS_WIN = 1 * MiB;
constexpr size_t WS_WPOOL = 30 * MiB;
constexpr size_t WS_WG = 31 * MiB;
constexpr size_t WS_WOUT = 35 * MiB;
constexpr size_t WS_WQ = 43 * MiB;
constexpr size_t WS_KEYS = 51 * MiB;
constexpr size_t WS_WSM = 52 * MiB;
constexpr size_t WS_H = 53 * MiB;
constexpr size_t WS_Z = 85 * MiB;
constexpr size_t WS_A2 = 197 * MiB;
constexpr size_t WS_T = 229 * MiB;
constexpr size_t WS_MRG = 293 * MiB;
constexpr size_t WS_Q = 325 * MiB;
constexpr size_t WS_IDX = 357 * MiB;
constexpr size_t WS_GATE = 361 * MiB;
constexpr size_t WS_EU = 365 * MiB;
constexpr size_t WS_EV = 429 * MiB;
constexpr size_t WS_END = 493 * MiB;

constexpr int LDS_BYTES = 147456;

__device__ __forceinline__ unsigned f2bf(float f) { unsigned u = __builtin_bit_cast(unsigned, f); return (u + 0x7fffu + ((u >> 16) & 1u)) >> 16; }
__device__ __forceinline__ unsigned pk2(float lo, float hi) { return f2bf(lo) | (f2bf(hi) << 16); }
__device__ __forceinline__ float bflo(unsigned w) { return __builtin_bit_cast(float, w << 16); }
__device__ __forceinline__ float bfhi(unsigned w) { return __builtin_bit_cast(float, w & 0xffff0000u); }
__device__ __forceinline__ float wave_sum(float v) {
#pragma unroll
    for (int o = 1; o < 64; o <<= 1) v += __shfl_xor(v, o);
    return v;
}
__device__ __forceinline__ float gelu_tanh(float x) {
    const float y = 1.5957691216057308f * (x + 0.044715f * x * x * x);
    const float e = __builtin_amdgcn_exp2f(-y * 1.4426950408889634f);
    return x * __builtin_amdgcn_rcpf(1.0f + e);
}
__device__ __forceinline__ float sigmoidf_(float x) { return __builtin_amdgcn_rcpf(1.0f + __builtin_amdgcn_exp2f(-x * 1.4426950408889634f)); }

namespace pg8 {
constexpr int BM = 256, BK = 64, HALF = 128, HTB = HALF * BK * 2, STAGE_BYTES = 8 * HTB, NXCD = 8, WGM = 8;
__host__ __device__ __forceinline__ int lds_byte(int r, int c) { const int st = (r >> 4) * 2 + (c >> 5), rr = r & 15, cc = c & 31, ob = rr * 64 + cc * 2; return st * 1024 + (ob ^ (((ob >> 9) & 1) << 5)); }
__host__ __device__ __forceinline__ void stage_rc(int b, int& R, int& C) { const int st = b / 1024, sb = b % 1024, swz = sb ^ (((sb >> 9) & 1) << 5); R = (st >> 1) * 16 + swz / 64; C = (st & 1) * 32 + (swz % 64) / 2; }
__host__ __device__ __forceinline__ int perm32(int rho) { const int n = rho >> 4, i = rho & 15; return 8 * (i >> 2) + 4 * n + (i & 3); }

struct Unit { int pm, pn; };
struct Gemm { const bf16_t* A; const bf16_t* Bt; int M, N, K, lda, ldb, mode; };
__device__ __forceinline__ const char* a_ptr(const Gemm& g, const Unit& u) {
    size_t off = (size_t)u.pm * BM * g.lda; if (g.mode == 1) off += (size_t)(u.pn >> 1) * 256; return (const char*)(g.A + off); }
__device__ __forceinline__ const char* b_ptr(const Gemm& g, const Unit& u) {
    size_t off = (g.mode == 1) ? ((size_t)(u.pn >> 1) * 512 * 256 + (size_t)(u.pn & 1) * 256 * 256) : (size_t)u.pn * BM * g.ldb; return (const char*)(g.Bt + off); }

struct StaticOrder {
    int nM, nN, nwg, G, c;
    __host__ __device__ void init(int M, int N, int G_, int c_) { nM = M / BM; nN = N / BM; nwg = nM * nN; G = G_; c = c_; }
    __host__ __device__ bool next(int i, Unit& u) const {
        const long L = (long)i * G + c; if (L >= nwg) return false;
        int wgid = (int)L; { const int q = nwg / NXCD, r = nwg % NXCD, xcd = wgid % NXCD, off = wgid / NXCD; wgid = (xcd < r ? xcd * (q + 1) : r * (q + 1) + (xcd - r) * q) + off; }
        const int nig = WGM * nN, gid = wgid / nig, fm = gid * WGM, gsz = (nM - fm) < WGM ? (nM - fm) : WGM;
        u.pm = fm + ((wgid % nig) % gsz); u.pn = (wgid % nig) / gsz; return true;
    }
};

__device__ __forceinline__ unsigned cvt_pk_bf16(float lo, float hi) { unsigned r; asm volatile("v_cvt_pk_bf16_f32 %0, %1, %2" : "=v"(r) : "v"(lo), "v"(hi)); return r; }


struct EpiZ {
    static constexpr bool PERM = true;
    bf16_t* Z; const float* b_gate;
    __device__ __forceinline__ void operator()(const f32x4 (&acc)[2][2][4][2], const Unit& u, int wr, int wc, int fr, int fq) const {
        const int row0 = u.pm * BM + wr * 64 + fr, col0 = u.pn * BM + wc * 32 + 8 * fq;
        const int mode = u.pn < 4 ? 0 : (u.pn < 12 ? 1 : 2);
        f32x4 bv[2][2];
#pragma unroll
        for (int bj = 0; bj < 2; ++bj)
#pragma unroll
            for (int n = 0; n < 2; ++n) bv[bj][n] = (mode == 2) ? *(const f32x4*)(b_gate + (col0 - 3072) + bj * HALF + 4 * n) : (f32x4){0.f, 0.f, 0.f, 0.f};
#pragma unroll
        for (int ai = 0; ai < 2; ++ai)
#pragma unroll
            for (int m = 0; m < 4; ++m) { bf16_t* rowp = Z + (size_t)(row0 + ai * HALF + m * 16) * INW + col0;
#pragma unroll
                for (int bj = 0; bj < 2; ++bj) { f32x4 v0 = acc[ai][bj][m][0], v1 = acc[ai][bj][m][1];
                    if (mode == 1) {
#pragma unroll
                        for (int j = 0; j < 4; ++j) { v0[j] = gelu_tanh(v0[j]); v1[j] = gelu_tanh(v1[j]); } }
                    if (mode == 2) { v0 += bv[bj][0]; v1 += bv[bj][1];
#pragma unroll
                        for (int j = 0; j < 4; ++j) { v0[j] = sigmoidf_(v0[j]); v1[j] = sigmoidf_(v1[j]); } }
                    u32x4 w; w.x = cvt_pk_bf16(v0[0], v0[1]); w.y = cvt_pk_bf16(v0[2], v0[3]); w.z = cvt_pk_bf16(v1[0], v1[1]); w.w = cvt_pk_bf16(v1[2], v1[3]);
                    *(u32x4*)(rowp + bj * HALF) = w; } }
    }
};
struct EpiPool {
    static constexpr bool PERM = true;
    float* T; const bf16_t* Z;
    __device__ __forceinline__ void operator()(const f32x4 (&acc)[2][2][4][2], const Unit& u, int wr, int wc, int fr, int fq) const {
        const int row0 = u.pm * BM + wr * 64 + fr, col0 = u.pn * BM + wc * 32 + 8 * fq;
#pragma unroll
        for (int ai = 0; ai < 2; ++ai)
#pragma unroll
            for (int m = 0; m < 4; ++m) { const size_t row = (size_t)(row0 + ai * HALF + m * 16);
#pragma unroll
                for (int bj = 0; bj < 2; ++bj) { const int c = col0 + bj * HALF;
                    const u32x4 g = *(const u32x4*)(Z + row * INW + 3072 + c);
                    const f32x4 a0 = acc[ai][bj][m][0], a1 = acc[ai][bj][m][1];
                    f32x4 o0, o1;
                    o0[0] = bflo(g.x) * a0[0]; o0[1] = bfhi(g.x) * a0[1]; o0[2] = bflo(g.y) * a0[2]; o0[3] = bfhi(g.y) * a0[3];
                    o1[0] = bflo(g.z) * a1[0]; o1[1] = bfhi(g.z) * a1[1]; o1[2] = bflo(g.w) * a1[2]; o1[3] = bfhi(g.w) * a1[3];
                    *(f32x4*)(T + row * D + c) = o0; *(f32x4*)(T + row * D + c + 4) = o1; }
                asm volatile("" ::: "memory"); }
    }
};
struct EpiMerge {
    static constexpr bool PERM = true;
    const float* T; const bf16_t* Z; bf16_t* O;
    __device__ __forceinline__ void operator()(const f32x4 (&acc)[2][2][4][2], const Unit& u, int wr, int wc, int fr, int fq) const {
        const int row0 = u.pm * BM + wr * 64 + fr, col0 = u.pn * BM + wc * 32 + 8 * fq;
#pragma unroll
        for (int ai = 0; ai < 2; ++ai)
#pragma unroll
            for (int m = 0; m < 4; ++m) { const size_t row = (size_t)(row0 + ai * HALF + m * 16);
#pragma unroll
                for (int bj = 0; bj < 2; ++bj) { const int c = col0 + bj * HALF;
                    const u32x4 g = *(const u32x4*)(Z + row * INW + 5120 + c);
                    const f32x4 t0 = *(const f32x4*)(T + row * D + c), t1 = *(const f32x4*)(T + row * D + c + 4);
                    const f32x4 a0 = acc[ai][bj][m][0], a1 = acc[ai][bj][m][1];
                    f32x4 o0, o1;
                    o0[0] = t0[0] + bflo(g.x) * a0[0]; o0[1] = t0[1] + bfhi(g.x) * a0[1]; o0[2] = t0[2] + bflo(g.y) * a0[2]; o0[3] = t0[3] + bfhi(g.y) * a0[3];
                    o1[0] = t1[0] + bflo(g.z) * a1[0]; o1[1] = t1[1] + bfhi(g.z) * a1[1]; o1[2] = t1[2] + bflo(g.w) * a1[2]; o1[3] = t1[3] + bfhi(g.w) * a1[3];
                    u32x4 w; w.x = cvt_pk_bf16(o0[0], o0[1]); w.y = cvt_pk_bf16(o0[2], o0[3]); w.z = cvt_pk_bf16(o1[0], o1[1]); w.w = cvt_pk_bf16(o1[2], o1[3]);
                    *(u32x4*)(O + row * D + c) = w; }
                asm volatile("" ::: "memory"); }
    }
};
struct EpiX1 {
    static constexpr bool PERM = false;
    const float* X; float* O;
    __device__ __forceinline__ void operator()(const f32x4 (&acc)[2][2][4][2], const Unit& u, int wr, int wc, int fr, int fq) const {
        const int row0 = u.pm * BM + wr * 64 + fr, col0 = u.pn * BM + wc * 32 + 4 * fq;
#pragma unroll
        for (int ai = 0; ai < 2; ++ai)
#pragma unroll
            for (int m = 0; m < 4; ++m) { const size_t off = (size_t)(row0 + ai * HALF + m * 16) * D + col0;
#pragma unroll
                for (int bj = 0; bj < 2; ++bj)
#pragma unroll
                    for (int n = 0; n < 2; ++n) { const f32x4 xv = *(const f32x4*)(X + off + bj * HALF + n * 16); *(f32x4*)(O + off + bj * HALF + n * 16) = xv + acc[ai][bj][m][n]; } }
    }
};
struct EpiQ {
    static constexpr bool PERM = true;
    bf16_t* O;
    __device__ __forceinline__ void operator()(const f32x4 (&acc)[2][2][4][2], const Unit& u, int wr, int wc, int fr, int fq) const {
        const int row0 = u.pm * BM + wr * 64 + fr, col0 = u.pn * BM + wc * 32 + 8 * fq;
#pragma unroll
        for (int ai = 0; ai < 2; ++ai)
#pragma unroll
            for (int m = 0; m < 4; ++m) { bf16_t* rowp = O + (size_t)(row0 + ai * HALF + m * 16) * D + col0;
#pragma unroll
                for (int bj = 0; bj < 2; ++bj) { const f32x4 v0 = acc[ai][bj][m][0], v1 = acc[ai][bj][m][1];
                    u32x4 w; w.x = cvt_pk_bf16(v0[0], v0[1]); w.y = cvt_pk_bf16(v0[2], v0[3]); w.z = cvt_pk_bf16(v1[0], v1[1]); w.w = cvt_pk_bf16(v1[2], v1[3]);
                    *(u32x4*)(rowp + bj * HALF) = w; } }
    }
};

template <class Epi, bool ALIGN_EPI = true>
__device__ __forceinline__ void gemm_phase(LAS unsigned char* lds, const Gemm g, const StaticOrder& S_, const Epi& E) {
    int tid_ = threadIdx.x; asm volatile("" : "+v"(tid_));
    const int tid = tid_, wid = __builtin_amdgcn_readfirstlane(tid >> 6), lane = tid & 63, wr = wid >> 2, wc = wid & 3, fr = lane & 15, fq = lane >> 4;
    const int K = g.K, nt = K / BK;
    unsigned voffA[2], voffB[2];
#pragma unroll
    for (int i = 0; i < 2; ++i) { int R, C; stage_rc(tid * 16 + i * 8192, R, C); const int Rb = Epi::PERM ? ((R & ~31) + perm32(R & 31)) : R;
        voffA[i] = (unsigned)(R * g.lda + C) * 2u; voffB[i] = (unsigned)(Rb * g.ldb + C) * 2u; }
    const size_t kstep = (size_t)(BK * 2);
    const size_t hstepA = (size_t)HALF * g.lda * 2, hstepB = (size_t)HALF * g.ldb * 2;
    const unsigned ldsw = (unsigned)wid * 1024u;
    const int aoff = lds_byte(wr * 64 + fr, fq * 8), boff = lds_byte(wc * 32 + fr, fq * 8);
#define PG8_SA(b, h) (((b) * 2 + (h)) * HTB)
#define PG8_SB(b, h) ((4 + (b) * 2 + (h)) * HTB)
#define PG8_STAGE(bufoff, gbase, voff) do { _Pragma("unroll") for (int _i = 0; _i < 2; ++_i) \
        __builtin_amdgcn_global_load_lds((const unsigned*)((const char*)(gbase) + (voff)[_i]), (LAS unsigned*)(lds + (bufoff) + ldsw + _i * 8192), 16, 0, 0); } while (0)
#define PG8_LDA(dst, b, h) do { _Pragma("unroll") for (int m = 0; m < 4; ++m) _Pragma("unroll") for (int k = 0; k < 2; ++k) dst[m][k] = *(const LAS bf16x8*)(lds + PG8_SA(b, h) + aoff + m * 2048 + k * 1024); } while (0)
#define PG8_LDB(dst, b, h) do { _Pragma("unroll") for (int n = 0; n < 2; ++n) _Pragma("unroll") for (int k = 0; k < 2; ++k) dst[n][k] = *(const LAS bf16x8*)(lds + PG8_SB(b, h) + boff + n * 2048 + k * 1024); } while (0)
#define PG8_MMA(ai, bj, At, Bt) do { __builtin_amdgcn_s_setprio(1); _Pragma("unroll") for (int m = 0; m < 4; ++m) _Pragma("unroll") for (int n = 0; n < 2; ++n) _Pragma("unroll") for (int k = 0; k < 2; ++k) \
        acc[ai][bj][m][n] = __builtin_amdgcn_mfma_f32_16x16x32_bf16(Bt[n][k], At[m][k], acc[ai][bj][m][n], 0, 0, 0); __builtin_amdgcn_s_setprio(0); } while (0)
#define PG8_WAIT_V(n) asm volatile("s_waitcnt vmcnt(" #n ")" ::: "memory")
#define PG8_WAIT_L(n) asm volatile("s_waitcnt lgkmcnt(" #n ")" ::: "memory")
#define PG8_BAR __builtin_amdgcn_s_barrier()
#define PG8_SCHED __builtin_amdgcn_sched_barrier(0)
    Unit cur, nxt; int ui = 0;
    if (!S_.next(0, cur)) return;
    f32x4 acc[2][2][4][2];
#pragma unroll
    for (int a = 0; a < 2; ++a)
#pragma unroll
        for (int b = 0; b < 2; ++b)
#pragma unroll
            for (int m = 0; m < 4; ++m)
#pragma unroll
                for (int n = 0; n < 2; ++n) acc[a][b][m][n] = (f32x4){0.f, 0.f, 0.f, 0.f};
    bf16x8 At[4][2], B0[2][2], B1[2][2];
    const char* cA = a_ptr(g, cur); const char* cB = b_ptr(g, cur);
    PG8_STAGE(PG8_SB(0, 0), cB, voffB); PG8_STAGE(PG8_SB(0, 1), cB + hstepB, voffB); PG8_STAGE(PG8_SA(0, 0), cA, voffA); PG8_STAGE(PG8_SA(0, 1), cA + hstepA, voffA);
    if (wr == 1) PG8_BAR;
    PG8_WAIT_V(2); PG8_BAR;
    PG8_STAGE(PG8_SB(1, 0), cB + kstep, voffB); PG8_STAGE(PG8_SA(1, 0), cA + kstep, voffA); PG8_STAGE(PG8_SB(1, 1), cB + hstepB + kstep, voffB);
    PG8_WAIT_V(6); PG8_BAR;
    for (;;) {
        const bool has_next = S_.next(ui + 1, nxt);
        const char* nA = has_next ? a_ptr(g, nxt) : cA; const char* nB = has_next ? b_ptr(g, nxt) : cB;
        for (int t = 0; t < nt; t += 2) {
            const bool last = (t == nt - 2);
            const char* a1 = cA + (size_t)(t + 1) * kstep;
            const char* a2 = last ? nA : cA + (size_t)(t + 2) * kstep; const char* b2 = last ? nB : cB + (size_t)(t + 2) * kstep;
            const char* a3 = a2 + kstep; const char* b3 = b2 + kstep;
            PG8_LDB(B0, 0, 0); PG8_LDB(B1, 0, 1); PG8_SCHED; PG8_LDA(At, 0, 0); PG8_STAGE(PG8_SA(1, 1), a1 + hstepA, voffA);
            PG8_WAIT_V(8); PG8_WAIT_L(0); PG8_BAR; PG8_MMA(0, 0, At, B0); PG8_MMA(0, 1, At, B1); PG8_BAR; PG8_SCHED;
            PG8_LDA(At, 0, 1); PG8_STAGE(PG8_SB(0, 0), b2, voffB); PG8_STAGE(PG8_SB(0, 1), b2 + hstepB, voffB); PG8_STAGE(PG8_SA(0, 0), a2, voffA);
            PG8_WAIT_V(8); PG8_WAIT_L(0); PG8_BAR; PG8_MMA(1, 0, At, B0); PG8_MMA(1, 1, At, B1); PG8_BAR; PG8_SCHED;
            PG8_LDB(B0, 1, 0); PG8_LDB(B1, 1, 1); PG8_SCHED; PG8_LDA(At, 1, 0); PG8_STAGE(PG8_SA(0, 1), a2 + hstepA, voffA);
            PG8_WAIT_V(8); PG8_WAIT_L(0); PG8_BAR; PG8_MMA(0, 0, At, B0); PG8_MMA(0, 1, At, B1); PG8_BAR; PG8_SCHED;
            PG8_LDA(At, 1, 1); PG8_STAGE(PG8_SB(1, 0), b3, voffB); PG8_STAGE(PG8_SB(1, 1), b3 + hstepB, voffB); PG8_STAGE(PG8_SA(1, 0), a3, voffA);
            PG8_WAIT_V(8); PG8_WAIT_L(0); PG8_BAR; PG8_MMA(1, 0, At, B0); PG8_MMA(1, 1, At, B1); PG8_BAR; PG8_SCHED;
        }
        if constexpr (ALIGN_EPI) { if (wr == 0) PG8_BAR; }
        E(acc, cur, wr, wc, fr, fq);
        if (!has_next) break;
#pragma unroll
        for (int a = 0; a < 2; ++a)
#pragma unroll
            for (int b = 0; b < 2; ++b)
#pragma unroll
                for (int m = 0; m < 4; ++m)
#pragma unroll
                    for (int n = 0; n < 2; ++n) acc[a][b][m][n] = (f32x4){0.f, 0.f, 0.f, 0.f};
        cur = nxt; cA = nA; cB = nB; ++ui;
        if constexpr (ALIGN_EPI) { if (wr == 1) PG8_BAR; }
    }
    PG8_WAIT_V(0);
    if constexpr (!ALIGN_EPI) { if (wr == 0) PG8_BAR; }
    PG8_BAR;
#undef PG8_SA
#undef PG8_SB
#undef PG8_STAGE
#undef PG8_LDA
#undef PG8_LDB
#undef PG8_MMA
#undef PG8_WAIT_V
#undef PG8_WAIT_L
#undef PG8_BAR
#undef PG8_SCHED
}
}

struct Args { const float* in[18]; float* out; unsigned char* ws; int ph_lo, ph_hi; };

__device__ __forceinline__ void p0_transpose_item(const float* W, int K, int N, bf16_t* WT, LAS float* scr, int item, int lane) {
    const int nblk = N / 32, kb = item / nblk, nb = item % nblk, k0 = 64 * kb, n0 = 32 * nb;
#pragma unroll 8
    for (int i = 0; i < 32; ++i) { const int kk = 2 * i + (lane >> 5); scr[kk * 33 + (lane & 31)] = W[(size_t)(k0 + kk) * N + n0 + (lane & 31)]; }
    asm volatile("s_waitcnt lgkmcnt(0)" ::: "memory");
    const int c = lane & 7;
#pragma unroll
    for (int j = 0; j < 4; ++j) { const int n = (lane >> 3) + 8 * j; const LAS float* s = scr + (8 * c) * 33 + n;
        u32x4 o; o.x = pk2(s[0 * 33], s[1 * 33]); o.y = pk2(s[2 * 33], s[3 * 33]); o.z = pk2(s[4 * 33], s[5 * 33]); o.w = pk2(s[6 * 33], s[7 * 33]);
        *(u32x4*)(WT + (size_t)(n0 + n) * K + k0 + 8 * c) = o; }
    asm volatile("s_waitcnt lgkmcnt(0)" ::: "memory");
}
__device__ __forceinline__ void rms_row_to_bf16(const float* xrow, const float* g, bf16_t* orow, int lane) {
    const f32x4* xr = (const f32x4*)xrow + lane;
    f32x4 v[8]; float s = 0.f;
#pragma unroll
    for (int j = 0; j < 8; ++j) { v[j] = xr[64 * j]; s += (v[j].x * v[j].x + v[j].y * v[j].y) + (v[j].z * v[j].z + v[j].w * v[j].w); }
    const float rstd = 1.0f / sqrtf(wave_sum(s) * (1.0f / D) + EPS);
    const f32x4* gr = (const f32x4*)g + lane;
    u32x2* o8 = (u32x2*)orow + lane;
#pragma unroll
    for (int j = 0; j < 8; ++j) { const f32x4 gv = gr[64 * j]; u32x2 o; o.x = pk2(v[j].x * rstd * gv.x, v[j].y * rstd * gv.y); o.y = pk2(v[j].z * rstd * gv.z, v[j].w * rstd * gv.w); o8[64 * j] = o; }
}
__device__ __forceinline__ void cvt_stream(const float* src, bf16_t* dst, size_t n8, size_t gtid, size_t nthr) {
    for (size_t i = gtid; i < n8; i += nthr) { const f32x4 a = ((const f32x4*)src)[2 * i], b = ((const f32x4*)src)[2 * i + 1];
        u32x4 o; o.x = pk2(a.x, a.y); o.y = pk2(a.z, a.w); o.z = pk2(b.x, b.y); o.w = pk2(b.z, b.w); ((u32x4*)dst)[i] = o; }
}

__device__ __forceinline__ void p0_prologue(const Args& a, LAS unsigned char* lds, int vcu, int G, int wave, int lane, int tid) {
    unsigned char* ws = a.ws;
    LAS float* scr = (LAS float*)(lds + wave * 16384);
    const int gw = vcu * NWAVES + wave, NGW = G * NWAVES;
    constexpr int I_IN = (D / 64) * (INW / 32), I_POOL1 = (256 / 64) * (512 / 32), I_G = (GWD / 64) * (D / 32), I_O = (D / 64) * (D / 32), I_Q = I_O;
    constexpr int NITEMS = I_IN + 4 * I_POOL1 + I_G + I_O + I_Q;
    for (int it = gw; it < NITEMS; it += NGW) {
        int r = it;
        if (r < I_IN) { p0_transpose_item(a.in[2], D, INW, (bf16_t*)(ws + WS_WIN), scr, r, lane); continue; } r -= I_IN;
        if (r < 4 * I_POOL1) { const int g = r / I_POOL1; p0_transpose_item(a.in[5] + (size_t)g * 256 * 512, 256, 512, (bf16_t*)(ws + WS_WPOOL) + (size_t)g * 512 * 256, scr, r % I_POOL1, lane); continue; } r -= 4 * I_POOL1;
        if (r < I_G) { p0_transpose_item(a.in[10], GWD, D, (bf16_t*)(ws + WS_WG), scr, r, lane); continue; } r -= I_G;
        if (r < I_O) { p0_transpose_item(a.in[11], D, D, (bf16_t*)(ws + WS_WOUT), scr, r, lane); continue; } r -= I_O;
        p0_transpose_item(a.in[13], D, D, (bf16_t*)(ws + WS_WQ), scr, r, lane);
    }
    for (int m = gw; m < S; m += NGW) rms_row_to_bf16(a.in[0] + (size_t)m * D, a.in[1], (bf16_t*)(ws + WS_H) + (size_t)m * D, lane);
    const size_t gtid = (size_t)vcu * NTHR + tid, nthr = (size_t)G * NTHR;
    cvt_stream(a.in[14], (bf16_t*)(ws + WS_KEYS), (size_t)8 * 2 * 128 * 128 / 8, gtid, nthr);
    {
        const float* src = a.in[8]; bf16_t* dst = (bf16_t*)(ws + WS_WSM);
        for (size_t i = gtid; i < (size_t)8 * 128 * 128 / 8; i += nthr) { const int s0 = (int)(i & 15) * 8, t = (int)(i >> 4) & 127;
            const f32x4 x0 = ((const f32x4*)src)[2 * i], x1 = ((const f32x4*)src)[2 * i + 1];
            float v[8] = {x0.x, x0.y, x0.z, x0.w, x1.x, x1.y, x1.z, x1.w};
#pragma unroll
            for (int j = 0; j < 8; ++j) v[j] = (s0 + j <= t) ? v[j] : 0.f;
            u32x4 o; o.x = pk2(v[0], v[1]); o.y = pk2(v[2], v[3]); o.z = pk2(v[4], v[5]); o.w = pk2(v[6], v[7]); ((u32x4*)dst)[i] = o; }
    }
    cvt_stream(a.in[15], (bf16_t*)(ws + WS_EU), (size_t)NEXP * D / 8, gtid, nthr);
    cvt_stream(a.in[16], (bf16_t*)(ws + WS_EV), (size_t)NEXP * D / 8, gtid, nthr);
}

__device__ __forceinline__ void p2_pool(const Args& a, int vcu, int G, int tid) {
    const bf16_t* Z = (const bf16_t*)(a.ws + WS_Z); bf16_t* A2 = (bf16_t*)(a.ws + WS_A2); const float* psc = a.in[4];
    const size_t gtid = (size_t)vcu * NTHR + tid, nthr = (size_t)G * NTHR;
    for (size_t id = gtid; id < (size_t)S * 128; id += nthr) {
        const int c8 = (int)(id & 127), t = (int)(id >> 7), g = c8 >> 5, w = 2 << g;
        const int j0 = (t - w + 1) > 0 ? (t - w + 1) : 0;
        float s[8] = {0.f, 0.f, 0.f, 0.f, 0.f, 0.f, 0.f, 0.f}; u32x4 r = {0u, 0u, 0u, 0u};
        for (int j = j0; j <= t; ++j) { r = *(const u32x4*)(Z + (size_t)j * INW + c8 * 8);
            s[0] += bflo(r.x); s[1] += bfhi(r.x); s[2] += bflo(r.y); s[3] += bfhi(r.y); s[4] += bflo(r.z); s[5] += bfhi(r.z); s[6] += bflo(r.w); s[7] += bfhi(r.w); }
        const float inv = 1.0f / (float)(t - j0 + 1);
        const float at[8] = {bflo(r.x), bfhi(r.x), bflo(r.y), bfhi(r.y), bflo(r.z), bfhi(r.z), bflo(r.w), bfhi(r.w)};
        const f32x4 p0 = *(const f32x4*)(psc + c8 * 8), p1 = *(const f32x4*)(psc + c8 * 8 + 4);
        const float ps[8] = {p0.x, p0.y, p0.z, p0.w, p1.x, p1.y, p1.z, p1.w};
        float o[8];
#pragma unroll
        for (int i = 0; i < 8; ++i) o[i] = (s[i] * inv - at[i]) * ps[i];
        u32x4 w4; w4.x = pk2(o[0], o[1]); w4.y = pk2(o[2], o[3]); w4.z = pk2(o[4], o[5]); w4.w = pk2(o[6], o[7]);
        *(u32x4*)(A2 + (size_t)t * D + c8 * 8) = w4;
    }
}
constexpr int VT_LD = 136;
__device__ __forceinline__ void p2_sgu(const Args& a, LAS unsigned char* lds, int vcu, int G, int wave, int lane, int tid) {
    const bf16_t* Z = (const bf16_t*)(a.ws + WS_Z); bf16_t* A2 = (bf16_t*)(a.ws + WS_A2); const bf16_t* WSM = (const bf16_t*)(a.ws + WS_WSM);
    const float* lng = a.in[6]; const float* lnb = a.in[7]; const float* bs = a.in[9];
    LAS float* st = (LAS float*)lds; LAS bf16_t* Vt = (LAS bf16_t*)(lds + 1024);
    const int fr = lane & 15, fq = lane >> 4;
    for (int item = vcu; item < 512; item += G) {
        const int c = item >> 3, h = item & 7, t0 = c * 128;
        for (int r = 0; r < 16; ++r) { const int sr = wave * 16 + r; const bf16_t* p = Z + (size_t)(t0 + sr) * INW + 2048 + lane * 8;
            const u32x4 r0 = *(const u32x4*)p, r1 = *(const u32x4*)(p + 512);
            float v[16] = {bflo(r0.x), bfhi(r0.x), bflo(r0.y), bfhi(r0.y), bflo(r0.z), bfhi(r0.z), bflo(r0.w), bfhi(r0.w),
                           bflo(r1.x), bfhi(r1.x), bflo(r1.y), bfhi(r1.y), bflo(r1.z), bfhi(r1.z), bflo(r1.w), bfhi(r1.w)};
            float sm = 0.f;
#pragma unroll
            for (int i = 0; i < 16; ++i) sm += v[i];
            const float mean = wave_sum(sm) * (1.0f / 1024.0f); float q = 0.f;
#pragma unroll
            for (int i = 0; i < 16; ++i) { const float d = v[i] - mean; q += d * d; }
            const float rstd = 1.0f / sqrtf(wave_sum(q) * (1.0f / 1024.0f) + EPS);
            if (lane == 0) { st[2 * sr] = mean; st[2 * sr + 1] = rstd; } }
        __syncthreads();
#pragma unroll
        for (int q = 0; q < 4; ++q) { const int id = tid + q * NTHR, sr = id >> 4, dc = id & 15;
            const u32x4 raw = *(const u32x4*)(Z + (size_t)(t0 + sr) * INW + 2048 + h * 128 + dc * 8);
            const float mean = st[2 * sr], rstd = st[2 * sr + 1];
            const float v[8] = {bflo(raw.x), bfhi(raw.x), bflo(raw.y), bfhi(raw.y), bflo(raw.z), bfhi(raw.z), bflo(raw.w), bfhi(raw.w)};
#pragma unroll
            for (int i = 0; i < 8; ++i) { const int d = dc * 8 + i; const float y = (v[i] - mean) * rstd * lng[h * 128 + d] + lnb[h * 128 + d]; Vt[d * VT_LD + sr] = (bf16_t)f2bf(y); } }
        __syncthreads();
        f32x4 acc[8];
#pragma unroll
        for (int db = 0; db < 8; ++db) acc[db] = (f32x4){0.f, 0.f, 0.f, 0.f};
        const int nks = (wave * 16 + 15) / 32 + 1;
        for (int ks = 0; ks < nks; ++ks) {
            const bf16x8 bW = *(const bf16x8*)(WSM + (size_t)(h * 128 + wave * 16 + fr) * 128 + ks * 32 + fq * 8);
#pragma unroll
            for (int db = 0; db < 8; ++db) { const bf16x8 aV = *(const LAS bf16x8*)(Vt + (db * 16 + fr) * VT_LD + ks * 32 + fq * 8);
                acc[db] = __builtin_amdgcn_mfma_f32_16x16x32_bf16(aV, bW, acc[db], 0, 0, 0); }
        }
        { const int t = t0 + wave * 16 + fr; const float bias = bs[h * 128 + wave * 16 + fr];
#pragma unroll
          for (int db = 0; db < 8; ++db) { const int col = h * 128 + db * 16 + fq * 4;
              const u32x2 ur = *(const u32x2*)(Z + (size_t)t * INW + 1024 + col);
              u32x2 o; o.x = pk2(bflo(ur.x) * (acc[db][0] + bias), bfhi(ur.x) * (acc[db][1] + bias)); o.y = pk2(bflo(ur.y) * (acc[db][2] + bias), bfhi(ur.y) * (acc[db][3] + bias));
              *(u32x2*)(A2 + (size_t)t * D + 1024 + col) = o; } }
        __syncthreads();
    }
}

template <int NV> __device__ __forceinline__ void row_top16(float (&v)[NV], int fr, float& tv, int& ti) {
    tv = 0.f; ti = 0;
    for (int it = 0; it < 16; ++it) {
        float m = v[0];
#pragma unroll
        for (int r = 1; r < NV; ++r) m = fmaxf(m, v[r]);
        m = fmaxf(m, __shfl_xor(m, 1)); m = fmaxf(m, __shfl_xor(m, 2)); m = fmaxf(m, __shfl_xor(m, 4)); m = fmaxf(m, __shfl_xor(m, 8));
        int c = 1 << 30;
#pragma unroll
        for (int r = 0; r < NV; ++r) { const int e = r * 16 + fr; c = (v[r] == m && e < c) ? e : c; }
        c = min(c, __shfl_xor(c, 1)); c = min(c, __shfl_xor(c, 2)); c = min(c, __shfl_xor(c, 4)); c = min(c, __shfl_xor(c, 8));
#pragma unroll
        for (int r = 0; r < NV; ++r) v[r] = (r * 16 + fr == c) ? -3.0e38f : v[r];
        if (fr == it) { tv = m; ti = c; }
    }
}
__device__ __forceinline__ void p7_topk(const Args& a, int vcu, int G, int wave, int lane) {
    const bf16_t* Q = (const bf16_t*)(a.ws + WS_Q); const bf16_t* KEYS = (const bf16_t*)(a.ws + WS_KEYS);
    int* IDX = (int*)(a.ws + WS_IDX); float* GATE = (float*)(a.ws + WS_GATE);
    const int gw = vcu * NWAVES + wave, NGW = G * NWAVES; const int fr = lane & 15, fq = lane >> 4;
    for (int item = gw; item < (S / 16) * 8; item += NGW) {
        const int h = item & 7, t0 = (item >> 3) * 16;
        f32x4 sc[2][8];
#pragma unroll
        for (int p = 0; p < 2; ++p) {
            bf16x8 af[4];
#pragma unroll
            for (int ks = 0; ks < 4; ++ks) af[ks] = *(const bf16x8*)(Q + (size_t)(t0 + fr) * D + h * 256 + p * 128 + ks * 32 + fq * 8);
#pragma unroll
            for (int nb = 0; nb < 8; ++nb) { f32x4 c = {0.f, 0.f, 0.f, 0.f};
#pragma unroll
                for (int ks = 0; ks < 4; ++ks) { const bf16x8 bf = *(const bf16x8*)(KEYS + (size_t)((h * 2 + p) * 128 + nb * 16 + fr) * 128 + ks * 32 + fq * 8);
                    c = __builtin_amdgcn_mfma_f32_16x16x32_bf16(af[ks], bf, c, 0, 0, 0); }
                sc[p][nb] = c; asm volatile("" ::: "memory"); }
        }
#pragma unroll 1
        for (int j = 0; j < 4; ++j) {
            float v1[8], v2[8];
#pragma unroll
            for (int nb = 0; nb < 8; ++nb) {
                v1[nb] = j == 0 ? sc[0][nb][0] : (j == 1 ? sc[0][nb][1] : (j == 2 ? sc[0][nb][2] : sc[0][nb][3]));
                v2[nb] = j == 0 ? sc[1][nb][0] : (j == 1 ? sc[1][nb][1] : (j == 2 ? sc[1][nb][2] : sc[1][nb][3])); }
            float t1, t2; int i1, i2;
            row_top16<8>(v1, fr, t1, i1); row_top16<8>(v2, fr, t2, i2);
            float cd[16];
#pragma unroll
            for (int r = 0; r < 16; ++r) cd[r] = __shfl(t1, (lane & 48) + r) + t2;
            float ts; int ci;
            row_top16<16>(cd, fr, ts, ci);
            const int ia = __shfl(i1, (lane & 48) + (ci >> 4)), ib = __shfl(i2, (lane & 48) + (ci & 15));
            const float tmax = __shfl(ts, lane & 48);
            float e = __expf(ts - tmax); float sum = e;
            sum += __shfl_xor(sum, 1); sum += __shfl_xor(sum, 2); sum += __shfl_xor(sum, 4); sum += __shfl_xor(sum, 8);
            const int t = t0 + fq * 4 + j;
            IDX[(size_t)t * 128 + h * 16 + fr] = ia * 128 + ib;
            GATE[(size_t)t * 128 + h * 16 + fr] = e / sum;
            asm volatile("" ::: "memory");
        }
    }
}

__device__ __forceinline__ void p8_peer(const Args& a, int vcu, int G, int wave, int lane) {
    const bf16_t* H2 = (const bf16_t*)(a.ws + WS_H); const bf16_t* EU = (const bf16_t*)(a.ws + WS_EU); const bf16_t* EV = (const bf16_t*)(a.ws + WS_EV);
    const int* IDX = (const int*)(a.ws + WS_IDX); const float* GATE = (const float*)(a.ws + WS_GATE);
    float* X1 = a.out; const float* fg = a.in[17];
    const int gw = vcu * NWAVES + wave, NGW = G * NWAVES;
    for (int t = gw; t < S; t += NGW) {
        u32x4 hp[4];
#pragma unroll
        for (int j = 0; j < 4; ++j) hp[j] = *(const u32x4*)(H2 + (size_t)t * D + j * 512 + lane * 8);
        const int id0 = IDX[(size_t)t * 128 + lane], id1 = IDX[(size_t)t * 128 + 64 + lane];
        const float g0 = GATE[(size_t)t * 128 + lane], g1 = GATE[(size_t)t * 128 + 64 + lane];
        float acc[32];
#pragma unroll
        for (int i = 0; i < 32; ++i) acc[i] = 0.f;
        for (int half = 0; half < 2; ++half) {
            const int idv = half ? id1 : id0; const float gv = half ? g1 : g0;
            for (int e = 0; e < 64; e += 4) {
                u32x4 ur[4][4], vr[4][4]; float ge[4];
#pragma unroll
                for (int q = 0; q < 4; ++q) { const int id = __builtin_amdgcn_readlane(idv, e + q);
                    ge[q] = __builtin_bit_cast(float, __builtin_amdgcn_readlane(__builtin_bit_cast(int, gv), e + q));
                    const bf16_t* up = EU + (size_t)id * D + lane * 8; const bf16_t* vp = EV + (size_t)id * D + lane * 8;
#pragma unroll
                    for (int j = 0; j < 4; ++j) { ur[q][j] = *(const u32x4*)(up + j * 512); vr[q][j] = *(const u32x4*)(vp + j * 512); } }
#pragma unroll
                for (int q = 0; q < 4; ++q) { float d = 0.f;
#pragma unroll
                    for (int j = 0; j < 4; ++j) {
                        d += bflo(ur[q][j].x) * bflo(hp[j].x) + bfhi(ur[q][j].x) * bfhi(hp[j].x);
                        d += bflo(ur[q][j].y) * bflo(hp[j].y) + bfhi(ur[q][j].y) * bfhi(hp[j].y);
                        d += bflo(ur[q][j].z) * bflo(hp[j].z) + bfhi(ur[q][j].z) * bfhi(hp[j].z);
                        d += bflo(ur[q][j].w) * bflo(hp[j].w) + bfhi(ur[q][j].w) * bfhi(hp[j].w); }
                    d = wave_sum(d);
                    const float aw = gelu_tanh(d) * ge[q];
#pragma unroll
                    for (int j = 0; j < 4; ++j) {
                        acc[j * 8 + 0] += aw * bflo(vr[q][j].x); acc[j * 8 + 1] += aw * bfhi(vr[q][j].x);
                        acc[j * 8 + 2] += aw * bflo(vr[q][j].y); acc[j * 8 + 3] += aw * bfhi(vr[q][j].y);
                        acc[j * 8 + 4] += aw * bflo(vr[q][j].z); acc[j * 8 + 5] += aw * bfhi(vr[q][j].z);
                        acc[j * 8 + 6] += aw * bflo(vr[q][j].w); acc[j * 8 + 7] += aw * bfhi(vr[q][j].w); } }
            }
        }
        float ss = 0.f;
#pragma unroll
        for (int j = 0; j < 4; ++j) { const f32x4 x0 = *(const f32x4*)(X1 + (size_t)t * D + j * 512 + lane * 8), x1 = *(const f32x4*)(X1 + (size_t)t * D + j * 512 + lane * 8 + 4);
            acc[j * 8 + 0] += x0.x; acc[j * 8 + 1] += x0.y; acc[j * 8 + 2] += x0.z; acc[j * 8 + 3] += x0.w; acc[j * 8 + 4] += x1.x; acc[j * 8 + 5] += x1.y; acc[j * 8 + 6] += x1.z; acc[j * 8 + 7] += x1.w;
#pragma unroll
            for (int i = 0; i < 8; ++i) ss += acc[j * 8 + i] * acc[j * 8 + i]; }
        const float rstd = 1.0f / sqrtf(wave_sum(ss) * (1.0f / D) + EPS);
#pragma unroll
        for (int j = 0; j < 4; ++j) { const f32x4 f0 = *(const f32x4*)(fg + j * 512 + lane * 8), f1 = *(const f32x4*)(fg + j * 512 + lane * 8 + 4);
            f32x4 o0, o1; o0.x = acc[j * 8 + 0] * rstd * f0.x; o0.y = acc[j * 8 + 1] * rstd * f0.y; o0.z = acc[j * 8 + 2] * rstd * f0.z; o0.w = acc[j * 8 + 3] * rstd * f0.w;
            o1.x = acc[j * 8 + 4] * rstd * f1.x; o1.y = acc[j * 8 + 5] * rstd * f1.y; o1.z = acc[j * 8 + 6] * rstd * f1.z; o1.w = acc[j * 8 + 7] * rstd * f1.w;
            *(f32x4*)(X1 + (size_t)t * D + j * 512 + lane * 8) = o0; *(f32x4*)(X1 + (size_t)t * D + j * 512 + lane * 8 + 4) = o1; }
    }
}

constexpr int N_PHASES = 9;
__global__ void __launch_bounds__(NTHR, 2) fwd(Args args) {
    extern __shared__ __attribute__((aligned(16))) unsigned char lds_raw[];
    LAS unsigned char* lds = (LAS unsigned char*)lds_raw;
    const int tid = threadIdx.x, lane = tid & 63, wave = __builtin_amdgcn_readfirstlane(tid >> 6);
    const int G = gridDim.x; const int bx = blockIdx.x; const int vcu = (G % 8 == 0) ? (bx % 8) * (G / 8) + bx / 8 : bx;
    unsigned char* ws = args.ws;
    const int lo = args.ph_lo, hi = args.ph_hi;
#define IN(k) (lo <= (k) && (k) < hi)
#define SEAM(k) do { if (IN(k) && IN((k) + 1)) { cg::this_grid().sync(); } } while (0)

    if (IN(0)) { p0_prologue(args, lds, vcu, G, wave, lane, tid); }
    SEAM(0);
    if (IN(1)) {
        pg8::Gemm g{(const bf16_t*)(ws + WS_H), (const bf16_t*)(ws + WS_WIN), S, INW, D, D, D, 0}; pg8::StaticOrder so; so.init(S, INW, G, bx);
        pg8::EpiZ E{(bf16_t*)(ws + WS_Z), args.in[3]};
        pg8::gemm_phase<pg8::EpiZ>(lds, g, so, E);
    }
    SEAM(1);
    if (IN(2)) { p2_pool(args, vcu, G, tid); p2_sgu(args, lds, vcu, G, wave, lane, tid); }
    SEAM(2);
    if (IN(3)) {
        pg8::StaticOrder so; so.init(S, D, G, bx);
        { pg8::Gemm g{(const bf16_t*)(ws + WS_A2), (const bf16_t*)(ws + WS_WPOOL), S, D, 256, D, 256, 1};
          pg8::EpiPool E{(float*)(ws + WS_T), (const bf16_t*)(ws + WS_Z)};
          pg8::gemm_phase<pg8::EpiPool>(lds, g, so, E); }
        asm volatile("s_waitcnt vmcnt(0)" ::: "memory"); __syncthreads();
        { pg8::Gemm g{(const bf16_t*)(ws + WS_A2) + 1024, (const bf16_t*)(ws + WS_WG), S, D, GWD, D, GWD, 0};
          pg8::EpiMerge E{(const float*)(ws + WS_T), (const bf16_t*)(ws + WS_Z), (bf16_t*)(ws + WS_MRG)};
          pg8::gemm_phase<pg8::EpiMerge>(lds, g, so, E); }
    }
    SEAM(3);
    if (IN(4)) {
        pg8::Gemm g{(const bf16_t*)(ws + WS_MRG), (const bf16_t*)(ws + WS_WOUT), S, D, D, D, D, 0}; pg8::StaticOrder so; so.init(S, D, G, bx);
        pg8::EpiX1 E{args.in[0], args.out};
        pg8::gemm_phase<pg8::EpiX1>(lds, g, so, E);
    }
    SEAM(4);
    if (IN(5)) {
        const int gw = vcu * NWAVES + wave, NGW = G * NWAVES;
        for (int m = gw; m < S; m += NGW) rms_row_to_bf16(args.out + (size_t)m * D, args.in[12], (bf16_t*)(ws + WS_H) + (size_t)m * D, lane);
    }
    SEAM(5);
    if (IN(6)) {
        pg8::Gemm g{(const bf16_t*)(ws + WS_H), (const bf16_t*)(ws + WS_WQ), S, D, D, D, D, 0}; pg8::StaticOrder so; so.init(S, D, G, bx);
        pg8::EpiQ E{(bf16_t*)(ws + WS_Q)};
        pg8::gemm_phase<pg8::EpiQ>(lds, g, so, E);
    }
    SEAM(6);
    if (IN(7)) { p7_topk(args, vcu, G, wave, lane); }
    SEAM(7);
    if (IN(8)) { p8_peer(args, vcu, G, wave, lane); }
#undef IN
#undef SEAM
}

extern "C" void kernel_launch(void* const* d_in, const int* in_sizes, int n_in, void* d_out, int out_size, void* d_ws, size_t ws_size, hipStream_t stream) {
    static int grid = 0;
    if (grid == 0) {
        if (n_in != 18 || out_size != S * D || ws_size < WS_END) { fprintf(stderr, "kernel_launch: unexpected shapes (n_in %d, out %d, ws %zu)\n", n_in, out_size, ws_size); grid = -1; return; }
        int dev = 0, cus = 0, per_cu = 0;
        if (hipGetDevice(&dev) != hipSuccess || hipDeviceGetAttribute(&cus, hipDeviceAttributeMultiprocessorCount, dev) != hipSuccess) { grid = -1; return; }
        if (hipFuncSetAttribute((const void*)fwd, hipFuncAttributeMaxDynamicSharedMemorySize, LDS_BYTES) != hipSuccess) { fprintf(stderr, "kernel_launch: hipFuncSetAttribute failed\n"); grid = -1; return; }
        if (hipOccupancyMaxActiveBlocksPerMultiprocessor(&per_cu, (const void*)fwd, NTHR, LDS_BYTES) != hipSuccess || per_cu < 1) { fprintf(stderr, "kernel_launch: occupancy query says %d\n", per_cu); per_cu = 1; }
        (void)hipGetLastError();
        grid = cus;
    }
    if (grid < 0) return;
    Args a{};
    for (int i = 0; i < 18; ++i) a.in[i] = (const float*)d_in[i];
    a.out = (float*)d_out; a.ws = (unsigned char*)d_ws;
#if MK_N_LAUNCHES == 1
    a.ph_lo = 0; a.ph_hi = N_PHASES;
    void* kargs[] = {&a};
    hipError_t e = hipLaunchCooperativeKernel((const void*)fwd, dim3(grid), dim3(NTHR), kargs, LDS_BYTES, stream);
    if (e != hipSuccess) fprintf(stderr, "kernel_launch: cooperative launch failed: %s (grid %d)\n", hipGetErrorString(e), grid);
#else
    for (int p = 0; p < N_PHASES; ++p) {
        a.ph_lo = p; a.ph_hi = p + 1;
        hipLaunchKernelGGL(fwd, dim3(grid), dim3(NTHR), LDS_BYTES, stream, a);
    }
#endif
}
```

```cpp
#include <hip/hip_runtime.h>
#include <hip/hip_cooperative_groups.h>
#include <cstdio>
#include <cstdint>
namespace cg = cooperative_groups;

#ifndef USE_CG_SYNC
#define USE_CG_SYNC 1
#endif
#ifndef MK_N_LAUNCHES
#define MK_N_LAUNCHES 1
#endif

#define LAS __attribute__((address_space(3)))
typedef unsigned short bf16_t;
typedef short bf16x8 __attribute__((ext_vector_type(8)));
typedef float f32x4 __attribute__((ext_vector_type(4)));
typedef unsigned u32x4 __attribute__((ext_vector_type(4)));
typedef unsigned u32x2 __attribute__((ext_vector_type(2)));

constexpr int S = 8192, D = 2048, INW = 7168, PW = 1024, GWD = 1024;
constexpr int NEXP = 16384;
constexpr float EPS = 1e-6f;
constexpr int NWAVES = 8, NTHR = 512;

constexpr size_t MiB = 1u << 20;
constexpr size_t WS_CTL = 0;
constexpr size_t WS_WIN = 1 * MiB;
constexpr size_t WS_WPOOL = 30 * MiB;
constexpr size_t WS_WG = 31 * MiB;
constexpr size_t WS_WOUT = 35 * MiB;
constexpr size_t WS_WQ = 43 * MiB;
constexpr size_t WS_KEYS = 51 * MiB;
constexpr size_t WS_WSM = 52 * MiB;
constexpr size_t WS_H = 53 * MiB;
constexpr size_t WS_Z = 85 * MiB;
constexpr size_t WS_A2 = 197 * MiB;
constexpr size_t WS_T = 229 * MiB;
constexpr size_t WS_MRG = 293 * MiB;
constexpr size_t WS_Q = 325 * MiB;
constexpr size_t WS_IDX = 357 * MiB;
constexpr size_t WS_GATE = 361 * MiB;
constexpr size_t WS_SS = 365 * MiB;
constexpr size_t WS_ESC = 369 * MiB;
constexpr size_t WS_EU = 370 * MiB;
constexpr size_t WS_EV = 402 * MiB;
constexpr size_t WS_END = 434 * MiB;

constexpr int LDS_BYTES = 147456;
constexpr int MISC_OFF = 131072 + 320;

__device__ __forceinline__ unsigned f2bf(float f) { unsigned u = __builtin_bit_cast(unsigned, f); return (u + 0x7fffu + ((u >> 16) & 1u)) >> 16; }
__device__ __forceinline__ unsigned pk2(float lo, float hi) { return f2bf(lo) | (f2bf(hi) << 16); }
__device__ __forceinline__ float bflo(unsigned w) { return __builtin_bit_cast(float, w << 16); }
__device__ __forceinline__ float bfhi(unsigned w) { return __builtin_bit_cast(float, w & 0xffff0000u); }
__device__ __forceinline__ float wave_sum(float v) {
#pragma unroll
    for (int o = 1; o < 64; o <<= 1) v += __shfl_xor(v, o);
    return v;
}
template <int CTRL> __device__ __forceinline__ float dpp_add_f32(float v) { return v + __builtin_bit_cast(float, __builtin_amdgcn_update_dpp(0, __builtin_bit_cast(int, v), CTRL, 0xF, 0xF, true)); }
__device__ __forceinline__ float row_sum_f32(float v) { v = dpp_add_f32<0xB1>(v); v = dpp_add_f32<0x4E>(v); v = dpp_add_f32<0x141>(v); v = dpp_add_f32<0x140>(v); return v; }
__device__ __forceinline__ float gelu_tanh(float x) {
    const float y = 1.5957691216057308f * (x + 0.044715f * x * x * x);
    const float e = __builtin_amdgcn_exp2f(-y * 1.4426950408889634f);
    return x * __builtin_amdgcn_rcpf(1.0f + e);
}
__device__ __forceinline__ float sigmoidf_(float x) { return __builtin_amdgcn_rcpf(1.0f + __builtin_amdgcn_exp2f(-x * 1.4426950408889634f)); }

namespace pg8 {
constexpr int BM = 256, BK = 64, HALF = 128, HTB = HALF * BK * 2, STAGE_BYTES = 8 * HTB, NXCD = 8, WGM = 8;
__host__ __device__ __forceinline__ int lds_byte(int r, int c) { const int st = (r >> 4) * 2 + (c >> 5), rr = r & 15, cc = c & 31, ob = rr * 64 + cc * 2; return st * 1024 + (ob ^ (((ob >> 9) & 1) << 5)); }
__host__ __device__ __forceinline__ void stage_rc(int b, int& R, int& C) { const int st = b / 1024, sb = b % 1024, swz = sb ^ (((sb >> 9) & 1) << 5); R = (st >> 1) * 16 + swz / 64; C = (st & 1) * 32 + (swz % 64) / 2; }
__host__ __device__ __forceinline__ int perm32(int rho) { const int n = rho >> 4, i = rho & 15; return 8 * (i >> 2) + 4 * n + (i & 3); }

struct Unit { int pm, pn; };
struct Gemm { const bf16_t* A; const bf16_t* Bt; int M, N, K, lda, ldb, mode; };
__device__ __forceinline__ const char* a_ptr(const Gemm& g, const Unit& u) {
    size_t off = (size_t)u.pm * BM * g.lda; if (g.mode == 1) off += (size_t)(u.pn >> 1) * 256; return (const char*)(g.A + off); }
__device__ __forceinline__ const char* b_ptr(const Gemm& g, const Unit& u) {
    size_t off = (g.mode == 1) ? ((size_t)(u.pn >> 1) * 512 * 256 + (size_t)(u.pn & 1) * 256 * 256) : (size_t)u.pn * BM * g.ldb; return (const char*)(g.Bt + off); }

struct StaticOrder {
    int nM, nN, nwg, G, c;
    __host__ __device__ void init(int M, int N, int G_, int c_) { nM = M / BM; nN = N / BM; nwg = nM * nN; G = G_; c = c_; }
    __host__ __device__ bool next(int i, Unit& u) const {
        const long L = (long)i * G + c; if (L >= nwg) return false;
        int wgid = (int)L; { const int q = nwg / NXCD, r = nwg % NXCD, xcd = wgid % NXCD, off = wgid / NXCD; wgid = (xcd < r ? xcd * (q + 1) : r * (q + 1) + (xcd - r) * q) + off; }
        const int nig = WGM * nN, gid = wgid / nig, fm = gid * WGM, gsz = (nM - fm) < WGM ? (nM - fm) : WGM;
        u.pm = fm + ((wgid % nig) % gsz); u.pn = (wgid % nig) / gsz; return true;
    }
};

__device__ __forceinline__ unsigned cvt_pk_bf16(float lo, float hi) { unsigned r; asm volatile("v_cvt_pk_bf16_f32 %0, %1, %2" : "=v"(r) : "v"(lo), "v"(hi)); return r; }


struct EpiZ {
    static constexpr bool PERM = true;
    bf16_t* Z; const float* b_gate;
    __device__ __forceinline__ void operator()(const f32x4 (&acc)[2][2][4][2], const Unit& u, int wr, int wc, int fr, int fq) const {
        const int row0 = u.pm * BM + wr * 64 + fr, col0 = u.pn * BM + wc * 32 + 8 * fq;
        const int mode = u.pn < 4 ? 0 : (u.pn < 12 ? 1 : 2);
        f32x4 bv[2][2];
#pragma unroll
        for (int bj = 0; bj < 2; ++bj)
#pragma unroll
            for (int n = 0; n < 2; ++n) bv[bj][n] = (mode == 2) ? *(const f32x4*)(b_gate + (col0 - 3072) + bj * HALF + 4 * n) : (f32x4){0.f, 0.f, 0.f, 0.f};
#pragma unroll
        for (int ai = 0; ai < 2; ++ai)
#pragma unroll
            for (int m = 0; m < 4; ++m) { bf16_t* rowp = Z + (size_t)(row0 + ai * HALF + m * 16) * INW + col0;
#pragma unroll
                for (int bj = 0; bj < 2; ++bj) { f32x4 v0 = acc[ai][bj][m][0], v1 = acc[ai][bj][m][1];
                    if (mode == 1) {
#pragma unroll
                        for (int j = 0; j < 4; ++j) { v0[j] = gelu_tanh(v0[j]); v1[j] = gelu_tanh(v1[j]); } }
                    if (mode == 2) { v0 += bv[bj][0]; v1 += bv[bj][1];
#pragma unroll
                        for (int j = 0; j < 4; ++j) { v0[j] = sigmoidf_(v0[j]); v1[j] = sigmoidf_(v1[j]); } }
                    u32x4 w; w.x = cvt_pk_bf16(v0[0], v0[1]); w.y = cvt_pk_bf16(v0[2], v0[3]); w.z = cvt_pk_bf16(v1[0], v1[1]); w.w = cvt_pk_bf16(v1[2], v1[3]);
                    *(u32x4*)(rowp + bj * HALF) = w; } }
    }
};
struct EpiPool {
    static constexpr bool PERM = true;
    bf16_t* T; const bf16_t* Z;
    __device__ __forceinline__ void operator()(const f32x4 (&acc)[2][2][4][2], const Unit& u, int wr, int wc, int fr, int fq) const {
        const int row0 = u.pm * BM + wr * 64 + fr, col0 = u.pn * BM + wc * 32 + 8 * fq;
#pragma unroll
        for (int ai = 0; ai < 2; ++ai)
#pragma unroll
            for (int m = 0; m < 4; ++m) { const size_t row = (size_t)(row0 + ai * HALF + m * 16);
#pragma unroll
                for (int bj = 0; bj < 2; ++bj) { const int c = col0 + bj * HALF;
                    const u32x4 g = *(const u32x4*)(Z + row * INW + 3072 + c);
                    const f32x4 a0 = acc[ai][bj][m][0], a1 = acc[ai][bj][m][1];
                    u32x4 w; w.x = cvt_pk_bf16(bflo(g.x) * a0[0], bfhi(g.x) * a0[1]); w.y = cvt_pk_bf16(bflo(g.y) * a0[2], bfhi(g.y) * a0[3]);
                    w.z = cvt_pk_bf16(bflo(g.z) * a1[0], bfhi(g.z) * a1[1]); w.w = cvt_pk_bf16(bflo(g.w) * a1[2], bfhi(g.w) * a1[3]);
                    *(u32x4*)(T + row * D + c) = w; asm volatile("" ::: "memory"); } }
    }
};
struct EpiMerge {
    static constexpr bool PERM = true;
    const bf16_t* T; const bf16_t* Z; bf16_t* O;
    __device__ __forceinline__ void operator()(const f32x4 (&acc)[2][2][4][2], const Unit& u, int wr, int wc, int fr, int fq) const {
        const int row0 = u.pm * BM + wr * 64 + fr, col0 = u.pn * BM + wc * 32 + 8 * fq;
#pragma unroll
        for (int ai = 0; ai < 2; ++ai)
#pragma unroll
            for (int m = 0; m < 4; ++m) { const size_t row = (size_t)(row0 + ai * HALF + m * 16);
#pragma unroll
                for (int bj = 0; bj < 2; ++bj) { const int c = col0 + bj * HALF;
                    const u32x4 g = *(const u32x4*)(Z + row * INW + 5120 + c);
                    const u32x4 t = *(const u32x4*)(T + row * D + c);
                    const f32x4 a0 = acc[ai][bj][m][0], a1 = acc[ai][bj][m][1];
                    u32x4 w; w.x = cvt_pk_bf16(bflo(t.x) + bflo(g.x) * a0[0], bfhi(t.x) + bfhi(g.x) * a0[1]); w.y = cvt_pk_bf16(bflo(t.y) + bflo(g.y) * a0[2], bfhi(t.y) + bfhi(g.y) * a0[3]);
                    w.z = cvt_pk_bf16(bflo(t.z) + bflo(g.z) * a1[0], bfhi(t.z) + bfhi(g.z) * a1[1]); w.w = cvt_pk_bf16(bflo(t.w) + bflo(g.w) * a1[2], bfhi(t.w) + bfhi(g.w) * a1[3]);
                    *(u32x4*)(O + row * D + c) = w; asm volatile("" ::: "memory"); } }
    }
};
struct EpiX1 {
    static constexpr bool PERM = true;
    const float* X; bf16_t* XB; float* SS;
    __device__ __forceinline__ void operator()(const f32x4 (&acc)[2][2][4][2], const Unit& u, int wr, int wc, int fr, int fq) const {
        const int row0 = u.pm * BM + wr * 64 + fr, col0 = u.pn * BM + wc * 32 + 8 * fq;
#pragma unroll
        for (int ai = 0; ai < 2; ++ai)
#pragma unroll
            for (int m = 0; m < 4; ++m) { const size_t row = (size_t)(row0 + ai * HALF + m * 16); float ss = 0.f;
#pragma unroll
                for (int bj = 0; bj < 2; ++bj) { const size_t off = row * D + col0 + bj * HALF;
                    const f32x4 x0 = *(const f32x4*)(X + off) + acc[ai][bj][m][0], x1 = *(const f32x4*)(X + off + 4) + acc[ai][bj][m][1];
                    ss += (x0[0] * x0[0] + x0[1] * x0[1]) + (x0[2] * x0[2] + x0[3] * x0[3]) + (x1[0] * x1[0] + x1[1] * x1[1]) + (x1[2] * x1[2] + x1[3] * x1[3]);
                    u32x4 w; w.x = cvt_pk_bf16(x0[0], x0[1]); w.y = cvt_pk_bf16(x0[2], x0[3]); w.z = cvt_pk_bf16(x1[0], x1[1]); w.w = cvt_pk_bf16(x1[2], x1[3]);
                    *(u32x4*)(XB + off) = w; }
                ss += __shfl_xor(ss, 16); ss += __shfl_xor(ss, 32);
                if (fq == 0) SS[row * 32 + u.pn * 4 + wc] = ss;
                asm volatile("" ::: "memory"); }
    }
};
struct EpiQ {
    static constexpr bool PERM = true;
    bf16_t* O; const float* SS;
    __device__ __forceinline__ void operator()(const f32x4 (&acc)[2][2][4][2], const Unit& u, int wr, int wc, int fr, int fq) const {
        const int row0 = u.pm * BM + wr * 64 + fr, col0 = u.pn * BM + wc * 32 + 8 * fq;
#pragma unroll
        for (int ai = 0; ai < 2; ++ai)
#pragma unroll
            for (int m = 0; m < 4; ++m) { const size_t row = (size_t)(row0 + ai * HALF + m * 16);
                const f32x4 p0 = *(const f32x4*)(SS + row * 32 + fq * 8), p1 = *(const f32x4*)(SS + row * 32 + fq * 8 + 4);
                float ss = ((p0[0] + p0[1]) + (p0[2] + p0[3])) + ((p1[0] + p1[1]) + (p1[2] + p1[3]));
                ss += __shfl_xor(ss, 16); ss += __shfl_xor(ss, 32);
                const float rstd = 1.0f / sqrtf(ss * (1.0f / D) + EPS);
                bf16_t* rowp = O + row * D + col0;
#pragma unroll
                for (int bj = 0; bj < 2; ++bj) { const f32x4 v0 = acc[ai][bj][m][0] * rstd, v1 = acc[ai][bj][m][1] * rstd;
                    u32x4 w; w.x = cvt_pk_bf16(v0[0], v0[1]); w.y = cvt_pk_bf16(v0[2], v0[3]); w.z = cvt_pk_bf16(v1[0], v1[1]); w.w = cvt_pk_bf16(v1[2], v1[3]);
                    *(u32x4*)(rowp + bj * HALF) = w; } }
    }
};

template <class Epi, bool ALIGN_EPI = true>
__device__ __forceinline__ void gemm_phase(LAS unsigned char* lds, const Gemm g, const StaticOrder& S_, const Epi& E) {
    int tid_ = threadIdx.x; asm volatile("" : "+v"(tid_));
    const int tid = tid_, wid = __builtin_amdgcn_readfirstlane(tid >> 6), lane = tid & 63, wr = wid >> 2, wc = wid & 3, fr = lane & 15, fq = lane >> 4;
    const int K = g.K, nt = K / BK;
    unsigned voffA[2], voffB[2];
#pragma unroll
    for (int i = 0; i < 2; ++i) { int R, C; stage_rc(tid * 16 + i * 8192, R, C); const int Rb = Epi::PERM ? ((R & ~31) + perm32(R & 31)) : R;
        voffA[i] = (unsigned)(R * g.lda + C) * 2u; voffB[i] = (unsigned)(Rb * g.ldb + C) * 2u; }
    const size_t kstep = (size_t)(BK * 2);
    const size_t hstepA = (size_t)HALF * g.lda * 2, hstepB = (size_t)HALF * g.ldb * 2;
    const unsigned ldsw = (unsigned)wid * 1024u;
    const int aoff = lds_byte(wr * 64 + fr, fq * 8), boff = lds_byte(wc * 32 + fr, fq * 8);
#define PG8_SA(b, h) (((b) * 2 + (h)) * HTB)
#define PG8_SB(b, h) ((4 + (b) * 2 + (h)) * HTB)
#define PG8_STAGE(bufoff, gbase, voff) do { _Pragma("unroll") for (int _i = 0; _i < 2; ++_i) \
        __builtin_amdgcn_global_load_lds((const unsigned*)((const char*)(gbase) + (voff)[_i]), (LAS unsigned*)(lds + (bufoff) + ldsw + _i * 8192), 16, 0, 0); } while (0)
#define PG8_LDA(dst, b, h) do { _Pragma("unroll") for (int m = 0; m < 4; ++m) _Pragma("unroll") for (int k = 0; k < 2; ++k) dst[m][k] = *(const LAS bf16x8*)(lds + PG8_SA(b, h) + aoff + m * 2048 + k * 1024); } while (0)
#define PG8_LDB(dst, b, h) do { _Pragma("unroll") for (int n = 0; n < 2; ++n) _Pragma("unroll") for (int k = 0; k < 2; ++k) dst[n][k] = *(const LAS bf16x8*)(lds + PG8_SB(b, h) + boff + n * 2048 + k * 1024); } while (0)
#define PG8_MMA(ai, bj, At, Bt) do { __builtin_amdgcn_s_setprio(1); _Pragma("unroll") for (int m = 0; m < 4; ++m) _Pragma("unroll") for (int n = 0; n < 2; ++n) _Pragma("unroll") for (int k = 0; k < 2; ++k) \
        acc[ai][bj][m][n] = __builtin_amdgcn_mfma_f32_16x16x32_bf16(Bt[n][k], At[m][k], acc[ai][bj][m][n], 0, 0, 0); __builtin_amdgcn_s_setprio(0); } while (0)
#define PG8_WAIT_V(n) asm volatile("s_waitcnt vmcnt(" #n ")" ::: "memory")
#define PG8_WAIT_L(n) asm volatile("s_waitcnt lgkmcnt(" #n ")" ::: "memory")
#define PG8_BAR __builtin_amdgcn_s_barrier()
#define PG8_SCHED __builtin_amdgcn_sched_barrier(0)
    Unit cur, nxt; int ui = 0;
    if (!S_.next(0, cur)) return;
    f32x4 acc[2][2][4][2];
#pragma unroll
    for (int a = 0; a < 2; ++a)
#pragma unroll
        for (int b = 0; b < 2; ++b)
#pragma unroll
            for (int m = 0; m < 4; ++m)
#pragma unroll
                for (int n = 0; n < 2; ++n) acc[a][b][m][n] = (f32x4){0.f, 0.f, 0.f, 0.f};
    bf16x8 At[4][2], B0[2][2], B1[2][2];
    const char* cA = a_ptr(g, cur); const char* cB = b_ptr(g, cur);
    PG8_STAGE(PG8_SB(0, 0), cB, voffB); PG8_STAGE(PG8_SB(0, 1), cB + hstepB, voffB); PG8_STAGE(PG8_SA(0, 0), cA, voffA); PG8_STAGE(PG8_SA(0, 1), cA + hstepA, voffA);
    if (wr == 1) PG8_BAR;
    PG8_WAIT_V(2); PG8_BAR;
    PG8_STAGE(PG8_SB(1, 0), cB + kstep, voffB); PG8_STAGE(PG8_SA(1, 0), cA + kstep, voffA); PG8_STAGE(PG8_SB(1, 1), cB + hstepB + kstep, voffB);
    PG8_WAIT_V(6); PG8_BAR;
    for (;;) {
        const bool has_next = S_.next(ui + 1, nxt);
        const char* nA = has_next ? a_ptr(g, nxt) : cA; const char* nB = has_next ? b_ptr(g, nxt) : cB;
        for (int t = 0; t < nt; t += 2) {
            const bool last = (t == nt - 2);
            const char* a1 = cA + (size_t)(t + 1) * kstep;
            const char* a2 = last ? nA : cA + (size_t)(t + 2) * kstep; const char* b2 = last ? nB : cB + (size_t)(t + 2) * kstep;
            const char* a3 = a2 + kstep; const char* b3 = b2 + kstep;
            PG8_LDB(B0, 0, 0); PG8_LDB(B1, 0, 1); PG8_SCHED; PG8_LDA(At, 0, 0); PG8_STAGE(PG8_SA(1, 1), a1 + hstepA, voffA);
            PG8_WAIT_V(8); PG8_WAIT_L(0); PG8_BAR; PG8_MMA(0, 0, At, B0); PG8_MMA(0, 1, At, B1); PG8_BAR; PG8_SCHED;
            PG8_LDA(At, 0, 1); PG8_STAGE(PG8_SB(0, 0), b2, voffB); PG8_STAGE(PG8_SB(0, 1), b2 + hstepB, voffB); PG8_STAGE(PG8_SA(0, 0), a2, voffA);
            PG8_WAIT_V(8); PG8_WAIT_L(0); PG8_BAR; PG8_MMA(1, 0, At, B0); PG8_MMA(1, 1, At, B1); PG8_BAR; PG8_SCHED;
            PG8_LDB(B0, 1, 0); PG8_LDB(B1, 1, 1); PG8_SCHED; PG8_LDA(At, 1, 0); PG8_STAGE(PG8_SA(0, 1), a2 + hstepA, voffA);
            PG8_WAIT_V(8); PG8_WAIT_L(0); PG8_BAR; PG8_MMA(0, 0, At, B0); PG8_MMA(0, 1, At, B1); PG8_BAR; PG8_SCHED;
            PG8_LDA(At, 1, 1); PG8_STAGE(PG8_SB(1, 0), b3, voffB); PG8_STAGE(PG8_SB(1, 1), b3 + hstepB, voffB); PG8_STAGE(PG8_SA(1, 0), a3, voffA);
            PG8_WAIT_V(8); PG8_WAIT_L(0); PG8_BAR; PG8_MMA(1, 0, At, B0); PG8_MMA(1, 1, At, B1); PG8_BAR; PG8_SCHED;
        }
        if constexpr (ALIGN_EPI) { if (wr == 0) PG8_BAR; }
        { int ln_ = threadIdx.x & 63; asm volatile("" : "+v"(ln_));
          E(acc, cur, wr, wc, ln_ & 15, ln_ >> 4); }
        if (!has_next) break;
#pragma unroll
        for (int a = 0; a < 2; ++a)
#pragma unroll
            for (int b = 0; b < 2; ++b)
#pragma unroll
                for (int m = 0; m < 4; ++m)
#pragma unroll
                    for (int n = 0; n < 2; ++n) acc[a][b][m][n] = (f32x4){0.f, 0.f, 0.f, 0.f};
        cur = nxt; cA = nA; cB = nB; ++ui;
        if constexpr (ALIGN_EPI) { if (wr == 1) PG8_BAR; }
    }
    PG8_WAIT_V(0);
    if constexpr (!ALIGN_EPI) { if (wr == 0) PG8_BAR; }
    PG8_BAR;
#undef PG8_SA
#undef PG8_SB
#undef PG8_STAGE
#undef PG8_LDA
#undef PG8_LDB
#undef PG8_MMA
#undef PG8_WAIT_V
#undef PG8_WAIT_L
#undef PG8_BAR
#undef PG8_SCHED
}
}

struct Args { const float* in[18]; float* out; unsigned char* ws; int ph_lo, ph_hi; };

__device__ __forceinline__ void p0_transpose_item(const float* W, int K, int N, bf16_t* WT, LAS float* scr, int item, int lane, const float* kgain = nullptr) {
    const int nblk = N / 32, kb = item / nblk, nb = item % nblk, k0 = 64 * kb, n0 = 32 * nb;
    { f32x4 wv[8];
#pragma unroll
      for (int i = 0; i < 8; ++i) wv[i] = *(const f32x4*)(W + (size_t)(k0 + 8 * i + (lane >> 3)) * N + n0 + 4 * (lane & 7));
#pragma unroll
      for (int i = 0; i < 8; ++i) { const int kk = 8 * i + (lane >> 3); const float gk = kgain ? kgain[k0 + kk] : 1.0f; LAS float* sp = scr + kk * 33 + 4 * (lane & 7);
          sp[0] = gk * wv[i].x; sp[1] = gk * wv[i].y; sp[2] = gk * wv[i].z; sp[3] = gk * wv[i].w; } }
    asm volatile("s_waitcnt lgkmcnt(0)" ::: "memory");
    const int c = lane & 7;
#pragma unroll
    for (int j = 0; j < 4; ++j) { const int n = (lane >> 3) + 8 * j; const LAS float* s = scr + (8 * c) * 33 + n;
        u32x4 o; o.x = pk2(s[0 * 33], s[1 * 33]); o.y = pk2(s[2 * 33], s[3 * 33]); o.z = pk2(s[4 * 33], s[5 * 33]); o.w = pk2(s[6 * 33], s[7 * 33]);
        *(u32x4*)(WT + (size_t)(n0 + n) * K + k0 + 8 * c) = o; }
    asm volatile("s_waitcnt lgkmcnt(0)" ::: "memory");
}
__device__ __forceinline__ void rms_row_to_bf16(const float* xrow, const float* g, bf16_t* orow, int lane) {
    const f32x4* xr = (const f32x4*)xrow + lane;
    f32x4 v[8]; float s = 0.f;
#pragma unroll
    for (int j = 0; j < 8; ++j) { v[j] = xr[64 * j]; s += (v[j].x * v[j].x + v[j].y * v[j].y) + (v[j].z * v[j].z + v[j].w * v[j].w); }
    const float rstd = 1.0f / sqrtf(wave_sum(s) * (1.0f / D) + EPS);
    const f32x4* gr = (const f32x4*)g + lane;
    u32x2* o8 = (u32x2*)orow + lane;
#pragma unroll
    for (int j = 0; j < 8; ++j) { const f32x4 gv = gr[64 * j]; u32x2 o; o.x = pk2(v[j].x * rstd * gv.x, v[j].y * rstd * gv.y); o.y = pk2(v[j].z * rstd * gv.z, v[j].w * rstd * gv.w); o8[64 * j] = o; }
}
__device__ __forceinline__ void cvt_stream(const float* src, bf16_t* dst, size_t n8, size_t gtid, size_t nthr) {
    for (size_t i = gtid; i < n8; i += nthr) { const f32x4 a = ((const f32x4*)src)[2 * i], b = ((const f32x4*)src)[2 * i + 1];
        u32x4 o; o.x = pk2(a.x, a.y); o.y = pk2(a.z, a.w); o.z = pk2(b.x, b.y); o.w = pk2(b.z, b.w); ((u32x4*)dst)[i] = o; }
}

__device__ __forceinline__ void expert_row_load(const float* src, f32x4 (&v)[8], int lane) {
    const f32x4* xr = (const f32x4*)src + lane;
#pragma unroll
    for (int k = 0; k < 8; ++k) v[k] = xr[64 * k];
}
__device__ __forceinline__ void expert_row_gain(f32x4 (&v)[8], const float* g, int lane) {
    const f32x4* gr = (const f32x4*)g + lane;
#pragma unroll
    for (int k = 0; k < 8; ++k) v[k] = v[k] * gr[64 * k];
}
__device__ __forceinline__ void expert_row_store(const f32x4 (&v)[8], unsigned char* dst, float* isc, int lane) {
    float am = 0.f;
#pragma unroll
    for (int k = 0; k < 8; ++k) am = fmaxf(am, fmaxf(fmaxf(fabsf(v[k].x), fabsf(v[k].y)), fmaxf(fabsf(v[k].z), fabsf(v[k].w))));
#pragma unroll
    for (int o = 1; o < 64; o <<= 1) am = fmaxf(am, __shfl_xor(am, o));
    float sc = 1.0f;
    if (am > 0.f) { const float q = fminf(fmaxf(448.0f / am, 1.0e-30f), 1.0e30f); sc = __builtin_bit_cast(float, __builtin_bit_cast(unsigned, q) & 0x7f800000u); }
    unsigned o[8];
#pragma unroll
    for (int k = 0; k < 8; ++k) { int w = __builtin_amdgcn_cvt_pk_fp8_f32(v[k].x * sc, v[k].y * sc, 0, false); w = __builtin_amdgcn_cvt_pk_fp8_f32(v[k].z * sc, v[k].w * sc, w, true); o[k] = (unsigned)w; }
    u32x4 o0, o1; o0.x = o[0]; o0.y = o[1]; o0.z = o[2]; o0.w = o[3]; o1.x = o[4]; o1.y = o[5]; o1.z = o[6]; o1.w = o[7];
    *(u32x4*)(dst + lane * 16) = o0; *(u32x4*)(dst + 1024 + lane * 16) = o1;
    if (lane == 0) *isc = 1.0f / sc;
}

__device__ __forceinline__ void p0_prologue(const Args& a, LAS unsigned char* lds, int vcu, int G, int wave, int lane, int tid) {
    unsigned char* ws = a.ws;
    LAS float* scr = (LAS float*)(lds + wave * 16384);
    const int gw = vcu * NWAVES + wave, NGW = G * NWAVES;
    constexpr int I_IN = (D / 64) * (INW / 32), I_POOL1 = (256 / 64) * (512 / 32), I_G = (GWD / 64) * (D / 32), I_O = (D / 64) * (D / 32), I_Q = I_O;
    constexpr int NITEMS = I_IN + 4 * I_POOL1 + I_G + I_O + I_Q;
    for (int it = gw; it < NITEMS; it += NGW) {
        int r = it;
        if (r < I_IN) { p0_transpose_item(a.in[2], D, INW, (bf16_t*)(ws + WS_WIN), scr, r, lane); continue; } r -= I_IN;
        if (r < 4 * I_POOL1) { const int g = r / I_POOL1; p0_transpose_item(a.in[5] + (size_t)g * 256 * 512, 256, 512, (bf16_t*)(ws + WS_WPOOL) + (size_t)g * 512 * 256, scr, r % I_POOL1, lane); continue; } r -= 4 * I_POOL1;
        if (r < I_G) { p0_transpose_item(a.in[10], GWD, D, (bf16_t*)(ws + WS_WG), scr, r, lane); continue; } r -= I_G;
        if (r < I_O) { p0_transpose_item(a.in[11], D, D, (bf16_t*)(ws + WS_WOUT), scr, r, lane); continue; } r -= I_O;
        p0_transpose_item(a.in[13], D, D, (bf16_t*)(ws + WS_WQ), scr, r, lane, a.in[12]);
    }
    for (int m = gw; m < S; m += NGW) rms_row_to_bf16(a.in[0] + (size_t)m * D, a.in[1], (bf16_t*)(ws + WS_H) + (size_t)m * D, lane);
    const size_t gtid = (size_t)vcu * NTHR + tid, nthr = (size_t)G * NTHR;
    cvt_stream(a.in[14], (bf16_t*)(ws + WS_KEYS), (size_t)8 * 2 * 128 * 128 / 8, gtid, nthr);
    {
        const float* src = a.in[8]; bf16_t* dst = (bf16_t*)(ws + WS_WSM);
        for (size_t i = gtid; i < (size_t)8 * 128 * 128 / 8; i += nthr) { const int s0 = (int)(i & 15) * 8, t = (int)(i >> 4) & 127;
            const f32x4 x0 = ((const f32x4*)src)[2 * i], x1 = ((const f32x4*)src)[2 * i + 1];
            float v[8] = {x0.x, x0.y, x0.z, x0.w, x1.x, x1.y, x1.z, x1.w};
#pragma unroll
            for (int j = 0; j < 8; ++j) v[j] = (s0 + j <= t) ? v[j] : 0.f;
            u32x4 o; o.x = pk2(v[0], v[1]); o.y = pk2(v[2], v[3]); o.z = pk2(v[4], v[5]); o.w = pk2(v[6], v[7]); ((u32x4*)dst)[i] = o; }
    }
}

__device__ __forceinline__ void p2_pool(const Args& a, int vcu, int G, int tid) {
    const bf16_t* Z = (const bf16_t*)(a.ws + WS_Z); bf16_t* A2 = (bf16_t*)(a.ws + WS_A2); const float* psc = a.in[4];
    const size_t gtid = (size_t)vcu * NTHR + tid, nthr = (size_t)G * NTHR;
    for (size_t id = gtid; id < (size_t)(S / 8) * 128; id += nthr) {
        const int c8 = (int)(id & 127), t0 = (int)(id >> 7) * 8, g = c8 >> 5, w = 2 << g;
        u32x4 row[23];
#pragma unroll
        for (int r = 0; r < 23; ++r) { const int t = t0 - 15 + r; const bool need = (r >= 16 - w) && (t >= 0);
            row[r] = need ? *(const u32x4*)(Z + (size_t)t * INW + c8 * 8) : (u32x4){0u, 0u, 0u, 0u}; }
        const f32x4 p0 = *(const f32x4*)(psc + c8 * 8), p1 = *(const f32x4*)(psc + c8 * 8 + 4);
        const float ps[8] = {p0.x, p0.y, p0.z, p0.w, p1.x, p1.y, p1.z, p1.w};
        float s[8] = {0.f, 0.f, 0.f, 0.f, 0.f, 0.f, 0.f, 0.f};
#pragma unroll
        for (int r = 0; r < 15; ++r) { const u32x4 q = row[r];
            s[0] += bflo(q.x); s[1] += bfhi(q.x); s[2] += bflo(q.y); s[3] += bfhi(q.y); s[4] += bflo(q.z); s[5] += bfhi(q.z); s[6] += bflo(q.w); s[7] += bfhi(q.w); }
#pragma unroll
        for (int i = 0; i < 8; ++i) {
            const u32x4 q = row[15 + i];
            const float at[8] = {bflo(q.x), bfhi(q.x), bflo(q.y), bfhi(q.y), bflo(q.z), bfhi(q.z), bflo(q.w), bfhi(q.w)};
#pragma unroll
            for (int c = 0; c < 8; ++c) s[c] += at[c];
            const int t = t0 + i; const int cnt = (t + 1) < w ? (t + 1) : w; const float inv = 1.0f / (float)cnt;
            float o[8];
#pragma unroll
            for (int c = 0; c < 8; ++c) o[c] = (s[c] * inv - at[c]) * ps[c];
            u32x4 w4; w4.x = pk2(o[0], o[1]); w4.y = pk2(o[2], o[3]); w4.z = pk2(o[4], o[5]); w4.w = pk2(o[6], o[7]);
            *(u32x4*)(A2 + (size_t)t * D + c8 * 8) = w4;
            const u32x4 d2 = row[15 + i - 1], d4 = row[15 + i - 3], d8 = row[15 + i - 7], d16 = row[15 + i - 15];
            const u32x4 dq = g == 0 ? d2 : (g == 1 ? d4 : (g == 2 ? d8 : d16));
            s[0] -= bflo(dq.x); s[1] -= bfhi(dq.x); s[2] -= bflo(dq.y); s[3] -= bfhi(dq.y); s[4] -= bflo(dq.z); s[5] -= bfhi(dq.z); s[6] -= bflo(dq.w); s[7] -= bfhi(dq.w);
        }
    }
}
constexpr int VT_LD = 136;
__device__ __forceinline__ void p2_sgu(const Args& a, LAS unsigned char* lds, int vcu, int G, int wave, int lane, int tid) {
    const bf16_t* Z = (const bf16_t*)(a.ws + WS_Z); bf16_t* A2 = (bf16_t*)(a.ws + WS_A2); const bf16_t* WSM = (const bf16_t*)(a.ws + WS_WSM);
    const float* lng = a.in[6]; const float* lnb = a.in[7]; const float* bs = a.in[9];
    LAS float* st = (LAS float*)lds; LAS bf16_t* Vt = (LAS bf16_t*)(lds + 1024);
    const int fr = lane & 15, fq = lane >> 4;
    for (int item = vcu; item < 512; item += G) {
        const int c = item >> 3, h = item & 7, t0 = c * 128;
        u32x4 raw[4][8];
#pragma unroll
        for (int p = 0; p < 4; ++p) { const bf16_t* rp = Z + (size_t)(t0 + wave * 16 + p * 4 + fq) * INW + 2048 + fr * 8;
#pragma unroll
            for (int j = 0; j < 8; ++j) raw[p][j] = *(const u32x4*)(rp + j * 128); }
        u32x4 rawB[4];
#pragma unroll
        for (int q = 0; q < 4; ++q) { const int id = tid + q * NTHR, sr = id & 127, dc = id >> 7; rawB[q] = *(const u32x4*)(Z + (size_t)(t0 + sr) * INW + 2048 + h * 128 + dc * 8); }
        bf16x8 bW[4];
#pragma unroll
        for (int ks = 0; ks < 4; ++ks) bW[ks] = *(const bf16x8*)(WSM + (size_t)(h * 128 + wave * 16 + fr) * 128 + ks * 32 + fq * 8);
        u32x2 ur[8];
#pragma unroll
        for (int db = 0; db < 8; ++db) ur[db] = *(const u32x2*)(Z + (size_t)(t0 + wave * 16 + fr) * INW + 1024 + h * 128 + db * 16 + fq * 4);
        const float bias = bs[h * 128 + wave * 16 + fr];
#pragma unroll
        for (int p = 0; p < 4; ++p) { float s = 0.f, q = 0.f;
#pragma unroll
            for (int j = 0; j < 8; ++j)
#pragma unroll
                for (int w = 0; w < 4; ++w) { const float a0 = bflo(raw[p][j][w]), a1 = bfhi(raw[p][j][w]); s += a0 + a1; q += a0 * a0 + a1 * a1; }
            s = row_sum_f32(s); q = row_sum_f32(q);
            if (fr == 0) { const float mean = s * (1.0f / 1024.0f); const float var = fmaxf(q * (1.0f / 1024.0f) - mean * mean, 0.f);
                const int sr = wave * 16 + p * 4 + fq; st[2 * sr] = mean; st[2 * sr + 1] = 1.0f / sqrtf(var + EPS); } }
        __syncthreads();
#pragma unroll
        for (int q = 0; q < 4; ++q) { const int id = tid + q * NTHR, sr = id & 127, dc = id >> 7;
            const u32x4 rw = rawB[q];
            const float mean = st[2 * sr], rstd = st[2 * sr + 1];
            const float v[8] = {bflo(rw.x), bfhi(rw.x), bflo(rw.y), bfhi(rw.y), bflo(rw.z), bfhi(rw.z), bflo(rw.w), bfhi(rw.w)};
            const f32x4 g0 = *(const f32x4*)(lng + h * 128 + dc * 8), g1 = *(const f32x4*)(lng + h * 128 + dc * 8 + 4), b0 = *(const f32x4*)(lnb + h * 128 + dc * 8), b1 = *(const f32x4*)(lnb + h * 128 + dc * 8 + 4);
            const float gg[8] = {g0.x, g0.y, g0.z, g0.w, g1.x, g1.y, g1.z, g1.w}, bb[8] = {b0.x, b0.y, b0.z, b0.w, b1.x, b1.y, b1.z, b1.w};
#pragma unroll
            for (int i = 0; i < 8; ++i) { const int d = dc * 8 + i; const float y = (v[i] - mean) * rstd * gg[i] + bb[i]; Vt[d * VT_LD + sr] = (bf16_t)f2bf(y); } }
        __syncthreads();
        f32x4 acc[8];
#pragma unroll
        for (int db = 0; db < 8; ++db) acc[db] = (f32x4){0.f, 0.f, 0.f, 0.f};
        const int nks = (wave * 16 + 15) / 32 + 1;
#pragma unroll
        for (int ks = 0; ks < 4; ++ks) if (ks < nks) {
#pragma unroll
            for (int db = 0; db < 8; ++db) { const bf16x8 aV = *(const LAS bf16x8*)(Vt + (db * 16 + fr) * VT_LD + ks * 32 + fq * 8);
                acc[db] = __builtin_amdgcn_mfma_f32_16x16x32_bf16(aV, bW[ks], acc[db], 0, 0, 0); }
        }
        { const int t = t0 + wave * 16 + fr;
#pragma unroll
          for (int db = 0; db < 8; ++db) { const int col = h * 128 + db * 16 + fq * 4;
              u32x2 o; o.x = pk2(bflo(ur[db].x) * (acc[db][0] + bias), bfhi(ur[db].x) * (acc[db][1] + bias)); o.y = pk2(bflo(ur[db].y) * (acc[db][2] + bias), bfhi(ur[db].y) * (acc[db][3] + bias));
              *(u32x2*)(A2 + (size_t)t * D + 1024 + col) = o; } }
        __syncthreads();
    }
}

__device__ __forceinline__ unsigned f2key(float f) { const unsigned b = __builtin_bit_cast(unsigned, f); return (b & 0x80000000u) ? ~b : (b | 0x80000000u); }
__device__ __forceinline__ float key2f(unsigned k) { const unsigned b = (k & 0x80000000u) ? (k ^ 0x80000000u) : ~k; return __builtin_bit_cast(float, b); }
template <int CTRL> __device__ __forceinline__ unsigned dpp_max_u32(unsigned v) { const unsigned o = (unsigned)__builtin_amdgcn_update_dpp(0, (int)v, CTRL, 0xF, 0xF, true); return v > o ? v : o; }
__device__ __forceinline__ unsigned row_max_u32(unsigned v) { v = dpp_max_u32<0xB1>(v); v = dpp_max_u32<0x4E>(v); v = dpp_max_u32<0x141>(v); v = dpp_max_u32<0x140>(v); return v; }
__device__ __forceinline__ void ce_desc(unsigned& a, unsigned& b) { const unsigned hi = a > b ? a : b, lo = a > b ? b : a; a = hi; b = lo; }
__device__ __forceinline__ void sort8_desc(unsigned (&k)[8]) {
    ce_desc(k[0], k[1]); ce_desc(k[2], k[3]); ce_desc(k[4], k[5]); ce_desc(k[6], k[7]);
    ce_desc(k[0], k[2]); ce_desc(k[1], k[3]); ce_desc(k[4], k[6]); ce_desc(k[5], k[7]);
    ce_desc(k[1], k[2]); ce_desc(k[5], k[6]);
    ce_desc(k[0], k[4]); ce_desc(k[1], k[5]); ce_desc(k[2], k[6]); ce_desc(k[3], k[7]);
    ce_desc(k[2], k[4]); ce_desc(k[3], k[5]);
    ce_desc(k[1], k[2]); ce_desc(k[3], k[4]); ce_desc(k[5], k[6]);
}
__device__ __forceinline__ void sort4_desc(unsigned (&k)[4]) { ce_desc(k[0], k[1]); ce_desc(k[2], k[3]); ce_desc(k[0], k[2]); ce_desc(k[1], k[3]); ce_desc(k[1], k[2]); }
template <int NV> __device__ __forceinline__ unsigned row_top16_sorted(unsigned (&k)[NV], int fr) {
    unsigned tk = 0u;
    for (int it = 0; it < 16; ++it) {
        const unsigned m = row_max_u32(k[0]);
        const unsigned wm = (k[0] == m) ? 0xffffffffu : 0u;
#pragma unroll
        for (int i = 0; i + 1 < NV; ++i) k[i] = (k[i + 1] & wm) | (k[i] & ~wm);
        k[NV - 1] = k[NV - 1] & ~wm;
        tk = (fr == it) ? m : tk;
    }
    return tk;
}
__device__ __forceinline__ unsigned cand_table(int fr) {
    constexpr unsigned T[16] = {0x03020100u, 0x07060504u, 0x0b0a0908u, 0x0f0e0d0cu, 0x13121110u, 0x17161514u, 0x23222120u, 0x32313024u, 0x42414033u, 0x61605150u, 0x90807170u, 0xd0c0b0a0u, 0xfffff0e0u, 0xffffffffu, 0xffffffffu, 0xffffffffu};
    unsigned w = T[0];
#pragma unroll
    for (int i = 1; i < 16; ++i) w = (fr == i) ? T[i] : w;
    return w;
}
constexpr int SC_LD = 132;
__device__ __forceinline__ void p7_topk(const Args& a, LAS unsigned char* lds, int vcu, int G, int wave, int lane_) {
    int lane = lane_; asm volatile("" : "+v"(lane));
    const bf16_t* Q = (const bf16_t*)(a.ws + WS_Q); const bf16_t* KEYS = (const bf16_t*)(a.ws + WS_KEYS);
    int* IDX = (int*)(a.ws + WS_IDX); float* GATE = (float*)(a.ws + WS_GATE);
    LAS float* SL = (LAS float*)(lds + wave * (16 * SC_LD * 4));
    const int gw = vcu * NWAVES + wave, NGW = G * NWAVES; const int fr = lane & 15, fq = lane >> 4;
    const unsigned ctab = cand_table(fr);
    int erow = gw;
    f32x4 er0[8], er1[8]; int e0 = 2 * NEXP, e1 = 2 * NEXP;
#define ER_LOAD() do { e0 = erow; e1 = erow + NGW; erow += 2 * NGW; \
        if (e0 < 2 * NEXP) expert_row_load(a.in[15 + (e0 >= NEXP)] + (size_t)(e0 & (NEXP - 1)) * D, er0, lane); \
        if (e1 < 2 * NEXP) expert_row_load(a.in[15 + (e1 >= NEXP)] + (size_t)(e1 & (NEXP - 1)) * D, er1, lane); } while (0)
#define ER_STORE() do { \
        if (e0 < NEXP) expert_row_gain(er0, a.in[12], lane); if (e1 < NEXP) expert_row_gain(er1, a.in[12], lane); \
        if (e0 < 2 * NEXP) expert_row_store(er0, a.ws + ((e0 >= NEXP) ? WS_EV : WS_EU) + (size_t)(e0 & (NEXP - 1)) * D, (float*)(a.ws + WS_ESC) + e0, lane); \
        if (e1 < 2 * NEXP) expert_row_store(er1, a.ws + ((e1 >= NEXP) ? WS_EV : WS_EU) + (size_t)(e1 & (NEXP - 1)) * D, (float*)(a.ws + WS_ESC) + e1, lane); } while (0)
    pg8::StaticOrder so7; so7.init(S, D, G, (int)blockIdx.x); pg8::Unit u7;
    for (int ui = 0; so7.next(ui >> 1, u7); ++ui) {
        const int h = u7.pn, t0 = u7.pm * 256 + ((ui & 1) * 8 + wave) * 16;
        unsigned tk[8];
#pragma unroll
        for (int i = 0; i < 8; ++i) tk[i] = 0u;
#pragma unroll 1
        for (int p = 0; p < 2; ++p) {
            {
                bf16x8 af[4];
#pragma unroll
                for (int ks = 0; ks < 4; ++ks) af[ks] = *(const bf16x8*)(Q + (size_t)(t0 + fr) * D + h * 256 + p * 128 + ks * 32 + fq * 8);
#pragma unroll 1
                for (int g4 = 0; g4 < 2; ++g4) {
                    bf16x8 bf[4][4];
#pragma unroll
                    for (int n4 = 0; n4 < 4; ++n4)
#pragma unroll
                        for (int ks = 0; ks < 4; ++ks) bf[n4][ks] = *(const bf16x8*)(KEYS + (size_t)((h * 2 + p) * 128 + (g4 * 4 + n4) * 16 + fr) * 128 + ks * 32 + fq * 8);
#pragma unroll
                    for (int n4 = 0; n4 < 4; ++n4) { f32x4 c = {0.f, 0.f, 0.f, 0.f};
#pragma unroll
                        for (int ks = 0; ks < 4; ++ks) c = __builtin_amdgcn_mfma_f32_16x16x32_bf16(af[ks], bf[n4][ks], c, 0, 0, 0);
#pragma unroll
                        for (int j = 0; j < 4; ++j) SL[(fq * 4 + j) * SC_LD + (g4 * 4 + n4) * 16 + fr] = c[j]; }
                    asm volatile("" ::: "memory"); }
            }
            ER_LOAD();
#pragma unroll 1
            for (int j = 0; j < 4; ++j) {
                unsigned k[8];
#pragma unroll
                for (int nb = 0; nb < 8; ++nb) k[nb] = (f2key(SL[(fq * 4 + j) * SC_LD + nb * 16 + fr]) & ~127u) | (127u - (unsigned)(nb * 16 + fr));
                sort8_desc(k);
                const unsigned r = row_top16_sorted<8>(k, fr);
#pragma unroll
                for (int i = 0; i < 8; ++i) tk[i] = (i == p * 4 + j) ? r : tk[i];
            }
            ER_STORE();
        }
#pragma unroll 1
        for (int j = 0; j < 4; ++j) {
            if ((j & 1) == 0) ER_LOAD();
            const unsigned tk1 = j == 0 ? tk[0] : (j == 1 ? tk[1] : (j == 2 ? tk[2] : tk[3])), tk2 = j == 0 ? tk[4] : (j == 1 ? tk[5] : (j == 2 ? tk[6] : tk[7]));
            const float t1 = key2f(tk1 & ~127u), t2 = key2f(tk2 & ~127u); const int i1 = 127 - (int)(tk1 & 127u), i2 = 127 - (int)(tk2 & 127u);
            unsigned kc[4];
#pragma unroll
            for (int e = 0; e < 4; ++e) { const unsigned ab = (ctab >> (8 * e)) & 255u; const int ca = (int)(ab >> 4), cb = (int)(ab & 15u);
                const float c = __shfl(t1, (lane & 48) + ca) + __shfl(t2, (lane & 48) + cb);
                kc[e] = (ab == 255u) ? 0u : ((f2key(c) & ~255u) | (255u - ab)); }
            sort4_desc(kc);
            const unsigned tkc = row_top16_sorted<4>(kc, fr);
            const float ts = key2f(tkc & ~255u); const int ci = 255 - (int)(tkc & 255u);
            const int ia = __shfl(i1, (lane & 48) + (ci >> 4)), ib = __shfl(i2, (lane & 48) + (ci & 15));
            const float tmax = __shfl(ts, lane & 48);
            const float e = __expf(ts - tmax); float sum = e;
            sum += __shfl_xor(sum, 1); sum += __shfl_xor(sum, 2); sum += __shfl_xor(sum, 4); sum += __shfl_xor(sum, 8);
            const int t = t0 + fq * 4 + j;
            IDX[(size_t)t * 128 + h * 16 + fr] = ia * 128 + ib;
            GATE[(size_t)t * 128 + h * 16 + fr] = e / sum;
            if ((j & 1) == 1) ER_STORE();
        }
    }
    for (; erow < 2 * NEXP; erow += NGW) { expert_row_load(a.in[15 + (erow >= NEXP)] + (size_t)(erow & (NEXP - 1)) * D, er0, lane); if (erow < NEXP) expert_row_gain(er0, a.in[12], lane);
        expert_row_store(er0, a.ws + ((erow >= NEXP) ? WS_EV : WS_EU) + (size_t)(erow & (NEXP - 1)) * D, (float*)(a.ws + WS_ESC) + erow, lane); }
#undef ER_LOAD
#undef ER_STORE
}

typedef float f32x2 __attribute__((ext_vector_type(2)));
__device__ __forceinline__ u32x4 bl128(__amdgpu_buffer_rsrc_t r, unsigned voff, unsigned soff) { return __builtin_amdgcn_raw_buffer_load_b128(r, voff, soff, 0); }
__device__ __forceinline__ u32x2 bl64(__amdgpu_buffer_rsrc_t r, unsigned voff, unsigned soff) { return __builtin_amdgcn_raw_buffer_load_b64(r, voff, soff, 0); }
__device__ __forceinline__ unsigned bl32(__amdgpu_buffer_rsrc_t r, unsigned voff, unsigned soff) { return __builtin_amdgcn_raw_buffer_load_b32(r, voff, soff, 0); }
__device__ __forceinline__ float wave_sum_dpp(float v) {
    v = dpp_add_f32<0xB1>(v); v = dpp_add_f32<0x4E>(v); v = dpp_add_f32<0x141>(v); v = dpp_add_f32<0x140>(v);
    v += __builtin_bit_cast(float, __builtin_amdgcn_update_dpp(0, __builtin_bit_cast(int, v), 0x142, 0xA, 0xF, false));
    v += __builtin_bit_cast(float, __builtin_amdgcn_update_dpp(0, __builtin_bit_cast(int, v), 0x143, 0xC, 0xF, false));
    return __builtin_bit_cast(float, __builtin_amdgcn_readlane(__builtin_bit_cast(int, v), 63));
}
__device__ __forceinline__ float wave_sum_fast(float v) {
    v = dpp_add_f32<0xB1>(v); v = dpp_add_f32<0x4E>(v); v = dpp_add_f32<0x141>(v); v = dpp_add_f32<0x140>(v);
    v += __shfl_xor(v, 16); v += __shfl_xor(v, 32); return v;
}
constexpr int TPW = 4, NSL = 16, SL_SHIFT = 10, RING = 8, SLOT = 2048;
typedef __bf16 bf16x2_t __attribute__((ext_vector_type(2)));
__device__ __forceinline__ float dot2bf(unsigned a, unsigned b, float c) { return __builtin_amdgcn_fdot2_f32_bf16(__builtin_bit_cast(bf16x2_t, a), __builtin_bit_cast(bf16x2_t, b), c, false); }
constexpr int NROWS = TPW * 128;
#define P8_ISSUE(TBASE) do { const unsigned ro_ = (unsigned)__builtin_amdgcn_readlane(lch_, ii_ & 63) * (unsigned)D; \
        const char* src_ = (const char*)a.ws + (TBASE) + ro_ + l16; LAS unsigned char* dstl_ = ring + (ii_ & (RING - 1)) * SLOT; \
        __builtin_amdgcn_global_load_lds((const unsigned*)src_, (LAS unsigned*)dstl_, 16, 0, 0); \
        __builtin_amdgcn_global_load_lds((const unsigned*)(src_ + 1024), (LAS unsigned*)(dstl_ + 1024), 16, 0, 0); \
        ++ii_; if ((ii_ & 63) == 0) lch_ = (int)LST[ii_ + lane]; } while (0)
#define P8_RING_READ(r0, r1) do { r0 = *(const LAS u32x4*)(ring + (ci_ & (RING - 1)) * SLOT + l16); r1 = *(const LAS u32x4*)(ring + (ci_ & (RING - 1)) * SLOT + 1024 + l16); } while (0)
#define P8_STREAM_INIT(TBASE, r0, r1) int ci_ = 0, ii_ = 0; int lch_ = (int)LST[lane]; \
        asm volatile("s_waitcnt vmcnt(0) lgkmcnt(0)" ::: "memory"); \
        _Pragma("unroll 1") for (int q_ = 0; q_ < RING; ++q_) P8_ISSUE(TBASE); \
        asm volatile("s_waitcnt vmcnt(14)" ::: "memory"); P8_RING_READ(r0, r1)
#define P8_ROW_READY() asm volatile("s_waitcnt lgkmcnt(0)" ::: "memory")
#define P8_ROW_ADVANCE(TBASE, r0, r1) do { ++ci_; P8_ISSUE(TBASE); asm volatile("s_waitcnt vmcnt(14)" ::: "memory"); P8_RING_READ(r0, r1); } while (0)
#define P8_STREAM_END() asm volatile("s_waitcnt vmcnt(0) lgkmcnt(0)" ::: "memory")
static_assert(RING == 8, "the counted wait above is vmcnt(2 * (RING - 1))");
__device__ __forceinline__ void p8_peer(const Args& a, LAS unsigned char* lds, float* dst, int vcu, int G, int wave, int lane_) {
    int lane = lane_; asm volatile("" : "+v"(lane));
    const __amdgpu_buffer_rsrc_t rws = __builtin_amdgcn_make_buffer_rsrc((void*)a.ws, (short)0, (int)WS_END, 0x00020000);
    const __amdgpu_buffer_rsrc_t rdst = __builtin_amdgcn_make_buffer_rsrc((void*)dst, (short)0, S * D * 4, 0x00020000);
    const __amdgpu_buffer_rsrc_t rfg = __builtin_amdgcn_make_buffer_rsrc((void*)a.in[17], (short)0, D * 4, 0x00020000);
    LAS unsigned char* ring = lds + wave * (RING * SLOT);
    LAS unsigned* SLW = (LAS unsigned*)(lds + 132096 + wave * 1280);
    LAS unsigned short* LST = (LAS unsigned short*)SLW;
    const int gw = vcu * NWAVES + wave, NGW = G * NWAVES;
    const unsigned l16 = (unsigned)lane * 16u, l8 = (unsigned)lane * 8u, l4 = (unsigned)lane * 4u;
#pragma unroll 1
    for (int tb = gw; tb < S; tb += TPW * NGW) {
        int sid[TPW][2], offv[TPW]; float act[TPW][2]; int cntv = 0;
#pragma unroll
        for (int k = 0; k < TPW; ++k) {
            const int t = (tb + k * NGW) < S ? (tb + k * NGW) : (S - 1);
            const unsigned oi = (unsigned)(WS_IDX + (size_t)t * 512);
            const int id0 = (int)bl32(rws, l4, oi), id1 = (int)bl32(rws, l4 + 256u, oi);
            const int sl0 = id0 >> SL_SHIFT, sl1 = id1 >> SL_SHIFT;
            int pos0 = 0, pos1 = 0, basec = 0, offacc = 0;
#pragma unroll
            for (int s = 0; s < NSL; ++s) {
                const unsigned long long m0 = __ballot(sl0 == s), m1 = __ballot(sl1 == s);
                const int c0 = __popcll(m0), c1 = __popcll(m1);
                const int b0 = (int)__builtin_amdgcn_mbcnt_hi((unsigned)(m0 >> 32), __builtin_amdgcn_mbcnt_lo((unsigned)m0, 0u));
                const int b1 = (int)__builtin_amdgcn_mbcnt_hi((unsigned)(m1 >> 32), __builtin_amdgcn_mbcnt_lo((unsigned)m1, 0u));
                pos0 = (sl0 == s) ? basec + b0 : pos0; pos1 = (sl1 == s) ? basec + c0 + b1 : pos1;
                basec += c0 + c1; offacc = (lane == s + 1) ? basec : offacc; cntv = (lane == s * TPW + k) ? (c0 + c1) : cntv;
            }
            offv[k] = offacc;
            SLW[pos0] = (unsigned)id0; SLW[pos1] = (unsigned)id1; SLW[128 + pos0] = (unsigned)lane; SLW[128 + pos1] = (unsigned)(64 + lane);
            asm volatile("s_waitcnt lgkmcnt(0)" ::: "memory");
            sid[k][0] = (int)SLW[lane]; sid[k][1] = (int)SLW[64 + lane];
            act[k][0] = __builtin_bit_cast(float, SLW[128 + lane]); act[k][1] = __builtin_bit_cast(float, SLW[192 + lane]);
            asm volatile("s_waitcnt lgkmcnt(0)" ::: "memory");
        }
        {
            int incl = cntv;
#pragma unroll
            for (int o = 1; o < 64; o <<= 1) { const int up = __shfl_up(incl, o); incl += (lane >= o) ? up : 0; }
            const int gb = incl - cntv;
            asm volatile("s_waitcnt lgkmcnt(0)" ::: "memory");
#pragma unroll
            for (int k = 0; k < TPW; ++k)
#pragma unroll
                for (int h = 0; h < 2; ++h) { const int sl = sid[k][h] >> SL_SHIFT;
                    const int p = __shfl(gb, sl * TPW + k) + (h * 64 + lane) - __shfl(offv[k], sl);
                    LST[p] = (unsigned short)sid[k][h]; }
            if (lane < RING) LST[NROWS + lane] = (unsigned short)0;
            asm volatile("s_waitcnt lgkmcnt(0)" ::: "memory");
        }
        int orig[TPW][2];
#pragma unroll
        for (int k = 0; k < TPW; ++k) { orig[k][0] = __builtin_bit_cast(int, act[k][0]); orig[k][1] = __builtin_bit_cast(int, act[k][1]); act[k][0] = 0.f; act[k][1] = 0.f; }
        {
            f32x2 hf[TPW][16];
#pragma unroll
            for (int k = 0; k < TPW; ++k) { const int t = (tb + k * NGW) < S ? (tb + k * NGW) : (S - 1);
#pragma unroll
                for (int kk = 0; kk < 8; ++kk) { const u32x2 w = bl64(rws, l8 + (unsigned)(kk * 512), (unsigned)(WS_H + (size_t)t * (D * 2)));
                    hf[k][kk * 2] = (f32x2){bflo(w.x), bfhi(w.x)}; hf[k][kk * 2 + 1] = (f32x2){bflo(w.y), bfhi(w.y)}; } }
            u32x4 r0, r1;
            P8_STREAM_INIT(WS_EU, r0, r1);
#pragma unroll 1
            for (int s = 0; s < NSL; ++s) {
#pragma unroll
                for (int k = 0; k < TPW; ++k) {
                    const int lo = __builtin_amdgcn_readlane(offv[k], s), hi = __builtin_amdgcn_readlane(offv[k], s + 1);
#pragma unroll 1
                    for (int e = lo; e < hi; ++e) {
                        P8_ROW_READY();
                        f32x2 dd0 = {0.f, 0.f}, dd1 = {0.f, 0.f};
#pragma unroll
                        for (int kk = 0; kk < 4; ++kk) {
                            { const unsigned w = r0[kk]; const f32x2 lo2 = __builtin_amdgcn_cvt_pk_f32_fp8((int)w, false), hi2 = __builtin_amdgcn_cvt_pk_f32_fp8((int)w, true);
                              dd0 = __builtin_elementwise_fma(lo2, hf[k][kk * 2], dd0); dd1 = __builtin_elementwise_fma(hi2, hf[k][kk * 2 + 1], dd1); }
                            { const unsigned w = r1[kk]; const f32x2 lo2 = __builtin_amdgcn_cvt_pk_f32_fp8((int)w, false), hi2 = __builtin_amdgcn_cvt_pk_f32_fp8((int)w, true);
                              dd0 = __builtin_elementwise_fma(lo2, hf[k][8 + kk * 2], dd0); dd1 = __builtin_elementwise_fma(hi2, hf[k][8 + kk * 2 + 1], dd1); } }
                        asm volatile("" : "+v"(dd0), "+v"(dd1));
                        P8_ROW_ADVANCE(WS_EU, r0, r1);
                        const float d = wave_sum_dpp((dd0.x + dd0.y) + (dd1.x + dd1.y));
                        act[k][0] = (lane == e) ? d : act[k][0]; act[k][1] = (lane == e - 64) ? d : act[k][1];
                    }
                }
            }
            P8_STREAM_END();
        }
#pragma unroll
        for (int k = 0; k < TPW; ++k) {
            const int t = (tb + k * NGW) < S ? (tb + k * NGW) : (S - 1);
            const float ssp = lane < 32 ? __builtin_bit_cast(float, bl32(rws, l4, (unsigned)(WS_SS + (size_t)t * 128))) : 0.f;
            const float rstd2 = 1.0f / sqrtf(wave_sum(ssp) * (1.0f / D) + EPS);
            const unsigned og = (unsigned)(WS_GATE + (size_t)t * 512);
#pragma unroll
            for (int h = 0; h < 2; ++h) {
                const float gate = __builtin_bit_cast(float, bl32(rws, (unsigned)orig[k][h] * 4u, og));
                const float su = __builtin_bit_cast(float, bl32(rws, (unsigned)sid[k][h] * 4u, (unsigned)WS_ESC)) * rstd2;
                const float sv = __builtin_bit_cast(float, bl32(rws, (unsigned)sid[k][h] * 4u, (unsigned)(WS_ESC + NEXP * 4)));
                act[k][h] = gelu_tanh(act[k][h] * su) * gate * sv; }
        }
        {
            float acc[TPW][32];
#pragma unroll
            for (int k = 0; k < TPW; ++k)
#pragma unroll
                for (int i = 0; i < 32; ++i) acc[k][i] = 0.f;
            u32x4 r0, r1;
            P8_STREAM_INIT(WS_EV, r0, r1);
#pragma unroll 1
            for (int s = 0; s < NSL; ++s) {
#pragma unroll
                for (int k = 0; k < TPW; ++k) {
                    const int lo = __builtin_amdgcn_readlane(offv[k], s), hi = __builtin_amdgcn_readlane(offv[k], s + 1);
#pragma unroll 1
                    for (int e = lo; e < hi; ++e) {
                        const int a0_ = __builtin_amdgcn_readlane(__builtin_bit_cast(int, act[k][0]), e & 63), a1_ = __builtin_amdgcn_readlane(__builtin_bit_cast(int, act[k][1]), e & 63);
                        const float aw = __builtin_bit_cast(float, e < 64 ? a0_ : a1_);
                        P8_ROW_READY();
#pragma unroll
                        for (int kk = 0; kk < 4; ++kk) {
                            { const unsigned w = r0[kk]; const int bb = kk * 4; const f32x2 lo2 = __builtin_amdgcn_cvt_pk_f32_fp8((int)w, false), hi2 = __builtin_amdgcn_cvt_pk_f32_fp8((int)w, true);
                              acc[k][bb + 0] += aw * lo2.x; acc[k][bb + 1] += aw * lo2.y; acc[k][bb + 2] += aw * hi2.x; acc[k][bb + 3] += aw * hi2.y; }
                            { const unsigned w = r1[kk]; const int bb = 16 + kk * 4; const f32x2 lo2 = __builtin_amdgcn_cvt_pk_f32_fp8((int)w, false), hi2 = __builtin_amdgcn_cvt_pk_f32_fp8((int)w, true);
                              acc[k][bb + 0] += aw * lo2.x; acc[k][bb + 1] += aw * lo2.y; acc[k][bb + 2] += aw * hi2.x; acc[k][bb + 3] += aw * hi2.y; } }
                        asm volatile("" : "+v"(acc[k][0]), "+v"(acc[k][16]));
                        P8_ROW_ADVANCE(WS_EV, r0, r1);
                    }
                }
            }
            P8_STREAM_END();
#pragma unroll
            for (int k = 0; k < TPW; ++k) { const int t = tb + k * NGW;
                if (t < S) {
                    float ss = 0.f; const unsigned ot = (unsigned)t * (unsigned)(D * 4);
#pragma unroll
                    for (int kk = 0; kk < 8; ++kk) { const u32x2 xw = bl64(rws, l8 + (unsigned)(kk * 512), (unsigned)(WS_H + (size_t)t * (D * 2)));
                        acc[k][kk * 4 + 0] += bflo(xw.x); acc[k][kk * 4 + 1] += bfhi(xw.x); acc[k][kk * 4 + 2] += bflo(xw.y); acc[k][kk * 4 + 3] += bfhi(xw.y);
                        ss += (acc[k][kk * 4 + 0] * acc[k][kk * 4 + 0] + acc[k][kk * 4 + 1] * acc[k][kk * 4 + 1]) + (acc[k][kk * 4 + 2] * acc[k][kk * 4 + 2] + acc[k][kk * 4 + 3] * acc[k][kk * 4 + 3]); }
                    const float rstd = 1.0f / sqrtf(wave_sum(ss) * (1.0f / D) + EPS);
#pragma unroll
                    for (int kk = 0; kk < 8; ++kk) { const f32x4 f0 = __builtin_bit_cast(f32x4, bl128(rfg, l16 + (unsigned)((kk & 3) * 1024), (unsigned)((kk >> 2) * 4096)));
                        f32x4 o0; o0.x = acc[k][kk * 4 + 0] * rstd * f0.x; o0.y = acc[k][kk * 4 + 1] * rstd * f0.y; o0.z = acc[k][kk * 4 + 2] * rstd * f0.z; o0.w = acc[k][kk * 4 + 3] * rstd * f0.w;
                        __builtin_amdgcn_raw_buffer_store_b128(__builtin_bit_cast(u32x4, o0), rdst, l16 + (unsigned)((kk & 3) * 1024), ot + (unsigned)((kk >> 2) * 4096), 0); }
                }
            }
        }
    }
}

#define XB_TMO      128
#define XB_XCNT(j)  (256  + 64 * (j))
#define XB_XSUB(j)  (1280 + 64 * (j))
#define XB_XGEN(j)  (2304 + 64 * (j))
#define XB_TOP      3328
#define XB_TOPGEN   3392
#define XCD_BAR_WORDS 3456
#define XB_SPIN_CAP (1u << 22)
__device__ __forceinline__ unsigned xb_ld(unsigned* p)              { return __hip_atomic_load(p, __ATOMIC_RELAXED, __HIP_MEMORY_SCOPE_AGENT); }
__device__ __forceinline__ unsigned xb_add(unsigned* p, unsigned v) { return __hip_atomic_fetch_add(p, v, __ATOMIC_RELAXED, __HIP_MEMORY_SCOPE_AGENT); }
__device__ __forceinline__ unsigned xb_xcc_id() { return (unsigned)__builtin_amdgcn_s_getreg((3 << 11) | 20) & 0xFu; }
#define XB_SPIN(cond, bar) do { unsigned _sp = 0; while (cond) { __builtin_amdgcn_s_sleep(1); \
    if ((++_sp & 255u) == 0u) { if (xb_ld(&(bar)[XB_TMO])) break; if (_sp > XB_SPIN_CAP) { atomicAdd(&(bar)[XB_TMO], 1u); break; } } } } while (0)
struct XcdBarrier { unsigned* bar; unsigned x; volatile LAS unsigned* st; };
__device__ __forceinline__ XcdBarrier xcd_barrier_post(unsigned* bar, volatile LAS unsigned* st) {
    XcdBarrier b; b.bar = bar; b.x = xb_xcc_id(); b.st = st;
    if (threadIdx.x == 0) (void)xb_add(&bar[XB_XCNT(b.x)], 1u);
    return b;
}
__device__ __forceinline__ void xcd_barrier_complete(unsigned* bar, unsigned x, unsigned G, unsigned& nloc, unsigned& nx) {
    unsigned sum, cnt, mine, sp = 0u;
    for (;;) {
        sum = 0u; cnt = 0u; mine = 0u;
#pragma unroll
        for (unsigned j = 0; j < 16; ++j) { const unsigned c = xb_ld(&bar[XB_XCNT(j)]); sum += c; cnt += (c > 0u) ? 1u : 0u; mine = (j == x) ? c : mine; }
        if (sum == G) break;
        __builtin_amdgcn_s_sleep(1);
        if ((++sp & 255u) == 0u) { if (xb_ld(&bar[XB_TMO])) break; if (sp > XB_SPIN_CAP) { atomicAdd(&bar[XB_TMO], 1u); break; } }
    }
    nloc = mine > 0u ? mine : 1u; nx = cnt > 0u ? cnt : 1u;
}
__device__ __forceinline__ void xcd_barrier(const XcdBarrier& b, unsigned G) {
    asm volatile("s_waitcnt vmcnt(0)" ::: "memory");
    __syncthreads();
    if (threadIdx.x == 0) {
        unsigned* bar = b.bar;
        __builtin_amdgcn_s_waitcnt(0);
        unsigned nloc = b.st[0], nx = b.st[1];
        if (nloc == 0u) { xcd_barrier_complete(bar, b.x, G, nloc, nx); b.st[0] = nloc; b.st[1] = nx; }
        const unsigned old = xb_add(&bar[XB_XSUB(b.x)], 1u);
        const unsigned gen = old / nloc;
        if (old + 1u == (gen + 1u) * nloc) {
            __builtin_amdgcn_fence(__ATOMIC_RELEASE, "agent");
            asm volatile("s_waitcnt vmcnt(0)" ::: "memory");
            const unsigned og = xb_add(&bar[XB_TOP], 1u);
            const unsigned tg = og / nx;
            if (og + 1u == (tg + 1u) * nx) xb_add(&bar[XB_TOPGEN], 1u);
            else XB_SPIN(xb_ld(&bar[XB_TOPGEN]) == tg, bar);
            __builtin_amdgcn_fence(__ATOMIC_ACQUIRE, "agent");
            xb_add(&bar[XB_XGEN(b.x)], 1u);
            asm volatile("s_waitcnt vmcnt(0)" ::: "memory");
        } else {
            XB_SPIN(xb_ld(&bar[XB_XGEN(b.x)]) == gen, bar);
            __builtin_amdgcn_fence(__ATOMIC_ACQUIRE, "agent");
            asm volatile("s_waitcnt vmcnt(0)" ::: "memory");
        }
    }
    __syncthreads();
}

constexpr int N_PHASES = 9;
#ifndef DUP_MASK
#define DUP_MASK 0
#endif
#define REP(k) for (int rep_ = 0; rep_ < 1 + ((DUP_MASK >> (k)) & 1); ++rep_)
__global__ void __launch_bounds__(NTHR, 2) fwd(Args args) {
    extern __shared__ __attribute__((aligned(16))) unsigned char lds_raw[];
    LAS unsigned char* lds = (LAS unsigned char*)lds_raw;
    const int tid = threadIdx.x, lane = tid & 63, wave = __builtin_amdgcn_readfirstlane(tid >> 6);
    const int G = gridDim.x; const int bx = blockIdx.x; const int vcu = (G % 8 == 0) ? (bx % 8) * (G / 8) + bx / 8 : bx;
    unsigned char* ws = args.ws;
    const int lo = args.ph_lo, hi = args.ph_hi;
#define IN(k) (lo <= (k) && (k) < hi)
    volatile LAS unsigned* MISC = (volatile LAS unsigned*)(lds + MISC_OFF);
    if (tid < 32) MISC[tid] = 0u;
    __syncthreads();
#if USE_CG_SYNC
    if (IN(0) && bx * NTHR + tid < XCD_BAR_WORDS) __hip_atomic_store((unsigned*)(ws + WS_CTL) + bx * NTHR + tid, 0u, __ATOMIC_RELAXED, __HIP_MEMORY_SCOPE_AGENT);
    XcdBarrier bar; bar.bar = (unsigned*)(ws + WS_CTL); bar.x = 0; bar.st = MISC + 8;
#else
    XcdBarrier bar = xcd_barrier_post((unsigned*)(ws + WS_CTL), MISC + 8);
#endif
#if USE_CG_SYNC
#define SEAM(k) do { if (IN(k) && IN((k) + ((k) == 4 ? 2 : 1))) { if ((k) == 0) { cg::this_grid().sync(); bar = xcd_barrier_post((unsigned*)(ws + WS_CTL), MISC + 8); } else xcd_barrier(bar, (unsigned)G); } } while (0)
#else
#define SEAM(k) do { if (IN(k) && IN((k) + ((k) == 4 ? 2 : 1))) { xcd_barrier(bar, (unsigned)G); } } while (0)
#endif

    if (IN(0)) REP(0) { p0_prologue(args, lds, vcu, G, wave, lane, tid); }
    SEAM(0);
    if (IN(1)) REP(1) {
        pg8::Gemm g{(const bf16_t*)(ws + WS_H), (const bf16_t*)(ws + WS_WIN), S, INW, D, D, D, 0}; pg8::StaticOrder so; so.init(S, INW, G, bx);
        pg8::EpiZ E{(bf16_t*)(ws + WS_Z), args.in[3]};
        pg8::gemm_phase<pg8::EpiZ>(lds, g, so, E);
    }
    SEAM(1);
    if (IN(2)) REP(2) { p2_pool(args, vcu, G, tid); p2_sgu(args, lds, vcu, G, wave, lane, tid); }
    SEAM(2);
    if (IN(3)) REP(3) {
        pg8::StaticOrder so; so.init(S, D, G, bx);
        { pg8::Gemm g{(const bf16_t*)(ws + WS_A2), (const bf16_t*)(ws + WS_WPOOL), S, D, 256, D, 256, 1};
          pg8::EpiPool E{(bf16_t*)(ws + WS_T), (const bf16_t*)(ws + WS_Z)};
          pg8::gemm_phase<pg8::EpiPool>(lds, g, so, E); }
        asm volatile("s_waitcnt vmcnt(0)" ::: "memory"); __syncthreads();
        { pg8::Gemm g{(const bf16_t*)(ws + WS_A2) + 1024, (const bf16_t*)(ws + WS_WG), S, D, GWD, D, GWD, 0};
          pg8::EpiMerge E{(const bf16_t*)(ws + WS_T), (const bf16_t*)(ws + WS_Z), (bf16_t*)(ws + WS_MRG)};
          pg8::gemm_phase<pg8::EpiMerge>(lds, g, so, E); }
    }
    SEAM(3);
    if (IN(4)) REP(4) {
        pg8::Gemm g{(const bf16_t*)(ws + WS_MRG), (const bf16_t*)(ws + WS_WOUT), S, D, D, D, D, 0}; pg8::StaticOrder so; so.init(S, D, G, bx);
        pg8::EpiX1 E{args.in[0], (bf16_t*)(ws + WS_H), (float*)(ws + WS_SS)};
        pg8::gemm_phase<pg8::EpiX1>(lds, g, so, E);
    }
    SEAM(4);
    if (IN(6)) REP(6) {
        pg8::Gemm g{(const bf16_t*)(ws + WS_H), (const bf16_t*)(ws + WS_WQ), S, D, D, D, D, 0}; pg8::StaticOrder so; so.init(S, D, G, bx);
        pg8::EpiQ E{(bf16_t*)(ws + WS_Q), (const float*)(ws + WS_SS)};
        pg8::gemm_phase<pg8::EpiQ>(lds, g, so, E);
    }
    if (IN(6) && IN(7)) { asm volatile("s_waitcnt vmcnt(0)" ::: "memory"); __syncthreads(); }
    if (IN(7)) REP(7) { p7_topk(args, lds, vcu, G, wave, lane); }
    SEAM(7);
    if (IN(8)) REP(8) { float* dst8 = (rep_ < ((DUP_MASK >> 8) & 1)) ? (float*)(ws + WS_T) : args.out; p8_peer(args, lds, dst8, vcu, G, wave, lane); }
#undef IN
#undef SEAM
}

extern "C" void kernel_launch(void* const* d_in, const int* in_sizes, int n_in, void* d_out, int out_size, void* d_ws, size_t ws_size, hipStream_t stream) {
    static int grid = 0;
    if (grid == 0) {
        if (n_in != 18 || out_size != S * D || ws_size < WS_END) { fprintf(stderr, "kernel_launch: unexpected shapes (n_in %d, out %d, ws %zu)\n", n_in, out_size, ws_size); grid = -1; return; }
        int dev = 0, cus = 0, per_cu = 0;
        if (hipGetDevice(&dev) != hipSuccess || hipDeviceGetAttribute(&cus, hipDeviceAttributeMultiprocessorCount, dev) != hipSuccess) { grid = -1; return; }
        if (hipFuncSetAttribute((const void*)fwd, hipFuncAttributeMaxDynamicSharedMemorySize, LDS_BYTES) != hipSuccess) { fprintf(stderr, "kernel_launch: hipFuncSetAttribute failed\n"); grid = -1; return; }
        if (hipOccupancyMaxActiveBlocksPerMultiprocessor(&per_cu, (const void*)fwd, NTHR, LDS_BYTES) != hipSuccess || per_cu < 1) { fprintf(stderr, "kernel_launch: occupancy query says %d\n", per_cu); per_cu = 1; }
        (void)hipGetLastError();
        grid = cus;
    }
    if (grid < 0) return;
#if !USE_CG_SYNC
    if (hipMemsetAsync((char*)d_ws + WS_CTL, 0, 16384, stream) != hipSuccess) { fprintf(stderr, "kernel_launch: memset failed\n"); return; }
#endif
    Args a{};
    for (int i = 0; i < 18; ++i) a.in[i] = (const float*)d_in[i];
    a.out = (float*)d_out; a.ws = (unsigned char*)d_ws;
#if MK_N_LAUNCHES == 1
    a.ph_lo = 0; a.ph_hi = N_PHASES;
    void* kargs[] = {&a};
    hipError_t e = hipLaunchCooperativeKernel((const void*)fwd, dim3(grid), dim3(NTHR), kargs, LDS_BYTES, stream);
    if (e != hipSuccess) fprintf(stderr, "kernel_launch: cooperative launch failed: %s (grid %d)\n", hipGetErrorString(e), grid);
#else
    for (int p = 0; p < N_PHASES; ++p) {
        a.ph_lo = p; a.ph_hi = p + 1;
        hipLaunchKernelGGL(fwd, dim3(grid), dim3(NTHR), LDS_BYTES, stream, a);
    }
#endif
}
```

```cpp
#include <hip/hip_runtime.h>
#include <hip/hip_cooperative_groups.h>
#include <cstdio>
#include <cstdint>
namespace cg = cooperative_groups;

#ifndef USE_CG_SYNC
#define USE_CG_SYNC 1
#endif
#ifndef MK_N_LAUNCHES
#define MK_N_LAUNCHES 1
#endif

#define LAS __attribute__((address_space(3)))
typedef unsigned short bf16_t;
typedef short bf16x8 __attribute__((ext_vector_type(8)));
typedef float f32x4 __attribute__((ext_vector_type(4)));
typedef unsigned u32x4 __attribute__((ext_vector_type(4)));
typedef unsigned u32x2 __attribute__((ext_vector_type(2)));

constexpr int S = 8192, D = 2048, INW = 7168, PW = 1024, GWD = 1024;
constexpr int NEXP = 16384;
constexpr float EPS = 1e-6f;
constexpr int NWAVES = 8, NTHR = 512;

constexpr size_t MiB = 1u << 20;
constexpr size_t WS_CTL = 0;
constexpr size_t WS_WIN = 1 * MiB;
constexpr size_t WS_WPOOL = 30 * MiB;
constexpr size_t WS_WG = 31 * MiB;
constexpr size_t WS_WOUT = 35 * MiB;
constexpr size_t WS_WQ = 43 * MiB;
constexpr size_t WS_KEYS = 51 * MiB;
constexpr size_t WS_WSM = 52 * MiB;
constexpr size_t WS_H = 53 * MiB;
constexpr size_t WS_Z = 85 * MiB;
constexpr size_t WS_A2 = 197 * MiB;
constexpr size_t WS_T = 229 * MiB;
constexpr size_t WS_MRG = 293 * MiB;
constexpr size_t WS_Q = 325 * MiB;
constexpr size_t WS_IDX = 357 * MiB;
constexpr size_t WS_GATE = 361 * MiB;
constexpr size_t WS_SS = 365 * MiB;
constexpr size_t WS_ESC = 369 * MiB;
constexpr size_t WS_EU = 370 * MiB;
constexpr size_t WS_EV = 402 * MiB;
constexpr size_t WS_END = 434 * MiB;

constexpr int LDS_BYTES = 147456;
constexpr int MISC_OFF = 131072 + 320;

__device__ __forceinline__ unsigned f2bf(float f) { unsigned u = __builtin_bit_cast(unsigned, f); return (u + 0x7fffu + ((u >> 16) & 1u)) >> 16; }
__device__ __forceinline__ unsigned pk2(float lo, float hi) { return f2bf(lo) | (f2bf(hi) << 16); }
__device__ __forceinline__ float bflo(unsigned w) { return __builtin_bit_cast(float, w << 16); }
__device__ __forceinline__ float bfhi(unsigned w) { return __builtin_bit_cast(float, w & 0xffff0000u); }
__device__ __forceinline__ float wave_sum(float v) {
#pragma unroll
    for (int o = 1; o < 64; o <<= 1) v += __shfl_xor(v, o);
    return v;
}
template <int CTRL> __device__ __forceinline__ float dpp_add_f32(float v) { return v + __builtin_bit_cast(float, __builtin_amdgcn_update_dpp(0, __builtin_bit_cast(int, v), CTRL, 0xF, 0xF, true)); }
__device__ __forceinline__ float row_sum_f32(float v) { v = dpp_add_f32<0xB1>(v); v = dpp_add_f32<0x4E>(v); v = dpp_add_f32<0x141>(v); v = dpp_add_f32<0x140>(v); return v; }
__device__ __forceinline__ float gelu_tanh(float x) {
    const float y = 1.5957691216057308f * (x + 0.044715f * x * x * x);
    const float e = __builtin_amdgcn_exp2f(-y * 1.4426950408889634f);
    return x * __builtin_amdgcn_rcpf(1.0f + e);
}
__device__ __forceinline__ float sigmoidf_(float x) { return __builtin_amdgcn_rcpf(1.0f + __builtin_amdgcn_exp2f(-x * 1.4426950408889634f)); }

namespace pg8 {
constexpr int BM = 256, BK = 64, HALF = 128, HTB = HALF * BK * 2, STAGE_BYTES = 8 * HTB, NXCD = 8, WGM = 1;
__host__ __device__ __forceinline__ int lds_byte(int r, int c) { const int st = (r >> 4) * 2 + (c >> 5), rr = r & 15, cc = c & 31, ob = rr * 64 + cc * 2; return st * 1024 + (ob ^ (((ob >> 9) & 1) << 5)); }
__host__ __device__ __forceinline__ void stage_rc(int b, int& R, int& C) { const int st = b / 1024, sb = b % 1024, swz = sb ^ (((sb >> 9) & 1) << 5); R = (st >> 1) * 16 + swz / 64; C = (st & 1) * 32 + (swz % 64) / 2; }
__host__ __device__ __forceinline__ int perm32(int rho) { const int n = rho >> 4, i = rho & 15; return 8 * (i >> 2) + 4 * n + (i & 3); }

struct Unit { int pm, pn; };
struct Gemm { const bf16_t* A; const bf16_t* Bt; int M, N, K, lda, ldb, mode; };
__device__ __forceinline__ const char* a_ptr(const Gemm& g, const Unit& u) {
    size_t off = (size_t)u.pm * BM * g.lda; if (g.mode == 1) off += (size_t)(u.pn >> 1) * 256; return (const char*)(g.A + off); }
__device__ __forceinline__ const char* b_ptr(const Gemm& g, const Unit& u) {
    size_t off = (g.mode == 1) ? ((size_t)(u.pn >> 1) * 512 * 256 + (size_t)(u.pn & 1) * 256 * 256) : (size_t)u.pn * BM * g.ldb; return (const char*)(g.Bt + off); }

struct StaticOrder {
    int nM, nN, nwg, G, c;
    __host__ __device__ void init(int M, int N, int G_, int c_) { nM = M / BM; nN = N / BM; nwg = nM * nN; G = G_; c = c_; }
    __host__ __device__ bool next(int i, Unit& u) const {
        const long L = (long)i * G + c; if (L >= nwg) return false;
        int wgid = (int)L; { const int q = nwg / NXCD, r = nwg % NXCD, xcd = wgid % NXCD, off = wgid / NXCD; wgid = (xcd < r ? xcd * (q + 1) : r * (q + 1) + (xcd - r) * q) + off; }
        const int nig = WGM * nN, gid = wgid / nig, fm = gid * WGM, gsz = (nM - fm) < WGM ? (nM - fm) : WGM;
        u.pm = fm + ((wgid % nig) % gsz); u.pn = (wgid % nig) / gsz; return true;
    }
};

__device__ __forceinline__ unsigned cvt_pk_bf16(float lo, float hi) { unsigned r; asm volatile("v_cvt_pk_bf16_f32 %0, %1, %2" : "=v"(r) : "v"(lo), "v"(hi)); return r; }


struct EpiZ {
    static constexpr bool PERM = true;
    bf16_t* Z; const float* b_gate;
    __device__ __forceinline__ void operator()(const f32x4 (&acc)[2][2][4][2], const Unit& u, int wr, int wc, int fr, int fq) const {
        const int row0 = u.pm * BM + wr * 64 + fr, col0 = u.pn * BM + wc * 32 + 8 * fq;
        const int mode = u.pn < 4 ? 0 : (u.pn < 12 ? 1 : 2);
        f32x4 bv[2][2];
#pragma unroll
        for (int bj = 0; bj < 2; ++bj)
#pragma unroll
            for (int n = 0; n < 2; ++n) bv[bj][n] = (mode == 2) ? *(const f32x4*)(b_gate + (col0 - 3072) + bj * HALF + 4 * n) : (f32x4){0.f, 0.f, 0.f, 0.f};
#pragma unroll
        for (int ai = 0; ai < 2; ++ai)
#pragma unroll
            for (int m = 0; m < 4; ++m) { bf16_t* rowp = Z + (size_t)(row0 + ai * HALF + m * 16) * INW + col0;
#pragma unroll
                for (int bj = 0; bj < 2; ++bj) { f32x4 v0 = acc[ai][bj][m][0], v1 = acc[ai][bj][m][1];
                    if (mode == 1) {
#pragma unroll
                        for (int j = 0; j < 4; ++j) { v0[j] = gelu_tanh(v0[j]); v1[j] = gelu_tanh(v1[j]); } }
                    if (mode == 2) { v0 += bv[bj][0]; v1 += bv[bj][1];
#pragma unroll
                        for (int j = 0; j < 4; ++j) { v0[j] = sigmoidf_(v0[j]); v1[j] = sigmoidf_(v1[j]); } }
                    u32x4 w; w.x = cvt_pk_bf16(v0[0], v0[1]); w.y = cvt_pk_bf16(v0[2], v0[3]); w.z = cvt_pk_bf16(v1[0], v1[1]); w.w = cvt_pk_bf16(v1[2], v1[3]);
                    *(u32x4*)(rowp + bj * HALF) = w; } }
    }
};
struct EpiPool {
    static constexpr bool PERM = true;
    bf16_t* T; const bf16_t* Z;
    __device__ __forceinline__ void operator()(const f32x4 (&acc)[2][2][4][2], const Unit& u, int wr, int wc, int fr, int fq) const {
        const int row0 = u.pm * BM + wr * 64 + fr, col0 = u.pn * BM + wc * 32 + 8 * fq;
#pragma unroll
        for (int ai = 0; ai < 2; ++ai)
#pragma unroll
            for (int m = 0; m < 4; ++m) { const size_t row = (size_t)(row0 + ai * HALF + m * 16);
#pragma unroll
                for (int bj = 0; bj < 2; ++bj) { const int c = col0 + bj * HALF;
                    const u32x4 g = *(const u32x4*)(Z + row * INW + 3072 + c);
                    const f32x4 a0 = acc[ai][bj][m][0], a1 = acc[ai][bj][m][1];
                    u32x4 w; w.x = cvt_pk_bf16(bflo(g.x) * a0[0], bfhi(g.x) * a0[1]); w.y = cvt_pk_bf16(bflo(g.y) * a0[2], bfhi(g.y) * a0[3]);
                    w.z = cvt_pk_bf16(bflo(g.z) * a1[0], bfhi(g.z) * a1[1]); w.w = cvt_pk_bf16(bflo(g.w) * a1[2], bfhi(g.w) * a1[3]);
                    *(u32x4*)(T + row * D + c) = w; asm volatile("" ::: "memory"); } }
    }
};
struct EpiMerge {
    static constexpr bool PERM = true;
    const bf16_t* T; const bf16_t* Z; bf16_t* O;
    __device__ __forceinline__ void operator()(const f32x4 (&acc)[2][2][4][2], const Unit& u, int wr, int wc, int fr, int fq) const {
        const int row0 = u.pm * BM + wr * 64 + fr, col0 = u.pn * BM + wc * 32 + 8 * fq;
#pragma unroll
        for (int ai = 0; ai < 2; ++ai)
#pragma unroll
            for (int m = 0; m < 4; ++m) { const size_t row = (size_t)(row0 + ai * HALF + m * 16);
#pragma unroll
                for (int bj = 0; bj < 2; ++bj) { const int c = col0 + bj * HALF;
                    const u32x4 g = *(const u32x4*)(Z + row * INW + 5120 + c);
                    const u32x4 t = *(const u32x4*)(T + row * D + c);
                    const f32x4 a0 = acc[ai][bj][m][0], a1 = acc[ai][bj][m][1];
                    u32x4 w; w.x = cvt_pk_bf16(bflo(t.x) + bflo(g.x) * a0[0], bfhi(t.x) + bfhi(g.x) * a0[1]); w.y = cvt_pk_bf16(bflo(t.y) + bflo(g.y) * a0[2], bfhi(t.y) + bfhi(g.y) * a0[3]);
                    w.z = cvt_pk_bf16(bflo(t.z) + bflo(g.z) * a1[0], bfhi(t.z) + bfhi(g.z) * a1[1]); w.w = cvt_pk_bf16(bflo(t.w) + bflo(g.w) * a1[2], bfhi(t.w) + bfhi(g.w) * a1[3]);
                    *(u32x4*)(O + row * D + c) = w; asm volatile("" ::: "memory"); } }
    }
};
struct EpiX1 {
    static constexpr bool PERM = true;
    const float* X; bf16_t* XB; float* SS;
    __device__ __forceinline__ void operator()(const f32x4 (&acc)[2][2][4][2], const Unit& u, int wr, int wc, int fr, int fq) const {
        const int row0 = u.pm * BM + wr * 64 + fr, col0 = u.pn * BM + wc * 32 + 8 * fq;
#pragma unroll
        for (int ai = 0; ai < 2; ++ai)
#pragma unroll
            for (int m = 0; m < 4; ++m) { const size_t row = (size_t)(row0 + ai * HALF + m * 16); float ss = 0.f;
#pragma unroll
                for (int bj = 0; bj < 2; ++bj) { const size_t off = row * D + col0 + bj * HALF;
                    const f32x4 x0 = *(const f32x4*)(X + off) + acc[ai][bj][m][0], x1 = *(const f32x4*)(X + off + 4) + acc[ai][bj][m][1];
                    ss += (x0[0] * x0[0] + x0[1] * x0[1]) + (x0[2] * x0[2] + x0[3] * x0[3]) + (x1[0] * x1[0] + x1[1] * x1[1]) + (x1[2] * x1[2] + x1[3] * x1[3]);
                    u32x4 w; w.x = cvt_pk_bf16(x0[0], x0[1]); w.y = cvt_pk_bf16(x0[2], x0[3]); w.z = cvt_pk_bf16(x1[0], x1[1]); w.w = cvt_pk_bf16(x1[2], x1[3]);
                    *(u32x4*)(XB + off) = w; }
                ss += __shfl_xor(ss, 16); ss += __shfl_xor(ss, 32);
                if (fq == 0) SS[row * 32 + u.pn * 4 + wc] = ss;
                asm volatile("" ::: "memory"); }
    }
};
struct EpiQ {
    static constexpr bool PERM = true;
    bf16_t* O; const float* SS;
    __device__ __forceinline__ void operator()(const f32x4 (&acc)[2][2][4][2], const Unit& u, int wr, int wc, int fr, int fq) const {
        const int row0 = u.pm * BM + wr * 64 + fr, col0 = u.pn * BM + wc * 32 + 8 * fq;
#pragma unroll
        for (int ai = 0; ai < 2; ++ai)
#pragma unroll
            for (int m = 0; m < 4; ++m) { const size_t row = (size_t)(row0 + ai * HALF + m * 16);
                const f32x4 p0 = *(const f32x4*)(SS + row * 32 + fq * 8), p1 = *(const f32x4*)(SS + row * 32 + fq * 8 + 4);
                float ss = ((p0[0] + p0[1]) + (p0[2] + p0[3])) + ((p1[0] + p1[1]) + (p1[2] + p1[3]));
                ss += __shfl_xor(ss, 16); ss += __shfl_xor(ss, 32);
                const float rstd = 1.0f / sqrtf(ss * (1.0f / D) + EPS);
                bf16_t* rowp = O + row * D + col0;
#pragma unroll
                for (int bj = 0; bj < 2; ++bj) { const f32x4 v0 = acc[ai][bj][m][0] * rstd, v1 = acc[ai][bj][m][1] * rstd;
                    u32x4 w; w.x = cvt_pk_bf16(v0[0], v0[1]); w.y = cvt_pk_bf16(v0[2], v0[3]); w.z = cvt_pk_bf16(v1[0], v1[1]); w.w = cvt_pk_bf16(v1[2], v1[3]);
                    *(u32x4*)(rowp + bj * HALF) = w; } }
    }
};

template <class Epi, bool ALIGN_EPI = true>
__device__ __forceinline__ void gemm_phase(LAS unsigned char* lds, const Gemm g, const StaticOrder& S_, const Epi& E) {
    int tid_ = threadIdx.x; asm volatile("" : "+v"(tid_));
    const int tid = tid_, wid = __builtin_amdgcn_readfirstlane(tid >> 6), lane = tid & 63, wr = wid >> 2, wc = wid & 3, fr = lane & 15, fq = lane >> 4;
    const int K = g.K, nt = K / BK;
    unsigned voffA[2], voffB[2];
#pragma unroll
    for (int i = 0; i < 2; ++i) { int R, C; stage_rc(tid * 16 + i * 8192, R, C); const int Rb = Epi::PERM ? ((R & ~31) + perm32(R & 31)) : R;
        voffA[i] = (unsigned)(R * g.lda + C) * 2u; voffB[i] = (unsigned)(Rb * g.ldb + C) * 2u; }
    const size_t kstep = (size_t)(BK * 2);
    const size_t hstepA = (size_t)HALF * g.lda * 2, hstepB = (size_t)HALF * g.ldb * 2;
    const unsigned ldsw = (unsigned)wid * 1024u;
    const int aoff = lds_byte(wr * 64 + fr, fq * 8), boff = lds_byte(wc * 32 + fr, fq * 8);
#define PG8_SA(b, h) (((b) * 2 + (h)) * HTB)
#define PG8_SB(b, h) ((4 + (b) * 2 + (h)) * HTB)
#define PG8_STAGE(bufoff, gbase, voff) do { _Pragma("unroll") for (int _i = 0; _i < 2; ++_i) \
        __builtin_amdgcn_global_load_lds((const unsigned*)((const char*)(gbase) + (voff)[_i]), (LAS unsigned*)(lds + (bufoff) + ldsw + _i * 8192), 16, 0, 0); } while (0)
#define PG8_LDA(dst, b, h) do { _Pragma("unroll") for (int m = 0; m < 4; ++m) _Pragma("unroll") for (int k = 0; k < 2; ++k) dst[m][k] = *(const LAS bf16x8*)(lds + PG8_SA(b, h) + aoff + m * 2048 + k * 1024); } while (0)
#define PG8_LDB(dst, b, h) do { _Pragma("unroll") for (int n = 0; n < 2; ++n) _Pragma("unroll") for (int k = 0; k < 2; ++k) dst[n][k] = *(const LAS bf16x8*)(lds + PG8_SB(b, h) + boff + n * 2048 + k * 1024); } while (0)
#define PG8_MMA(ai, bj, At, Bt) do { __builtin_amdgcn_s_setprio(1); _Pragma("unroll") for (int m = 0; m < 4; ++m) _Pragma("unroll") for (int n = 0; n < 2; ++n) _Pragma("unroll") for (int k = 0; k < 2; ++k) \
        acc[ai][bj][m][n] = __builtin_amdgcn_mfma_f32_16x16x32_bf16(Bt[n][k], At[m][k], acc[ai][bj][m][n], 0, 0, 0); __builtin_amdgcn_s_setprio(0); } while (0)
#define PG8_WAIT_V(n) asm volatile("s_waitcnt vmcnt(" #n ")" ::: "memory")
#define PG8_WAIT_L(n) asm volatile("s_waitcnt lgkmcnt(" #n ")" ::: "memory")
#define PG8_BAR __builtin_amdgcn_s_barrier()
#define PG8_SCHED __builtin_amdgcn_sched_barrier(0)
    Unit cur, nxt; int ui = 0;
    if (!S_.next(0, cur)) return;
    f32x4 acc[2][2][4][2];
#pragma unroll
    for (int a = 0; a < 2; ++a)
#pragma unroll
        for (int b = 0; b < 2; ++b)
#pragma unroll
            for (int m = 0; m < 4; ++m)
#pragma unroll
                for (int n = 0; n < 2; ++n) acc[a][b][m][n] = (f32x4){0.f, 0.f, 0.f, 0.f};
    bf16x8 At[4][2], B0[2][2], B1[2][2];
    const char* cA = a_ptr(g, cur); const char* cB = b_ptr(g, cur);
    PG8_STAGE(PG8_SB(0, 0), cB, voffB); PG8_STAGE(PG8_SB(0, 1), cB + hstepB, voffB); PG8_STAGE(PG8_SA(0, 0), cA, voffA); PG8_STAGE(PG8_SA(0, 1), cA + hstepA, voffA);
    if (wr == 1) PG8_BAR;
    PG8_WAIT_V(2); PG8_BAR;
    PG8_STAGE(PG8_SB(1, 0), cB + kstep, voffB); PG8_STAGE(PG8_SA(1, 0), cA + kstep, voffA); PG8_STAGE(PG8_SB(1, 1), cB + hstepB + kstep, voffB);
    PG8_WAIT_V(6); PG8_BAR;
    for (;;) {
        const bool has_next = S_.next(ui + 1, nxt);
        const char* nA = has_next ? a_ptr(g, nxt) : cA; const char* nB = has_next ? b_ptr(g, nxt) : cB;
        for (int t = 0; t < nt; t += 2) {
            const bool last = (t == nt - 2);
            const char* a1 = cA + (size_t)(t + 1) * kstep;
            const char* a2 = last ? nA : cA + (size_t)(t + 2) * kstep; const char* b2 = last ? nB : cB + (size_t)(t + 2) * kstep;
            const char* a3 = a2 + kstep; const char* b3 = b2 + kstep;
            PG8_LDB(B0, 0, 0); PG8_LDB(B1, 0, 1); PG8_SCHED; PG8_LDA(At, 0, 0); PG8_STAGE(PG8_SA(1, 1), a1 + hstepA, voffA);
            PG8_WAIT_V(8); PG8_WAIT_L(0); PG8_BAR; PG8_MMA(0, 0, At, B0); PG8_MMA(0, 1, At, B1); PG8_BAR; PG8_SCHED;
            PG8_LDA(At, 0, 1); PG8_STAGE(PG8_SB(0, 0), b2, voffB); PG8_STAGE(PG8_SB(0, 1), b2 + hstepB, voffB); PG8_STAGE(PG8_SA(0, 0), a2, voffA);
            PG8_WAIT_V(8); PG8_WAIT_L(0); PG8_BAR; PG8_MMA(1, 0, At, B0); PG8_MMA(1, 1, At, B1); PG8_BAR; PG8_SCHED;
            PG8_LDB(B0, 1, 0); PG8_LDB(B1, 1, 1); PG8_SCHED; PG8_LDA(At, 1, 0); PG8_STAGE(PG8_SA(0, 1), a2 + hstepA, voffA);
            PG8_WAIT_V(8); PG8_WAIT_L(0); PG8_BAR; PG8_MMA(0, 0, At, B0); PG8_MMA(0, 1, At, B1); PG8_BAR; PG8_SCHED;
            PG8_LDA(At, 1, 1); PG8_STAGE(PG8_SB(1, 0), b3, voffB); PG8_STAGE(PG8_SB(1, 1), b3 + hstepB, voffB); PG8_STAGE(PG8_SA(1, 0), a3, voffA);
            PG8_WAIT_V(8); PG8_WAIT_L(0); PG8_BAR; PG8_MMA(1, 0, At, B0); PG8_MMA(1, 1, At, B1); PG8_BAR; PG8_SCHED;
        }
        if constexpr (ALIGN_EPI) { if (wr == 0) PG8_BAR; }
        { int ln_ = threadIdx.x & 63; asm volatile("" : "+v"(ln_));
          E(acc, cur, wr, wc, ln_ & 15, ln_ >> 4); }
        if (!has_next) break;
#pragma unroll
        for (int a = 0; a < 2; ++a)
#pragma unroll
            for (int b = 0; b < 2; ++b)
#pragma unroll
                for (int m = 0; m < 4; ++m)
#pragma unroll
                    for (int n = 0; n < 2; ++n) acc[a][b][m][n] = (f32x4){0.f, 0.f, 0.f, 0.f};
        cur = nxt; cA = nA; cB = nB; ++ui;
        if constexpr (ALIGN_EPI) { if (wr == 1) PG8_BAR; }
    }
    PG8_WAIT_V(0);
    if constexpr (!ALIGN_EPI) { if (wr == 0) PG8_BAR; }
    PG8_BAR;
#undef PG8_SA
#undef PG8_SB
#undef PG8_STAGE
#undef PG8_LDA
#undef PG8_LDB
#undef PG8_MMA
#undef PG8_WAIT_V
#undef PG8_WAIT_L
#undef PG8_BAR
#undef PG8_SCHED
}
}

struct Args { const float* in[18]; float* out; unsigned char* ws; int ph_lo, ph_hi; };

__device__ __forceinline__ void p0_transpose_item(const float* W, int K, int N, bf16_t* WT, LAS float* scr, int item, int lane, const float* kgain = nullptr) {
    const int nblk = N / 32, kb = item / nblk, nb = item % nblk, k0 = 64 * kb, n0 = 32 * nb;
    { f32x4 wv[8];
#pragma unroll
      for (int i = 0; i < 8; ++i) wv[i] = *(const f32x4*)(W + (size_t)(k0 + 8 * i + (lane >> 3)) * N + n0 + 4 * (lane & 7));
#pragma unroll
      for (int i = 0; i < 8; ++i) { const int kk = 8 * i + (lane >> 3); const float gk = kgain ? kgain[k0 + kk] : 1.0f; LAS float* sp = scr + kk * 33 + 4 * (lane & 7);
          sp[0] = gk * wv[i].x; sp[1] = gk * wv[i].y; sp[2] = gk * wv[i].z; sp[3] = gk * wv[i].w; } }
    asm volatile("s_waitcnt lgkmcnt(0)" ::: "memory");
    const int c = lane & 7;
#pragma unroll
    for (int j = 0; j < 4; ++j) { const int n = (lane >> 3) + 8 * j; const LAS float* s = scr + (8 * c) * 33 + n;
        u32x4 o; o.x = pk2(s[0 * 33], s[1 * 33]); o.y = pk2(s[2 * 33], s[3 * 33]); o.z = pk2(s[4 * 33], s[5 * 33]); o.w = pk2(s[6 * 33], s[7 * 33]);
        *(u32x4*)(WT + (size_t)(n0 + n) * K + k0 + 8 * c) = o; }
    asm volatile("s_waitcnt lgkmcnt(0)" ::: "memory");
}
__device__ __forceinline__ void rms_row_to_bf16(const float* xrow, const float* g, bf16_t* orow, int lane) {
    const f32x4* xr = (const f32x4*)xrow + lane;
    f32x4 v[8]; float s = 0.f;
#pragma unroll
    for (int j = 0; j < 8; ++j) { v[j] = xr[64 * j]; s += (v[j].x * v[j].x + v[j].y * v[j].y) + (v[j].z * v[j].z + v[j].w * v[j].w); }
    const float rstd = 1.0f / sqrtf(wave_sum(s) * (1.0f / D) + EPS);
    const f32x4* gr = (const f32x4*)g + lane;
    u32x2* o8 = (u32x2*)orow + lane;
#pragma unroll
    for (int j = 0; j < 8; ++j) { const f32x4 gv = gr[64 * j]; u32x2 o; o.x = pk2(v[j].x * rstd * gv.x, v[j].y * rstd * gv.y); o.y = pk2(v[j].z * rstd * gv.z, v[j].w * rstd * gv.w); o8[64 * j] = o; }
}
__device__ __forceinline__ void cvt_stream(const float* src, bf16_t* dst, size_t n8, size_t gtid, size_t nthr) {
    for (size_t i = gtid; i < n8; i += nthr) { const f32x4 a = ((const f32x4*)src)[2 * i], b = ((const f32x4*)src)[2 * i + 1];
        u32x4 o; o.x = pk2(a.x, a.y); o.y = pk2(a.z, a.w); o.z = pk2(b.x, b.y); o.w = pk2(b.z, b.w); ((u32x4*)dst)[i] = o; }
}

__device__ __forceinline__ void expert_row_load(const float* src, f32x4 (&v)[8], int lane) {
    const f32x4* xr = (const f32x4*)src + lane;
#pragma unroll
    for (int k = 0; k < 8; ++k) v[k] = xr[64 * k];
}
__device__ __forceinline__ void expert_row_gain(f32x4 (&v)[8], const float* g, int lane) {
    const f32x4* gr = (const f32x4*)g + lane;
#pragma unroll
    for (int k = 0; k < 8; ++k) v[k] = v[k] * gr[64 * k];
}
__device__ __forceinline__ void expert_row_store(const f32x4 (&v)[8], unsigned char* dst, float* isc, int lane) {
    float am = 0.f;
#pragma unroll
    for (int k = 0; k < 8; ++k) am = fmaxf(am, fmaxf(fmaxf(fabsf(v[k].x), fabsf(v[k].y)), fmaxf(fabsf(v[k].z), fabsf(v[k].w))));
#pragma unroll
    for (int o = 1; o < 64; o <<= 1) am = fmaxf(am, __shfl_xor(am, o));
    float sc = 1.0f;
    if (am > 0.f) { const float q = fminf(fmaxf(448.0f / am, 1.0e-30f), 1.0e30f); sc = __builtin_bit_cast(float, __builtin_bit_cast(unsigned, q) & 0x7f800000u); }
    unsigned o[8];
#pragma unroll
    for (int k = 0; k < 8; ++k) { int w = __builtin_amdgcn_cvt_pk_fp8_f32(v[k].x * sc, v[k].y * sc, 0, false); w = __builtin_amdgcn_cvt_pk_fp8_f32(v[k].z * sc, v[k].w * sc, w, true); o[k] = (unsigned)w; }
    u32x4 o0, o1; o0.x = o[0]; o0.y = o[1]; o0.z = o[2]; o0.w = o[3]; o1.x = o[4]; o1.y = o[5]; o1.z = o[6]; o1.w = o[7];
    *(u32x4*)(dst + lane * 16) = o0; *(u32x4*)(dst + 1024 + lane * 16) = o1;
    if (lane == 0) *isc = 1.0f / sc;
}

__device__ __forceinline__ void p0_prologue(const Args& a, LAS unsigned char* lds, int vcu, int G, int wave, int lane, int tid) {
    unsigned char* ws = a.ws;
    LAS float* scr = (LAS float*)(lds + wave * 16384);
    const int gw = vcu * NWAVES + wave, NGW = G * NWAVES;
    constexpr int I_IN = (D / 64) * (INW / 32), I_POOL1 = (256 / 64) * (512 / 32), I_G = (GWD / 64) * (D / 32), I_O = (D / 64) * (D / 32), I_Q = I_O;
    constexpr int NITEMS = I_IN + 4 * I_POOL1 + I_G + I_O + I_Q;
    for (int it = gw; it < NITEMS; it += NGW) {
        int r = it;
        if (r < I_IN) { p0_transpose_item(a.in[2], D, INW, (bf16_t*)(ws + WS_WIN), scr, r, lane); continue; } r -= I_IN;
        if (r < 4 * I_POOL1) { const int g = r / I_POOL1; p0_transpose_item(a.in[5] + (size_t)g * 256 * 512, 256, 512, (bf16_t*)(ws + WS_WPOOL) + (size_t)g * 512 * 256, scr, r % I_POOL1, lane); continue; } r -= 4 * I_POOL1;
        if (r < I_G) { p0_transpose_item(a.in[10], GWD, D, (bf16_t*)(ws + WS_WG), scr, r, lane); continue; } r -= I_G;
        if (r < I_O) { p0_transpose_item(a.in[11], D, D, (bf16_t*)(ws + WS_WOUT), scr, r, lane); continue; } r -= I_O;
        p0_transpose_item(a.in[13], D, D, (bf16_t*)(ws + WS_WQ), scr, r, lane, a.in[12]);
    }
    for (int m = gw; m < S; m += NGW) rms_row_to_bf16(a.in[0] + (size_t)m * D, a.in[1], (bf16_t*)(ws + WS_H) + (size_t)m * D, lane);
    const size_t gtid = (size_t)vcu * NTHR + tid, nthr = (size_t)G * NTHR;
    cvt_stream(a.in[14], (bf16_t*)(ws + WS_KEYS), (size_t)8 * 2 * 128 * 128 / 8, gtid, nthr);
    {
        const float* src = a.in[8]; bf16_t* dst = (bf16_t*)(ws + WS_WSM);
        for (size_t i = gtid; i < (size_t)8 * 128 * 128 / 8; i += nthr) { const int s0 = (int)(i & 15) * 8, t = (int)(i >> 4) & 127;
            const f32x4 x0 = ((const f32x4*)src)[2 * i], x1 = ((const f32x4*)src)[2 * i + 1];
            float v[8] = {x0.x, x0.y, x0.z, x0.w, x1.x, x1.y, x1.z, x1.w};
#pragma unroll
            for (int j = 0; j < 8; ++j) v[j] = (s0 + j <= t) ? v[j] : 0.f;
            u32x4 o; o.x = pk2(v[0], v[1]); o.y = pk2(v[2], v[3]); o.z = pk2(v[4], v[5]); o.w = pk2(v[6], v[7]); ((u32x4*)dst)[i] = o; }
    }
}

__device__ __forceinline__ void p2_pool(const Args& a, int vcu, int G, int tid) {
    const bf16_t* Z = (const bf16_t*)(a.ws + WS_Z); bf16_t* A2 = (bf16_t*)(a.ws + WS_A2); const float* psc = a.in[4];
    const size_t gtid = (size_t)vcu * NTHR + tid, nthr = (size_t)G * NTHR;
    for (size_t id = gtid; id < (size_t)(S / 8) * 128; id += nthr) {
        const int c8 = (int)(id & 127), t0 = (int)(id >> 7) * 8, g = c8 >> 5, w = 2 << g;
        u32x4 row[23];
#pragma unroll
        for (int r = 0; r < 23; ++r) { const int t = t0 - 15 + r; const bool need = (r >= 16 - w) && (t >= 0);
            row[r] = need ? *(const u32x4*)(Z + (size_t)t * INW + c8 * 8) : (u32x4){0u, 0u, 0u, 0u}; }
        const f32x4 p0 = *(const f32x4*)(psc + c8 * 8), p1 = *(const f32x4*)(psc + c8 * 8 + 4);
        const float ps[8] = {p0.x, p0.y, p0.z, p0.w, p1.x, p1.y, p1.z, p1.w};
        float s[8] = {0.f, 0.f, 0.f, 0.f, 0.f, 0.f, 0.f, 0.f};
#pragma unroll
        for (int r = 0; r < 15; ++r) { const u32x4 q = row[r];
            s[0] += bflo(q.x); s[1] += bfhi(q.x); s[2] += bflo(q.y); s[3] += bfhi(q.y); s[4] += bflo(q.z); s[5] += bfhi(q.z); s[6] += bflo(q.w); s[7] += bfhi(q.w); }
#pragma unroll
        for (int i = 0; i < 8; ++i) {
            const u32x4 q = row[15 + i];
            const float at[8] = {bflo(q.x), bfhi(q.x), bflo(q.y), bfhi(q.y), bflo(q.z), bfhi(q.z), bflo(q.w), bfhi(q.w)};
#pragma unroll
            for (int c = 0; c < 8; ++c) s[c] += at[c];
            const int t = t0 + i; const int cnt = (t + 1) < w ? (t + 1) : w; const float inv = 1.0f / (float)cnt;
            float o[8];
#pragma unroll
            for (int c = 0; c < 8; ++c) o[c] = (s[c] * inv - at[c]) * ps[c];
            u32x4 w4; w4.x = pk2(o[0], o[1]); w4.y = pk2(o[2], o[3]); w4.z = pk2(o[4], o[5]); w4.w = pk2(o[6], o[7]);
            *(u32x4*)(A2 + (size_t)t * D + c8 * 8) = w4;
            const u32x4 d2 = row[15 + i - 1], d4 = row[15 + i - 3], d8 = row[15 + i - 7], d16 = row[15 + i - 15];
            const u32x4 dq = g == 0 ? d2 : (g == 1 ? d4 : (g == 2 ? d8 : d16));
            s[0] -= bflo(dq.x); s[1] -= bfhi(dq.x); s[2] -= bflo(dq.y); s[3] -= bfhi(dq.y); s[4] -= bflo(dq.z); s[5] -= bfhi(dq.z); s[6] -= bflo(dq.w); s[7] -= bfhi(dq.w);
        }
    }
}
constexpr int VT_LD = 136;
__device__ __forceinline__ void p2_sgu(const Args& a, LAS unsigned char* lds, int vcu, int G, int wave, int lane, int tid) {
    const bf16_t* Z = (const bf16_t*)(a.ws + WS_Z); bf16_t* A2 = (bf16_t*)(a.ws + WS_A2); const bf16_t* WSM = (const bf16_t*)(a.ws + WS_WSM);
    const float* lng = a.in[6]; const float* lnb = a.in[7]; const float* bs = a.in[9];
    LAS float* st = (LAS float*)lds; LAS bf16_t* Vt = (LAS bf16_t*)(lds + 1024);
    const int fr = lane & 15, fq = lane >> 4;
    for (int item = vcu; item < 512; item += G) {
        const int c = item >> 3, h = item & 7, t0 = c * 128;
        u32x4 raw[4][8];
#pragma unroll
        for (int p = 0; p < 4; ++p) { const bf16_t* rp = Z + (size_t)(t0 + wave * 16 + p * 4 + fq) * INW + 2048 + fr * 8;
#pragma unroll
            for (int j = 0; j < 8; ++j) raw[p][j] = *(const u32x4*)(rp + j * 128); }
        u32x4 rawB[4];
#pragma unroll
        for (int q = 0; q < 4; ++q) { const int id = tid + q * NTHR, sr = id & 127, dc = id >> 7; rawB[q] = *(const u32x4*)(Z + (size_t)(t0 + sr) * INW + 2048 + h * 128 + dc * 8); }
        bf16x8 bW[4];
#pragma unroll
        for (int ks = 0; ks < 4; ++ks) bW[ks] = *(const bf16x8*)(WSM + (size_t)(h * 128 + wave * 16 + fr) * 128 + ks * 32 + fq * 8);
        u32x2 ur[8];
#pragma unroll
        for (int db = 0; db < 8; ++db) ur[db] = *(const u32x2*)(Z + (size_t)(t0 + wave * 16 + fr) * INW + 1024 + h * 128 + db * 16 + fq * 4);
        const float bias = bs[h * 128 + wave * 16 + fr];
#pragma unroll
        for (int p = 0; p < 4; ++p) { float s = 0.f, q = 0.f;
#pragma unroll
            for (int j = 0; j < 8; ++j)
#pragma unroll
                for (int w = 0; w < 4; ++w) { const float a0 = bflo(raw[p][j][w]), a1 = bfhi(raw[p][j][w]); s += a0 + a1; q += a0 * a0 + a1 * a1; }
            s = row_sum_f32(s); q = row_sum_f32(q);
            if (fr == 0) { const float mean = s * (1.0f / 1024.0f); const float var = fmaxf(q * (1.0f / 1024.0f) - mean * mean, 0.f);
                const int sr = wave * 16 + p * 4 + fq; st[2 * sr] = mean; st[2 * sr + 1] = 1.0f / sqrtf(var + EPS); } }
        __syncthreads();
#pragma unroll
        for (int q = 0; q < 4; ++q) { const int id = tid + q * NTHR, sr = id & 127, dc = id >> 7;
            const u32x4 rw = rawB[q];
            const float mean = st[2 * sr], rstd = st[2 * sr + 1];
            const float v[8] = {bflo(rw.x), bfhi(rw.x), bflo(rw.y), bfhi(rw.y), bflo(rw.z), bfhi(rw.z), bflo(rw.w), bfhi(rw.w)};
            const f32x4 g0 = *(const f32x4*)(lng + h * 128 + dc * 8), g1 = *(const f32x4*)(lng + h * 128 + dc * 8 + 4), b0 = *(const f32x4*)(lnb + h * 128 + dc * 8), b1 = *(const f32x4*)(lnb + h * 128 + dc * 8 + 4);
            const float gg[8] = {g0.x, g0.y, g0.z, g0.w, g1.x, g1.y, g1.z, g1.w}, bb[8] = {b0.x, b0.y, b0.z, b0.w, b1.x, b1.y, b1.z, b1.w};
#pragma unroll
            for (int i = 0; i < 8; ++i) { const int d = dc * 8 + i; const float y = (v[i] - mean) * rstd * gg[i] + bb[i]; Vt[d * VT_LD + sr] = (bf16_t)f2bf(y); } }
        __syncthreads();
        f32x4 acc[8];
#pragma unroll
        for (int db = 0; db < 8; ++db) acc[db] = (f32x4){0.f, 0.f, 0.f, 0.f};
        const int nks = (wave * 16 + 15) / 32 + 1;
#pragma unroll
        for (int ks = 0; ks < 4; ++ks) if (ks < nks) {
#pragma unroll
            for (int db = 0; db < 8; ++db) { const bf16x8 aV = *(const LAS bf16x8*)(Vt + (db * 16 + fr) * VT_LD + ks * 32 + fq * 8);
                acc[db] = __builtin_amdgcn_mfma_f32_16x16x32_bf16(aV, bW[ks], acc[db], 0, 0, 0); }
        }
        { const int t = t0 + wave * 16 + fr;
#pragma unroll
          for (int db = 0; db < 8; ++db) { const int col = h * 128 + db * 16 + fq * 4;
              u32x2 o; o.x = pk2(bflo(ur[db].x) * (acc[db][0] + bias), bfhi(ur[db].x) * (acc[db][1] + bias)); o.y = pk2(bflo(ur[db].y) * (acc[db][2] + bias), bfhi(ur[db].y) * (acc[db][3] + bias));
              *(u32x2*)(A2 + (size_t)t * D + 1024 + col) = o; } }
        __syncthreads();
    }
}

__device__ __forceinline__ unsigned f2key(float f) { const unsigned b = __builtin_bit_cast(unsigned, f); return (b & 0x80000000u) ? ~b : (b | 0x80000000u); }
__device__ __forceinline__ float key2f(unsigned k) { const unsigned b = (k & 0x80000000u) ? (k ^ 0x80000000u) : ~k; return __builtin_bit_cast(float, b); }
template <int CTRL> __device__ __forceinline__ unsigned dpp_max_u32(unsigned v) { const unsigned o = (unsigned)__builtin_amdgcn_update_dpp(0, (int)v, CTRL, 0xF, 0xF, true); return v > o ? v : o; }
__device__ __forceinline__ unsigned row_max_u32(unsigned v) { v = dpp_max_u32<0xB1>(v); v = dpp_max_u32<0x4E>(v); v = dpp_max_u32<0x141>(v); v = dpp_max_u32<0x140>(v); return v; }
__device__ __forceinline__ void ce_desc(unsigned& a, unsigned& b) { const unsigned hi = a > b ? a : b, lo = a > b ? b : a; a = hi; b = lo; }
__device__ __forceinline__ void sort8_desc(unsigned (&k)[8]) {
    ce_desc(k[0], k[1]); ce_desc(k[2], k[3]); ce_desc(k[4], k[5]); ce_desc(k[6], k[7]);
    ce_desc(k[0], k[2]); ce_desc(k[1], k[3]); ce_desc(k[4], k[6]); ce_desc(k[5], k[7]);
    ce_desc(k[1], k[2]); ce_desc(k[5], k[6]);
    ce_desc(k[0], k[4]); ce_desc(k[1], k[5]); ce_desc(k[2], k[6]); ce_desc(k[3], k[7]);
    ce_desc(k[2], k[4]); ce_desc(k[3], k[5]);
    ce_desc(k[1], k[2]); ce_desc(k[3], k[4]); ce_desc(k[5], k[6]);
}
__device__ __forceinline__ void sort4_desc(unsigned (&k)[4]) { ce_desc(k[0], k[1]); ce_desc(k[2], k[3]); ce_desc(k[0], k[2]); ce_desc(k[1], k[3]); ce_desc(k[1], k[2]); }
template <int NV> __device__ __forceinline__ unsigned row_top16_sorted(unsigned (&k)[NV], int fr) {
    unsigned tk = 0u;
    for (int it = 0; it < 16; ++it) {
        const unsigned m = row_max_u32(k[0]);
        const unsigned wm = (k[0] == m) ? 0xffffffffu : 0u;
#pragma unroll
        for (int i = 0; i + 1 < NV; ++i) k[i] = (k[i + 1] & wm) | (k[i] & ~wm);
        k[NV - 1] = k[NV - 1] & ~wm;
        tk = (fr == it) ? m : tk;
    }
    return tk;
}
__device__ __forceinline__ unsigned cand_table(int fr) {
    constexpr unsigned T[16] = {0x03020100u, 0x07060504u, 0x0b0a0908u, 0x0f0e0d0cu, 0x13121110u, 0x17161514u, 0x23222120u, 0x32313024u, 0x42414033u, 0x61605150u, 0x90807170u, 0xd0c0b0a0u, 0xfffff0e0u, 0xffffffffu, 0xffffffffu, 0xffffffffu};
    unsigned w = T[0];
#pragma unroll
    for (int i = 1; i < 16; ++i) w = (fr == i) ? T[i] : w;
    return w;
}
constexpr int SC_LD = 132;
__device__ __forceinline__ void p7_topk(const Args& a, LAS unsigned char* lds, int vcu, int G, int wave, int lane_) {
    int lane = lane_; asm volatile("" : "+v"(lane));
    const bf16_t* Q = (const bf16_t*)(a.ws + WS_Q); const bf16_t* KEYS = (const bf16_t*)(a.ws + WS_KEYS);
    int* IDX = (int*)(a.ws + WS_IDX); float* GATE = (float*)(a.ws + WS_GATE);
    LAS float* SL = (LAS float*)(lds + wave * (16 * SC_LD * 4));
    const int gw = vcu * NWAVES + wave, NGW = G * NWAVES; const int fr = lane & 15, fq = lane >> 4;
    const unsigned ctab = cand_table(fr);
    int erow = gw;
    f32x4 er0[8], er1[8]; int e0 = 2 * NEXP, e1 = 2 * NEXP;
#define ER_LOAD() do { e0 = erow; e1 = erow + NGW; erow += 2 * NGW; \
        if (e0 < 2 * NEXP) expert_row_load(a.in[15 + (e0 >= NEXP)] + (size_t)(e0 & (NEXP - 1)) * D, er0, lane); \
        if (e1 < 2 * NEXP) expert_row_load(a.in[15 + (e1 >= NEXP)] + (size_t)(e1 & (NEXP - 1)) * D, er1, lane); } while (0)
#define ER_STORE() do { \
        if (e0 < NEXP) expert_row_gain(er0, a.in[12], lane); if (e1 < NEXP) expert_row_gain(er1, a.in[12], lane); \
        if (e0 < 2 * NEXP) expert_row_store(er0, a.ws + ((e0 >= NEXP) ? WS_EV : WS_EU) + (size_t)(e0 & (NEXP - 1)) * D, (float*)(a.ws + WS_ESC) + e0, lane); \
        if (e1 < 2 * NEXP) expert_row_store(er1, a.ws + ((e1 >= NEXP) ? WS_EV : WS_EU) + (size_t)(e1 & (NEXP - 1)) * D, (float*)(a.ws + WS_ESC) + e1, lane); } while (0)
    pg8::StaticOrder so7; so7.init(S, D, G, (int)blockIdx.x); pg8::Unit u7;
    for (int ui = 0; so7.next(ui >> 1, u7); ++ui) {
        const int h = u7.pn, t0 = u7.pm * 256 + ((ui & 1) * 8 + wave) * 16;
        unsigned tk[8];
#pragma unroll
        for (int i = 0; i < 8; ++i) tk[i] = 0u;
#pragma unroll 1
        for (int p = 0; p < 2; ++p) {
            {
                bf16x8 af[4];
#pragma unroll
                for (int ks = 0; ks < 4; ++ks) af[ks] = *(const bf16x8*)(Q + (size_t)(t0 + fr) * D + h * 256 + p * 128 + ks * 32 + fq * 8);
#pragma unroll 1
                for (int g4 = 0; g4 < 2; ++g4) {
                    bf16x8 bf[4][4];
#pragma unroll
                    for (int n4 = 0; n4 < 4; ++n4)
#pragma unroll
                        for (int ks = 0; ks < 4; ++ks) bf[n4][ks] = *(const bf16x8*)(KEYS + (size_t)((h * 2 + p) * 128 + (g4 * 4 + n4) * 16 + fr) * 128 + ks * 32 + fq * 8);
#pragma unroll
                    for (int n4 = 0; n4 < 4; ++n4) { f32x4 c = {0.f, 0.f, 0.f, 0.f};
#pragma unroll
                        for (int ks = 0; ks < 4; ++ks) c = __builtin_amdgcn_mfma_f32_16x16x32_bf16(af[ks], bf[n4][ks], c, 0, 0, 0);
#pragma unroll
                        for (int j = 0; j < 4; ++j) SL[(fq * 4 + j) * SC_LD + (g4 * 4 + n4) * 16 + fr] = c[j]; }
                    asm volatile("" ::: "memory"); }
            }
            ER_LOAD();
#pragma unroll 1
            for (int j = 0; j < 4; ++j) {
                unsigned k[8];
#pragma unroll
                for (int nb = 0; nb < 8; ++nb) k[nb] = (f2key(SL[(fq * 4 + j) * SC_LD + nb * 16 + fr]) & ~127u) | (127u - (unsigned)(nb * 16 + fr));
                sort8_desc(k);
                const unsigned r = row_top16_sorted<8>(k, fr);
#pragma unroll
                for (int i = 0; i < 8; ++i) tk[i] = (i == p * 4 + j) ? r : tk[i];
            }
            ER_STORE();
        }
#pragma unroll 1
        for (int j = 0; j < 4; ++j) {
            if ((j & 1) == 0) ER_LOAD();
            const unsigned tk1 = j == 0 ? tk[0] : (j == 1 ? tk[1] : (j == 2 ? tk[2] : tk[3])), tk2 = j == 0 ? tk[4] : (j == 1 ? tk[5] : (j == 2 ? tk[6] : tk[7]));
            const float t1 = key2f(tk1 & ~127u), t2 = key2f(tk2 & ~127u); const int i1 = 127 - (int)(tk1 & 127u), i2 = 127 - (int)(tk2 & 127u);
            unsigned kc[4];
#pragma unroll
            for (int e = 0; e < 4; ++e) { const unsigned ab = (ctab >> (8 * e)) & 255u; const int ca = (int)(ab >> 4), cb = (int)(ab & 15u);
                const float c = __shfl(t1, (lane & 48) + ca) + __shfl(t2, (lane & 48) + cb);
                kc[e] = (ab == 255u) ? 0u : ((f2key(c) & ~255u) | (255u - ab)); }
            sort4_desc(kc);
            const unsigned tkc = row_top16_sorted<4>(kc, fr);
            const float ts = key2f(tkc & ~255u); const int ci = 255 - (int)(tkc & 255u);
            const int ia = __shfl(i1, (lane & 48) + (ci >> 4)), ib = __shfl(i2, (lane & 48) + (ci & 15));
            const float tmax = __shfl(ts, lane & 48);
            const float e = __expf(ts - tmax); float sum = e;
            sum += __shfl_xor(sum, 1); sum += __shfl_xor(sum, 2); sum += __shfl_xor(sum, 4); sum += __shfl_xor(sum, 8);
            const int t = t0 + fq * 4 + j;
            IDX[(size_t)t * 128 + h * 16 + fr] = ia * 128 + ib;
            GATE[(size_t)t * 128 + h * 16 + fr] = e / sum;
            if ((j & 1) == 1) ER_STORE();
        }
    }
    for (; erow < 2 * NEXP; erow += NGW) { expert_row_load(a.in[15 + (erow >= NEXP)] + (size_t)(erow & (NEXP - 1)) * D, er0, lane); if (erow < NEXP) expert_row_gain(er0, a.in[12], lane);
        expert_row_store(er0, a.ws + ((erow >= NEXP) ? WS_EV : WS_EU) + (size_t)(erow & (NEXP - 1)) * D, (float*)(a.ws + WS_ESC) + erow, lane); }
#undef ER_LOAD
#undef ER_STORE
}

typedef float f32x2 __attribute__((ext_vector_type(2)));
__device__ __forceinline__ u32x4 bl128(__amdgpu_buffer_rsrc_t r, unsigned voff, unsigned soff) { return __builtin_amdgcn_raw_buffer_load_b128(r, voff, soff, 0); }
__device__ __forceinline__ u32x2 bl64(__amdgpu_buffer_rsrc_t r, unsigned voff, unsigned soff) { return __builtin_amdgcn_raw_buffer_load_b64(r, voff, soff, 0); }
__device__ __forceinline__ unsigned bl32(__amdgpu_buffer_rsrc_t r, unsigned voff, unsigned soff) { return __builtin_amdgcn_raw_buffer_load_b32(r, voff, soff, 0); }
__device__ __forceinline__ float wave_sum_dpp(float v) {
    v = dpp_add_f32<0xB1>(v); v = dpp_add_f32<0x4E>(v); v = dpp_add_f32<0x141>(v); v = dpp_add_f32<0x140>(v);
    v += __builtin_bit_cast(float, __builtin_amdgcn_update_dpp(0, __builtin_bit_cast(int, v), 0x142, 0xA, 0xF, false));
    v += __builtin_bit_cast(float, __builtin_amdgcn_update_dpp(0, __builtin_bit_cast(int, v), 0x143, 0xC, 0xF, false));
    return __builtin_bit_cast(float, __builtin_amdgcn_readlane(__builtin_bit_cast(int, v), 63));
}
__device__ __forceinline__ float wave_sum_fast(float v) {
    v = dpp_add_f32<0xB1>(v); v = dpp_add_f32<0x4E>(v); v = dpp_add_f32<0x141>(v); v = dpp_add_f32<0x140>(v);
    v += __shfl_xor(v, 16); v += __shfl_xor(v, 32); return v;
}
constexpr int TPW = 4, NSL = 16, SL_SHIFT = 10, RING = 8, SLOT = 2048;
typedef __bf16 bf16x2_t __attribute__((ext_vector_type(2)));
__device__ __forceinline__ float dot2bf(unsigned a, unsigned b, float c) { return __builtin_amdgcn_fdot2_f32_bf16(__builtin_bit_cast(bf16x2_t, a), __builtin_bit_cast(bf16x2_t, b), c, false); }
constexpr int NROWS = TPW * 128;
#define P8_ISSUE(TBASE) do { const unsigned ro_ = (unsigned)__builtin_amdgcn_readlane(lch_, ii_ & 63) * (unsigned)D; \
        const char* src_ = (const char*)a.ws + (TBASE) + ro_ + l16; LAS unsigned char* dstl_ = ring + (ii_ & (RING - 1)) * SLOT; \
        __builtin_amdgcn_global_load_lds((const unsigned*)src_, (LAS unsigned*)dstl_, 16, 0, 0); \
        __builtin_amdgcn_global_load_lds((const unsigned*)(src_ + 1024), (LAS unsigned*)(dstl_ + 1024), 16, 0, 0); \
        ++ii_; if ((ii_ & 63) == 0) lch_ = (int)LST[ii_ + lane]; } while (0)
#define P8_RING_READ(r0, r1) do { r0 = *(const LAS u32x4*)(ring + (ci_ & (RING - 1)) * SLOT + l16); r1 = *(const LAS u32x4*)(ring + (ci_ & (RING - 1)) * SLOT + 1024 + l16); } while (0)
#define P8_STREAM_INIT(TBASE, r0, r1) int ci_ = 0, ii_ = 0; int lch_ = (int)LST[lane]; \
        asm volatile("s_waitcnt vmcnt(0) lgkmcnt(0)" ::: "memory"); \
        _Pragma("unroll 1") for (int q_ = 0; q_ < RING; ++q_) P8_ISSUE(TBASE); \
        asm volatile("s_waitcnt vmcnt(14)" ::: "memory"); P8_RING_READ(r0, r1)
#define P8_ROW_READY() asm volatile("s_waitcnt lgkmcnt(0)" ::: "memory")
#define P8_ROW_ADVANCE(TBASE, r0, r1) do { ++ci_; P8_ISSUE(TBASE); asm volatile("s_waitcnt vmcnt(14)" ::: "memory"); P8_RING_READ(r0, r1); } while (0)
#define P8_STREAM_END() asm volatile("s_waitcnt vmcnt(0) lgkmcnt(0)" ::: "memory")
static_assert(RING == 8, "the counted wait above is vmcnt(2 * (RING - 1))");
__device__ __forceinline__ void p8_peer(const Args& a, LAS unsigned char* lds, float* dst, int vcu, int G, int wave, int lane_) {
    int lane = lane_; asm volatile("" : "+v"(lane));
    const __amdgpu_buffer_rsrc_t rws = __builtin_amdgcn_make_buffer_rsrc((void*)a.ws, (short)0, (int)WS_END, 0x00020000);
    const __amdgpu_buffer_rsrc_t rdst = __builtin_amdgcn_make_buffer_rsrc((void*)dst, (short)0, S * D * 4, 0x00020000);
    const __amdgpu_buffer_rsrc_t rfg = __builtin_amdgcn_make_buffer_rsrc((void*)a.in[17], (short)0, D * 4, 0x00020000);
    LAS unsigned char* ring = lds + wave * (RING * SLOT);
    LAS unsigned* SLW = (LAS unsigned*)(lds + 132096 + wave * 1280);
    LAS unsigned short* LST = (LAS unsigned short*)SLW;
    const int gw = vcu * NWAVES + wave, NGW = G * NWAVES;
    const unsigned l16 = (unsigned)lane * 16u, l8 = (unsigned)lane * 8u, l4 = (unsigned)lane * 4u;
#pragma unroll 1
    for (int tb = gw; tb < S; tb += TPW * NGW) {
        int sid[TPW][2], offv[TPW]; float act[TPW][2]; int cntv = 0;
#pragma unroll
        for (int k = 0; k < TPW; ++k) {
            const int t = (tb + k * NGW) < S ? (tb + k * NGW) : (S - 1);
            const unsigned oi = (unsigned)(WS_IDX + (size_t)t * 512);
            const int id0 = (int)bl32(rws, l4, oi), id1 = (int)bl32(rws, l4 + 256u, oi);
            const int sl0 = id0 >> SL_SHIFT, sl1 = id1 >> SL_SHIFT;
            int pos0 = 0, pos1 = 0, basec = 0, offacc = 0;
#pragma unroll
            for (int s = 0; s < NSL; ++s) {
                const unsigned long long m0 = __ballot(sl0 == s), m1 = __ballot(sl1 == s);
                const int c0 = __popcll(m0), c1 = __popcll(m1);
                const int b0 = (int)__builtin_amdgcn_mbcnt_hi((unsigned)(m0 >> 32), __builtin_amdgcn_mbcnt_lo((unsigned)m0, 0u));
                const int b1 = (int)__builtin_amdgcn_mbcnt_hi((unsigned)(m1 >> 32), __builtin_amdgcn_mbcnt_lo((unsigned)m1, 0u));
                pos0 = (sl0 == s) ? basec + b0 : pos0; pos1 = (sl1 == s) ? basec + c0 + b1 : pos1;
                basec += c0 + c1; offacc = (lane == s + 1) ? basec : offacc; cntv = (lane == s * TPW + k) ? (c0 + c1) : cntv;
            }
            offv[k] = offacc;
            SLW[pos0] = (unsigned)id0; SLW[pos1] = (unsigned)id1; SLW[128 + pos0] = (unsigned)lane; SLW[128 + pos1] = (unsigned)(64 + lane);
            asm volatile("s_waitcnt lgkmcnt(0)" ::: "memory");
            sid[k][0] = (int)SLW[lane]; sid[k][1] = (int)SLW[64 + lane];
            act[k][0] = __builtin_bit_cast(float, SLW[128 + lane]); act[k][1] = __builtin_bit_cast(float, SLW[192 + lane]);
            asm volatile("s_waitcnt lgkmcnt(0)" ::: "memory");
        }
        {
            int incl = cntv;
#pragma unroll
            for (int o = 1; o < 64; o <<= 1) { const int up = __shfl_up(incl, o); incl += (lane >= o) ? up : 0; }
            const int gb = incl - cntv;
            asm volatile("s_waitcnt lgkmcnt(0)" ::: "memory");
#pragma unroll
            for (int k = 0; k < TPW; ++k)
#pragma unroll
                for (int h = 0; h < 2; ++h) { const int sl = sid[k][h] >> SL_SHIFT;
                    const int p = __shfl(gb, sl * TPW + k) + (h * 64 + lane) - __shfl(offv[k], sl);
                    LST[p] = (unsigned short)sid[k][h]; }
            if (lane < RING) LST[NROWS + lane] = (unsigned short)0;
            asm volatile("s_waitcnt lgkmcnt(0)" ::: "memory");
        }
        int orig[TPW][2];
#pragma unroll
        for (int k = 0; k < TPW; ++k) { orig[k][0] = __builtin_bit_cast(int, act[k][0]); orig[k][1] = __builtin_bit_cast(int, act[k][1]); act[k][0] = 0.f; act[k][1] = 0.f; }
        {
            f32x2 hf[TPW][16];
#pragma unroll
            for (int k = 0; k < TPW; ++k) { const int t = (tb + k * NGW) < S ? (tb + k * NGW) : (S - 1);
#pragma unroll
                for (int kk = 0; kk < 8; ++kk) { const u32x2 w = bl64(rws, l8 + (unsigned)(kk * 512), (unsigned)(WS_H + (size_t)t * (D * 2)));
                    hf[k][kk * 2] = (f32x2){bflo(w.x), bfhi(w.x)}; hf[k][kk * 2 + 1] = (f32x2){bflo(w.y), bfhi(w.y)}; } }
            u32x4 r0, r1;
            P8_STREAM_INIT(WS_EU, r0, r1);
#pragma unroll 1
            for (int s = 0; s < NSL; ++s) {
#pragma unroll
                for (int k = 0; k < TPW; ++k) {
                    const int lo = __builtin_amdgcn_readlane(offv[k], s), hi = __builtin_amdgcn_readlane(offv[k], s + 1);
#pragma unroll 1
                    for (int e = lo; e < hi; ++e) {
                        P8_ROW_READY();
                        f32x2 dd0 = {0.f, 0.f}, dd1 = {0.f, 0.f};
#pragma unroll
                        for (int kk = 0; kk < 4; ++kk) {
                            { const unsigned w = r0[kk]; const f32x2 lo2 = __builtin_amdgcn_cvt_pk_f32_fp8((int)w, false), hi2 = __builtin_amdgcn_cvt_pk_f32_fp8((int)w, true);
                              dd0 = __builtin_elementwise_fma(lo2, hf[k][kk * 2], dd0); dd1 = __builtin_elementwise_fma(hi2, hf[k][kk * 2 + 1], dd1); }
                            { const unsigned w = r1[kk]; const f32x2 lo2 = __builtin_amdgcn_cvt_pk_f32_fp8((int)w, false), hi2 = __builtin_amdgcn_cvt_pk_f32_fp8((int)w, true);
                              dd0 = __builtin_elementwise_fma(lo2, hf[k][8 + kk * 2], dd0); dd1 = __builtin_elementwise_fma(hi2, hf[k][8 + kk * 2 + 1], dd1); } }
                        asm volatile("" : "+v"(dd0), "+v"(dd1));
                        P8_ROW_ADVANCE(WS_EU, r0, r1);
                        const float d = wave_sum_dpp((dd0.x + dd0.y) + (dd1.x + dd1.y));
                        act[k][0] = (lane == e) ? d : act[k][0]; act[k][1] = (lane == e - 64) ? d : act[k][1];
                    }
                }
            }
            P8_STREAM_END();
        }
#pragma unroll
        for (int k = 0; k < TPW; ++k) {
            const int t = (tb + k * NGW) < S ? (tb + k * NGW) : (S - 1);
            const float ssp = lane < 32 ? __builtin_bit_cast(float, bl32(rws, l4, (unsigned)(WS_SS + (size_t)t * 128))) : 0.f;
            const float rstd2 = 1.0f / sqrtf(wave_sum(ssp) * (1.0f / D) + EPS);
            const unsigned og = (unsigned)(WS_GATE + (size_t)t * 512);
#pragma unroll
            for (int h = 0; h < 2; ++h) {
                const float gate = __builtin_bit_cast(float, bl32(rws, (unsigned)orig[k][h] * 4u, og));
                const float su = __builtin_bit_cast(float, bl32(rws, (unsigned)sid[k][h] * 4u, (unsigned)WS_ESC)) * rstd2;
                const float sv = __builtin_bit_cast(float, bl32(rws, (unsigned)sid[k][h] * 4u, (unsigned)(WS_ESC + NEXP * 4)));
                act[k][h] = gelu_tanh(act[k][h] * su) * gate * sv; }
        }
        {
            float acc[TPW][32];
#pragma unroll
            for (int k = 0; k < TPW; ++k)
#pragma unroll
                for (int i = 0; i < 32; ++i) acc[k][i] = 0.f;
            u32x4 r0, r1;
            P8_STREAM_INIT(WS_EV, r0, r1);
#pragma unroll 1
            for (int s = 0; s < NSL; ++s) {
#pragma unroll
                for (int k = 0; k < TPW; ++k) {
                    const int lo = __builtin_amdgcn_readlane(offv[k], s), hi = __builtin_amdgcn_readlane(offv[k], s + 1);
#pragma unroll 1
                    for (int e = lo; e < hi; ++e) {
                        const int a0_ = __builtin_amdgcn_readlane(__builtin_bit_cast(int, act[k][0]), e & 63), a1_ = __builtin_amdgcn_readlane(__builtin_bit_cast(int, act[k][1]), e & 63);
                        const float aw = __builtin_bit_cast(float, e < 64 ? a0_ : a1_);
                        P8_ROW_READY();
#pragma unroll
                        for (int kk = 0; kk < 4; ++kk) {
                            { const unsigned w = r0[kk]; const int bb = kk * 4; const f32x2 lo2 = __builtin_amdgcn_cvt_pk_f32_fp8((int)w, false), hi2 = __builtin_amdgcn_cvt_pk_f32_fp8((int)w, true);
                              acc[k][bb + 0] += aw * lo2.x; acc[k][bb + 1] += aw * lo2.y; acc[k][bb + 2] += aw * hi2.x; acc[k][bb + 3] += aw * hi2.y; }
                            { const unsigned w = r1[kk]; const int bb = 16 + kk * 4; const f32x2 lo2 = __builtin_amdgcn_cvt_pk_f32_fp8((int)w, false), hi2 = __builtin_amdgcn_cvt_pk_f32_fp8((int)w, true);
                              acc[k][bb + 0] += aw * lo2.x; acc[k][bb + 1] += aw * lo2.y; acc[k][bb + 2] += aw * hi2.x; acc[k][bb + 3] += aw * hi2.y; } }
                        asm volatile("" : "+v"(acc[k][0]), "+v"(acc[k][16]));
                        P8_ROW_ADVANCE(WS_EV, r0, r1);
                    }
                }
            }
            P8_STREAM_END();
#pragma unroll
            for (int k = 0; k < TPW; ++k) { const int t = tb + k * NGW;
                if (t < S) {
                    float ss = 0.f; const unsigned ot = (unsigned)t * (unsigned)(D * 4);
#pragma unroll
                    for (int kk = 0; kk < 8; ++kk) { const u32x2 xw = bl64(rws, l8 + (unsigned)(kk * 512), (unsigned)(WS_H + (size_t)t * (D * 2)));
                        acc[k][kk * 4 + 0] += bflo(xw.x); acc[k][kk * 4 + 1] += bfhi(xw.x); acc[k][kk * 4 + 2] += bflo(xw.y); acc[k][kk * 4 + 3] += bfhi(xw.y);
                        ss += (acc[k][kk * 4 + 0] * acc[k][kk * 4 + 0] + acc[k][kk * 4 + 1] * acc[k][kk * 4 + 1]) + (acc[k][kk * 4 + 2] * acc[k][kk * 4 + 2] + acc[k][kk * 4 + 3] * acc[k][kk * 4 + 3]); }
                    const float rstd = 1.0f / sqrtf(wave_sum(ss) * (1.0f / D) + EPS);
#pragma unroll
                    for (int kk = 0; kk < 8; ++kk) { const f32x4 f0 = __builtin_bit_cast(f32x4, bl128(rfg, l16 + (unsigned)((kk & 3) * 1024), (unsigned)((kk >> 2) * 4096)));
                        f32x4 o0; o0.x = acc[k][kk * 4 + 0] * rstd * f0.x; o0.y = acc[k][kk * 4 + 1] * rstd * f0.y; o0.z = acc[k][kk * 4 + 2] * rstd * f0.z; o0.w = acc[k][kk * 4 + 3] * rstd * f0.w;
                        __builtin_amdgcn_raw_buffer_store_b128(__builtin_bit_cast(u32x4, o0), rdst, l16 + (unsigned)((kk & 3) * 1024), ot + (unsigned)((kk >> 2) * 4096), 0); }
                }
            }
        }
    }
}

#define XB_TMO      128
#define XB_XCNT(j)  (256  + 64 * (j))
#define XB_XSUB(j)  (1280 + 64 * (j))
#define XB_XGEN(j)  (2304 + 64 * (j))
#define XB_TOP      3328
#define XB_TOPGEN   3392
#define XCD_BAR_WORDS 3456
#define XB_SPIN_CAP (1u << 22)
__device__ __forceinline__ unsigned xb_ld(unsigned* p)              { return __hip_atomic_load(p, __ATOMIC_RELAXED, __HIP_MEMORY_SCOPE_AGENT); }
__device__ __forceinline__ unsigned xb_add(unsigned* p, unsigned v) { return __hip_atomic_fetch_add(p, v, __ATOMIC_RELAXED, __HIP_MEMORY_SCOPE_AGENT); }
__device__ __forceinline__ unsigned xb_xcc_id() { return (unsigned)__builtin_amdgcn_s_getreg((3 << 11) | 20) & 0xFu; }
#define XB_SPIN(cond, bar) do { unsigned _sp = 0; while (cond) { __builtin_amdgcn_s_sleep(1); \
    if ((++_sp & 255u) == 0u) { if (xb_ld(&(bar)[XB_TMO])) break; if (_sp > XB_SPIN_CAP) { atomicAdd(&(bar)[XB_TMO], 1u); break; } } } } while (0)
struct XcdBarrier { unsigned* bar; unsigned x; volatile LAS unsigned* st; };
__device__ __forceinline__ XcdBarrier xcd_barrier_post(unsigned* bar, volatile LAS unsigned* st) {
    XcdBarrier b; b.bar = bar; b.x = xb_xcc_id(); b.st = st;
    if (threadIdx.x == 0) (void)xb_add(&bar[XB_XCNT(b.x)], 1u);
    return b;
}
__device__ __forceinline__ void xcd_barrier_complete(unsigned* bar, unsigned x, unsigned G, unsigned& nloc, unsigned& nx) {
    unsigned sum, cnt, mine, sp = 0u;
    for (;;) {
        sum = 0u; cnt = 0u; mine = 0u;
#pragma unroll
        for (unsigned j = 0; j < 16; ++j) { const unsigned c = xb_ld(&bar[XB_XCNT(j)]); sum += c; cnt += (c > 0u) ? 1u : 0u; mine = (j == x) ? c : mine; }
        if (sum == G) break;
        __builtin_amdgcn_s_sleep(1);
        if ((++sp & 255u) == 0u) { if (xb_ld(&bar[XB_TMO])) break; if (sp > XB_SPIN_CAP) { atomicAdd(&bar[XB_TMO], 1u); break; } }
    }
    nloc = mine > 0u ? mine : 1u; nx = cnt > 0u ? cnt : 1u;
}
__device__ __forceinline__ void xcd_barrier(const XcdBarrier& b, unsigned G) {
    asm volatile("s_waitcnt vmcnt(0)" ::: "memory");
    __syncthreads();
    if (threadIdx.x == 0) {
        unsigned* bar = b.bar;
        __builtin_amdgcn_s_waitcnt(0);
        unsigned nloc = b.st[0], nx = b.st[1];
        if (nloc == 0u) { xcd_barrier_complete(bar, b.x, G, nloc, nx); b.st[0] = nloc; b.st[1] = nx; }
        const unsigned old = xb_add(&bar[XB_XSUB(b.x)], 1u);
        const unsigned gen = old / nloc;
        if (old + 1u == (gen + 1u) * nloc) {
            __builtin_amdgcn_fence(__ATOMIC_RELEASE, "agent");
            asm volatile("s_waitcnt vmcnt(0)" ::: "memory");
            const unsigned og = xb_add(&bar[XB_TOP], 1u);
            const unsigned tg = og / nx;
            if (og + 1u == (tg + 1u) * nx) xb_add(&bar[XB_TOPGEN], 1u);
            else XB_SPIN(xb_ld(&bar[XB_TOPGEN]) == tg, bar);
            __builtin_amdgcn_fence(__ATOMIC_ACQUIRE, "agent");
            xb_add(&bar[XB_XGEN(b.x)], 1u);
            asm volatile("s_waitcnt vmcnt(0)" ::: "memory");
        } else {
            XB_SPIN(xb_ld(&bar[XB_XGEN(b.x)]) == gen, bar);
            __builtin_amdgcn_fence(__ATOMIC_ACQUIRE, "agent");
            asm volatile("s_waitcnt vmcnt(0)" ::: "memory");
        }
    }
    __syncthreads();
}

constexpr int N_PHASES = 9;
#ifndef DUP_MASK
#define DUP_MASK 0
#endif
#define REP(k) for (int rep_ = 0; rep_ < 1 + ((DUP_MASK >> (k)) & 1); ++rep_)
__global__ void __launch_bounds__(NTHR, 2) fwd(Args args) {
    extern __shared__ __attribute__((aligned(16))) unsigned char lds_raw[];
    LAS unsigned char* lds = (LAS unsigned char*)lds_raw;
    const int tid = threadIdx.x, lane = tid & 63, wave = __builtin_amdgcn_readfirstlane(tid >> 6);
    const int G = gridDim.x; const int bx = blockIdx.x; const int vcu = (G % 8 == 0) ? (bx % 8) * (G / 8) + bx / 8 : bx;
    unsigned char* ws = args.ws;
    const int lo = args.ph_lo, hi = args.ph_hi;
#define IN(k) (lo <= (k) && (k) < hi)
    volatile LAS unsigned* MISC = (volatile LAS unsigned*)(lds + MISC_OFF);
    if (tid < 32) MISC[tid] = 0u;
    __syncthreads();
#if USE_CG_SYNC
    if (IN(0) && bx * NTHR + tid < XCD_BAR_WORDS) __hip_atomic_store((unsigned*)(ws + WS_CTL) + bx * NTHR + tid, 0u, __ATOMIC_RELAXED, __HIP_MEMORY_SCOPE_AGENT);
    XcdBarrier bar; bar.bar = (unsigned*)(ws + WS_CTL); bar.x = 0; bar.st = MISC + 8;
#else
    XcdBarrier bar = xcd_barrier_post((unsigned*)(ws + WS_CTL), MISC + 8);
#endif
#if USE_CG_SYNC
#define SEAM(k) do { if (IN(k) && IN((k) + ((k) == 4 ? 2 : 1))) { if ((k) == 0) { cg::this_grid().sync(); bar = xcd_barrier_post((unsigned*)(ws + WS_CTL), MISC + 8); } else xcd_barrier(bar, (unsigned)G); } } while (0)
#else
#define SEAM(k) do { if (IN(k) && IN((k) + ((k) == 4 ? 2 : 1))) { xcd_barrier(bar, (unsigned)G); } } while (0)
#endif

    if (IN(0)) REP(0) { p0_prologue(args, lds, vcu, G, wave, lane, tid); }
    SEAM(0);
    if (IN(1)) REP(1) {
        pg8::Gemm g{(const bf16_t*)(ws + WS_H), (const bf16_t*)(ws + WS_WIN), S, INW, D, D, D, 0}; pg8::StaticOrder so; so.init(S, INW, G, bx);
        pg8::EpiZ E{(bf16_t*)(ws + WS_Z), args.in[3]};
        pg8::gemm_phase<pg8::EpiZ>(lds, g, so, E);
    }
    SEAM(1);
    if (IN(2)) REP(2) { p2_pool(args, vcu, G, tid); p2_sgu(args, lds, vcu, G, wave, lane, tid); }
    SEAM(2);
    if (IN(3)) REP(3) {
        pg8::StaticOrder so; so.init(S, D, G, bx);
        { pg8::Gemm g{(const bf16_t*)(ws + WS_A2), (const bf16_t*)(ws + WS_WPOOL), S, D, 256, D, 256, 1};
          pg8::EpiPool E{(bf16_t*)(ws + WS_T), (const bf16_t*)(ws + WS_Z)};
          pg8::gemm_phase<pg8::EpiPool>(lds, g, so, E); }
        asm volatile("s_waitcnt vmcnt(0)" ::: "memory"); __syncthreads();
        { pg8::Gemm g{(const bf16_t*)(ws + WS_A2) + 1024, (const bf16_t*)(ws + WS_WG), S, D, GWD, D, GWD, 0};
          pg8::EpiMerge E{(const bf16_t*)(ws + WS_T), (const bf16_t*)(ws + WS_Z), (bf16_t*)(ws + WS_MRG)};
          pg8::gemm_phase<pg8::EpiMerge>(lds, g, so, E); }
    }
    SEAM(3);
    if (IN(4)) REP(4) {
        pg8::Gemm g{(const bf16_t*)(ws + WS_MRG), (const bf16_t*)(ws + WS_WOUT), S, D, D, D, D, 0}; pg8::StaticOrder so; so.init(S, D, G, bx);
        pg8::EpiX1 E{args.in[0], (bf16_t*)(ws + WS_H), (float*)(ws + WS_SS)};
        pg8::gemm_phase<pg8::EpiX1>(lds, g, so, E);
    }
    SEAM(4);
    if (IN(6)) REP(6) {
        pg8::Gemm g{(const bf16_t*)(ws + WS_H), (const bf16_t*)(ws + WS_WQ), S, D, D, D, D, 0}; pg8::StaticOrder so; so.init(S, D, G, bx);
        pg8::EpiQ E{(bf16_t*)(ws + WS_Q), (const float*)(ws + WS_SS)};
        pg8::gemm_phase<pg8::EpiQ>(lds, g, so, E);
    }
    if (IN(6) && IN(7)) { asm volatile("s_waitcnt vmcnt(0)" ::: "memory"); __syncthreads(); }
    if (IN(7)) REP(7) { p7_topk(args, lds, vcu, G, wave, lane); }
    SEAM(7);
    if (IN(8)) REP(8) { float* dst8 = (rep_ < ((DUP_MASK >> 8) & 1)) ? (float*)(ws + WS_T) : args.out; p8_peer(args, lds, dst8, vcu, G, wave, lane); }
#undef IN
#undef SEAM
}

extern "C" void kernel_launch(void* const* d_in, const int* in_sizes, int n_in, void* d_out, int out_size, void* d_ws, size_t ws_size, hipStream_t stream) {
    static int grid = 0;
    if (grid == 0) {
        if (n_in != 18 || out_size != S * D || ws_size < WS_END) { fprintf(stderr, "kernel_launch: unexpected shapes (n_in %d, out %d, ws %zu)\n", n_in, out_size, ws_size); grid = -1; return; }
        int dev = 0, cus = 0, per_cu = 0;
        if (hipGetDevice(&dev) != hipSuccess || hipDeviceGetAttribute(&cus, hipDeviceAttributeMultiprocessorCount, dev) != hipSuccess) { grid = -1; return; }
        if (hipFuncSetAttribute((const void*)fwd, hipFuncAttributeMaxDynamicSharedMemorySize, LDS_BYTES) != hipSuccess) { fprintf(stderr, "kernel_launch: hipFuncSetAttribute failed\n"); grid = -1; return; }
        if (hipOccupancyMaxActiveBlocksPerMultiprocessor(&per_cu, (const void*)fwd, NTHR, LDS_BYTES) != hipSuccess || per_cu < 1) { fprintf(stderr, "kernel_launch: occupancy query says %d\n", per_cu); per_cu = 1; }
        (void)hipGetLastError();
        grid = cus;
    }
    if (grid < 0) return;
#if !USE_CG_SYNC
    if (hipMemsetAsync((char*)d_ws + WS_CTL, 0, 16384, stream) != hipSuccess) { fprintf(stderr, "kernel_launch: memset failed\n"); return; }
#endif
    Args a{};
    for (int i = 0; i < 18; ++i) a.in[i] = (const float*)d_in[i];
    a.out = (float*)d_out; a.ws = (unsigned char*)d_ws;
#if MK_N_LAUNCHES == 1
    a.ph_lo = 0; a.ph_hi = N_PHASES;
    void* kargs[] = {&a};
    hipError_t e = hipLaunchCooperativeKernel((const void*)fwd, dim3(grid), dim3(NTHR), kargs, LDS_BYTES, stream);
    if (e != hipSuccess) fprintf(stderr, "kernel_launch: cooperative launch failed: %s (grid %d)\n", hipGetErrorString(e), grid);
#else
    for (int p = 0; p < N_PHASES; ++p) {
        a.ph_lo = p; a.ph_hi = p + 1;
        hipLaunchKernelGGL(fwd, dim3(grid), dim3(NTHR), LDS_BYTES, stream, a);
    }
#endif
}
```

```cpp
#include <hip/hip_runtime.h>
#include <hip/hip_cooperative_groups.h>
#include <cstdio>
#include <cstdint>
namespace cg = cooperative_groups;

#ifndef USE_CG_SYNC
#define USE_CG_SYNC 1
#endif
#ifndef MK_N_LAUNCHES
#define MK_N_LAUNCHES 1
#endif

#define LAS __attribute__((address_space(3)))
typedef unsigned short bf16_t;
typedef short bf16x8 __attribute__((ext_vector_type(8)));
typedef float f32x4 __attribute__((ext_vector_type(4)));
typedef unsigned u32x4 __attribute__((ext_vector_type(4)));
typedef unsigned u32x2 __attribute__((ext_vector_type(2)));

constexpr int S = 8192, D = 2048, INW = 7168, PW = 1024, GWD = 1024;
constexpr int NEXP = 16384;
constexpr float EPS = 1e-6f;
constexpr int NWAVES = 8, NTHR = 512;

constexpr size_t MiB = 1u << 20;
constexpr size_t WS_CTL = 0;
constexpr size_t WS_WIN = 1 * MiB;
constexpr size_t WS_WPOOL = 30 * MiB;
constexpr size_t WS_WG = 31 * MiB;
constexpr size_t WS_WOUT = 35 * MiB;
constexpr size_t WS_WQ = 43 * MiB;
constexpr size_t WS_KEYS = 51 * MiB;
constexpr size_t WS_WSM = 52 * MiB;
constexpr size_t WS_H = 53 * MiB;
constexpr size_t WS_Z = 85 * MiB;
constexpr size_t WS_A2 = 197 * MiB;
constexpr size_t WS_T = 229 * MiB;
constexpr size_t WS_MRG = 293 * MiB;
constexpr size_t WS_Q = 325 * MiB;
constexpr size_t WS_IDX = 357 * MiB;
constexpr size_t WS_GATE = 361 * MiB;
constexpr size_t WS_SS = 365 * MiB;
constexpr size_t WS_ESC = 369 * MiB;
constexpr size_t WS_EU = 370 * MiB;
constexpr size_t WS_EV = 402 * MiB;
constexpr size_t WS_XB = 434 * MiB;
constexpr size_t WS_END = 466 * MiB;

constexpr int LDS_BYTES = 147456;
constexpr int MISC_OFF = 131072 + 320;

__device__ __forceinline__ unsigned f2bf(float f) { unsigned u = __builtin_bit_cast(unsigned, f); return (u + 0x7fffu + ((u >> 16) & 1u)) >> 16; }
__device__ __forceinline__ unsigned pk2(float lo, float hi) { return f2bf(lo) | (f2bf(hi) << 16); }
__device__ __forceinline__ float bflo(unsigned w) { return __builtin_bit_cast(float, w << 16); }
__device__ __forceinline__ float bfhi(unsigned w) { return __builtin_bit_cast(float, w & 0xffff0000u); }
__device__ __forceinline__ float wave_sum(float v) {
#pragma unroll
    for (int o = 1; o < 64; o <<= 1) v += __shfl_xor(v, o);
    return v;
}
template <int CTRL> __device__ __forceinline__ float dpp_add_f32(float v) { return v + __builtin_bit_cast(float, __builtin_amdgcn_update_dpp(0, __builtin_bit_cast(int, v), CTRL, 0xF, 0xF, true)); }
__device__ __forceinline__ float row_sum_f32(float v) { v = dpp_add_f32<0xB1>(v); v = dpp_add_f32<0x4E>(v); v = dpp_add_f32<0x141>(v); v = dpp_add_f32<0x140>(v); return v; }
__device__ __forceinline__ float gelu_tanh(float x) {
    const float y = 1.5957691216057308f * (x + 0.044715f * x * x * x);
    const float e = __builtin_amdgcn_exp2f(-y * 1.4426950408889634f);
    return x * __builtin_amdgcn_rcpf(1.0f + e);
}
__device__ __forceinline__ float sigmoidf_(float x) { return __builtin_amdgcn_rcpf(1.0f + __builtin_amdgcn_exp2f(-x * 1.4426950408889634f)); }

namespace pg8 {
constexpr int BM = 256, BK = 64, HALF = 128, HTB = HALF * BK * 2, STAGE_BYTES = 8 * HTB, NXCD = 8, WGM = 1;
__host__ __device__ __forceinline__ int lds_byte(int r, int c) { const int st = (r >> 4) * 2 + (c >> 5), rr = r & 15, cc = c & 31, ob = rr * 64 + cc * 2; return st * 1024 + (ob ^ (((ob >> 9) & 1) << 5)); }
__host__ __device__ __forceinline__ void stage_rc(int b, int& R, int& C) { const int st = b / 1024, sb = b % 1024, swz = sb ^ (((sb >> 9) & 1) << 5); R = (st >> 1) * 16 + swz / 64; C = (st & 1) * 32 + (swz % 64) / 2; }
__host__ __device__ __forceinline__ int perm32(int rho) { const int n = rho >> 4, i = rho & 15; return 8 * (i >> 2) + 4 * n + (i & 3); }

struct Unit { int pm, pn; };
struct Gemm { const bf16_t* A; const bf16_t* Bt; int M, N, K, lda, ldb, mode; };
__device__ __forceinline__ const char* a_ptr(const Gemm& g, const Unit& u) {
    size_t off = (size_t)u.pm * BM * g.lda; if (g.mode == 1) off += (size_t)(u.pn >> 1) * 256; return (const char*)(g.A + off); }
__device__ __forceinline__ const char* b_ptr(const Gemm& g, const Unit& u) {
    size_t off = (g.mode == 1) ? ((size_t)(u.pn >> 1) * 512 * 256 + (size_t)(u.pn & 1) * 256 * 256) : (size_t)u.pn * BM * g.ldb; return (const char*)(g.Bt + off); }

struct StaticOrder {
    int nM, nN, nwg, G, c;
    __host__ __device__ void init(int M, int N, int G_, int c_) { nM = M / BM; nN = N / BM; nwg = nM * nN; G = G_; c = c_; }
    __host__ __device__ bool next(int i, Unit& u) const {
        const long L = (long)i * G + c; if (L >= nwg) return false;
        int wgid = (int)L; { const int q = nwg / NXCD, r = nwg % NXCD, xcd = wgid % NXCD, off = wgid / NXCD; wgid = (xcd < r ? xcd * (q + 1) : r * (q + 1) + (xcd - r) * q) + off; }
        const int nig = WGM * nN, gid = wgid / nig, fm = gid * WGM, gsz = (nM - fm) < WGM ? (nM - fm) : WGM;
        u.pm = fm + ((wgid % nig) % gsz); u.pn = (wgid % nig) / gsz; return true;
    }
};

__device__ __forceinline__ unsigned cvt_pk_bf16(float lo, float hi) { unsigned r; asm volatile("v_cvt_pk_bf16_f32 %0, %1, %2" : "=v"(r) : "v"(lo), "v"(hi)); return r; }


struct EpiZ {
    static constexpr bool PERM = true;
    bf16_t* Z; const float* b_gate;
    __device__ __forceinline__ void operator()(const f32x4 (&acc)[2][2][4][2], const Unit& u, int wr, int wc, int fr, int fq) const {
        const int row0 = u.pm * BM + wr * 64 + fr, col0 = u.pn * BM + wc * 32 + 8 * fq;
        const int mode = u.pn < 4 ? 0 : (u.pn < 12 ? 1 : 2);
        f32x4 bv[2][2];
#pragma unroll
        for (int bj = 0; bj < 2; ++bj)
#pragma unroll
            for (int n = 0; n < 2; ++n) bv[bj][n] = (mode == 2) ? *(const f32x4*)(b_gate + (col0 - 3072) + bj * HALF + 4 * n) : (f32x4){0.f, 0.f, 0.f, 0.f};
#pragma unroll
        for (int ai = 0; ai < 2; ++ai)
#pragma unroll
            for (int m = 0; m < 4; ++m) { bf16_t* rowp = Z + (size_t)(row0 + ai * HALF + m * 16) * INW + col0;
#pragma unroll
                for (int bj = 0; bj < 2; ++bj) { f32x4 v0 = acc[ai][bj][m][0], v1 = acc[ai][bj][m][1];
                    if (mode == 1) {
#pragma unroll
                        for (int j = 0; j < 4; ++j) { v0[j] = gelu_tanh(v0[j]); v1[j] = gelu_tanh(v1[j]); } }
                    if (mode == 2) { v0 += bv[bj][0]; v1 += bv[bj][1];
#pragma unroll
                        for (int j = 0; j < 4; ++j) { v0[j] = sigmoidf_(v0[j]); v1[j] = sigmoidf_(v1[j]); } }
                    u32x4 w; w.x = cvt_pk_bf16(v0[0], v0[1]); w.y = cvt_pk_bf16(v0[2], v0[3]); w.z = cvt_pk_bf16(v1[0], v1[1]); w.w = cvt_pk_bf16(v1[2], v1[3]);
                    *(u32x4*)(rowp + bj * HALF) = w; } }
    }
};
struct EpiPool {
    static constexpr bool PERM = true;
    bf16_t* T; const bf16_t* Z;
    __device__ __forceinline__ void operator()(const f32x4 (&acc)[2][2][4][2], const Unit& u, int wr, int wc, int fr, int fq) const {
        const int row0 = u.pm * BM + wr * 64 + fr, col0 = u.pn * BM + wc * 32 + 8 * fq;
#pragma unroll
        for (int ai = 0; ai < 2; ++ai)
#pragma unroll
            for (int m = 0; m < 4; ++m) { const size_t row = (size_t)(row0 + ai * HALF + m * 16);
#pragma unroll
                for (int bj = 0; bj < 2; ++bj) { const int c = col0 + bj * HALF;
                    const u32x4 g = *(const u32x4*)(Z + row * INW + 3072 + c);
                    const f32x4 a0 = acc[ai][bj][m][0], a1 = acc[ai][bj][m][1];
                    u32x4 w; w.x = cvt_pk_bf16(bflo(g.x) * a0[0], bfhi(g.x) * a0[1]); w.y = cvt_pk_bf16(bflo(g.y) * a0[2], bfhi(g.y) * a0[3]);
                    w.z = cvt_pk_bf16(bflo(g.z) * a1[0], bfhi(g.z) * a1[1]); w.w = cvt_pk_bf16(bflo(g.w) * a1[2], bfhi(g.w) * a1[3]);
                    *(u32x4*)(T + row * D + c) = w; asm volatile("" ::: "memory"); } }
    }
};
struct EpiMerge {
    static constexpr bool PERM = true;
    const bf16_t* T; const bf16_t* Z; bf16_t* O;
    __device__ __forceinline__ void operator()(const f32x4 (&acc)[2][2][4][2], const Unit& u, int wr, int wc, int fr, int fq) const {
        const int row0 = u.pm * BM + wr * 64 + fr, col0 = u.pn * BM + wc * 32 + 8 * fq;
#pragma unroll
        for (int ai = 0; ai < 2; ++ai)
#pragma unroll
            for (int m = 0; m < 4; ++m) { const size_t row = (size_t)(row0 + ai * HALF + m * 16);
#pragma unroll
                for (int bj = 0; bj < 2; ++bj) { const int c = col0 + bj * HALF;
                    const u32x4 g = *(const u32x4*)(Z + row * INW + 5120 + c);
                    const u32x4 t = *(const u32x4*)(T + row * D + c);
                    const f32x4 a0 = acc[ai][bj][m][0], a1 = acc[ai][bj][m][1];
                    u32x4 w; w.x = cvt_pk_bf16(bflo(t.x) + bflo(g.x) * a0[0], bfhi(t.x) + bfhi(g.x) * a0[1]); w.y = cvt_pk_bf16(bflo(t.y) + bflo(g.y) * a0[2], bfhi(t.y) + bfhi(g.y) * a0[3]);
                    w.z = cvt_pk_bf16(bflo(t.z) + bflo(g.z) * a1[0], bfhi(t.z) + bfhi(g.z) * a1[1]); w.w = cvt_pk_bf16(bflo(t.w) + bflo(g.w) * a1[2], bfhi(t.w) + bfhi(g.w) * a1[3]);
                    *(u32x4*)(O + row * D + c) = w; asm volatile("" ::: "memory"); } }
    }
};
struct EpiX1 {
    static constexpr bool PERM = true;
    const float* X; bf16_t* XB; float* SS;
    __device__ __forceinline__ void operator()(const f32x4 (&acc)[2][2][4][2], const Unit& u, int wr, int wc, int fr, int fq) const {
        const int row0 = u.pm * BM + wr * 64 + fr, col0 = u.pn * BM + wc * 32 + 8 * fq;
#pragma unroll
        for (int ai = 0; ai < 2; ++ai)
#pragma unroll
            for (int m = 0; m < 4; ++m) { const size_t row = (size_t)(row0 + ai * HALF + m * 16); float ss = 0.f;
#pragma unroll
                for (int bj = 0; bj < 2; ++bj) { const size_t off = row * D + col0 + bj * HALF;
                    const f32x4 x0 = *(const f32x4*)(X + off) + acc[ai][bj][m][0], x1 = *(const f32x4*)(X + off + 4) + acc[ai][bj][m][1];
                    ss += (x0[0] * x0[0] + x0[1] * x0[1]) + (x0[2] * x0[2] + x0[3] * x0[3]) + (x1[0] * x1[0] + x1[1] * x1[1]) + (x1[2] * x1[2] + x1[3] * x1[3]);
                    u32x4 w; w.x = cvt_pk_bf16(x0[0], x0[1]); w.y = cvt_pk_bf16(x0[2], x0[3]); w.z = cvt_pk_bf16(x1[0], x1[1]); w.w = cvt_pk_bf16(x1[2], x1[3]);
                    *(u32x4*)(XB + off) = w; }
                ss += __shfl_xor(ss, 16); ss += __shfl_xor(ss, 32);
                if (fq == 0) SS[row * 32 + u.pn * 4 + wc] = ss;
                asm volatile("" ::: "memory"); }
    }
};
struct EpiQ {
    static constexpr bool PERM = true;
    bf16_t* O; const float* SS;
    __device__ __forceinline__ void operator()(const f32x4 (&acc)[2][2][4][2], const Unit& u, int wr, int wc, int fr, int fq) const {
        const int row0 = u.pm * BM + wr * 64 + fr, col0 = u.pn * BM + wc * 32 + 8 * fq;
#pragma unroll
        for (int ai = 0; ai < 2; ++ai)
#pragma unroll
            for (int m = 0; m < 4; ++m) { const size_t row = (size_t)(row0 + ai * HALF + m * 16);
                const f32x4 p0 = *(const f32x4*)(SS + row * 32 + fq * 8), p1 = *(const f32x4*)(SS + row * 32 + fq * 8 + 4);
                float ss = ((p0[0] + p0[1]) + (p0[2] + p0[3])) + ((p1[0] + p1[1]) + (p1[2] + p1[3]));
                ss += __shfl_xor(ss, 16); ss += __shfl_xor(ss, 32);
                const float rstd = 1.0f / sqrtf(ss * (1.0f / D) + EPS);
                bf16_t* rowp = O + row * D + col0;
#pragma unroll
                for (int bj = 0; bj < 2; ++bj) { const f32x4 v0 = acc[ai][bj][m][0] * rstd, v1 = acc[ai][bj][m][1] * rstd;
                    u32x4 w; w.x = cvt_pk_bf16(v0[0], v0[1]); w.y = cvt_pk_bf16(v0[2], v0[3]); w.z = cvt_pk_bf16(v1[0], v1[1]); w.w = cvt_pk_bf16(v1[2], v1[3]);
                    *(u32x4*)(rowp + bj * HALF) = w; } }
    }
};

template <class Epi, bool ALIGN_EPI = true>
__device__ __forceinline__ void gemm_phase(LAS unsigned char* lds, const Gemm g, const StaticOrder& S_, const Epi& E) {
    int tid_ = threadIdx.x; asm volatile("" : "+v"(tid_));
    const int tid = tid_, wid = __builtin_amdgcn_readfirstlane(tid >> 6), lane = tid & 63, wr = wid >> 2, wc = wid & 3, fr = lane & 15, fq = lane >> 4;
    const int K = g.K, nt = K / BK;
    unsigned voffA[2], voffB[2];
#pragma unroll
    for (int i = 0; i < 2; ++i) { int R, C; stage_rc(tid * 16 + i * 8192, R, C); const int Rb = Epi::PERM ? ((R & ~31) + perm32(R & 31)) : R;
        voffA[i] = (unsigned)(R * g.lda + C) * 2u; voffB[i] = (unsigned)(Rb * g.ldb + C) * 2u; }
    const size_t kstep = (size_t)(BK * 2);
    const size_t hstepA = (size_t)HALF * g.lda * 2, hstepB = (size_t)HALF * g.ldb * 2;
    const unsigned ldsw = (unsigned)wid * 1024u;
    const int aoff = lds_byte(wr * 64 + fr, fq * 8), boff = lds_byte(wc * 32 + fr, fq * 8);
#define PG8_SA(b, h) (((b) * 2 + (h)) * HTB)
#define PG8_SB(b, h) ((4 + (b) * 2 + (h)) * HTB)
#define PG8_STAGE(bufoff, gbase, voff) do { _Pragma("unroll") for (int _i = 0; _i < 2; ++_i) \
        __builtin_amdgcn_global_load_lds((const unsigned*)((const char*)(gbase) + (voff)[_i]), (LAS unsigned*)(lds + (bufoff) + ldsw + _i * 8192), 16, 0, 0); } while (0)
#define PG8_LDA(dst, b, h) do { _Pragma("unroll") for (int m = 0; m < 4; ++m) _Pragma("unroll") for (int k = 0; k < 2; ++k) dst[m][k] = *(const LAS bf16x8*)(lds + PG8_SA(b, h) + aoff + m * 2048 + k * 1024); } while (0)
#define PG8_LDB(dst, b, h) do { _Pragma("unroll") for (int n = 0; n < 2; ++n) _Pragma("unroll") for (int k = 0; k < 2; ++k) dst[n][k] = *(const LAS bf16x8*)(lds + PG8_SB(b, h) + boff + n * 2048 + k * 1024); } while (0)
#define PG8_MMA(ai, bj, At, Bt) do { __builtin_amdgcn_s_setprio(1); _Pragma("unroll") for (int m = 0; m < 4; ++m) _Pragma("unroll") for (int n = 0; n < 2; ++n) _Pragma("unroll") for (int k = 0; k < 2; ++k) \
        acc[ai][bj][m][n] = __builtin_amdgcn_mfma_f32_16x16x32_bf16(Bt[n][k], At[m][k], acc[ai][bj][m][n], 0, 0, 0); __builtin_amdgcn_s_setprio(0); } while (0)
#define PG8_WAIT_V(n) asm volatile("s_waitcnt vmcnt(" #n ")" ::: "memory")
#define PG8_WAIT_L(n) asm volatile("s_waitcnt lgkmcnt(" #n ")" ::: "memory")
#define PG8_BAR __builtin_amdgcn_s_barrier()
#define PG8_SCHED __builtin_amdgcn_sched_barrier(0)
    Unit cur, nxt; int ui = 0;
    if (!S_.next(0, cur)) return;
    f32x4 acc[2][2][4][2];
#pragma unroll
    for (int a = 0; a < 2; ++a)
#pragma unroll
        for (int b = 0; b < 2; ++b)
#pragma unroll
            for (int m = 0; m < 4; ++m)
#pragma unroll
                for (int n = 0; n < 2; ++n) acc[a][b][m][n] = (f32x4){0.f, 0.f, 0.f, 0.f};
    bf16x8 At[4][2], B0[2][2], B1[2][2];
    const char* cA = a_ptr(g, cur); const char* cB = b_ptr(g, cur);
    PG8_STAGE(PG8_SB(0, 0), cB, voffB); PG8_STAGE(PG8_SB(0, 1), cB + hstepB, voffB); PG8_STAGE(PG8_SA(0, 0), cA, voffA); PG8_STAGE(PG8_SA(0, 1), cA + hstepA, voffA);
    if (wr == 1) PG8_BAR;
    PG8_WAIT_V(2); PG8_BAR;
    PG8_STAGE(PG8_SB(1, 0), cB + kstep, voffB); PG8_STAGE(PG8_SA(1, 0), cA + kstep, voffA); PG8_STAGE(PG8_SB(1, 1), cB + hstepB + kstep, voffB);
    PG8_WAIT_V(6); PG8_BAR;
    for (;;) {
        const bool has_next = S_.next(ui + 1, nxt);
        const char* nA = has_next ? a_ptr(g, nxt) : cA; const char* nB = has_next ? b_ptr(g, nxt) : cB;
        for (int t = 0; t < nt; t += 2) {
            const bool last = (t == nt - 2);
            const char* a1 = cA + (size_t)(t + 1) * kstep;
            const char* a2 = last ? nA : cA + (size_t)(t + 2) * kstep; const char* b2 = last ? nB : cB + (size_t)(t + 2) * kstep;
            const char* a3 = a2 + kstep; const char* b3 = b2 + kstep;
            PG8_LDB(B0, 0, 0); PG8_LDB(B1, 0, 1); PG8_SCHED; PG8_LDA(At, 0, 0); PG8_STAGE(PG8_SA(1, 1), a1 + hstepA, voffA);
            PG8_WAIT_V(8); PG8_WAIT_L(0); PG8_BAR; PG8_MMA(0, 0, At, B0); PG8_MMA(0, 1, At, B1); PG8_BAR; PG8_SCHED;
            PG8_LDA(At, 0, 1); PG8_STAGE(PG8_SB(0, 0), b2, voffB); PG8_STAGE(PG8_SB(0, 1), b2 + hstepB, voffB); PG8_STAGE(PG8_SA(0, 0), a2, voffA);
            PG8_WAIT_V(8); PG8_WAIT_L(0); PG8_BAR; PG8_MMA(1, 0, At, B0); PG8_MMA(1, 1, At, B1); PG8_BAR; PG8_SCHED;
            PG8_LDB(B0, 1, 0); PG8_LDB(B1, 1, 1); PG8_SCHED; PG8_LDA(At, 1, 0); PG8_STAGE(PG8_SA(0, 1), a2 + hstepA, voffA);
            PG8_WAIT_V(8); PG8_WAIT_L(0); PG8_BAR; PG8_MMA(0, 0, At, B0); PG8_MMA(0, 1, At, B1); PG8_BAR; PG8_SCHED;
            PG8_LDA(At, 1, 1); PG8_STAGE(PG8_SB(1, 0), b3, voffB); PG8_STAGE(PG8_SB(1, 1), b3 + hstepB, voffB); PG8_STAGE(PG8_SA(1, 0), a3, voffA);
            PG8_WAIT_V(8); PG8_WAIT_L(0); PG8_BAR; PG8_MMA(1, 0, At, B0); PG8_MMA(1, 1, At, B1); PG8_BAR; PG8_SCHED;
        }
        if constexpr (ALIGN_EPI) { if (wr == 0) PG8_BAR; }
        { int ln_ = threadIdx.x & 63; asm volatile("" : "+v"(ln_));
          E(acc, cur, wr, wc, ln_ & 15, ln_ >> 4); }
        if (!has_next) break;
#pragma unroll
        for (int a = 0; a < 2; ++a)
#pragma unroll
            for (int b = 0; b < 2; ++b)
#pragma unroll
                for (int m = 0; m < 4; ++m)
#pragma unroll
                    for (int n = 0; n < 2; ++n) acc[a][b][m][n] = (f32x4){0.f, 0.f, 0.f, 0.f};
        cur = nxt; cA = nA; cB = nB; ++ui;
        if constexpr (ALIGN_EPI) { if (wr == 1) PG8_BAR; }
    }
    PG8_WAIT_V(0);
    if constexpr (!ALIGN_EPI) { if (wr == 0) PG8_BAR; }
    PG8_BAR;
#undef PG8_SA
#undef PG8_SB
#undef PG8_STAGE
#undef PG8_LDA
#undef PG8_LDB
#undef PG8_MMA
#undef PG8_WAIT_V
#undef PG8_WAIT_L
#undef PG8_BAR
#undef PG8_SCHED
}
}

struct Args { const float* in[18]; float* out; unsigned char* ws; int ph_lo, ph_hi; };

__device__ __forceinline__ void p0_transpose_item(const float* W, int K, int N, bf16_t* WT, LAS float* scr, int item, int lane, const float* kgain = nullptr) {
    const int nblk = N / 32, kb = item / nblk, nb = item % nblk, k0 = 64 * kb, n0 = 32 * nb;
    { f32x4 wv[8];
#pragma unroll
      for (int i = 0; i < 8; ++i) wv[i] = *(const f32x4*)(W + (size_t)(k0 + 8 * i + (lane >> 3)) * N + n0 + 4 * (lane & 7));
#pragma unroll
      for (int i = 0; i < 8; ++i) { const int kk = 8 * i + (lane >> 3); const float gk = kgain ? kgain[k0 + kk] : 1.0f; LAS float* sp = scr + kk * 33 + 4 * (lane & 7);
          sp[0] = gk * wv[i].x; sp[1] = gk * wv[i].y; sp[2] = gk * wv[i].z; sp[3] = gk * wv[i].w; } }
    asm volatile("s_waitcnt lgkmcnt(0)" ::: "memory");
    const int c = lane & 7;
#pragma unroll
    for (int j = 0; j < 4; ++j) { const int n = (lane >> 3) + 8 * j; const LAS float* s = scr + (8 * c) * 33 + n;
        u32x4 o; o.x = pk2(s[0 * 33], s[1 * 33]); o.y = pk2(s[2 * 33], s[3 * 33]); o.z = pk2(s[4 * 33], s[5 * 33]); o.w = pk2(s[6 * 33], s[7 * 33]);
        *(u32x4*)(WT + (size_t)(n0 + n) * K + k0 + 8 * c) = o; }
    asm volatile("s_waitcnt lgkmcnt(0)" ::: "memory");
}
__device__ __forceinline__ void rms_row_to_bf16(const float* xrow, const float* g, bf16_t* orow, int lane) {
    const f32x4* xr = (const f32x4*)xrow + lane;
    f32x4 v[8]; float s = 0.f;
#pragma unroll
    for (int j = 0; j < 8; ++j) { v[j] = xr[64 * j]; s += (v[j].x * v[j].x + v[j].y * v[j].y) + (v[j].z * v[j].z + v[j].w * v[j].w); }
    const float rstd = 1.0f / sqrtf(wave_sum(s) * (1.0f / D) + EPS);
    const f32x4* gr = (const f32x4*)g + lane;
    u32x2* o8 = (u32x2*)orow + lane;
#pragma unroll
    for (int j = 0; j < 8; ++j) { const f32x4 gv = gr[64 * j]; u32x2 o; o.x = pk2(v[j].x * rstd * gv.x, v[j].y * rstd * gv.y); o.y = pk2(v[j].z * rstd * gv.z, v[j].w * rstd * gv.w); o8[64 * j] = o; }
}
__device__ __forceinline__ void cvt_stream(const float* src, bf16_t* dst, size_t n8, size_t gtid, size_t nthr) {
    for (size_t i = gtid; i < n8; i += nthr) { const f32x4 a = ((const f32x4*)src)[2 * i], b = ((const f32x4*)src)[2 * i + 1];
        u32x4 o; o.x = pk2(a.x, a.y); o.y = pk2(a.z, a.w); o.z = pk2(b.x, b.y); o.w = pk2(b.z, b.w); ((u32x4*)dst)[i] = o; }
}

__device__ __forceinline__ void expert_row_load(const float* src, f32x4 (&v)[8], int lane) {
    const f32x4* xr = (const f32x4*)src + lane;
#pragma unroll
    for (int k = 0; k < 8; ++k) v[k] = xr[64 * k];
}
__device__ __forceinline__ void expert_row_gain(f32x4 (&v)[8], const float* g, int lane) {
    const f32x4* gr = (const f32x4*)g + lane;
#pragma unroll
    for (int k = 0; k < 8; ++k) v[k] = v[k] * gr[64 * k];
}
__device__ __forceinline__ void expert_row_store(const f32x4 (&v)[8], unsigned char* dst, float* isc, int lane) {
    float am = 0.f;
#pragma unroll
    for (int k = 0; k < 8; ++k) am = fmaxf(am, fmaxf(fmaxf(fabsf(v[k].x), fabsf(v[k].y)), fmaxf(fabsf(v[k].z), fabsf(v[k].w))));
#pragma unroll
    for (int o = 1; o < 64; o <<= 1) am = fmaxf(am, __shfl_xor(am, o));
    float sc = 1.0f;
    if (am > 0.f) { const float q = fminf(fmaxf(448.0f / am, 1.0e-30f), 1.0e30f); sc = __builtin_bit_cast(float, __builtin_bit_cast(unsigned, q) & 0x7f800000u); }
    unsigned o[8];
#pragma unroll
    for (int k = 0; k < 8; ++k) { int w = __builtin_amdgcn_cvt_pk_fp8_f32(v[k].x * sc, v[k].y * sc, 0, false); w = __builtin_amdgcn_cvt_pk_fp8_f32(v[k].z * sc, v[k].w * sc, w, true); o[k] = (unsigned)w; }
    u32x4 o0, o1; o0.x = o[0]; o0.y = o[1]; o0.z = o[2]; o0.w = o[3]; o1.x = o[4]; o1.y = o[5]; o1.z = o[6]; o1.w = o[7];
    *(u32x4*)(dst + lane * 16) = o0; *(u32x4*)(dst + 1024 + lane * 16) = o1;
    if (lane == 0) *isc = 1.0f / sc;
}

__device__ __forceinline__ void p0_prologue(const Args& a, LAS unsigned char* lds, int vcu, int G, int wave, int lane, int tid) {
    unsigned char* ws = a.ws;
    LAS float* scr = (LAS float*)(lds + wave * 16384);
    const int gw = vcu * NWAVES + wave, NGW = G * NWAVES;
    constexpr int I_IN = (D / 64) * (INW / 32), I_POOL1 = (256 / 64) * (512 / 32), I_G = (GWD / 64) * (D / 32), I_O = (D / 64) * (D / 32), I_Q = I_O;
    constexpr int NITEMS = I_IN + 4 * I_POOL1 + I_G + I_O + I_Q;
    for (int it = gw; it < NITEMS; it += NGW) {
        int r = it;
        if (r < I_IN) { p0_transpose_item(a.in[2], D, INW, (bf16_t*)(ws + WS_WIN), scr, r, lane); continue; } r -= I_IN;
        if (r < 4 * I_POOL1) { const int g = r / I_POOL1; p0_transpose_item(a.in[5] + (size_t)g * 256 * 512, 256, 512, (bf16_t*)(ws + WS_WPOOL) + (size_t)g * 512 * 256, scr, r % I_POOL1, lane); continue; } r -= 4 * I_POOL1;
        if (r < I_G) { p0_transpose_item(a.in[10], GWD, D, (bf16_t*)(ws + WS_WG), scr, r, lane); continue; } r -= I_G;
        if (r < I_O) { p0_transpose_item(a.in[11], D, D, (bf16_t*)(ws + WS_WOUT), scr, r, lane); continue; } r -= I_O;
        p0_transpose_item(a.in[13], D, D, (bf16_t*)(ws + WS_WQ), scr, r, lane, a.in[12]);
    }
    for (int m = gw; m < S; m += NGW) rms_row_to_bf16(a.in[0] + (size_t)m * D, a.in[1], (bf16_t*)(ws + WS_H) + (size_t)m * D, lane);
    const size_t gtid = (size_t)vcu * NTHR + tid, nthr = (size_t)G * NTHR;
    cvt_stream(a.in[14], (bf16_t*)(ws + WS_KEYS), (size_t)8 * 2 * 128 * 128 / 8, gtid, nthr);
    {
        const float* src = a.in[8]; bf16_t* dst = (bf16_t*)(ws + WS_WSM);
        for (size_t i = gtid; i < (size_t)8 * 128 * 128 / 8; i += nthr) { const int s0 = (int)(i & 15) * 8, t = (int)(i >> 4) & 127;
            const f32x4 x0 = ((const f32x4*)src)[2 * i], x1 = ((const f32x4*)src)[2 * i + 1];
            float v[8] = {x0.x, x0.y, x0.z, x0.w, x1.x, x1.y, x1.z, x1.w};
#pragma unroll
            for (int j = 0; j < 8; ++j) v[j] = (s0 + j <= t) ? v[j] : 0.f;
            u32x4 o; o.x = pk2(v[0], v[1]); o.y = pk2(v[2], v[3]); o.z = pk2(v[4], v[5]); o.w = pk2(v[6], v[7]); ((u32x4*)dst)[i] = o; }
    }
}

__device__ __forceinline__ void p2_pool(const Args& a, int vcu, int G, int tid) {
    const bf16_t* Z = (const bf16_t*)(a.ws + WS_Z); bf16_t* A2 = (bf16_t*)(a.ws + WS_A2); const float* psc = a.in[4];
    const size_t gtid = (size_t)vcu * NTHR + tid, nthr = (size_t)G * NTHR;
    for (size_t id = gtid; id < (size_t)(S / 8) * 128; id += nthr) {
        const int c8 = (int)(id & 127), t0 = (int)(id >> 7) * 8, g = c8 >> 5, w = 2 << g;
        u32x4 row[23];
#pragma unroll
        for (int r = 0; r < 23; ++r) { const int t = t0 - 15 + r; const bool need = (r >= 16 - w) && (t >= 0);
            row[r] = need ? *(const u32x4*)(Z + (size_t)t * INW + c8 * 8) : (u32x4){0u, 0u, 0u, 0u}; }
        const f32x4 p0 = *(const f32x4*)(psc + c8 * 8), p1 = *(const f32x4*)(psc + c8 * 8 + 4);
        const float ps[8] = {p0.x, p0.y, p0.z, p0.w, p1.x, p1.y, p1.z, p1.w};
        float s[8] = {0.f, 0.f, 0.f, 0.f, 0.f, 0.f, 0.f, 0.f};
#pragma unroll
        for (int r = 0; r < 15; ++r) { const u32x4 q = row[r];
            s[0] += bflo(q.x); s[1] += bfhi(q.x); s[2] += bflo(q.y); s[3] += bfhi(q.y); s[4] += bflo(q.z); s[5] += bfhi(q.z); s[6] += bflo(q.w); s[7] += bfhi(q.w); }
#pragma unroll
        for (int i = 0; i < 8; ++i) {
            const u32x4 q = row[15 + i];
            const float at[8] = {bflo(q.x), bfhi(q.x), bflo(q.y), bfhi(q.y), bflo(q.z), bfhi(q.z), bflo(q.w), bfhi(q.w)};
#pragma unroll
            for (int c = 0; c < 8; ++c) s[c] += at[c];
            const int t = t0 + i; const int cnt = (t + 1) < w ? (t + 1) : w; const float inv = 1.0f / (float)cnt;
            float o[8];
#pragma unroll
            for (int c = 0; c < 8; ++c) o[c] = (s[c] * inv - at[c]) * ps[c];
            u32x4 w4; w4.x = pk2(o[0], o[1]); w4.y = pk2(o[2], o[3]); w4.z = pk2(o[4], o[5]); w4.w = pk2(o[6], o[7]);
            *(u32x4*)(A2 + (size_t)t * D + c8 * 8) = w4;
            const u32x4 d2 = row[15 + i - 1], d4 = row[15 + i - 3], d8 = row[15 + i - 7], d16 = row[15 + i - 15];
            const u32x4 dq = g == 0 ? d2 : (g == 1 ? d4 : (g == 2 ? d8 : d16));
            s[0] -= bflo(dq.x); s[1] -= bfhi(dq.x); s[2] -= bflo(dq.y); s[3] -= bfhi(dq.y); s[4] -= bflo(dq.z); s[5] -= bfhi(dq.z); s[6] -= bflo(dq.w); s[7] -= bfhi(dq.w);
        }
    }
}
constexpr int VT_LD = 136;
__device__ __forceinline__ void p2_sgu(const Args& a, LAS unsigned char* lds, int vcu, int G, int wave, int lane, int tid) {
    const bf16_t* Z = (const bf16_t*)(a.ws + WS_Z); bf16_t* A2 = (bf16_t*)(a.ws + WS_A2); const bf16_t* WSM = (const bf16_t*)(a.ws + WS_WSM);
    const float* lng = a.in[6]; const float* lnb = a.in[7]; const float* bs = a.in[9];
    LAS float* st = (LAS float*)lds; LAS bf16_t* Vt = (LAS bf16_t*)(lds + 1024);
    const int fr = lane & 15, fq = lane >> 4;
    for (int item = vcu; item < 512; item += G) {
        const int c = item >> 3, h = item & 7, t0 = c * 128;
        u32x4 raw[4][8];
#pragma unroll
        for (int p = 0; p < 4; ++p) { const bf16_t* rp = Z + (size_t)(t0 + wave * 16 + p * 4 + fq) * INW + 2048 + fr * 8;
#pragma unroll
            for (int j = 0; j < 8; ++j) raw[p][j] = *(const u32x4*)(rp + j * 128); }
        u32x4 rawB[4];
#pragma unroll
        for (int q = 0; q < 4; ++q) { const int id = tid + q * NTHR, sr = id & 127, dc = id >> 7; rawB[q] = *(const u32x4*)(Z + (size_t)(t0 + sr) * INW + 2048 + h * 128 + dc * 8); }
        bf16x8 bW[4];
#pragma unroll
        for (int ks = 0; ks < 4; ++ks) bW[ks] = *(const bf16x8*)(WSM + (size_t)(h * 128 + wave * 16 + fr) * 128 + ks * 32 + fq * 8);
        u32x2 ur[8];
#pragma unroll
        for (int db = 0; db < 8; ++db) ur[db] = *(const u32x2*)(Z + (size_t)(t0 + wave * 16 + fr) * INW + 1024 + h * 128 + db * 16 + fq * 4);
        const float bias = bs[h * 128 + wave * 16 + fr];
#pragma unroll
        for (int p = 0; p < 4; ++p) { float s = 0.f, q = 0.f;
#pragma unroll
            for (int j = 0; j < 8; ++j)
#pragma unroll
                for (int w = 0; w < 4; ++w) { const float a0 = bflo(raw[p][j][w]), a1 = bfhi(raw[p][j][w]); s += a0 + a1; q += a0 * a0 + a1 * a1; }
            s = row_sum_f32(s); q = row_sum_f32(q);
            if (fr == 0) { const float mean = s * (1.0f / 1024.0f); const float var = fmaxf(q * (1.0f / 1024.0f) - mean * mean, 0.f);
                const int sr = wave * 16 + p * 4 + fq; st[2 * sr] = mean; st[2 * sr + 1] = 1.0f / sqrtf(var + EPS); } }
        __syncthreads();
#pragma unroll
        for (int q = 0; q < 4; ++q) { const int id = tid + q * NTHR, sr = id & 127, dc = id >> 7;
            const u32x4 rw = rawB[q];
            const float mean = st[2 * sr], rstd = st[2 * sr + 1];
            const float v[8] = {bflo(rw.x), bfhi(rw.x), bflo(rw.y), bfhi(rw.y), bflo(rw.z), bfhi(rw.z), bflo(rw.w), bfhi(rw.w)};
            const f32x4 g0 = *(const f32x4*)(lng + h * 128 + dc * 8), g1 = *(const f32x4*)(lng + h * 128 + dc * 8 + 4), b0 = *(const f32x4*)(lnb + h * 128 + dc * 8), b1 = *(const f32x4*)(lnb + h * 128 + dc * 8 + 4);
            const float gg[8] = {g0.x, g0.y, g0.z, g0.w, g1.x, g1.y, g1.z, g1.w}, bb[8] = {b0.x, b0.y, b0.z, b0.w, b1.x, b1.y, b1.z, b1.w};
#pragma unroll
            for (int i = 0; i < 8; ++i) { const int d = dc * 8 + i; const float y = (v[i] - mean) * rstd * gg[i] + bb[i]; Vt[d * VT_LD + sr] = (bf16_t)f2bf(y); } }
        __syncthreads();
        f32x4 acc[8];
#pragma unroll
        for (int db = 0; db < 8; ++db) acc[db] = (f32x4){0.f, 0.f, 0.f, 0.f};
        const int nks = (wave * 16 + 15) / 32 + 1;
#pragma unroll
        for (int ks = 0; ks < 4; ++ks) if (ks < nks) {
#pragma unroll
            for (int db = 0; db < 8; ++db) { const bf16x8 aV = *(const LAS bf16x8*)(Vt + (db * 16 + fr) * VT_LD + ks * 32 + fq * 8);
                acc[db] = __builtin_amdgcn_mfma_f32_16x16x32_bf16(aV, bW[ks], acc[db], 0, 0, 0); }
        }
        { const int t = t0 + wave * 16 + fr;
#pragma unroll
          for (int db = 0; db < 8; ++db) { const int col = h * 128 + db * 16 + fq * 4;
              u32x2 o; o.x = pk2(bflo(ur[db].x) * (acc[db][0] + bias), bfhi(ur[db].x) * (acc[db][1] + bias)); o.y = pk2(bflo(ur[db].y) * (acc[db][2] + bias), bfhi(ur[db].y) * (acc[db][3] + bias));
              *(u32x2*)(A2 + (size_t)t * D + 1024 + col) = o; } }
        __syncthreads();
    }
}

__device__ __forceinline__ unsigned f2key(float f) { const unsigned b = __builtin_bit_cast(unsigned, f); return (b & 0x80000000u) ? ~b : (b | 0x80000000u); }
__device__ __forceinline__ float key2f(unsigned k) { const unsigned b = (k & 0x80000000u) ? (k ^ 0x80000000u) : ~k; return __builtin_bit_cast(float, b); }
template <int CTRL> __device__ __forceinline__ unsigned dpp_max_u32(unsigned v) { const unsigned o = (unsigned)__builtin_amdgcn_update_dpp(0, (int)v, CTRL, 0xF, 0xF, true); return v > o ? v : o; }
__device__ __forceinline__ unsigned row_max_u32(unsigned v) { v = dpp_max_u32<0xB1>(v); v = dpp_max_u32<0x4E>(v); v = dpp_max_u32<0x141>(v); v = dpp_max_u32<0x140>(v); return v; }
__device__ __forceinline__ void ce_desc(unsigned& a, unsigned& b) { const unsigned hi = a > b ? a : b, lo = a > b ? b : a; a = hi; b = lo; }
__device__ __forceinline__ void sort8_desc(unsigned (&k)[8]) {
    ce_desc(k[0], k[1]); ce_desc(k[2], k[3]); ce_desc(k[4], k[5]); ce_desc(k[6], k[7]);
    ce_desc(k[0], k[2]); ce_desc(k[1], k[3]); ce_desc(k[4], k[6]); ce_desc(k[5], k[7]);
    ce_desc(k[1], k[2]); ce_desc(k[5], k[6]);
    ce_desc(k[0], k[4]); ce_desc(k[1], k[5]); ce_desc(k[2], k[6]); ce_desc(k[3], k[7]);
    ce_desc(k[2], k[4]); ce_desc(k[3], k[5]);
    ce_desc(k[1], k[2]); ce_desc(k[3], k[4]); ce_desc(k[5], k[6]);
}
__device__ __forceinline__ void sort4_desc(unsigned (&k)[4]) { ce_desc(k[0], k[1]); ce_desc(k[2], k[3]); ce_desc(k[0], k[2]); ce_desc(k[1], k[3]); ce_desc(k[1], k[2]); }
template <int NV> __device__ __forceinline__ unsigned row_top16_sorted(unsigned (&k)[NV], int fr) {
    unsigned tk = 0u;
    for (int it = 0; it < 16; ++it) {
        const unsigned m = row_max_u32(k[0]);
        const unsigned wm = (k[0] == m) ? 0xffffffffu : 0u;
#pragma unroll
        for (int i = 0; i + 1 < NV; ++i) k[i] = (k[i + 1] & wm) | (k[i] & ~wm);
        k[NV - 1] = k[NV - 1] & ~wm;
        tk = (fr == it) ? m : tk;
    }
    return tk;
}
__device__ __forceinline__ unsigned cand_table(int fr) {
    constexpr unsigned T[16] = {0x03020100u, 0x07060504u, 0x0b0a0908u, 0x0f0e0d0cu, 0x13121110u, 0x17161514u, 0x23222120u, 0x32313024u, 0x42414033u, 0x61605150u, 0x90807170u, 0xd0c0b0a0u, 0xfffff0e0u, 0xffffffffu, 0xffffffffu, 0xffffffffu};
    unsigned w = T[0];
#pragma unroll
    for (int i = 1; i < 16; ++i) w = (fr == i) ? T[i] : w;
    return w;
}
constexpr int SC_LD = 132;
__device__ __forceinline__ void p7_topk(const Args& a, LAS unsigned char* lds, int vcu, int G, int wave, int lane_) {
    int lane = lane_; asm volatile("" : "+v"(lane));
    const bf16_t* Q = (const bf16_t*)(a.ws + WS_Q); const bf16_t* KEYS = (const bf16_t*)(a.ws + WS_KEYS);
    int* IDX = (int*)(a.ws + WS_IDX); float* GATE = (float*)(a.ws + WS_GATE);
    LAS float* SL = (LAS float*)(lds + wave * (16 * SC_LD * 4));
    const int gw = vcu * NWAVES + wave, NGW = G * NWAVES; const int fr = lane & 15, fq = lane >> 4;
    const unsigned ctab = cand_table(fr);
    int erow = gw;
    f32x4 er0[8], er1[8]; int e0 = 2 * NEXP, e1 = 2 * NEXP;
#define ER_LOAD() do { e0 = erow; e1 = erow + NGW; erow += 2 * NGW; \
        if (e0 < 2 * NEXP) expert_row_load(a.in[15 + (e0 >= NEXP)] + (size_t)(e0 & (NEXP - 1)) * D, er0, lane); \
        if (e1 < 2 * NEXP) expert_row_load(a.in[15 + (e1 >= NEXP)] + (size_t)(e1 & (NEXP - 1)) * D, er1, lane); } while (0)
#define ER_STORE() do { \
        if (e0 < NEXP) expert_row_gain(er0, a.in[12], lane); if (e1 < NEXP) expert_row_gain(er1, a.in[12], lane); \
        if (e0 < 2 * NEXP) expert_row_store(er0, a.ws + ((e0 >= NEXP) ? WS_EV : WS_EU) + (size_t)(e0 & (NEXP - 1)) * D, (float*)(a.ws + WS_ESC) + e0, lane); \
        if (e1 < 2 * NEXP) expert_row_store(er1, a.ws + ((e1 >= NEXP) ? WS_EV : WS_EU) + (size_t)(e1 & (NEXP - 1)) * D, (float*)(a.ws + WS_ESC) + e1, lane); } while (0)
    pg8::StaticOrder so7; so7.init(S, D, G, (int)blockIdx.x); pg8::Unit u7;
    for (int ui = 0; so7.next(ui >> 1, u7); ++ui) {
        const int h = u7.pn, t0 = u7.pm * 256 + ((ui & 1) * 8 + wave) * 16;
        unsigned tk[8];
#pragma unroll
        for (int i = 0; i < 8; ++i) tk[i] = 0u;
#pragma unroll 1
        for (int p = 0; p < 2; ++p) {
            {
                bf16x8 af[4];
#pragma unroll
                for (int ks = 0; ks < 4; ++ks) af[ks] = *(const bf16x8*)(Q + (size_t)(t0 + fr) * D + h * 256 + p * 128 + ks * 32 + fq * 8);
#pragma unroll 1
                for (int g4 = 0; g4 < 2; ++g4) {
                    bf16x8 bf[4][4];
#pragma unroll
                    for (int n4 = 0; n4 < 4; ++n4)
#pragma unroll
                        for (int ks = 0; ks < 4; ++ks) bf[n4][ks] = *(const bf16x8*)(KEYS + (size_t)((h * 2 + p) * 128 + (g4 * 4 + n4) * 16 + fr) * 128 + ks * 32 + fq * 8);
#pragma unroll
                    for (int n4 = 0; n4 < 4; ++n4) { f32x4 c = {0.f, 0.f, 0.f, 0.f};
#pragma unroll
                        for (int ks = 0; ks < 4; ++ks) c = __builtin_amdgcn_mfma_f32_16x16x32_bf16(af[ks], bf[n4][ks], c, 0, 0, 0);
#pragma unroll
                        for (int j = 0; j < 4; ++j) SL[(fq * 4 + j) * SC_LD + (g4 * 4 + n4) * 16 + fr] = c[j]; }
                    asm volatile("" ::: "memory"); }
            }
            ER_LOAD();
#pragma unroll 1
            for (int j = 0; j < 4; ++j) {
                unsigned k[8];
#pragma unroll
                for (int nb = 0; nb < 8; ++nb) k[nb] = (f2key(SL[(fq * 4 + j) * SC_LD + nb * 16 + fr]) & ~127u) | (127u - (unsigned)(nb * 16 + fr));
                sort8_desc(k);
                const unsigned r = row_top16_sorted<8>(k, fr);
#pragma unroll
                for (int i = 0; i < 8; ++i) tk[i] = (i == p * 4 + j) ? r : tk[i];
            }
            ER_STORE();
        }
#pragma unroll 1
        for (int j = 0; j < 4; ++j) {
            if ((j & 1) == 0) ER_LOAD();
            const unsigned tk1 = j == 0 ? tk[0] : (j == 1 ? tk[1] : (j == 2 ? tk[2] : tk[3])), tk2 = j == 0 ? tk[4] : (j == 1 ? tk[5] : (j == 2 ? tk[6] : tk[7]));
            const float t1 = key2f(tk1 & ~127u), t2 = key2f(tk2 & ~127u); const int i1 = 127 - (int)(tk1 & 127u), i2 = 127 - (int)(tk2 & 127u);
            unsigned kc[4];
#pragma unroll
            for (int e = 0; e < 4; ++e) { const unsigned ab = (ctab >> (8 * e)) & 255u; const int ca = (int)(ab >> 4), cb = (int)(ab & 15u);
                const float c = __shfl(t1, (lane & 48) + ca) + __shfl(t2, (lane & 48) + cb);
                kc[e] = (ab == 255u) ? 0u : ((f2key(c) & ~255u) | (255u - ab)); }
            sort4_desc(kc);
            const unsigned tkc = row_top16_sorted<4>(kc, fr);
            const float ts = key2f(tkc & ~255u); const int ci = 255 - (int)(tkc & 255u);
            const int ia = __shfl(i1, (lane & 48) + (ci >> 4)), ib = __shfl(i2, (lane & 48) + (ci & 15));
            const float tmax = __shfl(ts, lane & 48);
            const float e = __expf(ts - tmax); float sum = e;
            sum += __shfl_xor(sum, 1); sum += __shfl_xor(sum, 2); sum += __shfl_xor(sum, 4); sum += __shfl_xor(sum, 8);
            const int t = t0 + fq * 4 + j;
            IDX[(size_t)t * 128 + h * 16 + fr] = ia * 128 + ib;
            GATE[(size_t)t * 128 + h * 16 + fr] = e / sum;
            if ((j & 1) == 1) ER_STORE();
        }
    }
    for (; erow < 2 * NEXP; erow += NGW) { expert_row_load(a.in[15 + (erow >= NEXP)] + (size_t)(erow & (NEXP - 1)) * D, er0, lane); if (erow < NEXP) expert_row_gain(er0, a.in[12], lane);
        expert_row_store(er0, a.ws + ((erow >= NEXP) ? WS_EV : WS_EU) + (size_t)(erow & (NEXP - 1)) * D, (float*)(a.ws + WS_ESC) + erow, lane); }
#undef ER_LOAD
#undef ER_STORE
}

typedef float f32x2 __attribute__((ext_vector_type(2)));
__device__ __forceinline__ u32x4 bl128(__amdgpu_buffer_rsrc_t r, unsigned voff, unsigned soff) { return __builtin_amdgcn_raw_buffer_load_b128(r, voff, soff, 0); }
__device__ __forceinline__ u32x2 bl64(__amdgpu_buffer_rsrc_t r, unsigned voff, unsigned soff) { return __builtin_amdgcn_raw_buffer_load_b64(r, voff, soff, 0); }
__device__ __forceinline__ unsigned bl32(__amdgpu_buffer_rsrc_t r, unsigned voff, unsigned soff) { return __builtin_amdgcn_raw_buffer_load_b32(r, voff, soff, 0); }
__device__ __forceinline__ float wave_sum_dpp(float v) {
    v = dpp_add_f32<0xB1>(v); v = dpp_add_f32<0x4E>(v); v = dpp_add_f32<0x141>(v); v = dpp_add_f32<0x140>(v);
    v += __builtin_bit_cast(float, __builtin_amdgcn_update_dpp(0, __builtin_bit_cast(int, v), 0x142, 0xA, 0xF, false));
    v += __builtin_bit_cast(float, __builtin_amdgcn_update_dpp(0, __builtin_bit_cast(int, v), 0x143, 0xC, 0xF, false));
    return __builtin_bit_cast(float, __builtin_amdgcn_readlane(__builtin_bit_cast(int, v), 63));
}
__device__ __forceinline__ float wave_sum_fast(float v) {
    v = dpp_add_f32<0xB1>(v); v = dpp_add_f32<0x4E>(v); v = dpp_add_f32<0x141>(v); v = dpp_add_f32<0x140>(v);
    v += __shfl_xor(v, 16); v += __shfl_xor(v, 32); return v;
}
constexpr int TPW = 4, NSL = 16, SL_SHIFT = 10, RING = 8, SLOT = 2048;
typedef __bf16 bf16x2_t __attribute__((ext_vector_type(2)));
__device__ __forceinline__ float dot2bf(unsigned a, unsigned b, float c) { return __builtin_amdgcn_fdot2_f32_bf16(__builtin_bit_cast(bf16x2_t, a), __builtin_bit_cast(bf16x2_t, b), c, false); }
constexpr int NROWS = TPW * 128;
#define P8_ISSUE(TBASE) do { const unsigned ro_ = (unsigned)__builtin_amdgcn_readlane(lch_, ii_ & 63) * (unsigned)D; \
        const char* src_ = (const char*)a.ws + (TBASE) + ro_ + l16; LAS unsigned char* dstl_ = ring + (ii_ & (RING - 1)) * SLOT; \
        __builtin_amdgcn_global_load_lds((const unsigned*)src_, (LAS unsigned*)dstl_, 16, 0, 0); \
        __builtin_amdgcn_global_load_lds((const unsigned*)(src_ + 1024), (LAS unsigned*)(dstl_ + 1024), 16, 0, 0); \
        ++ii_; if ((ii_ & 63) == 0) lch_ = (int)LST[ii_ + lane]; } while (0)
#define P8_RING_READ(r0, r1) do { r0 = *(const LAS u32x4*)(ring + (ci_ & (RING - 1)) * SLOT + l16); r1 = *(const LAS u32x4*)(ring + (ci_ & (RING - 1)) * SLOT + 1024 + l16); } while (0)
#define P8_STREAM_INIT(TBASE, r0, r1) int ci_ = 0, ii_ = 0; int lch_ = (int)LST[lane]; \
        asm volatile("s_waitcnt vmcnt(0) lgkmcnt(0)" ::: "memory"); \
        _Pragma("unroll 1") for (int q_ = 0; q_ < RING; ++q_) P8_ISSUE(TBASE); \
        asm volatile("s_waitcnt vmcnt(14)" ::: "memory"); P8_RING_READ(r0, r1)
#define P8_ROW_READY() asm volatile("s_waitcnt lgkmcnt(0)" ::: "memory")
#define P8_ROW_ADVANCE(TBASE, r0, r1) do { ++ci_; P8_ISSUE(TBASE); asm volatile("s_waitcnt vmcnt(14)" ::: "memory"); P8_RING_READ(r0, r1); } while (0)
#define P8_STREAM_END() asm volatile("s_waitcnt vmcnt(0) lgkmcnt(0)" ::: "memory")
static_assert(RING == 8, "the counted wait above is vmcnt(2 * (RING - 1))");
__device__ __forceinline__ void p8_peer(const Args& a, LAS unsigned char* lds, float* dst, int vcu, int G, int wave, int lane_) {
    int lane = lane_; asm volatile("" : "+v"(lane));
    const __amdgpu_buffer_rsrc_t rws = __builtin_amdgcn_make_buffer_rsrc((void*)a.ws, (short)0, (int)WS_END, 0x00020000);
    const __amdgpu_buffer_rsrc_t rdst = __builtin_amdgcn_make_buffer_rsrc((void*)dst, (short)0, S * D * 4, 0x00020000);
    const __amdgpu_buffer_rsrc_t rfg = __builtin_amdgcn_make_buffer_rsrc((void*)a.in[17], (short)0, D * 4, 0x00020000);
    LAS unsigned char* ring = lds + wave * (RING * SLOT);
    LAS unsigned* SLW = (LAS unsigned*)(lds + 132096 + wave * 1280);
    LAS unsigned short* LST = (LAS unsigned short*)SLW;
    const int gw = vcu * NWAVES + wave, NGW = G * NWAVES;
    const unsigned l16 = (unsigned)lane * 16u, l8 = (unsigned)lane * 8u, l4 = (unsigned)lane * 4u;
#pragma unroll 1
    for (int tb = gw; tb < S; tb += TPW * NGW) {
        int sid[TPW][2], offv[TPW]; float act[TPW][2]; int cntv = 0;
#pragma unroll
        for (int k = 0; k < TPW; ++k) {
            const int t = (tb + k * NGW) < S ? (tb + k * NGW) : (S - 1);
            const unsigned oi = (unsigned)(WS_IDX + (size_t)t * 512);
            const int id0 = (int)bl32(rws, l4, oi), id1 = (int)bl32(rws, l4 + 256u, oi);
            const int sl0 = id0 >> SL_SHIFT, sl1 = id1 >> SL_SHIFT;
            int pos0 = 0, pos1 = 0, basec = 0, offacc = 0;
#pragma unroll
            for (int s = 0; s < NSL; ++s) {
                const unsigned long long m0 = __ballot(sl0 == s), m1 = __ballot(sl1 == s);
                const int c0 = __popcll(m0), c1 = __popcll(m1);
                const int b0 = (int)__builtin_amdgcn_mbcnt_hi((unsigned)(m0 >> 32), __builtin_amdgcn_mbcnt_lo((unsigned)m0, 0u));
                const int b1 = (int)__builtin_amdgcn_mbcnt_hi((unsigned)(m1 >> 32), __builtin_amdgcn_mbcnt_lo((unsigned)m1, 0u));
                pos0 = (sl0 == s) ? basec + b0 : pos0; pos1 = (sl1 == s) ? basec + c0 + b1 : pos1;
                basec += c0 + c1; offacc = (lane == s + 1) ? basec : offacc; cntv = (lane == s * TPW + k) ? (c0 + c1) : cntv;
            }
            offv[k] = offacc;
            SLW[pos0] = (unsigned)id0; SLW[pos1] = (unsigned)id1; SLW[128 + pos0] = (unsigned)lane; SLW[128 + pos1] = (unsigned)(64 + lane);
            asm volatile("s_waitcnt lgkmcnt(0)" ::: "memory");
            sid[k][0] = (int)SLW[lane]; sid[k][1] = (int)SLW[64 + lane];
            act[k][0] = __builtin_bit_cast(float, SLW[128 + lane]); act[k][1] = __builtin_bit_cast(float, SLW[192 + lane]);
            asm volatile("s_waitcnt lgkmcnt(0)" ::: "memory");
        }
        {
            int incl = cntv;
#pragma unroll
            for (int o = 1; o < 64; o <<= 1) { const int up = __shfl_up(incl, o); incl += (lane >= o) ? up : 0; }
            const int gb = incl - cntv;
            asm volatile("s_waitcnt lgkmcnt(0)" ::: "memory");
#pragma unroll
            for (int k = 0; k < TPW; ++k)
#pragma unroll
                for (int h = 0; h < 2; ++h) { const int sl = sid[k][h] >> SL_SHIFT;
                    const int p = __shfl(gb, sl * TPW + k) + (h * 64 + lane) - __shfl(offv[k], sl);
                    LST[p] = (unsigned short)sid[k][h]; }
            if (lane < RING) LST[NROWS + lane] = (unsigned short)0;
            asm volatile("s_waitcnt lgkmcnt(0)" ::: "memory");
        }
        int orig[TPW][2];
#pragma unroll
        for (int k = 0; k < TPW; ++k) { orig[k][0] = __builtin_bit_cast(int, act[k][0]); orig[k][1] = __builtin_bit_cast(int, act[k][1]); act[k][0] = 0.f; act[k][1] = 0.f; }
        {
            f32x2 hf[TPW][16];
#pragma unroll
            for (int k = 0; k < TPW; ++k) { const int t = (tb + k * NGW) < S ? (tb + k * NGW) : (S - 1);
#pragma unroll
                for (int kk = 0; kk < 8; ++kk) { const u32x2 w = bl64(rws, l8 + (unsigned)(kk * 512), (unsigned)(WS_XB + (size_t)t * (D * 2)));
                    hf[k][kk * 2] = (f32x2){bflo(w.x), bfhi(w.x)}; hf[k][kk * 2 + 1] = (f32x2){bflo(w.y), bfhi(w.y)}; } }
            u32x4 r0, r1;
            P8_STREAM_INIT(WS_EU, r0, r1);
#pragma unroll 1
            for (int s = 0; s < NSL; ++s) {
#pragma unroll
                for (int k = 0; k < TPW; ++k) {
                    const int lo = __builtin_amdgcn_readlane(offv[k], s), hi = __builtin_amdgcn_readlane(offv[k], s + 1);
#pragma unroll 1
                    for (int e = lo; e < hi; ++e) {
                        P8_ROW_READY();
                        f32x2 dd0 = {0.f, 0.f}, dd1 = {0.f, 0.f};
#pragma unroll
                        for (int kk = 0; kk < 4; ++kk) {
                            { const unsigned w = r0[kk]; const f32x2 lo2 = __builtin_amdgcn_cvt_pk_f32_fp8((int)w, false), hi2 = __builtin_amdgcn_cvt_pk_f32_fp8((int)w, true);
                              dd0 = __builtin_elementwise_fma(lo2, hf[k][kk * 2], dd0); dd1 = __builtin_elementwise_fma(hi2, hf[k][kk * 2 + 1], dd1); }
                            { const unsigned w = r1[kk]; const f32x2 lo2 = __builtin_amdgcn_cvt_pk_f32_fp8((int)w, false), hi2 = __builtin_amdgcn_cvt_pk_f32_fp8((int)w, true);
                              dd0 = __builtin_elementwise_fma(lo2, hf[k][8 + kk * 2], dd0); dd1 = __builtin_elementwise_fma(hi2, hf[k][8 + kk * 2 + 1], dd1); } }
                        asm volatile("" : "+v"(dd0), "+v"(dd1));
                        P8_ROW_ADVANCE(WS_EU, r0, r1);
                        const float d = wave_sum_dpp((dd0.x + dd0.y) + (dd1.x + dd1.y));
                        act[k][0] = (lane == e) ? d : act[k][0]; act[k][1] = (lane == e - 64) ? d : act[k][1];
                    }
                }
            }
            P8_STREAM_END();
        }
#pragma unroll
        for (int k = 0; k < TPW; ++k) {
            const int t = (tb + k * NGW) < S ? (tb + k * NGW) : (S - 1);
            const float ssp = lane < 32 ? __builtin_bit_cast(float, bl32(rws, l4, (unsigned)(WS_SS + (size_t)t * 128))) : 0.f;
            const float rstd2 = 1.0f / sqrtf(wave_sum(ssp) * (1.0f / D) + EPS);
            const unsigned og = (unsigned)(WS_GATE + (size_t)t * 512);
#pragma unroll
            for (int h = 0; h < 2; ++h) {
                const float gate = __builtin_bit_cast(float, bl32(rws, (unsigned)orig[k][h] * 4u, og));
                const float su = __builtin_bit_cast(float, bl32(rws, (unsigned)sid[k][h] * 4u, (unsigned)WS_ESC)) * rstd2;
                const float sv = __builtin_bit_cast(float, bl32(rws, (unsigned)sid[k][h] * 4u, (unsigned)(WS_ESC + NEXP * 4)));
                act[k][h] = gelu_tanh(act[k][h] * su) * gate * sv; }
        }
        {
            float acc[TPW][32];
#pragma unroll
            for (int k = 0; k < TPW; ++k)
#pragma unroll
                for (int i = 0; i < 32; ++i) acc[k][i] = 0.f;
            u32x4 r0, r1;
            P8_STREAM_INIT(WS_EV, r0, r1);
#pragma unroll 1
            for (int s = 0; s < NSL; ++s) {
#pragma unroll
                for (int k = 0; k < TPW; ++k) {
                    const int lo = __builtin_amdgcn_readlane(offv[k], s), hi = __builtin_amdgcn_readlane(offv[k], s + 1);
#pragma unroll 1
                    for (int e = lo; e < hi; ++e) {
                        const int a0_ = __builtin_amdgcn_readlane(__builtin_bit_cast(int, act[k][0]), e & 63), a1_ = __builtin_amdgcn_readlane(__builtin_bit_cast(int, act[k][1]), e & 63);
                        const float aw = __builtin_bit_cast(float, e < 64 ? a0_ : a1_);
                        P8_ROW_READY();
#pragma unroll
                        for (int kk = 0; kk < 4; ++kk) {
                            { const unsigned w = r0[kk]; const int bb = kk * 4; const f32x2 lo2 = __builtin_amdgcn_cvt_pk_f32_fp8((int)w, false), hi2 = __builtin_amdgcn_cvt_pk_f32_fp8((int)w, true);
                              acc[k][bb + 0] += aw * lo2.x; acc[k][bb + 1] += aw * lo2.y; acc[k][bb + 2] += aw * hi2.x; acc[k][bb + 3] += aw * hi2.y; }
                            { const unsigned w = r1[kk]; const int bb = 16 + kk * 4; const f32x2 lo2 = __builtin_amdgcn_cvt_pk_f32_fp8((int)w, false), hi2 = __builtin_amdgcn_cvt_pk_f32_fp8((int)w, true);
                              acc[k][bb + 0] += aw * lo2.x; acc[k][bb + 1] += aw * lo2.y; acc[k][bb + 2] += aw * hi2.x; acc[k][bb + 3] += aw * hi2.y; } }
                        asm volatile("" : "+v"(acc[k][0]), "+v"(acc[k][16]));
                        P8_ROW_ADVANCE(WS_EV, r0, r1);
                    }
                }
            }
            P8_STREAM_END();
#pragma unroll
            for (int k = 0; k < TPW; ++k) { const int t = tb + k * NGW;
                if (t < S) {
                    float ss = 0.f; const unsigned ot = (unsigned)t * (unsigned)(D * 4);
#pragma unroll
                    for (int kk = 0; kk < 8; ++kk) { const u32x2 xw = bl64(rws, l8 + (unsigned)(kk * 512), (unsigned)(WS_XB + (size_t)t * (D * 2)));
                        acc[k][kk * 4 + 0] += bflo(xw.x); acc[k][kk * 4 + 1] += bfhi(xw.x); acc[k][kk * 4 + 2] += bflo(xw.y); acc[k][kk * 4 + 3] += bfhi(xw.y);
                        ss += (acc[k][kk * 4 + 0] * acc[k][kk * 4 + 0] + acc[k][kk * 4 + 1] * acc[k][kk * 4 + 1]) + (acc[k][kk * 4 + 2] * acc[k][kk * 4 + 2] + acc[k][kk * 4 + 3] * acc[k][kk * 4 + 3]); }
                    const float rstd = 1.0f / sqrtf(wave_sum(ss) * (1.0f / D) + EPS);
#pragma unroll
                    for (int kk = 0; kk < 8; ++kk) { const f32x4 f0 = __builtin_bit_cast(f32x4, bl128(rfg, l16 + (unsigned)((kk & 3) * 1024), (unsigned)((kk >> 2) * 4096)));
                        f32x4 o0; o0.x = acc[k][kk * 4 + 0] * rstd * f0.x; o0.y = acc[k][kk * 4 + 1] * rstd * f0.y; o0.z = acc[k][kk * 4 + 2] * rstd * f0.z; o0.w = acc[k][kk * 4 + 3] * rstd * f0.w;
                        __builtin_amdgcn_raw_buffer_store_b128(__builtin_bit_cast(u32x4, o0), rdst, l16 + (unsigned)((kk & 3) * 1024), ot + (unsigned)((kk >> 2) * 4096), 0); }
                }
            }
        }
    }
}

#define XB_TMO      128
#define XB_XCNT(j)  (256  + 64 * (j))
#define XB_XSUB(j)  (1280 + 64 * (j))
#define XB_XGEN(j)  (2304 + 64 * (j))
#define XB_TOP      3328
#define XB_TOPGEN   3392
#define XCD_BAR_WORDS 3456
#define XB_SPIN_CAP (1u << 22)
__device__ __forceinline__ unsigned xb_ld(unsigned* p)              { return __hip_atomic_load(p, __ATOMIC_RELAXED, __HIP_MEMORY_SCOPE_AGENT); }
__device__ __forceinline__ unsigned xb_add(unsigned* p, unsigned v) { return __hip_atomic_fetch_add(p, v, __ATOMIC_RELAXED, __HIP_MEMORY_SCOPE_AGENT); }
__device__ __forceinline__ unsigned xb_xcc_id() { return (unsigned)__builtin_amdgcn_s_getreg((3 << 11) | 20) & 0xFu; }
#define XB_SPIN(cond, bar) do { unsigned _sp = 0; while (cond) { __builtin_amdgcn_s_sleep(1); \
    if ((++_sp & 255u) == 0u) { if (xb_ld(&(bar)[XB_TMO])) break; if (_sp > XB_SPIN_CAP) { atomicAdd(&(bar)[XB_TMO], 1u); break; } } } } while (0)
struct XcdBarrier { unsigned* bar; unsigned x; volatile LAS unsigned* st; };
__device__ __forceinline__ XcdBarrier xcd_barrier_post(unsigned* bar, volatile LAS unsigned* st) {
    XcdBarrier b; b.bar = bar; b.x = xb_xcc_id(); b.st = st;
    if (threadIdx.x == 0) (void)xb_add(&bar[XB_XCNT(b.x)], 1u);
    return b;
}
__device__ __forceinline__ void xcd_barrier_complete(unsigned* bar, unsigned x, unsigned G, unsigned& nloc, unsigned& nx) {
    unsigned sum, cnt, mine, sp = 0u;
    for (;;) {
        sum = 0u; cnt = 0u; mine = 0u;
#pragma unroll
        for (unsigned j = 0; j < 16; ++j) { const unsigned c = xb_ld(&bar[XB_XCNT(j)]); sum += c; cnt += (c > 0u) ? 1u : 0u; mine = (j == x) ? c : mine; }
        if (sum == G) break;
        __builtin_amdgcn_s_sleep(1);
        if ((++sp & 255u) == 0u) { if (xb_ld(&bar[XB_TMO])) break; if (sp > XB_SPIN_CAP) { atomicAdd(&bar[XB_TMO], 1u); break; } }
    }
    nloc = mine > 0u ? mine : 1u; nx = cnt > 0u ? cnt : 1u;
}
__device__ __forceinline__ void xcd_barrier(const XcdBarrier& b, unsigned G) {
    asm volatile("s_waitcnt vmcnt(0)" ::: "memory");
    __syncthreads();
    if (threadIdx.x == 0) {
        unsigned* bar = b.bar;
        __builtin_amdgcn_s_waitcnt(0);
        unsigned nloc = b.st[0], nx = b.st[1];
        if (nloc == 0u) { xcd_barrier_complete(bar, b.x, G, nloc, nx); b.st[0] = nloc; b.st[1] = nx; }
        const unsigned old = xb_add(&bar[XB_XSUB(b.x)], 1u);
        const unsigned gen = old / nloc;
        if (old + 1u == (gen + 1u) * nloc) {
            __builtin_amdgcn_fence(__ATOMIC_RELEASE, "agent");
            asm volatile("s_waitcnt vmcnt(0)" ::: "memory");
            const unsigned og = xb_add(&bar[XB_TOP], 1u);
            const unsigned tg = og / nx;
            if (og + 1u == (tg + 1u) * nx) xb_add(&bar[XB_TOPGEN], 1u);
            else XB_SPIN(xb_ld(&bar[XB_TOPGEN]) == tg, bar);
            __builtin_amdgcn_fence(__ATOMIC_ACQUIRE, "agent");
            xb_add(&bar[XB_XGEN(b.x)], 1u);
            asm volatile("s_waitcnt vmcnt(0)" ::: "memory");
        } else {
            XB_SPIN(xb_ld(&bar[XB_XGEN(b.x)]) == gen, bar);
            __builtin_amdgcn_fence(__ATOMIC_ACQUIRE, "agent");
            asm volatile("s_waitcnt vmcnt(0)" ::: "memory");
        }
    }
    __syncthreads();
}

constexpr int N_PHASES = 9;
#ifndef DUP_MASK
#define DUP_MASK 0
#endif
#define REP(k) for (int rep_ = 0; rep_ < 1 + ((DUP_MASK >> (k)) & 1); ++rep_)
__global__ void __launch_bounds__(NTHR, 2) fwd(Args args) {
    extern __shared__ __attribute__((aligned(16))) unsigned char lds_raw[];
    LAS unsigned char* lds = (LAS unsigned char*)lds_raw;
    const int tid = threadIdx.x, lane = tid & 63, wave = __builtin_amdgcn_readfirstlane(tid >> 6);
    const int G = gridDim.x; const int bx = blockIdx.x; const int vcu = (G % 8 == 0) ? (bx % 8) * (G / 8) + bx / 8 : bx;
    unsigned char* ws = args.ws;
    const int lo = args.ph_lo, hi = args.ph_hi;
#define IN(k) (lo <= (k) && (k) < hi)
    volatile LAS unsigned* MISC = (volatile LAS unsigned*)(lds + MISC_OFF);
    if (tid < 32) MISC[tid] = 0u;
    __syncthreads();
#if USE_CG_SYNC
    if (IN(0) && bx * NTHR + tid < XCD_BAR_WORDS) __hip_atomic_store((unsigned*)(ws + WS_CTL) + bx * NTHR + tid, 0u, __ATOMIC_RELAXED, __HIP_MEMORY_SCOPE_AGENT);
    XcdBarrier bar; bar.bar = (unsigned*)(ws + WS_CTL); bar.x = 0; bar.st = MISC + 8;
#else
    XcdBarrier bar = xcd_barrier_post((unsigned*)(ws + WS_CTL), MISC + 8);
#endif
#if USE_CG_SYNC
#define SEAM(k) do { if (IN(k) && IN((k) + ((k) == 4 ? 2 : 1))) { if ((k) == 0) { cg::this_grid().sync(); bar = xcd_barrier_post((unsigned*)(ws + WS_CTL), MISC + 8); } else xcd_barrier(bar, (unsigned)G); } } while (0)
#else
#define SEAM(k) do { if (IN(k) && IN((k) + ((k) == 4 ? 2 : 1))) { xcd_barrier(bar, (unsigned)G); } } while (0)
#endif

    if (IN(0)) REP(0) { p0_prologue(args, lds, vcu, G, wave, lane, tid); }
    SEAM(0);
    if (IN(1)) REP(1) {
        pg8::Gemm g{(const bf16_t*)(ws + WS_H), (const bf16_t*)(ws + WS_WIN), S, INW, D, D, D, 0}; pg8::StaticOrder so; so.init(S, INW, G, bx);
        pg8::EpiZ E{(bf16_t*)(ws + WS_Z), args.in[3]};
        pg8::gemm_phase<pg8::EpiZ>(lds, g, so, E);
    }
    SEAM(1);
    if (IN(2)) REP(2) { p2_pool(args, vcu, G, tid); p2_sgu(args, lds, vcu, G, wave, lane, tid); }
    SEAM(2);
    if (IN(3)) REP(3) {
        pg8::StaticOrder so; so.init(S, D, G, bx);
        { pg8::Gemm g{(const bf16_t*)(ws + WS_A2), (const bf16_t*)(ws + WS_WPOOL), S, D, 256, D, 256, 1};
          pg8::EpiPool E{(bf16_t*)(ws + WS_T), (const bf16_t*)(ws + WS_Z)};
          pg8::gemm_phase<pg8::EpiPool>(lds, g, so, E); }
        asm volatile("s_waitcnt vmcnt(0)" ::: "memory"); __syncthreads();
        { pg8::Gemm g{(const bf16_t*)(ws + WS_A2) + 1024, (const bf16_t*)(ws + WS_WG), S, D, GWD, D, GWD, 0};
          pg8::EpiMerge E{(const bf16_t*)(ws + WS_T), (const bf16_t*)(ws + WS_Z), (bf16_t*)(ws + WS_MRG)};
          pg8::gemm_phase<pg8::EpiMerge>(lds, g, so, E); }
    }
    SEAM(3);
    if (IN(4)) REP(4) {
        pg8::Gemm g{(const bf16_t*)(ws + WS_MRG), (const bf16_t*)(ws + WS_WOUT), S, D, D, D, D, 0}; pg8::StaticOrder so; so.init(S, D, G, bx);
        pg8::EpiX1 E{args.in[0], (bf16_t*)(ws + WS_XB), (float*)(ws + WS_SS)};
        pg8::gemm_phase<pg8::EpiX1>(lds, g, so, E);
    }
    SEAM(4);
    if (IN(6)) REP(6) {
        pg8::Gemm g{(const bf16_t*)(ws + WS_XB), (const bf16_t*)(ws + WS_WQ), S, D, D, D, D, 0}; pg8::StaticOrder so; so.init(S, D, G, bx);
        pg8::EpiQ E{(bf16_t*)(ws + WS_Q), (const float*)(ws + WS_SS)};
        pg8::gemm_phase<pg8::EpiQ>(lds, g, so, E);
    }
    if (IN(6) && IN(7)) { asm volatile("s_waitcnt vmcnt(0)" ::: "memory"); __syncthreads(); }
    if (IN(7)) REP(7) { p7_topk(args, lds, vcu, G, wave, lane); }
    SEAM(7);
    if (IN(8)) REP(8) { float* dst8 = (rep_ < ((DUP_MASK >> 8) & 1)) ? (float*)(ws + WS_T) : args.out; p8_peer(args, lds, dst8, vcu, G, wave, lane); }
#undef IN
#undef SEAM
}

extern "C" void kernel_launch(void* const* d_in, const int* in_sizes, int n_in, void* d_out, int out_size, void* d_ws, size_t ws_size, hipStream_t stream) {
    static int grid = 0;
    if (grid == 0) {
        if (n_in != 18 || out_size != S * D || ws_size < WS_END) { fprintf(stderr, "kernel_launch: unexpected shapes (n_in %d, out %d, ws %zu)\n", n_in, out_size, ws_size); grid = -1; return; }
        int dev = 0, cus = 0, per_cu = 0;
        if (hipGetDevice(&dev) != hipSuccess || hipDeviceGetAttribute(&cus, hipDeviceAttributeMultiprocessorCount, dev) != hipSuccess) { grid = -1; return; }
        if (hipFuncSetAttribute((const void*)fwd, hipFuncAttributeMaxDynamicSharedMemorySize, LDS_BYTES) != hipSuccess) { fprintf(stderr, "kernel_launch: hipFuncSetAttribute failed\n"); grid = -1; return; }
        if (hipOccupancyMaxActiveBlocksPerMultiprocessor(&per_cu, (const void*)fwd, NTHR, LDS_BYTES) != hipSuccess || per_cu < 1) { fprintf(stderr, "kernel_launch: occupancy query says %d\n", per_cu); per_cu = 1; }
        (void)hipGetLastError();
        grid = cus;
    }
    if (grid < 0) return;
#if !USE_CG_SYNC
    if (hipMemsetAsync((char*)d_ws + WS_CTL, 0, 16384, stream) != hipSuccess) { fprintf(stderr, "kernel_launch: memset failed\n"); return; }
#endif
    Args a{};
    for (int i = 0; i < 18; ++i) a.in[i] = (const float*)d_in[i];
    a.out = (float*)d_out; a.ws = (unsigned char*)d_ws;
#if MK_N_LAUNCHES == 1
    a.ph_lo = 0; a.ph_hi = N_PHASES;
    void* kargs[] = {&a};
    hipError_t e = hipLaunchCooperativeKernel((const void*)fwd, dim3(grid), dim3(NTHR), kargs, LDS_BYTES, stream);
    if (e != hipSuccess) fprintf(stderr, "kernel_launch: cooperative launch failed: %s (grid %d)\n", hipGetErrorString(e), grid);
#else
    for (int p = 0; p < N_PHASES; ++p) {
        a.ph_lo = p; a.ph_hi = p + 1;
        hipLaunchKernelGGL(fwd, dim3(grid), dim3(NTHR), LDS_BYTES, stream, a);
    }
#endif
}
```

```cpp
#include <hip/hip_runtime.h>
#include <hip/hip_cooperative_groups.h>
#include <cstdio>
#include <cstdint>
namespace cg = cooperative_groups;

#ifndef USE_CG_SYNC
#define USE_CG_SYNC 1
#endif
#ifndef MK_N_LAUNCHES
#define MK_N_LAUNCHES 1
#endif

#define LAS __attribute__((address_space(3)))
typedef unsigned short bf16_t;
typedef short bf16x8 __attribute__((ext_vector_type(8)));
typedef float f32x4 __attribute__((ext_vector_type(4)));
typedef unsigned u32x4 __attribute__((ext_vector_type(4)));
typedef unsigned u32x2 __attribute__((ext_vector_type(2)));

constexpr int S = 8192, D = 2048, INW = 7168, PW = 1024, GWD = 1024;
constexpr int NEXP = 16384;
constexpr float EPS = 1e-6f;
constexpr int NWAVES = 8, NTHR = 512;

constexpr size_t MiB = 1u << 20;
constexpr size_t WS_CTL = 0;
constexpr size_t WS_WIN = 1 * MiB;
constexpr size_t WS_WPOOL = 30 * MiB;
constexpr size_t WS_WG = 31 * MiB;
constexpr size_t WS_WOUT = 35 * MiB;
constexpr size_t WS_WQ = 43 * MiB;
constexpr size_t WS_KEYS = 51 * MiB;
constexpr size_t WS_WSM = 52 * MiB;
constexpr size_t WS_H = 53 * MiB;
constexpr size_t WS_Z = 85 * MiB;
constexpr size_t WS_A2 = 197 * MiB;
constexpr size_t WS_T = 229 * MiB;
constexpr size_t WS_MRG = 293 * MiB;
constexpr size_t WS_Q = 325 * MiB;
constexpr size_t WS_IDX = 357 * MiB;
constexpr size_t WS_GATE = 361 * MiB;
constexpr size_t WS_SS = 365 * MiB;
constexpr size_t WS_ESC = 369 * MiB;
constexpr size_t WS_EU = 370 * MiB;
constexpr size_t WS_EV = 402 * MiB;
constexpr size_t WS_XB = 434 * MiB;
constexpr size_t WS_END = 466 * MiB;

constexpr int LDS_BYTES = 147456;
constexpr int MISC_OFF = 131072 + 320;

__device__ __forceinline__ unsigned f2bf(float f) { unsigned u = __builtin_bit_cast(unsigned, f); return (u + 0x7fffu + ((u >> 16) & 1u)) >> 16; }
__device__ __forceinline__ unsigned pk2(float lo, float hi) { return f2bf(lo) | (f2bf(hi) << 16); }
__device__ __forceinline__ float bflo(unsigned w) { return __builtin_bit_cast(float, w << 16); }
__device__ __forceinline__ float bfhi(unsigned w) { return __builtin_bit_cast(float, w & 0xffff0000u); }
__device__ __forceinline__ float wave_sum(float v) {
#pragma unroll
    for (int o = 1; o < 64; o <<= 1) v += __shfl_xor(v, o);
    return v;
}
template <int CTRL> __device__ __forceinline__ float dpp_add_f32(float v) { return v + __builtin_bit_cast(float, __builtin_amdgcn_update_dpp(0, __builtin_bit_cast(int, v), CTRL, 0xF, 0xF, true)); }
__device__ __forceinline__ float row_sum_f32(float v) { v = dpp_add_f32<0xB1>(v); v = dpp_add_f32<0x4E>(v); v = dpp_add_f32<0x141>(v); v = dpp_add_f32<0x140>(v); return v; }
__device__ __forceinline__ float gelu_tanh(float x) {
    const float y = 1.5957691216057308f * (x + 0.044715f * x * x * x);
    const float e = __builtin_amdgcn_exp2f(-y * 1.4426950408889634f);
    return x * __builtin_amdgcn_rcpf(1.0f + e);
}
__device__ __forceinline__ float sigmoidf_(float x) { return __builtin_amdgcn_rcpf(1.0f + __builtin_amdgcn_exp2f(-x * 1.4426950408889634f)); }

namespace pg8 {
constexpr int BM = 256, BK = 64, HALF = 128, HTB = HALF * BK * 2, STAGE_BYTES = 8 * HTB, NXCD = 8, WGM = 1;
__host__ __device__ __forceinline__ int lds_byte(int r, int c) { const int st = (r >> 4) * 2 + (c >> 5), rr = r & 15, cc = c & 31, ob = rr * 64 + cc * 2; return st * 1024 + (ob ^ (((ob >> 9) & 1) << 5)); }
__host__ __device__ __forceinline__ void stage_rc(int b, int& R, int& C) { const int st = b / 1024, sb = b % 1024, swz = sb ^ (((sb >> 9) & 1) << 5); R = (st >> 1) * 16 + swz / 64; C = (st & 1) * 32 + (swz % 64) / 2; }
__host__ __device__ __forceinline__ int perm32(int rho) { const int n = rho >> 4, i = rho & 15; return 8 * (i >> 2) + 4 * n + (i & 3); }

struct Unit { int pm, pn; };
struct Gemm { const bf16_t* A; const bf16_t* Bt; int M, N, K, lda, ldb, mode; };
__device__ __forceinline__ const char* a_ptr(const Gemm& g, const Unit& u) {
    size_t off = (size_t)u.pm * BM * g.lda; if (g.mode == 1) off += (size_t)(u.pn >> 1) * 256; return (const char*)(g.A + off); }
__device__ __forceinline__ const char* b_ptr(const Gemm& g, const Unit& u) {
    size_t off = (g.mode == 1) ? ((size_t)(u.pn >> 1) * 512 * 256 + (size_t)(u.pn & 1) * 256 * 256) : (size_t)u.pn * BM * g.ldb; return (const char*)(g.Bt + off); }

struct StaticOrder {
    int nM, nN, nwg, G, c, pn0;
    __host__ __device__ void init(int M, int N, int G_, int c_, int pn0_ = 0) { nM = M / BM; nN = N / BM; nwg = nM * nN; G = G_; c = c_; pn0 = pn0_; }
    __host__ __device__ bool next(int i, Unit& u) const {
        const long L = (long)i * G + c; if (L >= nwg) return false;
        int wgid = (int)L; { const int q = nwg / NXCD, r = nwg % NXCD, xcd = wgid % NXCD, off = wgid / NXCD; wgid = (xcd < r ? xcd * (q + 1) : r * (q + 1) + (xcd - r) * q) + off; }
        const int nig = WGM * nN, gid = wgid / nig, fm = gid * WGM, gsz = (nM - fm) < WGM ? (nM - fm) : WGM;
        u.pm = fm + ((wgid % nig) % gsz); u.pn = pn0 + (wgid % nig) / gsz; return true;
    }
};

__device__ __forceinline__ unsigned cvt_pk_bf16(float lo, float hi) { unsigned r; asm volatile("v_cvt_pk_bf16_f32 %0, %1, %2" : "=v"(r) : "v"(lo), "v"(hi)); return r; }


struct EpiZ {
    static constexpr bool PERM = true;
    bf16_t* Z; const float* b_gate;
    __device__ __forceinline__ void operator()(const f32x4 (&acc)[2][2][4][2], const Unit& u, int wr, int wc, int fr, int fq) const {
        const int row0 = u.pm * BM + wr * 64 + fr, col0 = u.pn * BM + wc * 32 + 8 * fq;
        const int mode = u.pn < 4 ? 0 : (u.pn < 12 ? 1 : 2);
        f32x4 bv[2][2];
#pragma unroll
        for (int bj = 0; bj < 2; ++bj)
#pragma unroll
            for (int n = 0; n < 2; ++n) bv[bj][n] = (mode == 2) ? *(const f32x4*)(b_gate + (col0 - 3072) + bj * HALF + 4 * n) : (f32x4){0.f, 0.f, 0.f, 0.f};
#pragma unroll
        for (int ai = 0; ai < 2; ++ai)
#pragma unroll
            for (int m = 0; m < 4; ++m) { bf16_t* rowp = Z + (size_t)(row0 + ai * HALF + m * 16) * INW + col0;
#pragma unroll
                for (int bj = 0; bj < 2; ++bj) { f32x4 v0 = acc[ai][bj][m][0], v1 = acc[ai][bj][m][1];
                    if (mode == 1) {
#pragma unroll
                        for (int j = 0; j < 4; ++j) { v0[j] = gelu_tanh(v0[j]); v1[j] = gelu_tanh(v1[j]); } }
                    if (mode == 2) { v0 += bv[bj][0]; v1 += bv[bj][1];
#pragma unroll
                        for (int j = 0; j < 4; ++j) { v0[j] = sigmoidf_(v0[j]); v1[j] = sigmoidf_(v1[j]); } }
                    u32x4 w; w.x = cvt_pk_bf16(v0[0], v0[1]); w.y = cvt_pk_bf16(v0[2], v0[3]); w.z = cvt_pk_bf16(v1[0], v1[1]); w.w = cvt_pk_bf16(v1[2], v1[3]);
                    *(u32x4*)(rowp + bj * HALF) = w; } }
    }
};
struct EpiPool {
    static constexpr bool PERM = true;
    bf16_t* T; const bf16_t* Z;
    __device__ __forceinline__ void operator()(const f32x4 (&acc)[2][2][4][2], const Unit& u, int wr, int wc, int fr, int fq) const {
        const int row0 = u.pm * BM + wr * 64 + fr, col0 = u.pn * BM + wc * 32 + 8 * fq;
#pragma unroll
        for (int ai = 0; ai < 2; ++ai)
#pragma unroll
            for (int m = 0; m < 4; ++m) { const size_t row = (size_t)(row0 + ai * HALF + m * 16);
#pragma unroll
                for (int bj = 0; bj < 2; ++bj) { const int c = col0 + bj * HALF;
                    const u32x4 g = *(const u32x4*)(Z + row * INW + 3072 + c);
                    const f32x4 a0 = acc[ai][bj][m][0], a1 = acc[ai][bj][m][1];
                    u32x4 w; w.x = cvt_pk_bf16(bflo(g.x) * a0[0], bfhi(g.x) * a0[1]); w.y = cvt_pk_bf16(bflo(g.y) * a0[2], bfhi(g.y) * a0[3]);
                    w.z = cvt_pk_bf16(bflo(g.z) * a1[0], bfhi(g.z) * a1[1]); w.w = cvt_pk_bf16(bflo(g.w) * a1[2], bfhi(g.w) * a1[3]);
                    *(u32x4*)(T + row * D + c) = w; asm volatile("" ::: "memory"); } }
    }
};
struct EpiMerge {
    static constexpr bool PERM = true;
    const bf16_t* T; const bf16_t* Z; bf16_t* O;
    __device__ __forceinline__ void operator()(const f32x4 (&acc)[2][2][4][2], const Unit& u, int wr, int wc, int fr, int fq) const {
        const int row0 = u.pm * BM + wr * 64 + fr, col0 = u.pn * BM + wc * 32 + 8 * fq;
#pragma unroll
        for (int ai = 0; ai < 2; ++ai)
#pragma unroll
            for (int m = 0; m < 4; ++m) { const size_t row = (size_t)(row0 + ai * HALF + m * 16);
#pragma unroll
                for (int bj = 0; bj < 2; ++bj) { const int c = col0 + bj * HALF;
                    const u32x4 g = *(const u32x4*)(Z + row * INW + 5120 + c);
                    const u32x4 t = *(const u32x4*)(T + row * D + c);
                    const f32x4 a0 = acc[ai][bj][m][0], a1 = acc[ai][bj][m][1];
                    u32x4 w; w.x = cvt_pk_bf16(bflo(t.x) + bflo(g.x) * a0[0], bfhi(t.x) + bfhi(g.x) * a0[1]); w.y = cvt_pk_bf16(bflo(t.y) + bflo(g.y) * a0[2], bfhi(t.y) + bfhi(g.y) * a0[3]);
                    w.z = cvt_pk_bf16(bflo(t.z) + bflo(g.z) * a1[0], bfhi(t.z) + bfhi(g.z) * a1[1]); w.w = cvt_pk_bf16(bflo(t.w) + bflo(g.w) * a1[2], bfhi(t.w) + bfhi(g.w) * a1[3]);
                    *(u32x4*)(O + row * D + c) = w; asm volatile("" ::: "memory"); } }
    }
};
struct EpiX1 {
    static constexpr bool PERM = true;
    const float* X; bf16_t* XB; float* SS;
    __device__ __forceinline__ void operator()(const f32x4 (&acc)[2][2][4][2], const Unit& u, int wr, int wc, int fr, int fq) const {
        const int row0 = u.pm * BM + wr * 64 + fr, col0 = u.pn * BM + wc * 32 + 8 * fq;
#pragma unroll
        for (int ai = 0; ai < 2; ++ai)
#pragma unroll
            for (int m = 0; m < 4; ++m) { const size_t row = (size_t)(row0 + ai * HALF + m * 16); float ss = 0.f;
#pragma unroll
                for (int bj = 0; bj < 2; ++bj) { const size_t off = row * D + col0 + bj * HALF;
                    const f32x4 x0 = *(const f32x4*)(X + off) + acc[ai][bj][m][0], x1 = *(const f32x4*)(X + off + 4) + acc[ai][bj][m][1];
                    ss += (x0[0] * x0[0] + x0[1] * x0[1]) + (x0[2] * x0[2] + x0[3] * x0[3]) + (x1[0] * x1[0] + x1[1] * x1[1]) + (x1[2] * x1[2] + x1[3] * x1[3]);
                    u32x4 w; w.x = cvt_pk_bf16(x0[0], x0[1]); w.y = cvt_pk_bf16(x0[2], x0[3]); w.z = cvt_pk_bf16(x1[0], x1[1]); w.w = cvt_pk_bf16(x1[2], x1[3]);
                    *(u32x4*)(XB + off) = w; }
                ss += __shfl_xor(ss, 16); ss += __shfl_xor(ss, 32);
                if (fq == 0) SS[row * 32 + u.pn * 4 + wc] = ss;
                asm volatile("" ::: "memory"); }
    }
};
struct EpiQ {
    static constexpr bool PERM = true;
    bf16_t* O; const float* SS;
    __device__ __forceinline__ void operator()(const f32x4 (&acc)[2][2][4][2], const Unit& u, int wr, int wc, int fr, int fq) const {
        const int row0 = u.pm * BM + wr * 64 + fr, col0 = u.pn * BM + wc * 32 + 8 * fq;
#pragma unroll
        for (int ai = 0; ai < 2; ++ai)
#pragma unroll
            for (int m = 0; m < 4; ++m) { const size_t row = (size_t)(row0 + ai * HALF + m * 16);
                const f32x4 p0 = *(const f32x4*)(SS + row * 32 + fq * 8), p1 = *(const f32x4*)(SS + row * 32 + fq * 8 + 4);
                float ss = ((p0[0] + p0[1]) + (p0[2] + p0[3])) + ((p1[0] + p1[1]) + (p1[2] + p1[3]));
                ss += __shfl_xor(ss, 16); ss += __shfl_xor(ss, 32);
                const float rstd = 1.0f / sqrtf(ss * (1.0f / D) + EPS);
                bf16_t* rowp = O + row * D + col0;
#pragma unroll
                for (int bj = 0; bj < 2; ++bj) { const f32x4 v0 = acc[ai][bj][m][0] * rstd, v1 = acc[ai][bj][m][1] * rstd;
                    u32x4 w; w.x = cvt_pk_bf16(v0[0], v0[1]); w.y = cvt_pk_bf16(v0[2], v0[3]); w.z = cvt_pk_bf16(v1[0], v1[1]); w.w = cvt_pk_bf16(v1[2], v1[3]);
                    *(u32x4*)(rowp + bj * HALF) = w; } }
    }
};

template <class Epi, bool ALIGN_EPI = true>
__device__ __forceinline__ void gemm_phase(LAS unsigned char* lds, const Gemm g, const StaticOrder& S_, const Epi& E) {
    int tid_ = threadIdx.x; asm volatile("" : "+v"(tid_));
    const int tid = tid_, wid = __builtin_amdgcn_readfirstlane(tid >> 6), lane = tid & 63, wr = wid >> 2, wc = wid & 3, fr = lane & 15, fq = lane >> 4;
    const int K = g.K, nt = K / BK;
    unsigned voffA[2], voffB[2];
#pragma unroll
    for (int i = 0; i < 2; ++i) { int R, C; stage_rc(tid * 16 + i * 8192, R, C); const int Rb = Epi::PERM ? ((R & ~31) + perm32(R & 31)) : R;
        voffA[i] = (unsigned)(R * g.lda + C) * 2u; voffB[i] = (unsigned)(Rb * g.ldb + C) * 2u; }
    const size_t kstep = (size_t)(BK * 2);
    const size_t hstepA = (size_t)HALF * g.lda * 2, hstepB = (size_t)HALF * g.ldb * 2;
    const unsigned ldsw = (unsigned)wid * 1024u;
    const int aoff = lds_byte(wr * 64 + fr, fq * 8), boff = lds_byte(wc * 32 + fr, fq * 8);
#define PG8_SA(b, h) (((b) * 2 + (h)) * HTB)
#define PG8_SB(b, h) ((4 + (b) * 2 + (h)) * HTB)
#define PG8_STAGE(bufoff, gbase, voff) do { _Pragma("unroll") for (int _i = 0; _i < 2; ++_i) \
        __builtin_amdgcn_global_load_lds((const unsigned*)((const char*)(gbase) + (voff)[_i]), (LAS unsigned*)(lds + (bufoff) + ldsw + _i * 8192), 16, 0, 0); } while (0)
#define PG8_LDA(dst, b, h) do { _Pragma("unroll") for (int m = 0; m < 4; ++m) _Pragma("unroll") for (int k = 0; k < 2; ++k) dst[m][k] = *(const LAS bf16x8*)(lds + PG8_SA(b, h) + aoff + m * 2048 + k * 1024); } while (0)
#define PG8_LDB(dst, b, h) do { _Pragma("unroll") for (int n = 0; n < 2; ++n) _Pragma("unroll") for (int k = 0; k < 2; ++k) dst[n][k] = *(const LAS bf16x8*)(lds + PG8_SB(b, h) + boff + n * 2048 + k * 1024); } while (0)
#define PG8_MMA(ai, bj, At, Bt) do { __builtin_amdgcn_s_setprio(1); _Pragma("unroll") for (int m = 0; m < 4; ++m) _Pragma("unroll") for (int n = 0; n < 2; ++n) _Pragma("unroll") for (int k = 0; k < 2; ++k) \
        acc[ai][bj][m][n] = __builtin_amdgcn_mfma_f32_16x16x32_bf16(Bt[n][k], At[m][k], acc[ai][bj][m][n], 0, 0, 0); __builtin_amdgcn_s_setprio(0); } while (0)
#define PG8_WAIT_V(n) asm volatile("s_waitcnt vmcnt(" #n ")" ::: "memory")
#define PG8_WAIT_L(n) asm volatile("s_waitcnt lgkmcnt(" #n ")" ::: "memory")
#define PG8_BAR __builtin_amdgcn_s_barrier()
#define PG8_SCHED __builtin_amdgcn_sched_barrier(0)
    Unit cur, nxt; int ui = 0;
    if (!S_.next(0, cur)) return;
    f32x4 acc[2][2][4][2];
#pragma unroll
    for (int a = 0; a < 2; ++a)
#pragma unroll
        for (int b = 0; b < 2; ++b)
#pragma unroll
            for (int m = 0; m < 4; ++m)
#pragma unroll
                for (int n = 0; n < 2; ++n) acc[a][b][m][n] = (f32x4){0.f, 0.f, 0.f, 0.f};
    bf16x8 At[4][2], B0[2][2], B1[2][2];
    const char* cA = a_ptr(g, cur); const char* cB = b_ptr(g, cur);
    PG8_STAGE(PG8_SB(0, 0), cB, voffB); PG8_STAGE(PG8_SB(0, 1), cB + hstepB, voffB); PG8_STAGE(PG8_SA(0, 0), cA, voffA); PG8_STAGE(PG8_SA(0, 1), cA + hstepA, voffA);
    if (wr == 1) PG8_BAR;
    PG8_WAIT_V(2); PG8_BAR;
    PG8_STAGE(PG8_SB(1, 0), cB + kstep, voffB); PG8_STAGE(PG8_SA(1, 0), cA + kstep, voffA); PG8_STAGE(PG8_SB(1, 1), cB + hstepB + kstep, voffB);
    PG8_WAIT_V(6); PG8_BAR;
    for (;;) {
        const bool has_next = S_.next(ui + 1, nxt);
        const char* nA = has_next ? a_ptr(g, nxt) : cA; const char* nB = has_next ? b_ptr(g, nxt) : cB;
        for (int t = 0; t < nt; t += 2) {
            const bool last = (t == nt - 2);
            const char* a1 = cA + (size_t)(t + 1) * kstep;
            const char* a2 = last ? nA : cA + (size_t)(t + 2) * kstep; const char* b2 = last ? nB : cB + (size_t)(t + 2) * kstep;
            const char* a3 = a2 + kstep; const char* b3 = b2 + kstep;
            PG8_LDB(B0, 0, 0); PG8_LDB(B1, 0, 1); PG8_SCHED; PG8_LDA(At, 0, 0); PG8_STAGE(PG8_SA(1, 1), a1 + hstepA, voffA);
            PG8_WAIT_V(8); PG8_WAIT_L(0); PG8_BAR; PG8_MMA(0, 0, At, B0); PG8_MMA(0, 1, At, B1); PG8_BAR; PG8_SCHED;
            PG8_LDA(At, 0, 1); PG8_STAGE(PG8_SB(0, 0), b2, voffB); PG8_STAGE(PG8_SB(0, 1), b2 + hstepB, voffB); PG8_STAGE(PG8_SA(0, 0), a2, voffA);
            PG8_WAIT_V(8); PG8_WAIT_L(0); PG8_BAR; PG8_MMA(1, 0, At, B0); PG8_MMA(1, 1, At, B1); PG8_BAR; PG8_SCHED;
            PG8_LDB(B0, 1, 0); PG8_LDB(B1, 1, 1); PG8_SCHED; PG8_LDA(At, 1, 0); PG8_STAGE(PG8_SA(0, 1), a2 + hstepA, voffA);
            PG8_WAIT_V(8); PG8_WAIT_L(0); PG8_BAR; PG8_MMA(0, 0, At, B0); PG8_MMA(0, 1, At, B1); PG8_BAR; PG8_SCHED;
            PG8_LDA(At, 1, 1); PG8_STAGE(PG8_SB(1, 0), b3, voffB); PG8_STAGE(PG8_SB(1, 1), b3 + hstepB, voffB); PG8_STAGE(PG8_SA(1, 0), a3, voffA);
            PG8_WAIT_V(8); PG8_WAIT_L(0); PG8_BAR; PG8_MMA(1, 0, At, B0); PG8_MMA(1, 1, At, B1); PG8_BAR; PG8_SCHED;
        }
        if constexpr (ALIGN_EPI) { if (wr == 0) PG8_BAR; }
        { int ln_ = threadIdx.x & 63; asm volatile("" : "+v"(ln_));
          E(acc, cur, wr, wc, ln_ & 15, ln_ >> 4); }
        if (!has_next) break;
#pragma unroll
        for (int a = 0; a < 2; ++a)
#pragma unroll
            for (int b = 0; b < 2; ++b)
#pragma unroll
                for (int m = 0; m < 4; ++m)
#pragma unroll
                    for (int n = 0; n < 2; ++n) acc[a][b][m][n] = (f32x4){0.f, 0.f, 0.f, 0.f};
        cur = nxt; cA = nA; cB = nB; ++ui;
        if constexpr (ALIGN_EPI) { if (wr == 1) PG8_BAR; }
    }
    PG8_WAIT_V(0);
    if constexpr (!ALIGN_EPI) { if (wr == 0) PG8_BAR; }
    PG8_BAR;
#undef PG8_SA
#undef PG8_SB
#undef PG8_STAGE
#undef PG8_LDA
#undef PG8_LDB
#undef PG8_MMA
#undef PG8_WAIT_V
#undef PG8_WAIT_L
#undef PG8_BAR
#undef PG8_SCHED
}
}

struct Args { const float* in[18]; float* out; unsigned char* ws; int ph_lo, ph_hi; };

__device__ __forceinline__ void p0_transpose_item(const float* W, int K, int N, bf16_t* WT, LAS float* scr, int item, int lane, const float* kgain = nullptr) {
    const int nblk = N / 32, kb = item / nblk, nb = item % nblk, k0 = 64 * kb, n0 = 32 * nb;
    { f32x4 wv[8];
#pragma unroll
      for (int i = 0; i < 8; ++i) wv[i] = *(const f32x4*)(W + (size_t)(k0 + 8 * i + (lane >> 3)) * N + n0 + 4 * (lane & 7));
#pragma unroll
      for (int i = 0; i < 8; ++i) { const int kk = 8 * i + (lane >> 3); const float gk = kgain ? kgain[k0 + kk] : 1.0f; LAS float* sp = scr + kk * 33 + 4 * (lane & 7);
          sp[0] = gk * wv[i].x; sp[1] = gk * wv[i].y; sp[2] = gk * wv[i].z; sp[3] = gk * wv[i].w; } }
    asm volatile("s_waitcnt lgkmcnt(0)" ::: "memory");
    const int c = lane & 7;
#pragma unroll
    for (int j = 0; j < 4; ++j) { const int n = (lane >> 3) + 8 * j; const LAS float* s = scr + (8 * c) * 33 + n;
        u32x4 o; o.x = pk2(s[0 * 33], s[1 * 33]); o.y = pk2(s[2 * 33], s[3 * 33]); o.z = pk2(s[4 * 33], s[5 * 33]); o.w = pk2(s[6 * 33], s[7 * 33]);
        *(u32x4*)(WT + (size_t)(n0 + n) * K + k0 + 8 * c) = o; }
    asm volatile("s_waitcnt lgkmcnt(0)" ::: "memory");
}
__device__ __forceinline__ void rms_row_to_bf16(const float* xrow, const float* g, bf16_t* orow, int lane) {
    const f32x4* xr = (const f32x4*)xrow + lane;
    f32x4 v[8]; float s = 0.f;
#pragma unroll
    for (int j = 0; j < 8; ++j) { v[j] = xr[64 * j]; s += (v[j].x * v[j].x + v[j].y * v[j].y) + (v[j].z * v[j].z + v[j].w * v[j].w); }
    const float rstd = 1.0f / sqrtf(wave_sum(s) * (1.0f / D) + EPS);
    const f32x4* gr = (const f32x4*)g + lane;
    u32x2* o8 = (u32x2*)orow + lane;
#pragma unroll
    for (int j = 0; j < 8; ++j) { const f32x4 gv = gr[64 * j]; u32x2 o; o.x = pk2(v[j].x * rstd * gv.x, v[j].y * rstd * gv.y); o.y = pk2(v[j].z * rstd * gv.z, v[j].w * rstd * gv.w); o8[64 * j] = o; }
}
__device__ __forceinline__ void cvt_stream(const float* src, bf16_t* dst, size_t n8, size_t gtid, size_t nthr) {
    for (size_t i = gtid; i < n8; i += nthr) { const f32x4 a = ((const f32x4*)src)[2 * i], b = ((const f32x4*)src)[2 * i + 1];
        u32x4 o; o.x = pk2(a.x, a.y); o.y = pk2(a.z, a.w); o.z = pk2(b.x, b.y); o.w = pk2(b.z, b.w); ((u32x4*)dst)[i] = o; }
}

__device__ __forceinline__ void expert_row_load(const float* src, f32x4 (&v)[8], int lane) {
    const f32x4* xr = (const f32x4*)src + lane;
#pragma unroll
    for (int k = 0; k < 8; ++k) v[k] = xr[64 * k];
}
__device__ __forceinline__ void expert_row_gain(f32x4 (&v)[8], const float* g, int lane) {
    const f32x4* gr = (const f32x4*)g + lane;
#pragma unroll
    for (int k = 0; k < 8; ++k) v[k] = v[k] * gr[64 * k];
}
__device__ __forceinline__ void expert_row_store(const f32x4 (&v)[8], unsigned char* dst, float* isc, int lane) {
    float am = 0.f;
#pragma unroll
    for (int k = 0; k < 8; ++k) am = fmaxf(am, fmaxf(fmaxf(fabsf(v[k].x), fabsf(v[k].y)), fmaxf(fabsf(v[k].z), fabsf(v[k].w))));
#pragma unroll
    for (int o = 1; o < 64; o <<= 1) am = fmaxf(am, __shfl_xor(am, o));
    float sc = 1.0f;
    if (am > 0.f) { const float q = fminf(fmaxf(448.0f / am, 1.0e-30f), 1.0e30f); sc = __builtin_bit_cast(float, __builtin_bit_cast(unsigned, q) & 0x7f800000u); }
    unsigned o[8];
#pragma unroll
    for (int k = 0; k < 8; ++k) { int w = __builtin_amdgcn_cvt_pk_fp8_f32(v[k].x * sc, v[k].y * sc, 0, false); w = __builtin_amdgcn_cvt_pk_fp8_f32(v[k].z * sc, v[k].w * sc, w, true); o[k] = (unsigned)w; }
    u32x4 o0, o1; o0.x = o[0]; o0.y = o[1]; o0.z = o[2]; o0.w = o[3]; o1.x = o[4]; o1.y = o[5]; o1.z = o[6]; o1.w = o[7];
    *(u32x4*)(dst + lane * 16) = o0; *(u32x4*)(dst + 1024 + lane * 16) = o1;
    if (lane == 0) *isc = 1.0f / sc;
}

__device__ __forceinline__ void p0_prologue(const Args& a, LAS unsigned char* lds, int vcu, int G, int wave, int lane, int tid) {
    unsigned char* ws = a.ws;
    LAS float* scr = (LAS float*)(lds + wave * 16384);
    const int gw = vcu * NWAVES + wave, NGW = G * NWAVES;
    constexpr int I_IN = (D / 64) * (INW / 32), I_POOL1 = (256 / 64) * (512 / 32), I_G = (GWD / 64) * (D / 32), I_O = (D / 64) * (D / 32), I_Q = I_O;
    constexpr int NITEMS = I_IN + 4 * I_POOL1 + I_G + I_O + I_Q;
    for (int it = gw; it < NITEMS; it += NGW) {
        int r = it;
        if (r < I_IN) { p0_transpose_item(a.in[2], D, INW, (bf16_t*)(ws + WS_WIN), scr, r, lane); continue; } r -= I_IN;
        if (r < 4 * I_POOL1) { const int g = r / I_POOL1; p0_transpose_item(a.in[5] + (size_t)g * 256 * 512, 256, 512, (bf16_t*)(ws + WS_WPOOL) + (size_t)g * 512 * 256, scr, r % I_POOL1, lane); continue; } r -= 4 * I_POOL1;
        if (r < I_G) { p0_transpose_item(a.in[10], GWD, D, (bf16_t*)(ws + WS_WG), scr, r, lane); continue; } r -= I_G;
        if (r < I_O) { p0_transpose_item(a.in[11], D, D, (bf16_t*)(ws + WS_WOUT), scr, r, lane); continue; } r -= I_O;
        p0_transpose_item(a.in[13], D, D, (bf16_t*)(ws + WS_WQ), scr, r, lane, a.in[12]);
    }
    for (int m = gw; m < S; m += NGW) rms_row_to_bf16(a.in[0] + (size_t)m * D, a.in[1], (bf16_t*)(ws + WS_H) + (size_t)m * D, lane);
    const size_t gtid = (size_t)vcu * NTHR + tid, nthr = (size_t)G * NTHR;
    cvt_stream(a.in[14], (bf16_t*)(ws + WS_KEYS), (size_t)8 * 2 * 128 * 128 / 8, gtid, nthr);
    {
        const float* src = a.in[8]; bf16_t* dst = (bf16_t*)(ws + WS_WSM);
        for (size_t i = gtid; i < (size_t)8 * 128 * 128 / 8; i += nthr) { const int s0 = (int)(i & 15) * 8, t = (int)(i >> 4) & 127;
            const f32x4 x0 = ((const f32x4*)src)[2 * i], x1 = ((const f32x4*)src)[2 * i + 1];
            float v[8] = {x0.x, x0.y, x0.z, x0.w, x1.x, x1.y, x1.z, x1.w};
#pragma unroll
            for (int j = 0; j < 8; ++j) v[j] = (s0 + j <= t) ? v[j] : 0.f;
            u32x4 o; o.x = pk2(v[0], v[1]); o.y = pk2(v[2], v[3]); o.z = pk2(v[4], v[5]); o.w = pk2(v[6], v[7]); ((u32x4*)dst)[i] = o; }
    }
}

__device__ __forceinline__ void p2_pool(const Args& a, int vcu, int G, int tid) {
    const bf16_t* Z = (const bf16_t*)(a.ws + WS_Z); bf16_t* A2 = (bf16_t*)(a.ws + WS_A2); const float* psc = a.in[4];
    const size_t gtid = (size_t)vcu * NTHR + tid, nthr = (size_t)G * NTHR;
    for (size_t id = gtid; id < (size_t)(S / 8) * 128; id += nthr) {
        const int c8 = (int)(id & 127), t0 = (int)(id >> 7) * 8, g = c8 >> 5, w = 2 << g;
        u32x4 row[23];
#pragma unroll
        for (int r = 0; r < 23; ++r) { const int t = t0 - 15 + r; const bool need = (r >= 16 - w) && (t >= 0);
            row[r] = need ? *(const u32x4*)(Z + (size_t)t * INW + c8 * 8) : (u32x4){0u, 0u, 0u, 0u}; }
        const f32x4 p0 = *(const f32x4*)(psc + c8 * 8), p1 = *(const f32x4*)(psc + c8 * 8 + 4);
        const float ps[8] = {p0.x, p0.y, p0.z, p0.w, p1.x, p1.y, p1.z, p1.w};
        float s[8] = {0.f, 0.f, 0.f, 0.f, 0.f, 0.f, 0.f, 0.f};
#pragma unroll
        for (int r = 0; r < 15; ++r) { const u32x4 q = row[r];
            s[0] += bflo(q.x); s[1] += bfhi(q.x); s[2] += bflo(q.y); s[3] += bfhi(q.y); s[4] += bflo(q.z); s[5] += bfhi(q.z); s[6] += bflo(q.w); s[7] += bfhi(q.w); }
#pragma unroll
        for (int i = 0; i < 8; ++i) {
            const u32x4 q = row[15 + i];
            const float at[8] = {bflo(q.x), bfhi(q.x), bflo(q.y), bfhi(q.y), bflo(q.z), bfhi(q.z), bflo(q.w), bfhi(q.w)};
#pragma unroll
            for (int c = 0; c < 8; ++c) s[c] += at[c];
            const int t = t0 + i; const int cnt = (t + 1) < w ? (t + 1) : w; const float inv = 1.0f / (float)cnt;
            float o[8];
#pragma unroll
            for (int c = 0; c < 8; ++c) o[c] = (s[c] * inv - at[c]) * ps[c];
            u32x4 w4; w4.x = pk2(o[0], o[1]); w4.y = pk2(o[2], o[3]); w4.z = pk2(o[4], o[5]); w4.w = pk2(o[6], o[7]);
            *(u32x4*)(A2 + (size_t)t * D + c8 * 8) = w4;
            const u32x4 d2 = row[15 + i - 1], d4 = row[15 + i - 3], d8 = row[15 + i - 7], d16 = row[15 + i - 15];
            const u32x4 dq = g == 0 ? d2 : (g == 1 ? d4 : (g == 2 ? d8 : d16));
            s[0] -= bflo(dq.x); s[1] -= bfhi(dq.x); s[2] -= bflo(dq.y); s[3] -= bfhi(dq.y); s[4] -= bflo(dq.z); s[5] -= bfhi(dq.z); s[6] -= bflo(dq.w); s[7] -= bfhi(dq.w);
        }
    }
}
constexpr int VT_LD = 136;
__device__ __forceinline__ void p2_sgu(const Args& a, LAS unsigned char* lds, int item0, int item1, int istep, int wave, int lane, int tid) {
    const bf16_t* Z = (const bf16_t*)(a.ws + WS_Z); bf16_t* A2 = (bf16_t*)(a.ws + WS_A2); const bf16_t* WSM = (const bf16_t*)(a.ws + WS_WSM);
    const float* lng = a.in[6]; const float* lnb = a.in[7]; const float* bs = a.in[9];
    LAS float* st = (LAS float*)lds; LAS bf16_t* Vt = (LAS bf16_t*)(lds + 1024);
    const int fr = lane & 15, fq = lane >> 4;
    for (int item = item0; item < item1; item += istep) {
        const int c = item >> 3, h = item & 7, t0 = c * 128;
        u32x4 raw[4][8];
#pragma unroll
        for (int p = 0; p < 4; ++p) { const bf16_t* rp = Z + (size_t)(t0 + wave * 16 + p * 4 + fq) * INW + 2048 + fr * 8;
#pragma unroll
            for (int j = 0; j < 8; ++j) raw[p][j] = *(const u32x4*)(rp + j * 128); }
        u32x4 rawB[4];
#pragma unroll
        for (int q = 0; q < 4; ++q) { const int id = tid + q * NTHR, sr = id & 127, dc = id >> 7; rawB[q] = *(const u32x4*)(Z + (size_t)(t0 + sr) * INW + 2048 + h * 128 + dc * 8); }
        bf16x8 bW[4];
#pragma unroll
        for (int ks = 0; ks < 4; ++ks) bW[ks] = *(const bf16x8*)(WSM + (size_t)(h * 128 + wave * 16 + fr) * 128 + ks * 32 + fq * 8);
        u32x2 ur[8];
#pragma unroll
        for (int db = 0; db < 8; ++db) ur[db] = *(const u32x2*)(Z + (size_t)(t0 + wave * 16 + fr) * INW + 1024 + h * 128 + db * 16 + fq * 4);
        const float bias = bs[h * 128 + wave * 16 + fr];
#pragma unroll
        for (int p = 0; p < 4; ++p) { float s = 0.f, q = 0.f;
#pragma unroll
            for (int j = 0; j < 8; ++j)
#pragma unroll
                for (int w = 0; w < 4; ++w) { const float a0 = bflo(raw[p][j][w]), a1 = bfhi(raw[p][j][w]); s += a0 + a1; q += a0 * a0 + a1 * a1; }
            s = row_sum_f32(s); q = row_sum_f32(q);
            if (fr == 0) { const float mean = s * (1.0f / 1024.0f); const float var = fmaxf(q * (1.0f / 1024.0f) - mean * mean, 0.f);
                const int sr = wave * 16 + p * 4 + fq; st[2 * sr] = mean; st[2 * sr + 1] = 1.0f / sqrtf(var + EPS); } }
        __syncthreads();
#pragma unroll
        for (int q = 0; q < 4; ++q) { const int id = tid + q * NTHR, sr = id & 127, dc = id >> 7;
            const u32x4 rw = rawB[q];
            const float mean = st[2 * sr], rstd = st[2 * sr + 1];
            const float v[8] = {bflo(rw.x), bfhi(rw.x), bflo(rw.y), bfhi(rw.y), bflo(rw.z), bfhi(rw.z), bflo(rw.w), bfhi(rw.w)};
            const f32x4 g0 = *(const f32x4*)(lng + h * 128 + dc * 8), g1 = *(const f32x4*)(lng + h * 128 + dc * 8 + 4), b0 = *(const f32x4*)(lnb + h * 128 + dc * 8), b1 = *(const f32x4*)(lnb + h * 128 + dc * 8 + 4);
            const float gg[8] = {g0.x, g0.y, g0.z, g0.w, g1.x, g1.y, g1.z, g1.w}, bb[8] = {b0.x, b0.y, b0.z, b0.w, b1.x, b1.y, b1.z, b1.w};
#pragma unroll
            for (int i = 0; i < 8; ++i) { const int d = dc * 8 + i; const float y = (v[i] - mean) * rstd * gg[i] + bb[i]; Vt[d * VT_LD + sr] = (bf16_t)f2bf(y); } }
        __syncthreads();
        f32x4 acc[8];
#pragma unroll
        for (int db = 0; db < 8; ++db) acc[db] = (f32x4){0.f, 0.f, 0.f, 0.f};
        const int nks = (wave * 16 + 15) / 32 + 1;
#pragma unroll
        for (int ks = 0; ks < 4; ++ks) if (ks < nks) {
#pragma unroll
            for (int db = 0; db < 8; ++db) { const bf16x8 aV = *(const LAS bf16x8*)(Vt + (db * 16 + fr) * VT_LD + ks * 32 + fq * 8);
                acc[db] = __builtin_amdgcn_mfma_f32_16x16x32_bf16(aV, bW[ks], acc[db], 0, 0, 0); }
        }
        { const int t = t0 + wave * 16 + fr;
#pragma unroll
          for (int db = 0; db < 8; ++db) { const int col = h * 128 + db * 16 + fq * 4;
              u32x2 o; o.x = pk2(bflo(ur[db].x) * (acc[db][0] + bias), bfhi(ur[db].x) * (acc[db][1] + bias)); o.y = pk2(bflo(ur[db].y) * (acc[db][2] + bias), bfhi(ur[db].y) * (acc[db][3] + bias));
              *(u32x2*)(A2 + (size_t)t * D + 1024 + col) = o; } }
        __syncthreads();
    }
}

__device__ __forceinline__ unsigned f2key(float f) { const unsigned b = __builtin_bit_cast(unsigned, f); return (b & 0x80000000u) ? ~b : (b | 0x80000000u); }
__device__ __forceinline__ float key2f(unsigned k) { const unsigned b = (k & 0x80000000u) ? (k ^ 0x80000000u) : ~k; return __builtin_bit_cast(float, b); }
template <int CTRL> __device__ __forceinline__ unsigned dpp_max_u32(unsigned v) { const unsigned o = (unsigned)__builtin_amdgcn_update_dpp(0, (int)v, CTRL, 0xF, 0xF, true); return v > o ? v : o; }
__device__ __forceinline__ unsigned row_max_u32(unsigned v) { v = dpp_max_u32<0xB1>(v); v = dpp_max_u32<0x4E>(v); v = dpp_max_u32<0x141>(v); v = dpp_max_u32<0x140>(v); return v; }
__device__ __forceinline__ void ce_desc(unsigned& a, unsigned& b) { const unsigned hi = a > b ? a : b, lo = a > b ? b : a; a = hi; b = lo; }
__device__ __forceinline__ void sort8_desc(unsigned (&k)[8]) {
    ce_desc(k[0], k[1]); ce_desc(k[2], k[3]); ce_desc(k[4], k[5]); ce_desc(k[6], k[7]);
    ce_desc(k[0], k[2]); ce_desc(k[1], k[3]); ce_desc(k[4], k[6]); ce_desc(k[5], k[7]);
    ce_desc(k[1], k[2]); ce_desc(k[5], k[6]);
    ce_desc(k[0], k[4]); ce_desc(k[1], k[5]); ce_desc(k[2], k[6]); ce_desc(k[3], k[7]);
    ce_desc(k[2], k[4]); ce_desc(k[3], k[5]);
    ce_desc(k[1], k[2]); ce_desc(k[3], k[4]); ce_desc(k[5], k[6]);
}
__device__ __forceinline__ void sort4_desc(unsigned (&k)[4]) { ce_desc(k[0], k[1]); ce_desc(k[2], k[3]); ce_desc(k[0], k[2]); ce_desc(k[1], k[3]); ce_desc(k[1], k[2]); }
template <int NV> __device__ __forceinline__ unsigned row_top16_sorted(unsigned (&k)[NV], int fr) {
    unsigned tk = 0u;
    for (int it = 0; it < 16; ++it) {
        const unsigned m = row_max_u32(k[0]);
        const unsigned wm = (k[0] == m) ? 0xffffffffu : 0u;
#pragma unroll
        for (int i = 0; i + 1 < NV; ++i) k[i] = (k[i + 1] & wm) | (k[i] & ~wm);
        k[NV - 1] = k[NV - 1] & ~wm;
        tk = (fr == it) ? m : tk;
    }
    return tk;
}
__device__ __forceinline__ unsigned cand_table(int fr) {
    constexpr unsigned T[16] = {0x03020100u, 0x07060504u, 0x0b0a0908u, 0x0f0e0d0cu, 0x13121110u, 0x17161514u, 0x23222120u, 0x32313024u, 0x42414033u, 0x61605150u, 0x90807170u, 0xd0c0b0a0u, 0xfffff0e0u, 0xffffffffu, 0xffffffffu, 0xffffffffu};
    unsigned w = T[0];
#pragma unroll
    for (int i = 1; i < 16; ++i) w = (fr == i) ? T[i] : w;
    return w;
}
constexpr int SC_LD = 132;
__device__ __forceinline__ void p7_topk(const Args& a, LAS unsigned char* lds, int vcu, int G, int wave, int lane_) {
    int lane = lane_; asm volatile("" : "+v"(lane));
    const bf16_t* Q = (const bf16_t*)(a.ws + WS_Q); const bf16_t* KEYS = (const bf16_t*)(a.ws + WS_KEYS);
    int* IDX = (int*)(a.ws + WS_IDX); float* GATE = (float*)(a.ws + WS_GATE);
    LAS float* SL = (LAS float*)(lds + wave * (16 * SC_LD * 4));
    const int gw = vcu * NWAVES + wave, NGW = G * NWAVES; const int fr = lane & 15, fq = lane >> 4;
    const unsigned ctab = cand_table(fr);
    int erow = gw;
    f32x4 er0[8], er1[8]; int e0 = 2 * NEXP, e1 = 2 * NEXP;
#define ER_LOAD() do { e0 = erow; e1 = erow + NGW; erow += 2 * NGW; \
        if (e0 < 2 * NEXP) expert_row_load(a.in[15 + (e0 >= NEXP)] + (size_t)(e0 & (NEXP - 1)) * D, er0, lane); \
        if (e1 < 2 * NEXP) expert_row_load(a.in[15 + (e1 >= NEXP)] + (size_t)(e1 & (NEXP - 1)) * D, er1, lane); } while (0)
#define ER_STORE() do { \
        if (e0 < NEXP) expert_row_gain(er0, a.in[12], lane); if (e1 < NEXP) expert_row_gain(er1, a.in[12], lane); \
        if (e0 < 2 * NEXP) expert_row_store(er0, a.ws + ((e0 >= NEXP) ? WS_EV : WS_EU) + (size_t)(e0 & (NEXP - 1)) * D, (float*)(a.ws + WS_ESC) + e0, lane); \
        if (e1 < 2 * NEXP) expert_row_store(er1, a.ws + ((e1 >= NEXP) ? WS_EV : WS_EU) + (size_t)(e1 & (NEXP - 1)) * D, (float*)(a.ws + WS_ESC) + e1, lane); } while (0)
    pg8::StaticOrder so7; so7.init(S, D, G, (int)blockIdx.x); pg8::Unit u7;
    for (int ui = 0; so7.next(ui >> 1, u7); ++ui) {
        const int h = u7.pn, t0 = u7.pm * 256 + ((ui & 1) * 8 + wave) * 16;
        unsigned tk[8];
#pragma unroll
        for (int i = 0; i < 8; ++i) tk[i] = 0u;
#pragma unroll 1
        for (int p = 0; p < 2; ++p) {
            {
                bf16x8 af[4];
#pragma unroll
                for (int ks = 0; ks < 4; ++ks) af[ks] = *(const bf16x8*)(Q + (size_t)(t0 + fr) * D + h * 256 + p * 128 + ks * 32 + fq * 8);
#pragma unroll 1
                for (int g4 = 0; g4 < 2; ++g4) {
                    bf16x8 bf[4][4];
#pragma unroll
                    for (int n4 = 0; n4 < 4; ++n4)
#pragma unroll
                        for (int ks = 0; ks < 4; ++ks) bf[n4][ks] = *(const bf16x8*)(KEYS + (size_t)((h * 2 + p) * 128 + (g4 * 4 + n4) * 16 + fr) * 128 + ks * 32 + fq * 8);
#pragma unroll
                    for (int n4 = 0; n4 < 4; ++n4) { f32x4 c = {0.f, 0.f, 0.f, 0.f};
#pragma unroll
                        for (int ks = 0; ks < 4; ++ks) c = __builtin_amdgcn_mfma_f32_16x16x32_bf16(af[ks], bf[n4][ks], c, 0, 0, 0);
#pragma unroll
                        for (int j = 0; j < 4; ++j) SL[(fq * 4 + j) * SC_LD + (g4 * 4 + n4) * 16 + fr] = c[j]; }
                    asm volatile("" ::: "memory"); }
            }
            ER_LOAD();
#pragma unroll 1
            for (int j = 0; j < 4; ++j) {
                unsigned k[8];
#pragma unroll
                for (int nb = 0; nb < 8; ++nb) k[nb] = (f2key(SL[(fq * 4 + j) * SC_LD + nb * 16 + fr]) & ~127u) | (127u - (unsigned)(nb * 16 + fr));
                sort8_desc(k);
                const unsigned r = row_top16_sorted<8>(k, fr);
#pragma unroll
                for (int i = 0; i < 8; ++i) tk[i] = (i == p * 4 + j) ? r : tk[i];
            }
            ER_STORE();
        }
#pragma unroll 1
        for (int j = 0; j < 4; ++j) {
            if ((j & 1) == 0) ER_LOAD();
            const unsigned tk1 = j == 0 ? tk[0] : (j == 1 ? tk[1] : (j == 2 ? tk[2] : tk[3])), tk2 = j == 0 ? tk[4] : (j == 1 ? tk[5] : (j == 2 ? tk[6] : tk[7]));
            const float t1 = key2f(tk1 & ~127u), t2 = key2f(tk2 & ~127u); const int i1 = 127 - (int)(tk1 & 127u), i2 = 127 - (int)(tk2 & 127u);
            unsigned kc[4];
#pragma unroll
            for (int e = 0; e < 4; ++e) { const unsigned ab = (ctab >> (8 * e)) & 255u; const int ca = (int)(ab >> 4), cb = (int)(ab & 15u);
                const float c = __shfl(t1, (lane & 48) + ca) + __shfl(t2, (lane & 48) + cb);
                kc[e] = (ab == 255u) ? 0u : ((f2key(c) & ~255u) | (255u - ab)); }
            sort4_desc(kc);
            const unsigned tkc = row_top16_sorted<4>(kc, fr);
            const float ts = key2f(tkc & ~255u); const int ci = 255 - (int)(tkc & 255u);
            const int ia = __shfl(i1, (lane & 48) + (ci >> 4)), ib = __shfl(i2, (lane & 48) + (ci & 15));
            const float tmax = __shfl(ts, lane & 48);
            const float e = __expf(ts - tmax); float sum = e;
            sum += __shfl_xor(sum, 1); sum += __shfl_xor(sum, 2); sum += __shfl_xor(sum, 4); sum += __shfl_xor(sum, 8);
            const int t = t0 + fq * 4 + j;
            IDX[(size_t)t * 128 + h * 16 + fr] = ia * 128 + ib;
            GATE[(size_t)t * 128 + h * 16 + fr] = e / sum;
            if ((j & 1) == 1) ER_STORE();
        }
    }
    for (; erow < 2 * NEXP; erow += NGW) { expert_row_load(a.in[15 + (erow >= NEXP)] + (size_t)(erow & (NEXP - 1)) * D, er0, lane); if (erow < NEXP) expert_row_gain(er0, a.in[12], lane);
        expert_row_store(er0, a.ws + ((erow >= NEXP) ? WS_EV : WS_EU) + (size_t)(erow & (NEXP - 1)) * D, (float*)(a.ws + WS_ESC) + erow, lane); }
#undef ER_LOAD
#undef ER_STORE
}

typedef float f32x2 __attribute__((ext_vector_type(2)));
__device__ __forceinline__ u32x4 bl128(__amdgpu_buffer_rsrc_t r, unsigned voff, unsigned soff) { return __builtin_amdgcn_raw_buffer_load_b128(r, voff, soff, 0); }
__device__ __forceinline__ u32x2 bl64(__amdgpu_buffer_rsrc_t r, unsigned voff, unsigned soff) { return __builtin_amdgcn_raw_buffer_load_b64(r, voff, soff, 0); }
__device__ __forceinline__ unsigned bl32(__amdgpu_buffer_rsrc_t r, unsigned voff, unsigned soff) { return __builtin_amdgcn_raw_buffer_load_b32(r, voff, soff, 0); }
__device__ __forceinline__ float wave_sum_dpp(float v) {
    v = dpp_add_f32<0xB1>(v); v = dpp_add_f32<0x4E>(v); v = dpp_add_f32<0x141>(v); v = dpp_add_f32<0x140>(v);
    v += __builtin_bit_cast(float, __builtin_amdgcn_update_dpp(0, __builtin_bit_cast(int, v), 0x142, 0xA, 0xF, false));
    v += __builtin_bit_cast(float, __builtin_amdgcn_update_dpp(0, __builtin_bit_cast(int, v), 0x143, 0xC, 0xF, false));
    return __builtin_bit_cast(float, __builtin_amdgcn_readlane(__builtin_bit_cast(int, v), 63));
}
__device__ __forceinline__ float wave_sum_fast(float v) {
    v = dpp_add_f32<0xB1>(v); v = dpp_add_f32<0x4E>(v); v = dpp_add_f32<0x141>(v); v = dpp_add_f32<0x140>(v);
    v += __shfl_xor(v, 16); v += __shfl_xor(v, 32); return v;
}
constexpr int TPW = 4, NSL = 16, SL_SHIFT = 10, RING = 8, SLOT = 2048;
typedef __bf16 bf16x2_t __attribute__((ext_vector_type(2)));
__device__ __forceinline__ float dot2bf(unsigned a, unsigned b, float c) { return __builtin_amdgcn_fdot2_f32_bf16(__builtin_bit_cast(bf16x2_t, a), __builtin_bit_cast(bf16x2_t, b), c, false); }
constexpr int NROWS = TPW * 128;
#define P8_ISSUE(TBASE) do { const unsigned ro_ = (unsigned)__builtin_amdgcn_readlane(lch_, ii_ & 63) * (unsigned)D; \
        const char* src_ = (const char*)a.ws + (TBASE) + ro_ + l16; LAS unsigned char* dstl_ = ring + (ii_ & (RING - 1)) * SLOT; \
        __builtin_amdgcn_global_load_lds((const unsigned*)src_, (LAS unsigned*)dstl_, 16, 0, 0); \
        __builtin_amdgcn_global_load_lds((const unsigned*)(src_ + 1024), (LAS unsigned*)(dstl_ + 1024), 16, 0, 0); \
        ++ii_; if ((ii_ & 63) == 0) lch_ = (int)LST[ii_ + lane]; } while (0)
#define P8_RING_READ(r0, r1) do { r0 = *(const LAS u32x4*)(ring + (ci_ & (RING - 1)) * SLOT + l16); r1 = *(const LAS u32x4*)(ring + (ci_ & (RING - 1)) * SLOT + 1024 + l16); } while (0)
#define P8_STREAM_INIT(TBASE, r0, r1) int ci_ = 0, ii_ = 0; int lch_ = (int)LST[lane]; \
        asm volatile("s_waitcnt vmcnt(0) lgkmcnt(0)" ::: "memory"); \
        _Pragma("unroll 1") for (int q_ = 0; q_ < RING; ++q_) P8_ISSUE(TBASE); \
        asm volatile("s_waitcnt vmcnt(14)" ::: "memory"); P8_RING_READ(r0, r1)
#define P8_ROW_READY() asm volatile("s_waitcnt lgkmcnt(0)" ::: "memory")
#define P8_ROW_ADVANCE(TBASE, r0, r1) do { ++ci_; P8_ISSUE(TBASE); asm volatile("s_waitcnt vmcnt(14)" ::: "memory"); P8_RING_READ(r0, r1); } while (0)
#define P8_STREAM_END() asm volatile("s_waitcnt vmcnt(0) lgkmcnt(0)" ::: "memory")
static_assert(RING == 8, "the counted wait above is vmcnt(2 * (RING - 1))");
__device__ __forceinline__ void p8_peer(const Args& a, LAS unsigned char* lds, float* dst, int vcu, int G, int wave, int lane_) {
    int lane = lane_; asm volatile("" : "+v"(lane));
    const __amdgpu_buffer_rsrc_t rws = __builtin_amdgcn_make_buffer_rsrc((void*)a.ws, (short)0, (int)WS_END, 0x00020000);
    const __amdgpu_buffer_rsrc_t rdst = __builtin_amdgcn_make_buffer_rsrc((void*)dst, (short)0, S * D * 4, 0x00020000);
    const __amdgpu_buffer_rsrc_t rfg = __builtin_amdgcn_make_buffer_rsrc((void*)a.in[17], (short)0, D * 4, 0x00020000);
    LAS unsigned char* ring = lds + wave * (RING * SLOT);
    LAS unsigned* SLW = (LAS unsigned*)(lds + 132096 + wave * 1280);
    LAS unsigned short* LST = (LAS unsigned short*)SLW;
    const int gw = vcu * NWAVES + wave, NGW = G * NWAVES;
    const unsigned l16 = (unsigned)lane * 16u, l8 = (unsigned)lane * 8u, l4 = (unsigned)lane * 4u;
#pragma unroll 1
    for (int tb = gw; tb < S; tb += TPW * NGW) {
        int sid[TPW][2], offv[TPW]; float act[TPW][2]; int cntv = 0;
#pragma unroll
        for (int k = 0; k < TPW; ++k) {
            const int t = (tb + k * NGW) < S ? (tb + k * NGW) : (S - 1);
            const unsigned oi = (unsigned)(WS_IDX + (size_t)t * 512);
            const int id0 = (int)bl32(rws, l4, oi), id1 = (int)bl32(rws, l4 + 256u, oi);
            const int sl0 = id0 >> SL_SHIFT, sl1 = id1 >> SL_SHIFT;
            int pos0 = 0, pos1 = 0, basec = 0, offacc = 0;
#pragma unroll
            for (int s = 0; s < NSL; ++s) {
                const unsigned long long m0 = __ballot(sl0 == s), m1 = __ballot(sl1 == s);
                const int c0 = __popcll(m0), c1 = __popcll(m1);
                const int b0 = (int)__builtin_amdgcn_mbcnt_hi((unsigned)(m0 >> 32), __builtin_amdgcn_mbcnt_lo((unsigned)m0, 0u));
                const int b1 = (int)__builtin_amdgcn_mbcnt_hi((unsigned)(m1 >> 32), __builtin_amdgcn_mbcnt_lo((unsigned)m1, 0u));
                pos0 = (sl0 == s) ? basec + b0 : pos0; pos1 = (sl1 == s) ? basec + c0 + b1 : pos1;
                basec += c0 + c1; offacc = (lane == s + 1) ? basec : offacc; cntv = (lane == s * TPW + k) ? (c0 + c1) : cntv;
            }
            offv[k] = offacc;
            SLW[pos0] = (unsigned)id0; SLW[pos1] = (unsigned)id1; SLW[128 + pos0] = (unsigned)lane; SLW[128 + pos1] = (unsigned)(64 + lane);
            asm volatile("s_waitcnt lgkmcnt(0)" ::: "memory");
            sid[k][0] = (int)SLW[lane]; sid[k][1] = (int)SLW[64 + lane];
            act[k][0] = __builtin_bit_cast(float, SLW[128 + lane]); act[k][1] = __builtin_bit_cast(float, SLW[192 + lane]);
            asm volatile("s_waitcnt lgkmcnt(0)" ::: "memory");
        }
        {
            int incl = cntv;
#pragma unroll
            for (int o = 1; o < 64; o <<= 1) { const int up = __shfl_up(incl, o); incl += (lane >= o) ? up : 0; }
            const int gb = incl - cntv;
            asm volatile("s_waitcnt lgkmcnt(0)" ::: "memory");
#pragma unroll
            for (int k = 0; k < TPW; ++k)
#pragma unroll
                for (int h = 0; h < 2; ++h) { const int sl = sid[k][h] >> SL_SHIFT;
                    const int p = __shfl(gb, sl * TPW + k) + (h * 64 + lane) - __shfl(offv[k], sl);
                    LST[p] = (unsigned short)sid[k][h]; }
            if (lane < RING) LST[NROWS + lane] = (unsigned short)0;
            asm volatile("s_waitcnt lgkmcnt(0)" ::: "memory");
        }
        int orig[TPW][2];
#pragma unroll
        for (int k = 0; k < TPW; ++k) { orig[k][0] = __builtin_bit_cast(int, act[k][0]); orig[k][1] = __builtin_bit_cast(int, act[k][1]); act[k][0] = 0.f; act[k][1] = 0.f; }
        {
            f32x2 hf[TPW][16];
#pragma unroll
            for (int k = 0; k < TPW; ++k) { const int t = (tb + k * NGW) < S ? (tb + k * NGW) : (S - 1);
#pragma unroll
                for (int kk = 0; kk < 8; ++kk) { const u32x2 w = bl64(rws, l8 + (unsigned)(kk * 512), (unsigned)(WS_XB + (size_t)t * (D * 2)));
                    hf[k][kk * 2] = (f32x2){bflo(w.x), bfhi(w.x)}; hf[k][kk * 2 + 1] = (f32x2){bflo(w.y), bfhi(w.y)}; } }
            u32x4 r0, r1;
            P8_STREAM_INIT(WS_EU, r0, r1);
#pragma unroll 1
            for (int s = 0; s < NSL; ++s) {
#pragma unroll
                for (int k = 0; k < TPW; ++k) {
                    const int lo = __builtin_amdgcn_readlane(offv[k], s), hi = __builtin_amdgcn_readlane(offv[k], s + 1);
#pragma unroll 1
                    for (int e = lo; e < hi; ++e) {
                        P8_ROW_READY();
                        f32x2 dd0 = {0.f, 0.f}, dd1 = {0.f, 0.f};
#pragma unroll
                        for (int kk = 0; kk < 4; ++kk) {
                            { const unsigned w = r0[kk]; const f32x2 lo2 = __builtin_amdgcn_cvt_pk_f32_fp8((int)w, false), hi2 = __builtin_amdgcn_cvt_pk_f32_fp8((int)w, true);
                              dd0 = __builtin_elementwise_fma(lo2, hf[k][kk * 2], dd0); dd1 = __builtin_elementwise_fma(hi2, hf[k][kk * 2 + 1], dd1); }
                            { const unsigned w = r1[kk]; const f32x2 lo2 = __builtin_amdgcn_cvt_pk_f32_fp8((int)w, false), hi2 = __builtin_amdgcn_cvt_pk_f32_fp8((int)w, true);
                              dd0 = __builtin_elementwise_fma(lo2, hf[k][8 + kk * 2], dd0); dd1 = __builtin_elementwise_fma(hi2, hf[k][8 + kk * 2 + 1], dd1); } }
                        asm volatile("" : "+v"(dd0), "+v"(dd1));
                        P8_ROW_ADVANCE(WS_EU, r0, r1);
                        const float d = wave_sum_dpp((dd0.x + dd0.y) + (dd1.x + dd1.y));
                        act[k][0] = (lane == e) ? d : act[k][0]; act[k][1] = (lane == e - 64) ? d : act[k][1];
                    }
                }
            }
            P8_STREAM_END();
        }
#pragma unroll
        for (int k = 0; k < TPW; ++k) {
            const int t = (tb + k * NGW) < S ? (tb + k * NGW) : (S - 1);
            const float ssp = lane < 32 ? __builtin_bit_cast(float, bl32(rws, l4, (unsigned)(WS_SS + (size_t)t * 128))) : 0.f;
            const float rstd2 = 1.0f / sqrtf(wave_sum(ssp) * (1.0f / D) + EPS);
            const unsigned og = (unsigned)(WS_GATE + (size_t)t * 512);
#pragma unroll
            for (int h = 0; h < 2; ++h) {
                const float gate = __builtin_bit_cast(float, bl32(rws, (unsigned)orig[k][h] * 4u, og));
                const float su = __builtin_bit_cast(float, bl32(rws, (unsigned)sid[k][h] * 4u, (unsigned)WS_ESC)) * rstd2;
                const float sv = __builtin_bit_cast(float, bl32(rws, (unsigned)sid[k][h] * 4u, (unsigned)(WS_ESC + NEXP * 4)));
                act[k][h] = gelu_tanh(act[k][h] * su) * gate * sv; }
        }
        {
            float acc[TPW][32];
#pragma unroll
            for (int k = 0; k < TPW; ++k)
#pragma unroll
                for (int i = 0; i < 32; ++i) acc[k][i] = 0.f;
            u32x4 r0, r1;
            P8_STREAM_INIT(WS_EV, r0, r1);
#pragma unroll 1
            for (int s = 0; s < NSL; ++s) {
#pragma unroll
                for (int k = 0; k < TPW; ++k) {
                    const int lo = __builtin_amdgcn_readlane(offv[k], s), hi = __builtin_amdgcn_readlane(offv[k], s + 1);
#pragma unroll 1
                    for (int e = lo; e < hi; ++e) {
                        const int a0_ = __builtin_amdgcn_readlane(__builtin_bit_cast(int, act[k][0]), e & 63), a1_ = __builtin_amdgcn_readlane(__builtin_bit_cast(int, act[k][1]), e & 63);
                        const float aw = __builtin_bit_cast(float, e < 64 ? a0_ : a1_);
                        P8_ROW_READY();
#pragma unroll
                        for (int kk = 0; kk < 4; ++kk) {
                            { const unsigned w = r0[kk]; const int bb = kk * 4; const f32x2 lo2 = __builtin_amdgcn_cvt_pk_f32_fp8((int)w, false), hi2 = __builtin_amdgcn_cvt_pk_f32_fp8((int)w, true);
                              acc[k][bb + 0] += aw * lo2.x; acc[k][bb + 1] += aw * lo2.y; acc[k][bb + 2] += aw * hi2.x; acc[k][bb + 3] += aw * hi2.y; }
                            { const unsigned w = r1[kk]; const int bb = 16 + kk * 4; const f32x2 lo2 = __builtin_amdgcn_cvt_pk_f32_fp8((int)w, false), hi2 = __builtin_amdgcn_cvt_pk_f32_fp8((int)w, true);
                              acc[k][bb + 0] += aw * lo2.x; acc[k][bb + 1] += aw * lo2.y; acc[k][bb + 2] += aw * hi2.x; acc[k][bb + 3] += aw * hi2.y; } }
                        asm volatile("" : "+v"(acc[k][0]), "+v"(acc[k][16]));
                        P8_ROW_ADVANCE(WS_EV, r0, r1);
                    }
                }
            }
            P8_STREAM_END();
#pragma unroll
            for (int k = 0; k < TPW; ++k) { const int t = tb + k * NGW;
                if (t < S) {
                    float ss = 0.f; const unsigned ot = (unsigned)t * (unsigned)(D * 4);
#pragma unroll
                    for (int kk = 0; kk < 8; ++kk) { const u32x2 xw = bl64(rws, l8 + (unsigned)(kk * 512), (unsigned)(WS_XB + (size_t)t * (D * 2)));
                        acc[k][kk * 4 + 0] += bflo(xw.x); acc[k][kk * 4 + 1] += bfhi(xw.x); acc[k][kk * 4 + 2] += bflo(xw.y); acc[k][kk * 4 + 3] += bfhi(xw.y);
                        ss += (acc[k][kk * 4 + 0] * acc[k][kk * 4 + 0] + acc[k][kk * 4 + 1] * acc[k][kk * 4 + 1]) + (acc[k][kk * 4 + 2] * acc[k][kk * 4 + 2] + acc[k][kk * 4 + 3] * acc[k][kk * 4 + 3]); }
                    const float rstd = 1.0f / sqrtf(wave_sum(ss) * (1.0f / D) + EPS);
#pragma unroll
                    for (int kk = 0; kk < 8; ++kk) { const f32x4 f0 = __builtin_bit_cast(f32x4, bl128(rfg, l16 + (unsigned)((kk & 3) * 1024), (unsigned)((kk >> 2) * 4096)));
                        f32x4 o0; o0.x = acc[k][kk * 4 + 0] * rstd * f0.x; o0.y = acc[k][kk * 4 + 1] * rstd * f0.y; o0.z = acc[k][kk * 4 + 2] * rstd * f0.z; o0.w = acc[k][kk * 4 + 3] * rstd * f0.w;
                        __builtin_amdgcn_raw_buffer_store_b128(__builtin_bit_cast(u32x4, o0), rdst, l16 + (unsigned)((kk & 3) * 1024), ot + (unsigned)((kk >> 2) * 4096), 0); }
                }
            }
        }
    }
}

#define XB_TMO      128
#define XB_XCNT(j)  (256  + 64 * (j))
#define XB_XSUB(j)  (1280 + 64 * (j))
#define XB_XGEN(j)  (2304 + 64 * (j))
#define XB_TOP      3328
#define XB_TOPGEN   3392
#define XCD_BAR_WORDS 3456
#define XB_SPIN_CAP (1u << 22)
__device__ __forceinline__ unsigned xb_ld(unsigned* p)              { return __hip_atomic_load(p, __ATOMIC_RELAXED, __HIP_MEMORY_SCOPE_AGENT); }
__device__ __forceinline__ unsigned xb_add(unsigned* p, unsigned v) { return __hip_atomic_fetch_add(p, v, __ATOMIC_RELAXED, __HIP_MEMORY_SCOPE_AGENT); }
__device__ __forceinline__ unsigned xb_xcc_id() { return (unsigned)__builtin_amdgcn_s_getreg((3 << 11) | 20) & 0xFu; }
#define XB_SPIN(cond, bar) do { unsigned _sp = 0; while (cond) { __builtin_amdgcn_s_sleep(1); \
    if ((++_sp & 255u) == 0u) { if (xb_ld(&(bar)[XB_TMO])) break; if (_sp > XB_SPIN_CAP) { atomicAdd(&(bar)[XB_TMO], 1u); break; } } } } while (0)
struct XcdBarrier { unsigned* bar; unsigned x; volatile LAS unsigned* st; };
__device__ __forceinline__ XcdBarrier xcd_barrier_post(unsigned* bar, volatile LAS unsigned* st) {
    XcdBarrier b; b.bar = bar; b.x = xb_xcc_id(); b.st = st;
    if (threadIdx.x == 0) (void)xb_add(&bar[XB_XCNT(b.x)], 1u);
    return b;
}
__device__ __forceinline__ void xcd_barrier_complete(unsigned* bar, unsigned x, unsigned G, unsigned& nloc, unsigned& nx) {
    unsigned sum, cnt, mine, sp = 0u;
    for (;;) {
        sum = 0u; cnt = 0u; mine = 0u;
#pragma unroll
        for (unsigned j = 0; j < 16; ++j) { const unsigned c = xb_ld(&bar[XB_XCNT(j)]); sum += c; cnt += (c > 0u) ? 1u : 0u; mine = (j == x) ? c : mine; }
        if (sum == G) break;
        __builtin_amdgcn_s_sleep(1);
        if ((++sp & 255u) == 0u) { if (xb_ld(&bar[XB_TMO])) break; if (sp > XB_SPIN_CAP) { atomicAdd(&bar[XB_TMO], 1u); break; } }
    }
    nloc = mine > 0u ? mine : 1u; nx = cnt > 0u ? cnt : 1u;
}
__device__ __forceinline__ void xcd_barrier(const XcdBarrier& b, unsigned G) {
    asm volatile("s_waitcnt vmcnt(0)" ::: "memory");
    __syncthreads();
    if (threadIdx.x == 0) {
        unsigned* bar = b.bar;
        __builtin_amdgcn_s_waitcnt(0);
        unsigned nloc = b.st[0], nx = b.st[1];
        if (nloc == 0u) { xcd_barrier_complete(bar, b.x, G, nloc, nx); b.st[0] = nloc; b.st[1] = nx; }
        const unsigned old = xb_add(&bar[XB_XSUB(b.x)], 1u);
        const unsigned gen = old / nloc;
        if (old + 1u == (gen + 1u) * nloc) {
            __builtin_amdgcn_fence(__ATOMIC_RELEASE, "agent");
            asm volatile("s_waitcnt vmcnt(0)" ::: "memory");
            const unsigned og = xb_add(&bar[XB_TOP], 1u);
            const unsigned tg = og / nx;
            if (og + 1u == (tg + 1u) * nx) xb_add(&bar[XB_TOPGEN], 1u);
            else XB_SPIN(xb_ld(&bar[XB_TOPGEN]) == tg, bar);
            __builtin_amdgcn_fence(__ATOMIC_ACQUIRE, "agent");
            xb_add(&bar[XB_XGEN(b.x)], 1u);
            asm volatile("s_waitcnt vmcnt(0)" ::: "memory");
        } else {
            XB_SPIN(xb_ld(&bar[XB_XGEN(b.x)]) == gen, bar);
            __builtin_amdgcn_fence(__ATOMIC_ACQUIRE, "agent");
            asm volatile("s_waitcnt vmcnt(0)" ::: "memory");
        }
    }
    __syncthreads();
}

constexpr int N_PHASES = 9;
#ifndef DUP_MASK
#define DUP_MASK 0
#endif
#define REP(k) for (int rep_ = 0; rep_ < 1 + ((DUP_MASK >> (k)) & 1); ++rep_)
__global__ void __launch_bounds__(NTHR, 2) fwd(Args args) {
    extern __shared__ __attribute__((aligned(16))) unsigned char lds_raw[];
    LAS unsigned char* lds = (LAS unsigned char*)lds_raw;
    const int tid = threadIdx.x, lane = tid & 63, wave = __builtin_amdgcn_readfirstlane(tid >> 6);
    const int G = gridDim.x; const int bx = blockIdx.x; const int vcu = (G % 8 == 0) ? (bx % 8) * (G / 8) + bx / 8 : bx;
    unsigned char* ws = args.ws;
    const int lo = args.ph_lo, hi = args.ph_hi;
#define IN(k) (lo <= (k) && (k) < hi)
    volatile LAS unsigned* MISC = (volatile LAS unsigned*)(lds + MISC_OFF);
    if (tid < 32) MISC[tid] = 0u;
    __syncthreads();
#if USE_CG_SYNC
    if (IN(0) && bx * NTHR + tid < XCD_BAR_WORDS) __hip_atomic_store((unsigned*)(ws + WS_CTL) + bx * NTHR + tid, 0u, __ATOMIC_RELAXED, __HIP_MEMORY_SCOPE_AGENT);
    XcdBarrier bar; bar.bar = (unsigned*)(ws + WS_CTL); bar.x = 0; bar.st = MISC + 8;
#else
    XcdBarrier bar = xcd_barrier_post((unsigned*)(ws + WS_CTL), MISC + 8);
#endif
#if USE_CG_SYNC
#define SEAM(k) do { if (IN(k) && IN((k) + ((k) == 4 ? 2 : 1))) { if ((k) == 0) { cg::this_grid().sync(); bar = xcd_barrier_post((unsigned*)(ws + WS_CTL), MISC + 8); } else xcd_barrier(bar, (unsigned)G); } } while (0)
#else
#define SEAM(k) do { if (IN(k) && IN((k) + ((k) == 4 ? 2 : 1))) { xcd_barrier(bar, (unsigned)G); } } while (0)
#endif

    if (IN(0)) REP(0) { p0_prologue(args, lds, vcu, G, wave, lane, tid); }
    SEAM(0);
    constexpr int P1_TILES = 24;
    if (IN(1)) REP(1) {
        pg8::Gemm g{(const bf16_t*)(ws + WS_H), (const bf16_t*)(ws + WS_WIN), S, P1_TILES * 256, D, D, D, 0}; pg8::StaticOrder so; so.init(S, P1_TILES * 256, G, bx);
        pg8::EpiZ E{(bf16_t*)(ws + WS_Z), args.in[3]};
        pg8::gemm_phase<pg8::EpiZ>(lds, g, so, E);
    }
    SEAM(1);
    if (IN(2)) REP(2) {
        const int G2 = G / 2;
        if (G2 >= 1 && bx < G2) {
            pg8::Gemm g{(const bf16_t*)(ws + WS_H), (const bf16_t*)(ws + WS_WIN), S, INW, D, D, D, 0}; pg8::StaticOrder so; so.init(S, (28 - P1_TILES) * 256, G2, bx, P1_TILES);
            pg8::EpiZ E{(bf16_t*)(ws + WS_Z), args.in[3]};
            pg8::gemm_phase<pg8::EpiZ>(lds, g, so, E);
            p2_pool(args, bx, G2, tid);
        } else {
            p2_sgu(args, lds, bx - G2, 512, G - G2, wave, lane, tid);
        }
    }
    SEAM(2);
    if (IN(3)) REP(3) {
        pg8::StaticOrder so; so.init(S, D, G, bx);
        { pg8::Gemm g{(const bf16_t*)(ws + WS_A2), (const bf16_t*)(ws + WS_WPOOL), S, D, 256, D, 256, 1};
          pg8::EpiPool E{(bf16_t*)(ws + WS_T), (const bf16_t*)(ws + WS_Z)};
          pg8::gemm_phase<pg8::EpiPool>(lds, g, so, E); }
        asm volatile("s_waitcnt vmcnt(0)" ::: "memory"); __syncthreads();
        { pg8::Gemm g{(const bf16_t*)(ws + WS_A2) + 1024, (const bf16_t*)(ws + WS_WG), S, D, GWD, D, GWD, 0};
          pg8::EpiMerge E{(const bf16_t*)(ws + WS_T), (const bf16_t*)(ws + WS_Z), (bf16_t*)(ws + WS_MRG)};
          pg8::gemm_phase<pg8::EpiMerge>(lds, g, so, E); }
    }
    SEAM(3);
    if (IN(4)) REP(4) {
        pg8::Gemm g{(const bf16_t*)(ws + WS_MRG), (const bf16_t*)(ws + WS_WOUT), S, D, D, D, D, 0}; pg8::StaticOrder so; so.init(S, D, G, bx);
        pg8::EpiX1 E{args.in[0], (bf16_t*)(ws + WS_XB), (float*)(ws + WS_SS)};
        pg8::gemm_phase<pg8::EpiX1>(lds, g, so, E);
    }
    SEAM(4);
    if (IN(6)) REP(6) {
        pg8::Gemm g{(const bf16_t*)(ws + WS_XB), (const bf16_t*)(ws + WS_WQ), S, D, D, D, D, 0}; pg8::StaticOrder so; so.init(S, D, G, bx);
        pg8::EpiQ E{(bf16_t*)(ws + WS_Q), (const float*)(ws + WS_SS)};
        pg8::gemm_phase<pg8::EpiQ>(lds, g, so, E);
    }
    if (IN(6) && IN(7)) { asm volatile("s_waitcnt vmcnt(0)" ::: "memory"); __syncthreads(); }
    if (IN(7)) REP(7) { p7_topk(args, lds, vcu, G, wave, lane); }
    SEAM(7);
    if (IN(8)) REP(8) { float* dst8 = (rep_ < ((DUP_MASK >> 8) & 1)) ? (float*)(ws + WS_T) : args.out; p8_peer(args, lds, dst8, vcu, G, wave, lane); }
#undef IN
#undef SEAM
}

extern "C" void kernel_launch(void* const* d_in, const int* in_sizes, int n_in, void* d_out, int out_size, void* d_ws, size_t ws_size, hipStream_t stream) {
    static int grid = 0;
    if (grid == 0) {
        if (n_in != 18 || out_size != S * D || ws_size < WS_END) { fprintf(stderr, "kernel_launch: unexpected shapes (n_in %d, out %d, ws %zu)\n", n_in, out_size, ws_size); grid = -1; return; }
        int dev = 0, cus = 0, per_cu = 0;
        if (hipGetDevice(&dev) != hipSuccess || hipDeviceGetAttribute(&cus, hipDeviceAttributeMultiprocessorCount, dev) != hipSuccess) { grid = -1; return; }
        if (hipFuncSetAttribute((const void*)fwd, hipFuncAttributeMaxDynamicSharedMemorySize, LDS_BYTES) != hipSuccess) { fprintf(stderr, "kernel_launch: hipFuncSetAttribute failed\n"); grid = -1; return; }
        if (hipOccupancyMaxActiveBlocksPerMultiprocessor(&per_cu, (const void*)fwd, NTHR, LDS_BYTES) != hipSuccess || per_cu < 1) { fprintf(stderr, "kernel_launch: occupancy query says %d\n", per_cu); per_cu = 1; }
        (void)hipGetLastError();
        grid = cus;
    }
    if (grid < 0) return;
#if !USE_CG_SYNC
    if (hipMemsetAsync((char*)d_ws + WS_CTL, 0, 16384, stream) != hipSuccess) { fprintf(stderr, "kernel_launch: memset failed\n"); return; }
#endif
    Args a{};
    for (int i = 0; i < 18; ++i) a.in[i] = (const float*)d_in[i];
    a.out = (float*)d_out; a.ws = (unsigned char*)d_ws;
#if MK_N_LAUNCHES == 1
    a.ph_lo = 0; a.ph_hi = N_PHASES;
    void* kargs[] = {&a};
    hipError_t e = hipLaunchCooperativeKernel((const void*)fwd, dim3(grid), dim3(NTHR), kargs, LDS_BYTES, stream);
    if (e != hipSuccess) fprintf(stderr, "kernel_launch: cooperative launch failed: %s (grid %d)\n", hipGetErrorString(e), grid);
#else
    for (int p = 0; p < N_PHASES; ++p) {
        a.ph_lo = p; a.ph_hi = p + 1;
        hipLaunchKernelGGL(fwd, dim3(grid), dim3(NTHR), LDS_BYTES, stream, a);
    }
#endif
}
```

```cpp
#include <hip/hip_runtime.h>
#include <hip/hip_cooperative_groups.h>
#include <cstdio>
#include <cstdint>
namespace cg = cooperative_groups;

#ifndef USE_CG_SYNC
#define USE_CG_SYNC 1
#endif
#ifndef MK_N_LAUNCHES
#define MK_N_LAUNCHES 1
#endif

#define LAS __attribute__((address_space(3)))
typedef unsigned short bf16_t;
typedef short bf16x8 __attribute__((ext_vector_type(8)));
typedef float f32x4 __attribute__((ext_vector_type(4)));
typedef unsigned u32x4 __attribute__((ext_vector_type(4)));
typedef unsigned u32x2 __attribute__((ext_vector_type(2)));

constexpr int S = 8192, D = 2048, INW = 7168, PW = 1024, GWD = 1024;
constexpr int NEXP = 16384;
constexpr float EPS = 1e-6f;
constexpr int NWAVES = 8, NTHR = 512;

constexpr size_t MiB = 1u << 20;
constexpr size_t WS_CTL = 0;
constexpr size_t WS_WIN = 1 * MiB;
constexpr size_t WS_WPOOL = 30 * MiB;
constexpr size_t WS_WG = 31 * MiB;
constexpr size_t WS_WOUT = 35 * MiB;
constexpr size_t WS_WQ = 43 * MiB;
constexpr size_t WS_KEYS = 51 * MiB;
constexpr size_t WS_WSM = 52 * MiB;
constexpr size_t WS_H = 53 * MiB;
constexpr size_t WS_Z = 85 * MiB;
constexpr size_t WS_A2 = 197 * MiB;
constexpr size_t WS_T = 229 * MiB;
constexpr size_t WS_MRG = 293 * MiB;
constexpr size_t WS_Q = 325 * MiB;
constexpr size_t WS_IDX = 357 * MiB;
constexpr size_t WS_GATE = 361 * MiB;
constexpr size_t WS_SS = 365 * MiB;
constexpr size_t WS_ESC = 369 * MiB;
constexpr size_t WS_EU = 370 * MiB;
constexpr size_t WS_EV = 402 * MiB;
constexpr size_t WS_XB = 434 * MiB;
constexpr size_t WS_END = 466 * MiB;

constexpr int LDS_BYTES = 147456;
constexpr int MISC_OFF = 131072 + 320;

__device__ __forceinline__ unsigned f2bf(float f) { unsigned u = __builtin_bit_cast(unsigned, f); return (u + 0x7fffu + ((u >> 16) & 1u)) >> 16; }
__device__ __forceinline__ unsigned pk2(float lo, float hi) { return f2bf(lo) | (f2bf(hi) << 16); }
__device__ __forceinline__ float bflo(unsigned w) { return __builtin_bit_cast(float, w << 16); }
__device__ __forceinline__ float bfhi(unsigned w) { return __builtin_bit_cast(float, w & 0xffff0000u); }
__device__ __forceinline__ float wave_sum(float v) {
#pragma unroll
    for (int o = 1; o < 64; o <<= 1) v += __shfl_xor(v, o);
    return v;
}
template <int CTRL> __device__ __forceinline__ float dpp_add_f32(float v) { return v + __builtin_bit_cast(float, __builtin_amdgcn_update_dpp(0, __builtin_bit_cast(int, v), CTRL, 0xF, 0xF, true)); }
__device__ __forceinline__ float row_sum_f32(float v) { v = dpp_add_f32<0xB1>(v); v = dpp_add_f32<0x4E>(v); v = dpp_add_f32<0x141>(v); v = dpp_add_f32<0x140>(v); return v; }
__device__ __forceinline__ float gelu_tanh(float x) {
    const float y = 1.5957691216057308f * (x + 0.044715f * x * x * x);
    const float e = __builtin_amdgcn_exp2f(-y * 1.4426950408889634f);
    return x * __builtin_amdgcn_rcpf(1.0f + e);
}
__device__ __forceinline__ float sigmoidf_(float x) { return __builtin_amdgcn_rcpf(1.0f + __builtin_amdgcn_exp2f(-x * 1.4426950408889634f)); }

namespace pg8 {
constexpr int BM = 256, BK = 64, HALF = 128, HTB = HALF * BK * 2, STAGE_BYTES = 8 * HTB, NXCD = 8, WGM = 1;
__host__ __device__ __forceinline__ int lds_byte(int r, int c) { const int st = (r >> 4) * 2 + (c >> 5), rr = r & 15, cc = c & 31, ob = rr * 64 + cc * 2; return st * 1024 + (ob ^ (((ob >> 9) & 1) << 5)); }
__host__ __device__ __forceinline__ void stage_rc(int b, int& R, int& C) { const int st = b / 1024, sb = b % 1024, swz = sb ^ (((sb >> 9) & 1) << 5); R = (st >> 1) * 16 + swz / 64; C = (st & 1) * 32 + (swz % 64) / 2; }
__host__ __device__ __forceinline__ int perm32(int rho) { const int n = rho >> 4, i = rho & 15; return 8 * (i >> 2) + 4 * n + (i & 3); }

struct Unit { int pm, pn; };
struct Gemm { const bf16_t* A; const bf16_t* Bt; int M, N, K, lda, ldb, mode; };
__device__ __forceinline__ const char* a_ptr(const Gemm& g, const Unit& u) {
    size_t off = (size_t)u.pm * BM * g.lda; if (g.mode == 1) off += (size_t)(u.pn >> 1) * 256; return (const char*)(g.A + off); }
__device__ __forceinline__ const char* b_ptr(const Gemm& g, const Unit& u) {
    size_t off = (g.mode == 1) ? ((size_t)(u.pn >> 1) * 512 * 256 + (size_t)(u.pn & 1) * 256 * 256) : (size_t)u.pn * BM * g.ldb; return (const char*)(g.Bt + off); }

struct StaticOrder {
    int nM, nN, nwg, G, c, pn0;
    __host__ __device__ void init(int M, int N, int G_, int c_, int pn0_ = 0) { nM = M / BM; nN = N / BM; nwg = nM * nN; G = G_; c = c_; pn0 = pn0_; }
    __host__ __device__ bool next(int i, Unit& u) const {
        const long L = (long)i * G + c; if (L >= nwg) return false;
        int wgid = (int)L; { const int q = nwg / NXCD, r = nwg % NXCD, xcd = wgid % NXCD, off = wgid / NXCD; wgid = (xcd < r ? xcd * (q + 1) : r * (q + 1) + (xcd - r) * q) + off; }
        const int nig = WGM * nN, gid = wgid / nig, fm = gid * WGM, gsz = (nM - fm) < WGM ? (nM - fm) : WGM;
        u.pm = fm + ((wgid % nig) % gsz); u.pn = pn0 + (wgid % nig) / gsz; return true;
    }
};

__device__ __forceinline__ unsigned cvt_pk_bf16(float lo, float hi) { unsigned r; asm volatile("v_cvt_pk_bf16_f32 %0, %1, %2" : "=v"(r) : "v"(lo), "v"(hi)); return r; }


struct EpiZ {
    static constexpr bool PERM = true;
    bf16_t* Z; const float* b_gate;
    __device__ __forceinline__ void operator()(const f32x4 (&acc)[2][2][4][2], const Unit& u, int wr, int wc, int fr, int fq) const {
        const int row0 = u.pm * BM + wr * 64 + fr, col0 = u.pn * BM + wc * 32 + 8 * fq;
        const int mode = u.pn < 4 ? 0 : (u.pn < 12 ? 1 : 2);
        f32x4 bv[2][2];
#pragma unroll
        for (int bj = 0; bj < 2; ++bj)
#pragma unroll
            for (int n = 0; n < 2; ++n) bv[bj][n] = (mode == 2) ? *(const f32x4*)(b_gate + (col0 - 3072) + bj * HALF + 4 * n) : (f32x4){0.f, 0.f, 0.f, 0.f};
#pragma unroll
        for (int ai = 0; ai < 2; ++ai)
#pragma unroll
            for (int m = 0; m < 4; ++m) { bf16_t* rowp = Z + (size_t)(row0 + ai * HALF + m * 16) * INW + col0;
#pragma unroll
                for (int bj = 0; bj < 2; ++bj) { f32x4 v0 = acc[ai][bj][m][0], v1 = acc[ai][bj][m][1];
                    if (mode == 1) {
#pragma unroll
                        for (int j = 0; j < 4; ++j) { v0[j] = gelu_tanh(v0[j]); v1[j] = gelu_tanh(v1[j]); } }
                    if (mode == 2) { v0 += bv[bj][0]; v1 += bv[bj][1];
#pragma unroll
                        for (int j = 0; j < 4; ++j) { v0[j] = sigmoidf_(v0[j]); v1[j] = sigmoidf_(v1[j]); } }
                    u32x4 w; w.x = cvt_pk_bf16(v0[0], v0[1]); w.y = cvt_pk_bf16(v0[2], v0[3]); w.z = cvt_pk_bf16(v1[0], v1[1]); w.w = cvt_pk_bf16(v1[2], v1[3]);
                    *(u32x4*)(rowp + bj * HALF) = w; } }
    }
};
struct EpiPool {
    static constexpr bool PERM = true;
    bf16_t* T; const bf16_t* Z;
    __device__ __forceinline__ void operator()(const f32x4 (&acc)[2][2][4][2], const Unit& u, int wr, int wc, int fr, int fq) const {
        const int row0 = u.pm * BM + wr * 64 + fr, col0 = u.pn * BM + wc * 32 + 8 * fq;
#pragma unroll
        for (int ai = 0; ai < 2; ++ai)
#pragma unroll
            for (int m = 0; m < 4; ++m) { const size_t row = (size_t)(row0 + ai * HALF + m * 16);
#pragma unroll
                for (int bj = 0; bj < 2; ++bj) { const int c = col0 + bj * HALF;
                    const u32x4 g = *(const u32x4*)(Z + row * INW + 3072 + c);
                    const f32x4 a0 = acc[ai][bj][m][0], a1 = acc[ai][bj][m][1];
                    u32x4 w; w.x = cvt_pk_bf16(bflo(g.x) * a0[0], bfhi(g.x) * a0[1]); w.y = cvt_pk_bf16(bflo(g.y) * a0[2], bfhi(g.y) * a0[3]);
                    w.z = cvt_pk_bf16(bflo(g.z) * a1[0], bfhi(g.z) * a1[1]); w.w = cvt_pk_bf16(bflo(g.w) * a1[2], bfhi(g.w) * a1[3]);
                    *(u32x4*)(T + row * D + c) = w; asm volatile("" ::: "memory"); } }
    }
};
struct EpiMerge {
    static constexpr bool PERM = true;
    const bf16_t* T; const bf16_t* Z; bf16_t* O;
    __device__ __forceinline__ void operator()(const f32x4 (&acc)[2][2][4][2], const Unit& u, int wr, int wc, int fr, int fq) const {
        const int row0 = u.pm * BM + wr * 64 + fr, col0 = u.pn * BM + wc * 32 + 8 * fq;
#pragma unroll
        for (int ai = 0; ai < 2; ++ai)
#pragma unroll
            for (int m = 0; m < 4; ++m) { const size_t row = (size_t)(row0 + ai * HALF + m * 16);
#pragma unroll
                for (int bj = 0; bj < 2; ++bj) { const int c = col0 + bj * HALF;
                    const u32x4 g = *(const u32x4*)(Z + row * INW + 5120 + c);
                    const u32x4 t = *(const u32x4*)(T + row * D + c);
                    const f32x4 a0 = acc[ai][bj][m][0], a1 = acc[ai][bj][m][1];
                    u32x4 w; w.x = cvt_pk_bf16(bflo(t.x) + bflo(g.x) * a0[0], bfhi(t.x) + bfhi(g.x) * a0[1]); w.y = cvt_pk_bf16(bflo(t.y) + bflo(g.y) * a0[2], bfhi(t.y) + bfhi(g.y) * a0[3]);
                    w.z = cvt_pk_bf16(bflo(t.z) + bflo(g.z) * a1[0], bfhi(t.z) + bfhi(g.z) * a1[1]); w.w = cvt_pk_bf16(bflo(t.w) + bflo(g.w) * a1[2], bfhi(t.w) + bfhi(g.w) * a1[3]);
                    *(u32x4*)(O + row * D + c) = w; asm volatile("" ::: "memory"); } }
    }
};
struct EpiX1 {
    static constexpr bool PERM = true;
    const float* X; bf16_t* XB; float* SS;
    __device__ __forceinline__ void operator()(const f32x4 (&acc)[2][2][4][2], const Unit& u, int wr, int wc, int fr, int fq) const {
        const int row0 = u.pm * BM + wr * 64 + fr, col0 = u.pn * BM + wc * 32 + 8 * fq;
#pragma unroll
        for (int ai = 0; ai < 2; ++ai)
#pragma unroll
            for (int m = 0; m < 4; ++m) { const size_t row = (size_t)(row0 + ai * HALF + m * 16); float ss = 0.f;
#pragma unroll
                for (int bj = 0; bj < 2; ++bj) { const size_t off = row * D + col0 + bj * HALF;
                    const f32x4 x0 = *(const f32x4*)(X + off) + acc[ai][bj][m][0], x1 = *(const f32x4*)(X + off + 4) + acc[ai][bj][m][1];
                    ss += (x0[0] * x0[0] + x0[1] * x0[1]) + (x0[2] * x0[2] + x0[3] * x0[3]) + (x1[0] * x1[0] + x1[1] * x1[1]) + (x1[2] * x1[2] + x1[3] * x1[3]);
                    u32x4 w; w.x = cvt_pk_bf16(x0[0], x0[1]); w.y = cvt_pk_bf16(x0[2], x0[3]); w.z = cvt_pk_bf16(x1[0], x1[1]); w.w = cvt_pk_bf16(x1[2], x1[3]);
                    *(u32x4*)(XB + off) = w; }
                ss += __shfl_xor(ss, 16); ss += __shfl_xor(ss, 32);
                if (fq == 0) SS[row * 32 + u.pn * 4 + wc] = ss;
                asm volatile("" ::: "memory"); }
    }
};
struct EpiQ {
    static constexpr bool PERM = true;
    bf16_t* O; const float* SS;
    __device__ __forceinline__ void operator()(const f32x4 (&acc)[2][2][4][2], const Unit& u, int wr, int wc, int fr, int fq) const {
        const int row0 = u.pm * BM + wr * 64 + fr, col0 = u.pn * BM + wc * 32 + 8 * fq;
#pragma unroll
        for (int ai = 0; ai < 2; ++ai)
#pragma unroll
            for (int m = 0; m < 4; ++m) { const size_t row = (size_t)(row0 + ai * HALF + m * 16);
                const f32x4 p0 = *(const f32x4*)(SS + row * 32 + fq * 8), p1 = *(const f32x4*)(SS + row * 32 + fq * 8 + 4);
                float ss = ((p0[0] + p0[1]) + (p0[2] + p0[3])) + ((p1[0] + p1[1]) + (p1[2] + p1[3]));
                ss += __shfl_xor(ss, 16); ss += __shfl_xor(ss, 32);
                const float rstd = 1.0f / sqrtf(ss * (1.0f / D) + EPS);
                bf16_t* rowp = O + row * D + col0;
#pragma unroll
                for (int bj = 0; bj < 2; ++bj) { const f32x4 v0 = acc[ai][bj][m][0] * rstd, v1 = acc[ai][bj][m][1] * rstd;
                    u32x4 w; w.x = cvt_pk_bf16(v0[0], v0[1]); w.y = cvt_pk_bf16(v0[2], v0[3]); w.z = cvt_pk_bf16(v1[0], v1[1]); w.w = cvt_pk_bf16(v1[2], v1[3]);
                    *(u32x4*)(rowp + bj * HALF) = w; } }
    }
};

template <class Epi, bool ALIGN_EPI = true>
__device__ __forceinline__ void gemm_phase(LAS unsigned char* lds, const Gemm g, const StaticOrder& S_, const Epi& E) {
    int tid_ = threadIdx.x; asm volatile("" : "+v"(tid_));
    const int tid = tid_, wid = __builtin_amdgcn_readfirstlane(tid >> 6), lane = tid & 63, wr = wid >> 2, wc = wid & 3, fr = lane & 15, fq = lane >> 4;
    const int K = g.K, nt = K / BK;
    unsigned voffA[2], voffB[2];
#pragma unroll
    for (int i = 0; i < 2; ++i) { int R, C; stage_rc(tid * 16 + i * 8192, R, C); const int Rb = Epi::PERM ? ((R & ~31) + perm32(R & 31)) : R;
        voffA[i] = (unsigned)(R * g.lda + C) * 2u; voffB[i] = (unsigned)(Rb * g.ldb + C) * 2u; }
    const size_t kstep = (size_t)(BK * 2);
    const size_t hstepA = (size_t)HALF * g.lda * 2, hstepB = (size_t)HALF * g.ldb * 2;
    const unsigned ldsw = (unsigned)wid * 1024u;
    const int aoff = lds_byte(wr * 64 + fr, fq * 8), boff = lds_byte(wc * 32 + fr, fq * 8);
#define PG8_SA(b, h) (((b) * 2 + (h)) * HTB)
#define PG8_SB(b, h) ((4 + (b) * 2 + (h)) * HTB)
#define PG8_STAGE(bufoff, gbase, voff) do { _Pragma("unroll") for (int _i = 0; _i < 2; ++_i) \
        __builtin_amdgcn_global_load_lds((const unsigned*)((const char*)(gbase) + (voff)[_i]), (LAS unsigned*)(lds + (bufoff) + ldsw + _i * 8192), 16, 0, 0); } while (0)
#define PG8_LDA(dst, b, h) do { _Pragma("unroll") for (int m = 0; m < 4; ++m) _Pragma("unroll") for (int k = 0; k < 2; ++k) dst[m][k] = *(const LAS bf16x8*)(lds + PG8_SA(b, h) + aoff + m * 2048 + k * 1024); } while (0)
#define PG8_LDB(dst, b, h) do { _Pragma("unroll") for (int n = 0; n < 2; ++n) _Pragma("unroll") for (int k = 0; k < 2; ++k) dst[n][k] = *(const LAS bf16x8*)(lds + PG8_SB(b, h) + boff + n * 2048 + k * 1024); } while (0)
#define PG8_MMA(ai, bj, At, Bt) do { __builtin_amdgcn_s_setprio(1); _Pragma("unroll") for (int m = 0; m < 4; ++m) _Pragma("unroll") for (int n = 0; n < 2; ++n) _Pragma("unroll") for (int k = 0; k < 2; ++k) \
        acc[ai][bj][m][n] = __builtin_amdgcn_mfma_f32_16x16x32_bf16(Bt[n][k], At[m][k], acc[ai][bj][m][n], 0, 0, 0); __builtin_amdgcn_s_setprio(0); } while (0)
#define PG8_WAIT_V(n) asm volatile("s_waitcnt vmcnt(" #n ")" ::: "memory")
#define PG8_WAIT_L(n) asm volatile("s_waitcnt lgkmcnt(" #n ")" ::: "memory")
#define PG8_BAR __builtin_amdgcn_s_barrier()
#define PG8_SCHED __builtin_amdgcn_sched_barrier(0)
    Unit cur, nxt; int ui = 0;
    if (!S_.next(0, cur)) return;
    f32x4 acc[2][2][4][2];
#pragma unroll
    for (int a = 0; a < 2; ++a)
#pragma unroll
        for (int b = 0; b < 2; ++b)
#pragma unroll
            for (int m = 0; m < 4; ++m)
#pragma unroll
                for (int n = 0; n < 2; ++n) acc[a][b][m][n] = (f32x4){0.f, 0.f, 0.f, 0.f};
    bf16x8 At[4][2], B0[2][2], B1[2][2];
    const char* cA = a_ptr(g, cur); const char* cB = b_ptr(g, cur);
    PG8_STAGE(PG8_SB(0, 0), cB, voffB); PG8_STAGE(PG8_SB(0, 1), cB + hstepB, voffB); PG8_STAGE(PG8_SA(0, 0), cA, voffA); PG8_STAGE(PG8_SA(0, 1), cA + hstepA, voffA);
    if (wr == 1) PG8_BAR;
    PG8_WAIT_V(2); PG8_BAR;
    PG8_STAGE(PG8_SB(1, 0), cB + kstep, voffB); PG8_STAGE(PG8_SA(1, 0), cA + kstep, voffA); PG8_STAGE(PG8_SB(1, 1), cB + hstepB + kstep, voffB);
    PG8_WAIT_V(6); PG8_BAR;
    for (;;) {
        const bool has_next = S_.next(ui + 1, nxt);
        const char* nA = has_next ? a_ptr(g, nxt) : cA; const char* nB = has_next ? b_ptr(g, nxt) : cB;
        for (int t = 0; t < nt; t += 2) {
            const bool last = (t == nt - 2);
            const char* a1 = cA + (size_t)(t + 1) * kstep;
            const char* a2 = last ? nA : cA + (size_t)(t + 2) * kstep; const char* b2 = last ? nB : cB + (size_t)(t + 2) * kstep;
            const char* a3 = a2 + kstep; const char* b3 = b2 + kstep;
            PG8_LDB(B0, 0, 0); PG8_LDB(B1, 0, 1); PG8_SCHED; PG8_LDA(At, 0, 0); PG8_STAGE(PG8_SA(1, 1), a1 + hstepA, voffA);
            PG8_WAIT_V(8); PG8_WAIT_L(0); PG8_BAR; PG8_MMA(0, 0, At, B0); PG8_MMA(0, 1, At, B1); PG8_BAR; PG8_SCHED;
            PG8_LDA(At, 0, 1); PG8_STAGE(PG8_SB(0, 0), b2, voffB); PG8_STAGE(PG8_SB(0, 1), b2 + hstepB, voffB); PG8_STAGE(PG8_SA(0, 0), a2, voffA);
            PG8_WAIT_V(8); PG8_WAIT_L(0); PG8_BAR; PG8_MMA(1, 0, At, B0); PG8_MMA(1, 1, At, B1); PG8_BAR; PG8_SCHED;
            PG8_LDB(B0, 1, 0); PG8_LDB(B1, 1, 1); PG8_SCHED; PG8_LDA(At, 1, 0); PG8_STAGE(PG8_SA(0, 1), a2 + hstepA, voffA);
            PG8_WAIT_V(8); PG8_WAIT_L(0); PG8_BAR; PG8_MMA(0, 0, At, B0); PG8_MMA(0, 1, At, B1); PG8_BAR; PG8_SCHED;
            PG8_LDA(At, 1, 1); PG8_STAGE(PG8_SB(1, 0), b3, voffB); PG8_STAGE(PG8_SB(1, 1), b3 + hstepB, voffB); PG8_STAGE(PG8_SA(1, 0), a3, voffA);
            PG8_WAIT_V(8); PG8_WAIT_L(0); PG8_BAR; PG8_MMA(1, 0, At, B0); PG8_MMA(1, 1, At, B1); PG8_BAR; PG8_SCHED;
        }
        if constexpr (ALIGN_EPI) { if (wr == 0) PG8_BAR; }
        { int ln_ = threadIdx.x & 63; asm volatile("" : "+v"(ln_));
          E(acc, cur, wr, wc, ln_ & 15, ln_ >> 4); }
        if (!has_next) break;
#pragma unroll
        for (int a = 0; a < 2; ++a)
#pragma unroll
            for (int b = 0; b < 2; ++b)
#pragma unroll
                for (int m = 0; m < 4; ++m)
#pragma unroll
                    for (int n = 0; n < 2; ++n) acc[a][b][m][n] = (f32x4){0.f, 0.f, 0.f, 0.f};
        cur = nxt; cA = nA; cB = nB; ++ui;
        if constexpr (ALIGN_EPI) { if (wr == 1) PG8_BAR; }
    }
    PG8_WAIT_V(0);
    if constexpr (!ALIGN_EPI) { if (wr == 0) PG8_BAR; }
    PG8_BAR;
#undef PG8_SA
#undef PG8_SB
#undef PG8_STAGE
#undef PG8_LDA
#undef PG8_LDB
#undef PG8_MMA
#undef PG8_WAIT_V
#undef PG8_WAIT_L
#undef PG8_BAR
#undef PG8_SCHED
}
}

struct Args { const float* in[18]; float* out; unsigned char* ws; int ph_lo, ph_hi; };

__device__ __forceinline__ void p0_transpose_item(const float* W, int K, int N, bf16_t* WT, LAS float* scr, int item, int lane, const float* kgain = nullptr) {
    const int nblk = N / 32, kb = item / nblk, nb = item % nblk, k0 = 64 * kb, n0 = 32 * nb;
    { f32x4 wv[8];
#pragma unroll
      for (int i = 0; i < 8; ++i) wv[i] = *(const f32x4*)(W + (size_t)(k0 + 8 * i + (lane >> 3)) * N + n0 + 4 * (lane & 7));
#pragma unroll
      for (int i = 0; i < 8; ++i) { const int kk = 8 * i + (lane >> 3); const float gk = kgain ? kgain[k0 + kk] : 1.0f; LAS float* sp = scr + kk * 33 + 4 * (lane & 7);
          sp[0] = gk * wv[i].x; sp[1] = gk * wv[i].y; sp[2] = gk * wv[i].z; sp[3] = gk * wv[i].w; } }
    asm volatile("s_waitcnt lgkmcnt(0)" ::: "memory");
    const int c = lane & 7;
#pragma unroll
    for (int j = 0; j < 4; ++j) { const int n = (lane >> 3) + 8 * j; const LAS float* s = scr + (8 * c) * 33 + n;
        u32x4 o; o.x = pk2(s[0 * 33], s[1 * 33]); o.y = pk2(s[2 * 33], s[3 * 33]); o.z = pk2(s[4 * 33], s[5 * 33]); o.w = pk2(s[6 * 33], s[7 * 33]);
        *(u32x4*)(WT + (size_t)(n0 + n) * K + k0 + 8 * c) = o; }
    asm volatile("s_waitcnt lgkmcnt(0)" ::: "memory");
}
__device__ __forceinline__ void rms_row_to_bf16(const float* xrow, const float* g, bf16_t* orow, int lane) {
    const f32x4* xr = (const f32x4*)xrow + lane;
    f32x4 v[8]; float s = 0.f;
#pragma unroll
    for (int j = 0; j < 8; ++j) { v[j] = xr[64 * j]; s += (v[j].x * v[j].x + v[j].y * v[j].y) + (v[j].z * v[j].z + v[j].w * v[j].w); }
    const float rstd = 1.0f / sqrtf(wave_sum(s) * (1.0f / D) + EPS);
    const f32x4* gr = (const f32x4*)g + lane;
    u32x2* o8 = (u32x2*)orow + lane;
#pragma unroll
    for (int j = 0; j < 8; ++j) { const f32x4 gv = gr[64 * j]; u32x2 o; o.x = pk2(v[j].x * rstd * gv.x, v[j].y * rstd * gv.y); o.y = pk2(v[j].z * rstd * gv.z, v[j].w * rstd * gv.w); o8[64 * j] = o; }
}
__device__ __forceinline__ void cvt_stream(const float* src, bf16_t* dst, size_t n8, size_t gtid, size_t nthr) {
    for (size_t i = gtid; i < n8; i += nthr) { const f32x4 a = ((const f32x4*)src)[2 * i], b = ((const f32x4*)src)[2 * i + 1];
        u32x4 o; o.x = pk2(a.x, a.y); o.y = pk2(a.z, a.w); o.z = pk2(b.x, b.y); o.w = pk2(b.z, b.w); ((u32x4*)dst)[i] = o; }
}

__device__ __forceinline__ void expert_row_load(const float* src, f32x4 (&v)[8], int lane) {
    const f32x4* xr = (const f32x4*)src + lane;
#pragma unroll
    for (int k = 0; k < 8; ++k) v[k] = xr[64 * k];
}
__device__ __forceinline__ void expert_row_gain(f32x4 (&v)[8], const float* g, int lane) {
    const f32x4* gr = (const f32x4*)g + lane;
#pragma unroll
    for (int k = 0; k < 8; ++k) v[k] = v[k] * gr[64 * k];
}
__device__ __forceinline__ void expert_row_store(const f32x4 (&v)[8], unsigned char* dst, float* isc, int lane) {
    float am = 0.f;
#pragma unroll
    for (int k = 0; k < 8; ++k) am = fmaxf(am, fmaxf(fmaxf(fabsf(v[k].x), fabsf(v[k].y)), fmaxf(fabsf(v[k].z), fabsf(v[k].w))));
#pragma unroll
    for (int o = 1; o < 64; o <<= 1) am = fmaxf(am, __shfl_xor(am, o));
    float sc = 1.0f;
    if (am > 0.f) { const float q = fminf(fmaxf(448.0f / am, 1.0e-30f), 1.0e30f); sc = __builtin_bit_cast(float, __builtin_bit_cast(unsigned, q) & 0x7f800000u); }
    unsigned o[8];
#pragma unroll
    for (int k = 0; k < 8; ++k) { int w = __builtin_amdgcn_cvt_pk_fp8_f32(v[k].x * sc, v[k].y * sc, 0, false); w = __builtin_amdgcn_cvt_pk_fp8_f32(v[k].z * sc, v[k].w * sc, w, true); o[k] = (unsigned)w; }
    u32x4 o0, o1; o0.x = o[0]; o0.y = o[1]; o0.z = o[2]; o0.w = o[3]; o1.x = o[4]; o1.y = o[5]; o1.z = o[6]; o1.w = o[7];
    *(u32x4*)(dst + lane * 16) = o0; *(u32x4*)(dst + 1024 + lane * 16) = o1;
    if (lane == 0) *isc = 1.0f / sc;
}

__device__ __forceinline__ void p0_prologue(const Args& a, LAS unsigned char* lds, int vcu, int G, int wave, int lane, int tid) {
    unsigned char* ws = a.ws;
    LAS float* scr = (LAS float*)(lds + wave * 16384);
    const int gw = vcu * NWAVES + wave, NGW = G * NWAVES;
    constexpr int I_IN = (D / 64) * (INW / 32), I_POOL1 = (256 / 64) * (512 / 32), I_G = (GWD / 64) * (D / 32), I_O = (D / 64) * (D / 32), I_Q = I_O;
    constexpr int NITEMS = I_IN + 4 * I_POOL1 + I_G + I_O + I_Q;
    for (int it = gw; it < NITEMS; it += NGW) {
        int r = it;
        if (r < I_IN) { p0_transpose_item(a.in[2], D, INW, (bf16_t*)(ws + WS_WIN), scr, r, lane); continue; } r -= I_IN;
        if (r < 4 * I_POOL1) { const int g = r / I_POOL1; p0_transpose_item(a.in[5] + (size_t)g * 256 * 512, 256, 512, (bf16_t*)(ws + WS_WPOOL) + (size_t)g * 512 * 256, scr, r % I_POOL1, lane); continue; } r -= 4 * I_POOL1;
        if (r < I_G) { p0_transpose_item(a.in[10], GWD, D, (bf16_t*)(ws + WS_WG), scr, r, lane); continue; } r -= I_G;
        if (r < I_O) { p0_transpose_item(a.in[11], D, D, (bf16_t*)(ws + WS_WOUT), scr, r, lane); continue; } r -= I_O;
        p0_transpose_item(a.in[13], D, D, (bf16_t*)(ws + WS_WQ), scr, r, lane, a.in[12]);
    }
    for (int m = gw; m < S; m += NGW) rms_row_to_bf16(a.in[0] + (size_t)m * D, a.in[1], (bf16_t*)(ws + WS_H) + (size_t)m * D, lane);
    const size_t gtid = (size_t)vcu * NTHR + tid, nthr = (size_t)G * NTHR;
    cvt_stream(a.in[14], (bf16_t*)(ws + WS_KEYS), (size_t)8 * 2 * 128 * 128 / 8, gtid, nthr);
    {
        const float* src = a.in[8]; bf16_t* dst = (bf16_t*)(ws + WS_WSM);
        for (size_t i = gtid; i < (size_t)8 * 128 * 128 / 8; i += nthr) { const int s0 = (int)(i & 15) * 8, t = (int)(i >> 4) & 127;
            const f32x4 x0 = ((const f32x4*)src)[2 * i], x1 = ((const f32x4*)src)[2 * i + 1];
            float v[8] = {x0.x, x0.y, x0.z, x0.w, x1.x, x1.y, x1.z, x1.w};
#pragma unroll
            for (int j = 0; j < 8; ++j) v[j] = (s0 + j <= t) ? v[j] : 0.f;
            u32x4 o; o.x = pk2(v[0], v[1]); o.y = pk2(v[2], v[3]); o.z = pk2(v[4], v[5]); o.w = pk2(v[6], v[7]); ((u32x4*)dst)[i] = o; }
    }
}

__device__ __forceinline__ void p2_pool(const Args& a, int vcu, int G, int tid) {
    const bf16_t* Z = (const bf16_t*)(a.ws + WS_Z); bf16_t* A2 = (bf16_t*)(a.ws + WS_A2); const float* psc = a.in[4];
    const size_t gtid = (size_t)vcu * NTHR + tid, nthr = (size_t)G * NTHR;
    for (size_t id = gtid; id < (size_t)(S / 8) * 128; id += nthr) {
        const int c8 = (int)(id & 127), t0 = (int)(id >> 7) * 8, g = c8 >> 5, w = 2 << g;
        u32x4 row[23];
#pragma unroll
        for (int r = 0; r < 23; ++r) { const int t = t0 - 15 + r; const bool need = (r >= 16 - w) && (t >= 0);
            row[r] = need ? *(const u32x4*)(Z + (size_t)t * INW + c8 * 8) : (u32x4){0u, 0u, 0u, 0u}; }
        const f32x4 p0 = *(const f32x4*)(psc + c8 * 8), p1 = *(const f32x4*)(psc + c8 * 8 + 4);
        const float ps[8] = {p0.x, p0.y, p0.z, p0.w, p1.x, p1.y, p1.z, p1.w};
        float s[8] = {0.f, 0.f, 0.f, 0.f, 0.f, 0.f, 0.f, 0.f};
#pragma unroll
        for (int r = 0; r < 15; ++r) { const u32x4 q = row[r];
            s[0] += bflo(q.x); s[1] += bfhi(q.x); s[2] += bflo(q.y); s[3] += bfhi(q.y); s[4] += bflo(q.z); s[5] += bfhi(q.z); s[6] += bflo(q.w); s[7] += bfhi(q.w); }
#pragma unroll
        for (int i = 0; i < 8; ++i) {
            const u32x4 q = row[15 + i];
            const float at[8] = {bflo(q.x), bfhi(q.x), bflo(q.y), bfhi(q.y), bflo(q.z), bfhi(q.z), bflo(q.w), bfhi(q.w)};
#pragma unroll
            for (int c = 0; c < 8; ++c) s[c] += at[c];
            const int t = t0 + i; const int cnt = (t + 1) < w ? (t + 1) : w; const float inv = 1.0f / (float)cnt;
            float o[8];
#pragma unroll
            for (int c = 0; c < 8; ++c) o[c] = (s[c] * inv - at[c]) * ps[c];
            u32x4 w4; w4.x = pk2(o[0], o[1]); w4.y = pk2(o[2], o[3]); w4.z = pk2(o[4], o[5]); w4.w = pk2(o[6], o[7]);
            *(u32x4*)(A2 + (size_t)t * D + c8 * 8) = w4;
            const u32x4 d2 = row[15 + i - 1], d4 = row[15 + i - 3], d8 = row[15 + i - 7], d16 = row[15 + i - 15];
            const u32x4 dq = g == 0 ? d2 : (g == 1 ? d4 : (g == 2 ? d8 : d16));
            s[0] -= bflo(dq.x); s[1] -= bfhi(dq.x); s[2] -= bflo(dq.y); s[3] -= bfhi(dq.y); s[4] -= bflo(dq.z); s[5] -= bfhi(dq.z); s[6] -= bflo(dq.w); s[7] -= bfhi(dq.w);
        }
    }
}
constexpr int VT_LD = 136;
__device__ __forceinline__ void p2_sgu(const Args& a, LAS unsigned char* lds, int item0, int item1, int istep, int wave, int lane, int tid) {
    const bf16_t* Z = (const bf16_t*)(a.ws + WS_Z); bf16_t* A2 = (bf16_t*)(a.ws + WS_A2); const bf16_t* WSM = (const bf16_t*)(a.ws + WS_WSM);
    const float* lng = a.in[6]; const float* lnb = a.in[7]; const float* bs = a.in[9];
    LAS float* st = (LAS float*)lds; LAS bf16_t* Vt = (LAS bf16_t*)(lds + 1024);
    const int fr = lane & 15, fq = lane >> 4;
    int prev_c = -1;
    for (int item = item0; item < item1; item += istep) {
        const int c = item >> 3, h = item & 7, t0 = c * 128; const bool need_stats = (c != prev_c); prev_c = c;
        u32x4 raw[4][8];
        if (need_stats) {
#pragma unroll
        for (int p = 0; p < 4; ++p) { const bf16_t* rp = Z + (size_t)(t0 + wave * 16 + p * 4 + fq) * INW + 2048 + fr * 8;
#pragma unroll
            for (int j = 0; j < 8; ++j) raw[p][j] = *(const u32x4*)(rp + j * 128); } }
        u32x4 rawB[4];
#pragma unroll
        for (int q = 0; q < 4; ++q) { const int id = tid + q * NTHR, sr = id & 127, dc = id >> 7; rawB[q] = *(const u32x4*)(Z + (size_t)(t0 + sr) * INW + 2048 + h * 128 + dc * 8); }
        bf16x8 bW[4];
#pragma unroll
        for (int ks = 0; ks < 4; ++ks) bW[ks] = *(const bf16x8*)(WSM + (size_t)(h * 128 + wave * 16 + fr) * 128 + ks * 32 + fq * 8);
        u32x2 ur[8];
#pragma unroll
        for (int db = 0; db < 8; ++db) ur[db] = *(const u32x2*)(Z + (size_t)(t0 + wave * 16 + fr) * INW + 1024 + h * 128 + db * 16 + fq * 4);
        const float bias = bs[h * 128 + wave * 16 + fr];
        if (need_stats) {
#pragma unroll
        for (int p = 0; p < 4; ++p) { float s = 0.f, q = 0.f;
#pragma unroll
            for (int j = 0; j < 8; ++j)
#pragma unroll
                for (int w = 0; w < 4; ++w) { const float a0 = bflo(raw[p][j][w]), a1 = bfhi(raw[p][j][w]); s += a0 + a1; q += a0 * a0 + a1 * a1; }
            s = row_sum_f32(s); q = row_sum_f32(q);
            if (fr == 0) { const float mean = s * (1.0f / 1024.0f); const float var = fmaxf(q * (1.0f / 1024.0f) - mean * mean, 0.f);
                const int sr = wave * 16 + p * 4 + fq; st[2 * sr] = mean; st[2 * sr + 1] = 1.0f / sqrtf(var + EPS); } }
        __syncthreads();
        }
#pragma unroll
        for (int q = 0; q < 4; ++q) { const int id = tid + q * NTHR, sr = id & 127, dc = id >> 7;
            const u32x4 rw = rawB[q];
            const float mean = st[2 * sr], rstd = st[2 * sr + 1];
            const float v[8] = {bflo(rw.x), bfhi(rw.x), bflo(rw.y), bfhi(rw.y), bflo(rw.z), bfhi(rw.z), bflo(rw.w), bfhi(rw.w)};
            const f32x4 g0 = *(const f32x4*)(lng + h * 128 + dc * 8), g1 = *(const f32x4*)(lng + h * 128 + dc * 8 + 4), b0 = *(const f32x4*)(lnb + h * 128 + dc * 8), b1 = *(const f32x4*)(lnb + h * 128 + dc * 8 + 4);
            const float gg[8] = {g0.x, g0.y, g0.z, g0.w, g1.x, g1.y, g1.z, g1.w}, bb[8] = {b0.x, b0.y, b0.z, b0.w, b1.x, b1.y, b1.z, b1.w};
#pragma unroll
            for (int i = 0; i < 8; ++i) { const int d = dc * 8 + i; const float y = (v[i] - mean) * rstd * gg[i] + bb[i]; Vt[d * VT_LD + sr] = (bf16_t)f2bf(y); } }
        __syncthreads();
        f32x4 acc[8];
#pragma unroll
        for (int db = 0; db < 8; ++db) acc[db] = (f32x4){0.f, 0.f, 0.f, 0.f};
        const int nks = (wave * 16 + 15) / 32 + 1;
#pragma unroll
        for (int ks = 0; ks < 4; ++ks) if (ks < nks) {
#pragma unroll
            for (int db = 0; db < 8; ++db) { const bf16x8 aV = *(const LAS bf16x8*)(Vt + (db * 16 + fr) * VT_LD + ks * 32 + fq * 8);
                acc[db] = __builtin_amdgcn_mfma_f32_16x16x32_bf16(aV, bW[ks], acc[db], 0, 0, 0); }
        }
        { const int t = t0 + wave * 16 + fr;
#pragma unroll
          for (int db = 0; db < 8; ++db) { const int col = h * 128 + db * 16 + fq * 4;
              u32x2 o; o.x = pk2(bflo(ur[db].x) * (acc[db][0] + bias), bfhi(ur[db].x) * (acc[db][1] + bias)); o.y = pk2(bflo(ur[db].y) * (acc[db][2] + bias), bfhi(ur[db].y) * (acc[db][3] + bias));
              *(u32x2*)(A2 + (size_t)t * D + 1024 + col) = o; } }
        __syncthreads();
    }
}

__device__ __forceinline__ unsigned f2key(float f) { const unsigned b = __builtin_bit_cast(unsigned, f); return (b & 0x80000000u) ? ~b : (b | 0x80000000u); }
__device__ __forceinline__ float key2f(unsigned k) { const unsigned b = (k & 0x80000000u) ? (k ^ 0x80000000u) : ~k; return __builtin_bit_cast(float, b); }
template <int CTRL> __device__ __forceinline__ unsigned dpp_max_u32(unsigned v) { const unsigned o = (unsigned)__builtin_amdgcn_update_dpp(0, (int)v, CTRL, 0xF, 0xF, true); return v > o ? v : o; }
__device__ __forceinline__ unsigned row_max_u32(unsigned v) { v = dpp_max_u32<0xB1>(v); v = dpp_max_u32<0x4E>(v); v = dpp_max_u32<0x141>(v); v = dpp_max_u32<0x140>(v); return v; }
__device__ __forceinline__ void ce_desc(unsigned& a, unsigned& b) { const unsigned hi = a > b ? a : b, lo = a > b ? b : a; a = hi; b = lo; }
__device__ __forceinline__ void sort8_desc(unsigned (&k)[8]) {
    ce_desc(k[0], k[1]); ce_desc(k[2], k[3]); ce_desc(k[4], k[5]); ce_desc(k[6], k[7]);
    ce_desc(k[0], k[2]); ce_desc(k[1], k[3]); ce_desc(k[4], k[6]); ce_desc(k[5], k[7]);
    ce_desc(k[1], k[2]); ce_desc(k[5], k[6]);
    ce_desc(k[0], k[4]); ce_desc(k[1], k[5]); ce_desc(k[2], k[6]); ce_desc(k[3], k[7]);
    ce_desc(k[2], k[4]); ce_desc(k[3], k[5]);
    ce_desc(k[1], k[2]); ce_desc(k[3], k[4]); ce_desc(k[5], k[6]);
}
__device__ __forceinline__ void sort4_desc(unsigned (&k)[4]) { ce_desc(k[0], k[1]); ce_desc(k[2], k[3]); ce_desc(k[0], k[2]); ce_desc(k[1], k[3]); ce_desc(k[1], k[2]); }
template <int NV> __device__ __forceinline__ unsigned row_top16_sorted(unsigned (&k)[NV], int fr) {
    unsigned tk = 0u;
    for (int it = 0; it < 16; ++it) {
        const unsigned m = row_max_u32(k[0]);
        const unsigned wm = (k[0] == m) ? 0xffffffffu : 0u;
#pragma unroll
        for (int i = 0; i + 1 < NV; ++i) k[i] = (k[i + 1] & wm) | (k[i] & ~wm);
        k[NV - 1] = k[NV - 1] & ~wm;
        tk = (fr == it) ? m : tk;
    }
    return tk;
}
__device__ __forceinline__ unsigned cand_table(int fr) {
    constexpr unsigned T[16] = {0x03020100u, 0x07060504u, 0x0b0a0908u, 0x0f0e0d0cu, 0x13121110u, 0x17161514u, 0x23222120u, 0x32313024u, 0x42414033u, 0x61605150u, 0x90807170u, 0xd0c0b0a0u, 0xfffff0e0u, 0xffffffffu, 0xffffffffu, 0xffffffffu};
    unsigned w = T[0];
#pragma unroll
    for (int i = 1; i < 16; ++i) w = (fr == i) ? T[i] : w;
    return w;
}
constexpr int SC_LD = 132;
__device__ __forceinline__ void p7_topk(const Args& a, LAS unsigned char* lds, int vcu, int G, int wave, int lane_) {
    int lane = lane_; asm volatile("" : "+v"(lane));
    const bf16_t* Q = (const bf16_t*)(a.ws + WS_Q); const bf16_t* KEYS = (const bf16_t*)(a.ws + WS_KEYS);
    int* IDX = (int*)(a.ws + WS_IDX); float* GATE = (float*)(a.ws + WS_GATE);
    LAS float* SL = (LAS float*)(lds + wave * (16 * SC_LD * 4));
    const int gw = vcu * NWAVES + wave, NGW = G * NWAVES; const int fr = lane & 15, fq = lane >> 4;
    const unsigned ctab = cand_table(fr);
    int erow = gw;
    f32x4 er0[8], er1[8]; int e0 = 2 * NEXP, e1 = 2 * NEXP;
#define ER_LOAD() do { e0 = erow; e1 = erow + NGW; erow += 2 * NGW; \
        if (e0 < 2 * NEXP) expert_row_load(a.in[15 + (e0 >= NEXP)] + (size_t)(e0 & (NEXP - 1)) * D, er0, lane); \
        if (e1 < 2 * NEXP) expert_row_load(a.in[15 + (e1 >= NEXP)] + (size_t)(e1 & (NEXP - 1)) * D, er1, lane); } while (0)
#define ER_STORE() do { \
        if (e0 < NEXP) expert_row_gain(er0, a.in[12], lane); if (e1 < NEXP) expert_row_gain(er1, a.in[12], lane); \
        if (e0 < 2 * NEXP) expert_row_store(er0, a.ws + ((e0 >= NEXP) ? WS_EV : WS_EU) + (size_t)(e0 & (NEXP - 1)) * D, (float*)(a.ws + WS_ESC) + e0, lane); \
        if (e1 < 2 * NEXP) expert_row_store(er1, a.ws + ((e1 >= NEXP) ? WS_EV : WS_EU) + (size_t)(e1 & (NEXP - 1)) * D, (float*)(a.ws + WS_ESC) + e1, lane); } while (0)
    pg8::StaticOrder so7; so7.init(S, D, G, (int)blockIdx.x); pg8::Unit u7;
    for (int ui = 0; so7.next(ui >> 1, u7); ++ui) {
        const int h = u7.pn, t0 = u7.pm * 256 + ((ui & 1) * 8 + wave) * 16;
        unsigned tk[8];
#pragma unroll
        for (int i = 0; i < 8; ++i) tk[i] = 0u;
#pragma unroll 1
        for (int p = 0; p < 2; ++p) {
            {
                bf16x8 af[4];
#pragma unroll
                for (int ks = 0; ks < 4; ++ks) af[ks] = *(const bf16x8*)(Q + (size_t)(t0 + fr) * D + h * 256 + p * 128 + ks * 32 + fq * 8);
#pragma unroll 1
                for (int g4 = 0; g4 < 2; ++g4) {
                    bf16x8 bf[4][4];
#pragma unroll
                    for (int n4 = 0; n4 < 4; ++n4)
#pragma unroll
                        for (int ks = 0; ks < 4; ++ks) bf[n4][ks] = *(const bf16x8*)(KEYS + (size_t)((h * 2 + p) * 128 + (g4 * 4 + n4) * 16 + fr) * 128 + ks * 32 + fq * 8);
#pragma unroll
                    for (int n4 = 0; n4 < 4; ++n4) { f32x4 c = {0.f, 0.f, 0.f, 0.f};
#pragma unroll
                        for (int ks = 0; ks < 4; ++ks) c = __builtin_amdgcn_mfma_f32_16x16x32_bf16(af[ks], bf[n4][ks], c, 0, 0, 0);
#pragma unroll
                        for (int j = 0; j < 4; ++j) SL[(fq * 4 + j) * SC_LD + (g4 * 4 + n4) * 16 + fr] = c[j]; }
                    asm volatile("" ::: "memory"); }
            }
            ER_LOAD();
#pragma unroll 1
            for (int j = 0; j < 4; ++j) {
                unsigned k[8];
#pragma unroll
                for (int nb = 0; nb < 8; ++nb) k[nb] = (f2key(SL[(fq * 4 + j) * SC_LD + nb * 16 + fr]) & ~127u) | (127u - (unsigned)(nb * 16 + fr));
                sort8_desc(k);
                const unsigned r = row_top16_sorted<8>(k, fr);
#pragma unroll
                for (int i = 0; i < 8; ++i) tk[i] = (i == p * 4 + j) ? r : tk[i];
            }
            ER_STORE();
        }
#pragma unroll 1
        for (int j = 0; j < 4; ++j) {
            if ((j & 1) == 0) ER_LOAD();
            const unsigned tk1 = j == 0 ? tk[0] : (j == 1 ? tk[1] : (j == 2 ? tk[2] : tk[3])), tk2 = j == 0 ? tk[4] : (j == 1 ? tk[5] : (j == 2 ? tk[6] : tk[7]));
            const float t1 = key2f(tk1 & ~127u), t2 = key2f(tk2 & ~127u); const int i1 = 127 - (int)(tk1 & 127u), i2 = 127 - (int)(tk2 & 127u);
            unsigned kc[4];
#pragma unroll
            for (int e = 0; e < 4; ++e) { const unsigned ab = (ctab >> (8 * e)) & 255u; const int ca = (int)(ab >> 4), cb = (int)(ab & 15u);
                const float c = __shfl(t1, (lane & 48) + ca) + __shfl(t2, (lane & 48) + cb);
                kc[e] = (ab == 255u) ? 0u : ((f2key(c) & ~255u) | (255u - ab)); }
            sort4_desc(kc);
            const unsigned tkc = row_top16_sorted<4>(kc, fr);
            const float ts = key2f(tkc & ~255u); const int ci = 255 - (int)(tkc & 255u);
            const int ia = __shfl(i1, (lane & 48) + (ci >> 4)), ib = __shfl(i2, (lane & 48) + (ci & 15));
            const float tmax = __shfl(ts, lane & 48);
            const float e = __expf(ts - tmax); float sum = e;
            sum += __shfl_xor(sum, 1); sum += __shfl_xor(sum, 2); sum += __shfl_xor(sum, 4); sum += __shfl_xor(sum, 8);
            const int t = t0 + fq * 4 + j;
            IDX[(size_t)t * 128 + h * 16 + fr] = ia * 128 + ib;
            GATE[(size_t)t * 128 + h * 16 + fr] = e / sum;
            if ((j & 1) == 1) ER_STORE();
        }
    }
    for (; erow < 2 * NEXP; erow += NGW) { expert_row_load(a.in[15 + (erow >= NEXP)] + (size_t)(erow & (NEXP - 1)) * D, er0, lane); if (erow < NEXP) expert_row_gain(er0, a.in[12], lane);
        expert_row_store(er0, a.ws + ((erow >= NEXP) ? WS_EV : WS_EU) + (size_t)(erow & (NEXP - 1)) * D, (float*)(a.ws + WS_ESC) + erow, lane); }
#undef ER_LOAD
#undef ER_STORE
}

typedef float f32x2 __attribute__((ext_vector_type(2)));
__device__ __forceinline__ u32x4 bl128(__amdgpu_buffer_rsrc_t r, unsigned voff, unsigned soff) { return __builtin_amdgcn_raw_buffer_load_b128(r, voff, soff, 0); }
__device__ __forceinline__ u32x2 bl64(__amdgpu_buffer_rsrc_t r, unsigned voff, unsigned soff) { return __builtin_amdgcn_raw_buffer_load_b64(r, voff, soff, 0); }
__device__ __forceinline__ unsigned bl32(__amdgpu_buffer_rsrc_t r, unsigned voff, unsigned soff) { return __builtin_amdgcn_raw_buffer_load_b32(r, voff, soff, 0); }
__device__ __forceinline__ float wave_sum_dpp(float v) {
    v = dpp_add_f32<0xB1>(v); v = dpp_add_f32<0x4E>(v); v = dpp_add_f32<0x141>(v); v = dpp_add_f32<0x140>(v);
    v += __builtin_bit_cast(float, __builtin_amdgcn_update_dpp(0, __builtin_bit_cast(int, v), 0x142, 0xA, 0xF, false));
    v += __builtin_bit_cast(float, __builtin_amdgcn_update_dpp(0, __builtin_bit_cast(int, v), 0x143, 0xC, 0xF, false));
    return __builtin_bit_cast(float, __builtin_amdgcn_readlane(__builtin_bit_cast(int, v), 63));
}
__device__ __forceinline__ float wave_sum_fast(float v) {
    v = dpp_add_f32<0xB1>(v); v = dpp_add_f32<0x4E>(v); v = dpp_add_f32<0x141>(v); v = dpp_add_f32<0x140>(v);
    v += __shfl_xor(v, 16); v += __shfl_xor(v, 32); return v;
}
constexpr int TPW = 4, NSL = 16, SL_SHIFT = 10, RING = 8, SLOT = 2048;
typedef __bf16 bf16x2_t __attribute__((ext_vector_type(2)));
__device__ __forceinline__ float dot2bf(unsigned a, unsigned b, float c) { return __builtin_amdgcn_fdot2_f32_bf16(__builtin_bit_cast(bf16x2_t, a), __builtin_bit_cast(bf16x2_t, b), c, false); }
constexpr int NROWS = TPW * 128;
#define P8_ISSUE(TBASE) do { const unsigned ro_ = (unsigned)__builtin_amdgcn_readlane(lch_, ii_ & 63) * (unsigned)D; \
        const char* src_ = (const char*)a.ws + (TBASE) + ro_ + l16; LAS unsigned char* dstl_ = ring + (ii_ & (RING - 1)) * SLOT; \
        __builtin_amdgcn_global_load_lds((const unsigned*)src_, (LAS unsigned*)dstl_, 16, 0, 0); \
        __builtin_amdgcn_global_load_lds((const unsigned*)(src_ + 1024), (LAS unsigned*)(dstl_ + 1024), 16, 0, 0); \
        ++ii_; if ((ii_ & 63) == 0) lch_ = (int)LST[ii_ + lane]; } while (0)
#define P8_RING_READ(r0, r1) do { r0 = *(const LAS u32x4*)(ring + (ci_ & (RING - 1)) * SLOT + l16); r1 = *(const LAS u32x4*)(ring + (ci_ & (RING - 1)) * SLOT + 1024 + l16); } while (0)
#define P8_STREAM_INIT(TBASE, r0, r1) int ci_ = 0, ii_ = 0; int lch_ = (int)LST[lane]; \
        asm volatile("s_waitcnt vmcnt(0) lgkmcnt(0)" ::: "memory"); \
        _Pragma("unroll 1") for (int q_ = 0; q_ < RING; ++q_) P8_ISSUE(TBASE); \
        asm volatile("s_waitcnt vmcnt(14)" ::: "memory"); P8_RING_READ(r0, r1)
#define P8_ROW_READY() asm volatile("s_waitcnt lgkmcnt(0)" ::: "memory")
#define P8_ROW_ADVANCE(TBASE, r0, r1) do { ++ci_; P8_ISSUE(TBASE); asm volatile("s_waitcnt vmcnt(14)" ::: "memory"); P8_RING_READ(r0, r1); } while (0)
#define P8_STREAM_END() asm volatile("s_waitcnt vmcnt(0) lgkmcnt(0)" ::: "memory")
static_assert(RING == 8, "the counted wait above is vmcnt(2 * (RING - 1))");
__device__ __forceinline__ void p8_peer(const Args& a, LAS unsigned char* lds, float* dst, int vcu, int G, int wave, int lane_) {
    int lane = lane_; asm volatile("" : "+v"(lane));
    const __amdgpu_buffer_rsrc_t rws = __builtin_amdgcn_make_buffer_rsrc((void*)a.ws, (short)0, (int)WS_END, 0x00020000);
    const __amdgpu_buffer_rsrc_t rdst = __builtin_amdgcn_make_buffer_rsrc((void*)dst, (short)0, S * D * 4, 0x00020000);
    const __amdgpu_buffer_rsrc_t rfg = __builtin_amdgcn_make_buffer_rsrc((void*)a.in[17], (short)0, D * 4, 0x00020000);
    LAS unsigned char* ring = lds + wave * (RING * SLOT);
    LAS unsigned* SLW = (LAS unsigned*)(lds + 132096 + wave * 1280);
    LAS unsigned short* LST = (LAS unsigned short*)SLW;
    const int gw = vcu * NWAVES + wave, NGW = G * NWAVES;
    const unsigned l16 = (unsigned)lane * 16u, l8 = (unsigned)lane * 8u, l4 = (unsigned)lane * 4u;
#pragma unroll 1
    for (int tb = gw; tb < S; tb += TPW * NGW) {
        int sid[TPW][2], offv[TPW]; float act[TPW][2]; int cntv = 0;
#pragma unroll
        for (int k = 0; k < TPW; ++k) {
            const int t = (tb + k * NGW) < S ? (tb + k * NGW) : (S - 1);
            const unsigned oi = (unsigned)(WS_IDX + (size_t)t * 512);
            const int id0 = (int)bl32(rws, l4, oi), id1 = (int)bl32(rws, l4 + 256u, oi);
            const int sl0 = id0 >> SL_SHIFT, sl1 = id1 >> SL_SHIFT;
            int pos0 = 0, pos1 = 0, basec = 0, offacc = 0;
#pragma unroll
            for (int s = 0; s < NSL; ++s) {
                const unsigned long long m0 = __ballot(sl0 == s), m1 = __ballot(sl1 == s);
                const int c0 = __popcll(m0), c1 = __popcll(m1);
                const int b0 = (int)__builtin_amdgcn_mbcnt_hi((unsigned)(m0 >> 32), __builtin_amdgcn_mbcnt_lo((unsigned)m0, 0u));
                const int b1 = (int)__builtin_amdgcn_mbcnt_hi((unsigned)(m1 >> 32), __builtin_amdgcn_mbcnt_lo((unsigned)m1, 0u));
                pos0 = (sl0 == s) ? basec + b0 : pos0; pos1 = (sl1 == s) ? basec + c0 + b1 : pos1;
                basec += c0 + c1; offacc = (lane == s + 1) ? basec : offacc; cntv = (lane == s * TPW + k) ? (c0 + c1) : cntv;
            }
            offv[k] = offacc;
            SLW[pos0] = (unsigned)id0; SLW[pos1] = (unsigned)id1; SLW[128 + pos0] = (unsigned)lane; SLW[128 + pos1] = (unsigned)(64 + lane);
            asm volatile("s_waitcnt lgkmcnt(0)" ::: "memory");
            sid[k][0] = (int)SLW[lane]; sid[k][1] = (int)SLW[64 + lane];
            act[k][0] = __builtin_bit_cast(float, SLW[128 + lane]); act[k][1] = __builtin_bit_cast(float, SLW[192 + lane]);
            asm volatile("s_waitcnt lgkmcnt(0)" ::: "memory");
        }
        {
            int incl = cntv;
#pragma unroll
            for (int o = 1; o < 64; o <<= 1) { const int up = __shfl_up(incl, o); incl += (lane >= o) ? up : 0; }
            const int gb = incl - cntv;
            asm volatile("s_waitcnt lgkmcnt(0)" ::: "memory");
#pragma unroll
            for (int k = 0; k < TPW; ++k)
#pragma unroll
                for (int h = 0; h < 2; ++h) { const int sl = sid[k][h] >> SL_SHIFT;
                    const int p = __shfl(gb, sl * TPW + k) + (h * 64 + lane) - __shfl(offv[k], sl);
                    LST[p] = (unsigned short)sid[k][h]; }
            if (lane < RING) LST[NROWS + lane] = (unsigned short)0;
            asm volatile("s_waitcnt lgkmcnt(0)" ::: "memory");
        }
        int orig[TPW][2];
#pragma unroll
        for (int k = 0; k < TPW; ++k) { orig[k][0] = __builtin_bit_cast(int, act[k][0]); orig[k][1] = __builtin_bit_cast(int, act[k][1]); act[k][0] = 0.f; act[k][1] = 0.f; }
        {
            f32x2 hf[TPW][16];
#pragma unroll
            for (int k = 0; k < TPW; ++k) { const int t = (tb + k * NGW) < S ? (tb + k * NGW) : (S - 1);
#pragma unroll
                for (int kk = 0; kk < 8; ++kk) { const u32x2 w = bl64(rws, l8 + (unsigned)(kk * 512), (unsigned)(WS_XB + (size_t)t * (D * 2)));
                    hf[k][kk * 2] = (f32x2){bflo(w.x), bfhi(w.x)}; hf[k][kk * 2 + 1] = (f32x2){bflo(w.y), bfhi(w.y)}; } }
            u32x4 r0, r1;
            P8_STREAM_INIT(WS_EU, r0, r1);
#pragma unroll 1
            for (int s = 0; s < NSL; ++s) {
#pragma unroll
                for (int k = 0; k < TPW; ++k) {
                    const int lo = __builtin_amdgcn_readlane(offv[k], s), hi = __builtin_amdgcn_readlane(offv[k], s + 1);
#pragma unroll 1
                    for (int e = lo; e < hi; ++e) {
                        P8_ROW_READY();
                        f32x2 dd0 = {0.f, 0.f}, dd1 = {0.f, 0.f};
#pragma unroll
                        for (int kk = 0; kk < 4; ++kk) {
                            { const unsigned w = r0[kk]; const f32x2 lo2 = __builtin_amdgcn_cvt_pk_f32_fp8((int)w, false), hi2 = __builtin_amdgcn_cvt_pk_f32_fp8((int)w, true);
                              dd0 = __builtin_elementwise_fma(lo2, hf[k][kk * 2], dd0); dd1 = __builtin_elementwise_fma(hi2, hf[k][kk * 2 + 1], dd1); }
                            { const unsigned w = r1[kk]; const f32x2 lo2 = __builtin_amdgcn_cvt_pk_f32_fp8((int)w, false), hi2 = __builtin_amdgcn_cvt_pk_f32_fp8((int)w, true);
                              dd0 = __builtin_elementwise_fma(lo2, hf[k][8 + kk * 2], dd0); dd1 = __builtin_elementwise_fma(hi2, hf[k][8 + kk * 2 + 1], dd1); } }
                        asm volatile("" : "+v"(dd0), "+v"(dd1));
                        P8_ROW_ADVANCE(WS_EU, r0, r1);
                        const float d = wave_sum_dpp((dd0.x + dd0.y) + (dd1.x + dd1.y));
                        act[k][0] = (lane == e) ? d : act[k][0]; act[k][1] = (lane == e - 64) ? d : act[k][1];
                    }
                }
            }
            P8_STREAM_END();
        }
#pragma unroll
        for (int k = 0; k < TPW; ++k) {
            const int t = (tb + k * NGW) < S ? (tb + k * NGW) : (S - 1);
            const float ssp = lane < 32 ? __builtin_bit_cast(float, bl32(rws, l4, (unsigned)(WS_SS + (size_t)t * 128))) : 0.f;
            const float rstd2 = 1.0f / sqrtf(wave_sum(ssp) * (1.0f / D) + EPS);
            const unsigned og = (unsigned)(WS_GATE + (size_t)t * 512);
#pragma unroll
            for (int h = 0; h < 2; ++h) {
                const float gate = __builtin_bit_cast(float, bl32(rws, (unsigned)orig[k][h] * 4u, og));
                const float su = __builtin_bit_cast(float, bl32(rws, (unsigned)sid[k][h] * 4u, (unsigned)WS_ESC)) * rstd2;
                const float sv = __builtin_bit_cast(float, bl32(rws, (unsigned)sid[k][h] * 4u, (unsigned)(WS_ESC + NEXP * 4)));
                act[k][h] = gelu_tanh(act[k][h] * su) * gate * sv; }
        }
        {
            float acc[TPW][32];
#pragma unroll
            for (int k = 0; k < TPW; ++k)
#pragma unroll
                for (int i = 0; i < 32; ++i) acc[k][i] = 0.f;
            u32x4 r0, r1;
            P8_STREAM_INIT(WS_EV, r0, r1);
#pragma unroll 1
            for (int s = 0; s < NSL; ++s) {
#pragma unroll
                for (int k = 0; k < TPW; ++k) {
                    const int lo = __builtin_amdgcn_readlane(offv[k], s), hi = __builtin_amdgcn_readlane(offv[k], s + 1);
#pragma unroll 1
                    for (int e = lo; e < hi; ++e) {
                        const int a0_ = __builtin_amdgcn_readlane(__builtin_bit_cast(int, act[k][0]), e & 63), a1_ = __builtin_amdgcn_readlane(__builtin_bit_cast(int, act[k][1]), e & 63);
                        const float aw = __builtin_bit_cast(float, e < 64 ? a0_ : a1_);
                        P8_ROW_READY();
#pragma unroll
                        for (int kk = 0; kk < 4; ++kk) {
                            { const unsigned w = r0[kk]; const int bb = kk * 4; const f32x2 lo2 = __builtin_amdgcn_cvt_pk_f32_fp8((int)w, false), hi2 = __builtin_amdgcn_cvt_pk_f32_fp8((int)w, true);
                              acc[k][bb + 0] += aw * lo2.x; acc[k][bb + 1] += aw * lo2.y; acc[k][bb + 2] += aw * hi2.x; acc[k][bb + 3] += aw * hi2.y; }
                            { const unsigned w = r1[kk]; const int bb = 16 + kk * 4; const f32x2 lo2 = __builtin_amdgcn_cvt_pk_f32_fp8((int)w, false), hi2 = __builtin_amdgcn_cvt_pk_f32_fp8((int)w, true);
                              acc[k][bb + 0] += aw * lo2.x; acc[k][bb + 1] += aw * lo2.y; acc[k][bb + 2] += aw * hi2.x; acc[k][bb + 3] += aw * hi2.y; } }
                        asm volatile("" : "+v"(acc[k][0]), "+v"(acc[k][16]));
                        P8_ROW_ADVANCE(WS_EV, r0, r1);
                    }
                }
            }
            P8_STREAM_END();
#pragma unroll
            for (int k = 0; k < TPW; ++k) { const int t = tb + k * NGW;
                if (t < S) {
                    float ss = 0.f; const unsigned ot = (unsigned)t * (unsigned)(D * 4);
#pragma unroll
                    for (int kk = 0; kk < 8; ++kk) { const u32x2 xw = bl64(rws, l8 + (unsigned)(kk * 512), (unsigned)(WS_XB + (size_t)t * (D * 2)));
                        acc[k][kk * 4 + 0] += bflo(xw.x); acc[k][kk * 4 + 1] += bfhi(xw.x); acc[k][kk * 4 + 2] += bflo(xw.y); acc[k][kk * 4 + 3] += bfhi(xw.y);
                        ss += (acc[k][kk * 4 + 0] * acc[k][kk * 4 + 0] + acc[k][kk * 4 + 1] * acc[k][kk * 4 + 1]) + (acc[k][kk * 4 + 2] * acc[k][kk * 4 + 2] + acc[k][kk * 4 + 3] * acc[k][kk * 4 + 3]); }
                    const float rstd = 1.0f / sqrtf(wave_sum(ss) * (1.0f / D) + EPS);
#pragma unroll
                    for (int kk = 0; kk < 8; ++kk) { const f32x4 f0 = __builtin_bit_cast(f32x4, bl128(rfg, l16 + (unsigned)((kk & 3) * 1024), (unsigned)((kk >> 2) * 4096)));
                        f32x4 o0; o0.x = acc[k][kk * 4 + 0] * rstd * f0.x; o0.y = acc[k][kk * 4 + 1] * rstd * f0.y; o0.z = acc[k][kk * 4 + 2] * rstd * f0.z; o0.w = acc[k][kk * 4 + 3] * rstd * f0.w;
                        __builtin_amdgcn_raw_buffer_store_b128(__builtin_bit_cast(u32x4, o0), rdst, l16 + (unsigned)((kk & 3) * 1024), ot + (unsigned)((kk >> 2) * 4096), 0); }
                }
            }
        }
    }
}

#define XB_TMO      128
#define XB_XCNT(j)  (256  + 64 * (j))
#define XB_XSUB(j)  (1280 + 64 * (j))
#define XB_XGEN(j)  (2304 + 64 * (j))
#define XB_TOP      3328
#define XB_TOPGEN   3392
#define XCD_BAR_WORDS 3456
#define XB_SPIN_CAP (1u << 22)
__device__ __forceinline__ unsigned xb_ld(unsigned* p)              { return __hip_atomic_load(p, __ATOMIC_RELAXED, __HIP_MEMORY_SCOPE_AGENT); }
__device__ __forceinline__ unsigned xb_add(unsigned* p, unsigned v) { return __hip_atomic_fetch_add(p, v, __ATOMIC_RELAXED, __HIP_MEMORY_SCOPE_AGENT); }
__device__ __forceinline__ unsigned xb_xcc_id() { return (unsigned)__builtin_amdgcn_s_getreg((3 << 11) | 20) & 0xFu; }
#define XB_SPIN(cond, bar) do { unsigned _sp = 0; while (cond) { __builtin_amdgcn_s_sleep(1); \
    if ((++_sp & 255u) == 0u) { if (xb_ld(&(bar)[XB_TMO])) break; if (_sp > XB_SPIN_CAP) { atomicAdd(&(bar)[XB_TMO], 1u); break; } } } } while (0)
struct XcdBarrier { unsigned* bar; unsigned x; volatile LAS unsigned* st; };
__device__ __forceinline__ XcdBarrier xcd_barrier_post(unsigned* bar, volatile LAS unsigned* st) {
    XcdBarrier b; b.bar = bar; b.x = xb_xcc_id(); b.st = st;
    if (threadIdx.x == 0) (void)xb_add(&bar[XB_XCNT(b.x)], 1u);
    return b;
}
__device__ __forceinline__ void xcd_barrier_complete(unsigned* bar, unsigned x, unsigned G, unsigned& nloc, unsigned& nx) {
    unsigned sum, cnt, mine, sp = 0u;
    for (;;) {
        sum = 0u; cnt = 0u; mine = 0u;
#pragma unroll
        for (unsigned j = 0; j < 16; ++j) { const unsigned c = xb_ld(&bar[XB_XCNT(j)]); sum += c; cnt += (c > 0u) ? 1u : 0u; mine = (j == x) ? c : mine; }
        if (sum == G) break;
        __builtin_amdgcn_s_sleep(1);
        if ((++sp & 255u) == 0u) { if (xb_ld(&bar[XB_TMO])) break; if (sp > XB_SPIN_CAP) { atomicAdd(&bar[XB_TMO], 1u); break; } }
    }
    nloc = mine > 0u ? mine : 1u; nx = cnt > 0u ? cnt : 1u;
}
__device__ __forceinline__ void xcd_barrier(const XcdBarrier& b, unsigned G) {
    asm volatile("s_waitcnt vmcnt(0)" ::: "memory");
    __syncthreads();
    if (threadIdx.x == 0) {
        unsigned* bar = b.bar;
        __builtin_amdgcn_s_waitcnt(0);
        unsigned nloc = b.st[0], nx = b.st[1];
        if (nloc == 0u) { xcd_barrier_complete(bar, b.x, G, nloc, nx); b.st[0] = nloc; b.st[1] = nx; }
        const unsigned old = xb_add(&bar[XB_XSUB(b.x)], 1u);
        const unsigned gen = old / nloc;
        if (old + 1u == (gen + 1u) * nloc) {
            __builtin_amdgcn_fence(__ATOMIC_RELEASE, "agent");
            asm volatile("s_waitcnt vmcnt(0)" ::: "memory");
            const unsigned og = xb_add(&bar[XB_TOP], 1u);
            const unsigned tg = og / nx;
            if (og + 1u == (tg + 1u) * nx) xb_add(&bar[XB_TOPGEN], 1u);
            else XB_SPIN(xb_ld(&bar[XB_TOPGEN]) == tg, bar);
            __builtin_amdgcn_fence(__ATOMIC_ACQUIRE, "agent");
            xb_add(&bar[XB_XGEN(b.x)], 1u);
            asm volatile("s_waitcnt vmcnt(0)" ::: "memory");
        } else {
            XB_SPIN(xb_ld(&bar[XB_XGEN(b.x)]) == gen, bar);
            __builtin_amdgcn_fence(__ATOMIC_ACQUIRE, "agent");
            asm volatile("s_waitcnt vmcnt(0)" ::: "memory");
        }
    }
    __syncthreads();
}

constexpr int N_PHASES = 9;
#ifndef DUP_MASK
#define DUP_MASK 0
#endif
#define REP(k) for (int rep_ = 0; rep_ < 1 + ((DUP_MASK >> (k)) & 1); ++rep_)
__global__ void __launch_bounds__(NTHR, 2) fwd(Args args) {
    extern __shared__ __attribute__((aligned(16))) unsigned char lds_raw[];
    LAS unsigned char* lds = (LAS unsigned char*)lds_raw;
    const int tid = threadIdx.x, lane = tid & 63, wave = __builtin_amdgcn_readfirstlane(tid >> 6);
    const int G = gridDim.x; const int bx = blockIdx.x; const int vcu = (G % 8 == 0) ? (bx % 8) * (G / 8) + bx / 8 : bx;
    unsigned char* ws = args.ws;
    const int lo = args.ph_lo, hi = args.ph_hi;
#define IN(k) (lo <= (k) && (k) < hi)
    volatile LAS unsigned* MISC = (volatile LAS unsigned*)(lds + MISC_OFF);
    if (tid < 32) MISC[tid] = 0u;
    __syncthreads();
#if USE_CG_SYNC
    if (IN(0) && bx * NTHR + tid < XCD_BAR_WORDS) __hip_atomic_store((unsigned*)(ws + WS_CTL) + bx * NTHR + tid, 0u, __ATOMIC_RELAXED, __HIP_MEMORY_SCOPE_AGENT);
    XcdBarrier bar; bar.bar = (unsigned*)(ws + WS_CTL); bar.x = 0; bar.st = MISC + 8;
#else
    XcdBarrier bar = xcd_barrier_post((unsigned*)(ws + WS_CTL), MISC + 8);
#endif
#if USE_CG_SYNC
#define SEAM(k) do { if (IN(k) && IN((k) + ((k) == 4 ? 2 : 1))) { if ((k) == 0) { cg::this_grid().sync(); bar = xcd_barrier_post((unsigned*)(ws + WS_CTL), MISC + 8); } else xcd_barrier(bar, (unsigned)G); } } while (0)
#else
#define SEAM(k) do { if (IN(k) && IN((k) + ((k) == 4 ? 2 : 1))) { xcd_barrier(bar, (unsigned)G); } } while (0)
#endif

    if (IN(0)) REP(0) { p0_prologue(args, lds, vcu, G, wave, lane, tid); }
    SEAM(0);
    constexpr int P1_TILES = 24;
    if (IN(1)) REP(1) {
        pg8::Gemm g{(const bf16_t*)(ws + WS_H), (const bf16_t*)(ws + WS_WIN), S, P1_TILES * 256, D, D, D, 0}; pg8::StaticOrder so; so.init(S, P1_TILES * 256, G, bx);
        pg8::EpiZ E{(bf16_t*)(ws + WS_Z), args.in[3]};
        pg8::gemm_phase<pg8::EpiZ>(lds, g, so, E);
    }
    SEAM(1);
    if (IN(2)) REP(2) {
        const int G2 = G / 2;
        if (G2 >= 1 && bx < G2) {
            pg8::Gemm g{(const bf16_t*)(ws + WS_H), (const bf16_t*)(ws + WS_WIN), S, INW, D, D, D, 0}; pg8::StaticOrder so; so.init(S, (28 - P1_TILES) * 256, G2, bx, P1_TILES);
            pg8::EpiZ E{(bf16_t*)(ws + WS_Z), args.in[3]};
            pg8::gemm_phase<pg8::EpiZ>(lds, g, so, E);
        } else {
            for (int bi = bx - G2; bi < 128; bi += G - G2) { const int it0 = (bi >> 1) * 8 + (bi & 1) * 4; p2_sgu(args, lds, it0, it0 + 4, 1, wave, lane, tid); }
        }
        p2_pool(args, vcu, G, tid);
    }
    SEAM(2);
    if (IN(3)) REP(3) {
        pg8::StaticOrder so; so.init(S, D, G, bx);
        { pg8::Gemm g{(const bf16_t*)(ws + WS_A2), (const bf16_t*)(ws + WS_WPOOL), S, D, 256, D, 256, 1};
          pg8::EpiPool E{(bf16_t*)(ws + WS_T), (const bf16_t*)(ws + WS_Z)};
          pg8::gemm_phase<pg8::EpiPool>(lds, g, so, E); }
        asm volatile("s_waitcnt vmcnt(0)" ::: "memory"); __syncthreads();
        { pg8::Gemm g{(const bf16_t*)(ws + WS_A2) + 1024, (const bf16_t*)(ws + WS_WG), S, D, GWD, D, GWD, 0};
          pg8::EpiMerge E{(const bf16_t*)(ws + WS_T), (const bf16_t*)(ws + WS_Z), (bf16_t*)(ws + WS_MRG)};
          pg8::gemm_phase<pg8::EpiMerge>(lds, g, so, E); }
    }
    SEAM(3);
    if (IN(4)) REP(4) {
        pg8::Gemm g{(const bf16_t*)(ws + WS_MRG), (const bf16_t*)(ws + WS_WOUT), S, D, D, D, D, 0}; pg8::StaticOrder so; so.init(S, D, G, bx);
        pg8::EpiX1 E{args.in[0], (bf16_t*)(ws + WS_XB), (float*)(ws + WS_SS)};
        pg8::gemm_phase<pg8::EpiX1>(lds, g, so, E);
    }
    SEAM(4);
    if (IN(6)) REP(6) {
        pg8::Gemm g{(const bf16_t*)(ws + WS_XB), (const bf16_t*)(ws + WS_WQ), S, D, D, D, D, 0}; pg8::StaticOrder so; so.init(S, D, G, bx);
        pg8::EpiQ E{(bf16_t*)(ws + WS_Q), (const float*)(ws + WS_SS)};
        pg8::gemm_phase<pg8::EpiQ>(lds, g, so, E);
    }
    if (IN(6) && IN(7)) { asm volatile("s_waitcnt vmcnt(0)" ::: "memory"); __syncthreads(); }
    if (IN(7)) REP(7) { p7_topk(args, lds, vcu, G, wave, lane); }
    SEAM(7);
    if (IN(8)) REP(8) { float* dst8 = (rep_ < ((DUP_MASK >> 8) & 1)) ? (float*)(ws + WS_T) : args.out; p8_peer(args, lds, dst8, vcu, G, wave, lane); }
#undef IN
#undef SEAM
}

extern "C" void kernel_launch(void* const* d_in, const int* in_sizes, int n_in, void* d_out, int out_size, void* d_ws, size_t ws_size, hipStream_t stream) {
    static int grid = 0;
    if (grid == 0) {
        if (n_in != 18 || out_size != S * D || ws_size < WS_END) { fprintf(stderr, "kernel_launch: unexpected shapes (n_in %d, out %d, ws %zu)\n", n_in, out_size, ws_size); grid = -1; return; }
        int dev = 0, cus = 0, per_cu = 0;
        if (hipGetDevice(&dev) != hipSuccess || hipDeviceGetAttribute(&cus, hipDeviceAttributeMultiprocessorCount, dev) != hipSuccess) { grid = -1; return; }
        if (hipFuncSetAttribute((const void*)fwd, hipFuncAttributeMaxDynamicSharedMemorySize, LDS_BYTES) != hipSuccess) { fprintf(stderr, "kernel_launch: hipFuncSetAttribute failed\n"); grid = -1; return; }
        if (hipOccupancyMaxActiveBlocksPerMultiprocessor(&per_cu, (const void*)fwd, NTHR, LDS_BYTES) != hipSuccess || per_cu < 1) { fprintf(stderr, "kernel_launch: occupancy query says %d\n", per_cu); per_cu = 1; }
        (void)hipGetLastError();
        grid = cus;
    }
    if (grid < 0) return;
#if !USE_CG_SYNC
    if (hipMemsetAsync((char*)d_ws + WS_CTL, 0, 16384, stream) != hipSuccess) { fprintf(stderr, "kernel_launch: memset failed\n"); return; }
#endif
    Args a{};
    for (int i = 0; i < 18; ++i) a.in[i] = (const float*)d_in[i];
    a.out = (float*)d_out; a.ws = (unsigned char*)d_ws;
#if MK_N_LAUNCHES == 1
    a.ph_lo = 0; a.ph_hi = N_PHASES;
    void* kargs[] = {&a};
    hipError_t e = hipLaunchCooperativeKernel((const void*)fwd, dim3(grid), dim3(NTHR), kargs, LDS_BYTES, stream);
    if (e != hipSuccess) fprintf(stderr, "kernel_launch: cooperative launch failed: %s (grid %d)\n", hipGetErrorString(e), grid);
#else
    for (int p = 0; p < N_PHASES; ++p) {
        a.ph_lo = p; a.ph_hi = p + 1;
        hipLaunchKernelGGL(fwd, dim3(grid), dim3(NTHR), LDS_BYTES, stream, a);
    }
#endif
}
```

```cpp
#include <hip/hip_runtime.h>
#include <hip/hip_cooperative_groups.h>
#include <cstdio>
#include <cstdint>
namespace cg = cooperative_groups;

#ifndef USE_CG_SYNC
#define USE_CG_SYNC 1
#endif
#ifndef MK_N_LAUNCHES
#define MK_N_LAUNCHES 1
#endif

#define LAS __attribute__((address_space(3)))
typedef unsigned short bf16_t;
typedef short bf16x8 __attribute__((ext_vector_type(8)));
typedef float f32x4 __attribute__((ext_vector_type(4)));
typedef unsigned u32x4 __attribute__((ext_vector_type(4)));
typedef unsigned u32x2 __attribute__((ext_vector_type(2)));

constexpr int S = 8192, D = 2048, INW = 7168, PW = 1024, GWD = 1024;
constexpr int NEXP = 16384;
constexpr float EPS = 1e-6f;
constexpr int NWAVES = 8, NTHR = 512;

constexpr size_t MiB = 1u << 20;
constexpr size_t WS_CTL = 0;
constexpr size_t WS_WIN = 1 * MiB;
constexpr size_t WS_WPOOL = 30 * MiB;
constexpr size_t WS_WG = 31 * MiB;
constexpr size_t WS_WOUT = 35 * MiB;
constexpr size_t WS_WQ = 43 * MiB;
constexpr size_t WS_KEYS = 51 * MiB;
constexpr size_t WS_WSM = 52 * MiB;
constexpr size_t WS_H = 53 * MiB;
constexpr size_t WS_Z = 85 * MiB;
constexpr size_t WS_A2 = 197 * MiB;
constexpr size_t WS_T = 229 * MiB;
constexpr size_t WS_MRG = 293 * MiB;
constexpr size_t WS_Q = 325 * MiB;
constexpr size_t WS_IDX = 357 * MiB;
constexpr size_t WS_GATE = 361 * MiB;
constexpr size_t WS_SS = 365 * MiB;
constexpr size_t WS_ESC = 369 * MiB;
constexpr size_t WS_EU = 370 * MiB;
constexpr size_t WS_EV = 402 * MiB;
constexpr size_t WS_XB = 434 * MiB;
constexpr size_t WS_END = 466 * MiB;

constexpr int LDS_BYTES = 147456;
constexpr int MISC_OFF = 131072 + 320;

__device__ __forceinline__ unsigned f2bf(float f) { unsigned u = __builtin_bit_cast(unsigned, f); return (u + 0x7fffu + ((u >> 16) & 1u)) >> 16; }
__device__ __forceinline__ unsigned pk2(float lo, float hi) { return f2bf(lo) | (f2bf(hi) << 16); }
__device__ __forceinline__ float bflo(unsigned w) { return __builtin_bit_cast(float, w << 16); }
__device__ __forceinline__ float bfhi(unsigned w) { return __builtin_bit_cast(float, w & 0xffff0000u); }
__device__ __forceinline__ float wave_sum(float v) {
#pragma unroll
    for (int o = 1; o < 64; o <<= 1) v += __shfl_xor(v, o);
    return v;
}
template <int CTRL> __device__ __forceinline__ float dpp_add_f32(float v) { return v + __builtin_bit_cast(float, __builtin_amdgcn_update_dpp(0, __builtin_bit_cast(int, v), CTRL, 0xF, 0xF, true)); }
__device__ __forceinline__ float row_sum_f32(float v) { v = dpp_add_f32<0xB1>(v); v = dpp_add_f32<0x4E>(v); v = dpp_add_f32<0x141>(v); v = dpp_add_f32<0x140>(v); return v; }
__device__ __forceinline__ float gelu_tanh(float x) {
    const float y = 1.5957691216057308f * (x + 0.044715f * x * x * x);
    const float e = __builtin_amdgcn_exp2f(-y * 1.4426950408889634f);
    return x * __builtin_amdgcn_rcpf(1.0f + e);
}
__device__ __forceinline__ float sigmoidf_(float x) { return __builtin_amdgcn_rcpf(1.0f + __builtin_amdgcn_exp2f(-x * 1.4426950408889634f)); }

namespace pg8 {
constexpr int BM = 256, BK = 64, HALF = 128, HTB = HALF * BK * 2, STAGE_BYTES = 8 * HTB, NXCD = 8, WGM = 1;
__host__ __device__ __forceinline__ int lds_byte(int r, int c) { const int st = (r >> 4) * 2 + (c >> 5), rr = r & 15, cc = c & 31, ob = rr * 64 + cc * 2; return st * 1024 + (ob ^ (((ob >> 9) & 1) << 5)); }
__host__ __device__ __forceinline__ void stage_rc(int b, int& R, int& C) { const int st = b / 1024, sb = b % 1024, swz = sb ^ (((sb >> 9) & 1) << 5); R = (st >> 1) * 16 + swz / 64; C = (st & 1) * 32 + (swz % 64) / 2; }
__host__ __device__ __forceinline__ int perm32(int rho) { const int n = rho >> 4, i = rho & 15; return 8 * (i >> 2) + 4 * n + (i & 3); }

struct Unit { int pm, pn; };
struct Gemm { const bf16_t* A; const bf16_t* Bt; int M, N, K, lda, ldb, mode; };
__device__ __forceinline__ const char* a_ptr(const Gemm& g, const Unit& u) {
    size_t off = (size_t)u.pm * BM * g.lda; if (g.mode == 1) off += (size_t)(u.pn >> 1) * 256; return (const char*)(g.A + off); }
__device__ __forceinline__ const char* b_ptr(const Gemm& g, const Unit& u) {
    size_t off = (g.mode == 1) ? ((size_t)(u.pn >> 1) * 512 * 256 + (size_t)(u.pn & 1) * 256 * 256) : (size_t)u.pn * BM * g.ldb; return (const char*)(g.Bt + off); }

struct StaticOrder {
    int nM, nN, nwg, G, c, pn0;
    __host__ __device__ void init(int M, int N, int G_, int c_, int pn0_ = 0) { nM = M / BM; nN = N / BM; nwg = nM * nN; G = G_; c = c_; pn0 = pn0_; }
    __host__ __device__ bool next(int i, Unit& u) const {
        const long L = (long)i * G + c; if (L >= nwg) return false;
        int wgid = (int)L; { const int q = nwg / NXCD, r = nwg % NXCD, xcd = wgid % NXCD, off = wgid / NXCD; wgid = (xcd < r ? xcd * (q + 1) : r * (q + 1) + (xcd - r) * q) + off; }
        const int nig = WGM * nN, gid = wgid / nig, fm = gid * WGM, gsz = (nM - fm) < WGM ? (nM - fm) : WGM;
        u.pm = fm + ((wgid % nig) % gsz); u.pn = pn0 + (wgid % nig) / gsz; return true;
    }
};

__device__ __forceinline__ unsigned cvt_pk_bf16(float lo, float hi) { unsigned r; asm volatile("v_cvt_pk_bf16_f32 %0, %1, %2" : "=v"(r) : "v"(lo), "v"(hi)); return r; }


struct EpiZ {
    static constexpr bool PERM = true;
    bf16_t* Z; const float* b_gate;
    __device__ __forceinline__ void operator()(const f32x4 (&acc)[2][2][4][2], const Unit& u, int wr, int wc, int fr, int fq) const {
        const int row0 = u.pm * BM + wr * 64 + fr, col0 = u.pn * BM + wc * 32 + 8 * fq;
        const int mode = u.pn < 4 ? 0 : (u.pn < 12 ? 1 : 2);
        f32x4 bv[2][2];
#pragma unroll
        for (int bj = 0; bj < 2; ++bj)
#pragma unroll
            for (int n = 0; n < 2; ++n) bv[bj][n] = (mode == 2) ? *(const f32x4*)(b_gate + (col0 - 3072) + bj * HALF + 4 * n) : (f32x4){0.f, 0.f, 0.f, 0.f};
#pragma unroll
        for (int ai = 0; ai < 2; ++ai)
#pragma unroll
            for (int m = 0; m < 4; ++m) { bf16_t* rowp = Z + (size_t)(row0 + ai * HALF + m * 16) * INW + col0;
#pragma unroll
                for (int bj = 0; bj < 2; ++bj) { f32x4 v0 = acc[ai][bj][m][0], v1 = acc[ai][bj][m][1];
                    if (mode == 1) {
#pragma unroll
                        for (int j = 0; j < 4; ++j) { v0[j] = gelu_tanh(v0[j]); v1[j] = gelu_tanh(v1[j]); } }
                    if (mode == 2) { v0 += bv[bj][0]; v1 += bv[bj][1];
#pragma unroll
                        for (int j = 0; j < 4; ++j) { v0[j] = sigmoidf_(v0[j]); v1[j] = sigmoidf_(v1[j]); } }
                    u32x4 w; w.x = cvt_pk_bf16(v0[0], v0[1]); w.y = cvt_pk_bf16(v0[2], v0[3]); w.z = cvt_pk_bf16(v1[0], v1[1]); w.w = cvt_pk_bf16(v1[2], v1[3]);
                    *(u32x4*)(rowp + bj * HALF) = w; } }
    }
};
struct EpiPool {
    static constexpr bool PERM = true;
    bf16_t* T; const bf16_t* Z;
    __device__ __forceinline__ void operator()(const f32x4 (&acc)[2][2][4][2], const Unit& u, int wr, int wc, int fr, int fq) const {
        const int row0 = u.pm * BM + wr * 64 + fr, col0 = u.pn * BM + wc * 32 + 8 * fq;
#pragma unroll
        for (int ai = 0; ai < 2; ++ai)
#pragma unroll
            for (int m = 0; m < 4; ++m) { const size_t row = (size_t)(row0 + ai * HALF + m * 16);
#pragma unroll
                for (int bj = 0; bj < 2; ++bj) { const int c = col0 + bj * HALF;
                    const u32x4 g = *(const u32x4*)(Z + row * INW + 3072 + c);
                    const f32x4 a0 = acc[ai][bj][m][0], a1 = acc[ai][bj][m][1];
                    u32x4 w; w.x = cvt_pk_bf16(bflo(g.x) * a0[0], bfhi(g.x) * a0[1]); w.y = cvt_pk_bf16(bflo(g.y) * a0[2], bfhi(g.y) * a0[3]);
                    w.z = cvt_pk_bf16(bflo(g.z) * a1[0], bfhi(g.z) * a1[1]); w.w = cvt_pk_bf16(bflo(g.w) * a1[2], bfhi(g.w) * a1[3]);
                    *(u32x4*)(T + row * D + c) = w; asm volatile("" ::: "memory"); } }
    }
};
struct EpiMerge {
    static constexpr bool PERM = true;
    const bf16_t* T; const bf16_t* Z; bf16_t* O;
    __device__ __forceinline__ void operator()(const f32x4 (&acc)[2][2][4][2], const Unit& u, int wr, int wc, int fr, int fq) const {
        const int row0 = u.pm * BM + wr * 64 + fr, col0 = u.pn * BM + wc * 32 + 8 * fq;
#pragma unroll
        for (int ai = 0; ai < 2; ++ai)
#pragma unroll
            for (int m = 0; m < 4; ++m) { const size_t row = (size_t)(row0 + ai * HALF + m * 16);
#pragma unroll
                for (int bj = 0; bj < 2; ++bj) { const int c = col0 + bj * HALF;
                    const u32x4 g = *(const u32x4*)(Z + row * INW + 5120 + c);
                    const u32x4 t = *(const u32x4*)(T + row * D + c);
                    const f32x4 a0 = acc[ai][bj][m][0], a1 = acc[ai][bj][m][1];
                    u32x4 w; w.x = cvt_pk_bf16(bflo(t.x) + bflo(g.x) * a0[0], bfhi(t.x) + bfhi(g.x) * a0[1]); w.y = cvt_pk_bf16(bflo(t.y) + bflo(g.y) * a0[2], bfhi(t.y) + bfhi(g.y) * a0[3]);
                    w.z = cvt_pk_bf16(bflo(t.z) + bflo(g.z) * a1[0], bfhi(t.z) + bfhi(g.z) * a1[1]); w.w = cvt_pk_bf16(bflo(t.w) + bflo(g.w) * a1[2], bfhi(t.w) + bfhi(g.w) * a1[3]);
                    *(u32x4*)(O + row * D + c) = w; asm volatile("" ::: "memory"); } }
    }
};
struct EpiX1 {
    static constexpr bool PERM = true;
    const float* X; bf16_t* XB; float* SS;
    __device__ __forceinline__ void operator()(const f32x4 (&acc)[2][2][4][2], const Unit& u, int wr, int wc, int fr, int fq) const {
        const int row0 = u.pm * BM + wr * 64 + fr, col0 = u.pn * BM + wc * 32 + 8 * fq;
#pragma unroll
        for (int ai = 0; ai < 2; ++ai)
#pragma unroll
            for (int m = 0; m < 4; ++m) { const size_t row = (size_t)(row0 + ai * HALF + m * 16); float ss = 0.f;
#pragma unroll
                for (int bj = 0; bj < 2; ++bj) { const size_t off = row * D + col0 + bj * HALF;
                    const f32x4 x0 = *(const f32x4*)(X + off) + acc[ai][bj][m][0], x1 = *(const f32x4*)(X + off + 4) + acc[ai][bj][m][1];
                    ss += (x0[0] * x0[0] + x0[1] * x0[1]) + (x0[2] * x0[2] + x0[3] * x0[3]) + (x1[0] * x1[0] + x1[1] * x1[1]) + (x1[2] * x1[2] + x1[3] * x1[3]);
                    u32x4 w; w.x = cvt_pk_bf16(x0[0], x0[1]); w.y = cvt_pk_bf16(x0[2], x0[3]); w.z = cvt_pk_bf16(x1[0], x1[1]); w.w = cvt_pk_bf16(x1[2], x1[3]);
                    *(u32x4*)(XB + off) = w; }
                ss += __shfl_xor(ss, 16); ss += __shfl_xor(ss, 32);
                if (fq == 0) SS[row * 32 + u.pn * 4 + wc] = ss;
                asm volatile("" ::: "memory"); }
    }
};
struct EpiQ {
    static constexpr bool PERM = true;
    bf16_t* O; const float* SS;
    __device__ __forceinline__ void operator()(const f32x4 (&acc)[2][2][4][2], const Unit& u, int wr, int wc, int fr, int fq) const {
        const int row0 = u.pm * BM + wr * 64 + fr, col0 = u.pn * BM + wc * 32 + 8 * fq;
#pragma unroll
        for (int ai = 0; ai < 2; ++ai)
#pragma unroll
            for (int m = 0; m < 4; ++m) { const size_t row = (size_t)(row0 + ai * HALF + m * 16);
                const f32x4 p0 = *(const f32x4*)(SS + row * 32 + fq * 8), p1 = *(const f32x4*)(SS + row * 32 + fq * 8 + 4);
                float ss = ((p0[0] + p0[1]) + (p0[2] + p0[3])) + ((p1[0] + p1[1]) + (p1[2] + p1[3]));
                ss += __shfl_xor(ss, 16); ss += __shfl_xor(ss, 32);
                const float rstd = 1.0f / sqrtf(ss * (1.0f / D) + EPS);
                bf16_t* rowp = O + row * D + col0;
#pragma unroll
                for (int bj = 0; bj < 2; ++bj) { const f32x4 v0 = acc[ai][bj][m][0] * rstd, v1 = acc[ai][bj][m][1] * rstd;
                    u32x4 w; w.x = cvt_pk_bf16(v0[0], v0[1]); w.y = cvt_pk_bf16(v0[2], v0[3]); w.z = cvt_pk_bf16(v1[0], v1[1]); w.w = cvt_pk_bf16(v1[2], v1[3]);
                    *(u32x4*)(rowp + bj * HALF) = w; } }
    }
};

template <class Epi, bool ALIGN_EPI = true>
__device__ __forceinline__ void gemm_phase(LAS unsigned char* lds, const Gemm g, const StaticOrder& S_, const Epi& E) {
    int tid_ = threadIdx.x; asm volatile("" : "+v"(tid_));
    const int tid = tid_, wid = __builtin_amdgcn_readfirstlane(tid >> 6), lane = tid & 63, wr = wid >> 2, wc = wid & 3, fr = lane & 15, fq = lane >> 4;
    const int K = g.K, nt = K / BK;
    unsigned voffA[2], voffB[2];
#pragma unroll
    for (int i = 0; i < 2; ++i) { int R, C; stage_rc(tid * 16 + i * 8192, R, C); const int Rb = Epi::PERM ? ((R & ~31) + perm32(R & 31)) : R;
        voffA[i] = (unsigned)(R * g.lda + C) * 2u; voffB[i] = (unsigned)(Rb * g.ldb + C) * 2u; }
    const size_t kstep = (size_t)(BK * 2);
    const size_t hstepA = (size_t)HALF * g.lda * 2, hstepB = (size_t)HALF * g.ldb * 2;
    const unsigned ldsw = (unsigned)wid * 1024u;
    const int aoff = lds_byte(wr * 64 + fr, fq * 8), boff = lds_byte(wc * 32 + fr, fq * 8);
#define PG8_SA(b, h) (((b) * 2 + (h)) * HTB)
#define PG8_SB(b, h) ((4 + (b) * 2 + (h)) * HTB)
#define PG8_STAGE(bufoff, gbase, voff) do { _Pragma("unroll") for (int _i = 0; _i < 2; ++_i) \
        __builtin_amdgcn_global_load_lds((const unsigned*)((const char*)(gbase) + (voff)[_i]), (LAS unsigned*)(lds + (bufoff) + ldsw + _i * 8192), 16, 0, 0); } while (0)
#define PG8_LDA(dst, b, h) do { _Pragma("unroll") for (int m = 0; m < 4; ++m) _Pragma("unroll") for (int k = 0; k < 2; ++k) dst[m][k] = *(const LAS bf16x8*)(lds + PG8_SA(b, h) + aoff + m * 2048 + k * 1024); } while (0)
#define PG8_LDB(dst, b, h) do { _Pragma("unroll") for (int n = 0; n < 2; ++n) _Pragma("unroll") for (int k = 0; k < 2; ++k) dst[n][k] = *(const LAS bf16x8*)(lds + PG8_SB(b, h) + boff + n * 2048 + k * 1024); } while (0)
#define PG8_MMA(ai, bj, At, Bt) do { __builtin_amdgcn_s_setprio(1); _Pragma("unroll") for (int m = 0; m < 4; ++m) _Pragma("unroll") for (int n = 0; n < 2; ++n) _Pragma("unroll") for (int k = 0; k < 2; ++k) \
        acc[ai][bj][m][n] = __builtin_amdgcn_mfma_f32_16x16x32_bf16(Bt[n][k], At[m][k], acc[ai][bj][m][n], 0, 0, 0); __builtin_amdgcn_s_setprio(0); } while (0)
#define PG8_WAIT_V(n) asm volatile("s_waitcnt vmcnt(" #n ")" ::: "memory")
#define PG8_WAIT_L(n) asm volatile("s_waitcnt lgkmcnt(" #n ")" ::: "memory")
#define PG8_BAR __builtin_amdgcn_s_barrier()
#define PG8_SCHED __builtin_amdgcn_sched_barrier(0)
    Unit cur, nxt; int ui = 0;
    if (!S_.next(0, cur)) return;
    f32x4 acc[2][2][4][2];
#pragma unroll
    for (int a = 0; a < 2; ++a)
#pragma unroll
        for (int b = 0; b < 2; ++b)
#pragma unroll
            for (int m = 0; m < 4; ++m)
#pragma unroll
                for (int n = 0; n < 2; ++n) acc[a][b][m][n] = (f32x4){0.f, 0.f, 0.f, 0.f};
    bf16x8 At[4][2], B0[2][2], B1[2][2];
    const char* cA = a_ptr(g, cur); const char* cB = b_ptr(g, cur);
    PG8_STAGE(PG8_SB(0, 0), cB, voffB); PG8_STAGE(PG8_SB(0, 1), cB + hstepB, voffB); PG8_STAGE(PG8_SA(0, 0), cA, voffA); PG8_STAGE(PG8_SA(0, 1), cA + hstepA, voffA);
    if (wr == 1) PG8_BAR;
    PG8_WAIT_V(2); PG8_BAR;
    PG8_STAGE(PG8_SB(1, 0), cB + kstep, voffB); PG8_STAGE(PG8_SA(1, 0), cA + kstep, voffA); PG8_STAGE(PG8_SB(1, 1), cB + hstepB + kstep, voffB);
    PG8_WAIT_V(6); PG8_BAR;
    for (;;) {
        const bool has_next = S_.next(ui + 1, nxt);
        const char* nA = has_next ? a_ptr(g, nxt) : cA; const char* nB = has_next ? b_ptr(g, nxt) : cB;
        for (int t = 0; t < nt; t += 2) {
            const bool last = (t == nt - 2);
            const char* a1 = cA + (size_t)(t + 1) * kstep;
            const char* a2 = last ? nA : cA + (size_t)(t + 2) * kstep; const char* b2 = last ? nB : cB + (size_t)(t + 2) * kstep;
            const char* a3 = a2 + kstep; const char* b3 = b2 + kstep;
            PG8_LDB(B0, 0, 0); PG8_LDB(B1, 0, 1); PG8_SCHED; PG8_LDA(At, 0, 0); PG8_STAGE(PG8_SA(1, 1), a1 + hstepA, voffA);
            PG8_WAIT_V(8); PG8_WAIT_L(0); PG8_BAR; PG8_MMA(0, 0, At, B0); PG8_MMA(0, 1, At, B1); PG8_BAR; PG8_SCHED;
            PG8_LDA(At, 0, 1); PG8_STAGE(PG8_SB(0, 0), b2, voffB); PG8_STAGE(PG8_SB(0, 1), b2 + hstepB, voffB); PG8_STAGE(PG8_SA(0, 0), a2, voffA);
            PG8_WAIT_V(8); PG8_WAIT_L(0); PG8_BAR; PG8_MMA(1, 0, At, B0); PG8_MMA(1, 1, At, B1); PG8_BAR; PG8_SCHED;
            PG8_LDB(B0, 1, 0); PG8_LDB(B1, 1, 1); PG8_SCHED; PG8_LDA(At, 1, 0); PG8_STAGE(PG8_SA(0, 1), a2 + hstepA, voffA);
            PG8_WAIT_V(8); PG8_WAIT_L(0); PG8_BAR; PG8_MMA(0, 0, At, B0); PG8_MMA(0, 1, At, B1); PG8_BAR; PG8_SCHED;
            PG8_LDA(At, 1, 1); PG8_STAGE(PG8_SB(1, 0), b3, voffB); PG8_STAGE(PG8_SB(1, 1), b3 + hstepB, voffB); PG8_STAGE(PG8_SA(1, 0), a3, voffA);
            PG8_WAIT_V(8); PG8_WAIT_L(0); PG8_BAR; PG8_MMA(1, 0, At, B0); PG8_MMA(1, 1, At, B1); PG8_BAR; PG8_SCHED;
        }
        if constexpr (ALIGN_EPI) { if (wr == 0) PG8_BAR; }
        { int ln_ = threadIdx.x & 63; asm volatile("" : "+v"(ln_));
          E(acc, cur, wr, wc, ln_ & 15, ln_ >> 4); }
        if (!has_next) break;
#pragma unroll
        for (int a = 0; a < 2; ++a)
#pragma unroll
            for (int b = 0; b < 2; ++b)
#pragma unroll
                for (int m = 0; m < 4; ++m)
#pragma unroll
                    for (int n = 0; n < 2; ++n) acc[a][b][m][n] = (f32x4){0.f, 0.f, 0.f, 0.f};
        cur = nxt; cA = nA; cB = nB; ++ui;
        if constexpr (ALIGN_EPI) { if (wr == 1) PG8_BAR; }
    }
    PG8_WAIT_V(0);
    if constexpr (!ALIGN_EPI) { if (wr == 0) PG8_BAR; }
    PG8_BAR;
#undef PG8_SA
#undef PG8_SB
#undef PG8_STAGE
#undef PG8_LDA
#undef PG8_LDB
#undef PG8_MMA
#undef PG8_WAIT_V
#undef PG8_WAIT_L
#undef PG8_BAR
#undef PG8_SCHED
}
}

struct Args { const float* in[18]; float* out; unsigned char* ws; int ph_lo, ph_hi; };

__device__ __forceinline__ void p0_transpose_item(const float* W, int K, int N, bf16_t* WT, LAS float* scr, int item, int lane, const float* kgain = nullptr) {
    const int nblk = N / 32, kb = item / nblk, nb = item % nblk, k0 = 64 * kb, n0 = 32 * nb;
    { f32x4 wv[8];
#pragma unroll
      for (int i = 0; i < 8; ++i) wv[i] = *(const f32x4*)(W + (size_t)(k0 + 8 * i + (lane >> 3)) * N + n0 + 4 * (lane & 7));
#pragma unroll
      for (int i = 0; i < 8; ++i) { const int kk = 8 * i + (lane >> 3); const float gk = kgain ? kgain[k0 + kk] : 1.0f; LAS float* sp = scr + kk * 33 + 4 * (lane & 7);
          sp[0] = gk * wv[i].x; sp[1] = gk * wv[i].y; sp[2] = gk * wv[i].z; sp[3] = gk * wv[i].w; } }
    asm volatile("s_waitcnt lgkmcnt(0)" ::: "memory");
    const int c = lane & 7;
#pragma unroll
    for (int j = 0; j < 4; ++j) { const int n = (lane >> 3) + 8 * j; const LAS float* s = scr + (8 * c) * 33 + n;
        u32x4 o; o.x = pk2(s[0 * 33], s[1 * 33]); o.y = pk2(s[2 * 33], s[3 * 33]); o.z = pk2(s[4 * 33], s[5 * 33]); o.w = pk2(s[6 * 33], s[7 * 33]);
        *(u32x4*)(WT + (size_t)(n0 + n) * K + k0 + 8 * c) = o; }
    asm volatile("s_waitcnt lgkmcnt(0)" ::: "memory");
}
__device__ __forceinline__ void rms_row_to_bf16(const float* xrow, const float* g, bf16_t* orow, int lane) {
    const f32x4* xr = (const f32x4*)xrow + lane;
    f32x4 v[8]; float s = 0.f;
#pragma unroll
    for (int j = 0; j < 8; ++j) { v[j] = xr[64 * j]; s += (v[j].x * v[j].x + v[j].y * v[j].y) + (v[j].z * v[j].z + v[j].w * v[j].w); }
    const float rstd = 1.0f / sqrtf(wave_sum(s) * (1.0f / D) + EPS);
    const f32x4* gr = (const f32x4*)g + lane;
    u32x2* o8 = (u32x2*)orow + lane;
#pragma unroll
    for (int j = 0; j < 8; ++j) { const f32x4 gv = gr[64 * j]; u32x2 o; o.x = pk2(v[j].x * rstd * gv.x, v[j].y * rstd * gv.y); o.y = pk2(v[j].z * rstd * gv.z, v[j].w * rstd * gv.w); o8[64 * j] = o; }
}
__device__ __forceinline__ void cvt_stream(const float* src, bf16_t* dst, size_t n8, size_t gtid, size_t nthr) {
    for (size_t i = gtid; i < n8; i += nthr) { const f32x4 a = ((const f32x4*)src)[2 * i], b = ((const f32x4*)src)[2 * i + 1];
        u32x4 o; o.x = pk2(a.x, a.y); o.y = pk2(a.z, a.w); o.z = pk2(b.x, b.y); o.w = pk2(b.z, b.w); ((u32x4*)dst)[i] = o; }
}

__device__ __forceinline__ void expert_row_load(const float* src, f32x4 (&v)[8], int lane) {
    const f32x4* xr = (const f32x4*)src + lane;
#pragma unroll
    for (int k = 0; k < 8; ++k) v[k] = xr[64 * k];
}
__device__ __forceinline__ void expert_row_gain(f32x4 (&v)[8], const float* g, int lane) {
    const f32x4* gr = (const f32x4*)g + lane;
#pragma unroll
    for (int k = 0; k < 8; ++k) v[k] = v[k] * gr[64 * k];
}
__device__ __forceinline__ void expert_row_store(const f32x4 (&v)[8], unsigned char* dst, float* isc, int lane) {
    float am = 0.f;
#pragma unroll
    for (int k = 0; k < 8; ++k) am = fmaxf(am, fmaxf(fmaxf(fabsf(v[k].x), fabsf(v[k].y)), fmaxf(fabsf(v[k].z), fabsf(v[k].w))));
#pragma unroll
    for (int o = 1; o < 64; o <<= 1) am = fmaxf(am, __shfl_xor(am, o));
    float sc = 1.0f;
    if (am > 0.f) { const float q = fminf(fmaxf(448.0f / am, 1.0e-30f), 1.0e30f); sc = __builtin_bit_cast(float, __builtin_bit_cast(unsigned, q) & 0x7f800000u); }
    unsigned o[8];
#pragma unroll
    for (int k = 0; k < 8; ++k) { int w = __builtin_amdgcn_cvt_pk_fp8_f32(v[k].x * sc, v[k].y * sc, 0, false); w = __builtin_amdgcn_cvt_pk_fp8_f32(v[k].z * sc, v[k].w * sc, w, true); o[k] = (unsigned)w; }
    u32x4 o0, o1; o0.x = o[0]; o0.y = o[1]; o0.z = o[2]; o0.w = o[3]; o1.x = o[4]; o1.y = o[5]; o1.z = o[6]; o1.w = o[7];
    *(u32x4*)(dst + lane * 16) = o0; *(u32x4*)(dst + 1024 + lane * 16) = o1;
    if (lane == 0) *isc = 1.0f / sc;
}

__device__ __forceinline__ void p0_score_weights(const Args& a, int item, int lane) {
    const float* wq = a.in[13]; const float* g2 = a.in[12]; const float* keys = a.in[14]; bf16_t* M = (bf16_t*)(a.ws + WS_WQ);
    const int b = item >> 7, kt = item & 127, fr = lane & 15, fq = lane >> 4;
    const int k = kt * 16 + fr; const float gk = g2[k];
    bf16x8 wf[4];
#pragma unroll
    for (int ks = 0; ks < 4; ++ks) { const float* p = wq + (size_t)k * D + b * 128 + ks * 32 + fq * 8; const f32x4 x0 = *(const f32x4*)p, x1 = *(const f32x4*)(p + 4);
        u32x4 w; w.x = pk2(gk * x0.x, gk * x0.y); w.y = pk2(gk * x0.z, gk * x0.w); w.z = pk2(gk * x1.x, gk * x1.y); w.w = pk2(gk * x1.z, gk * x1.w); wf[ks] = __builtin_bit_cast(bf16x8, w); }
#pragma unroll 2
    for (int nb = 0; nb < 8; ++nb) {
        f32x4 acc = {0.f, 0.f, 0.f, 0.f};
#pragma unroll
        for (int ks = 0; ks < 4; ++ks) { const float* p = keys + (size_t)(b * 128 + nb * 16 + fr) * 128 + ks * 32 + fq * 8; const f32x4 x0 = *(const f32x4*)p, x1 = *(const f32x4*)(p + 4);
            u32x4 w; w.x = pk2(x0.x, x0.y); w.y = pk2(x0.z, x0.w); w.z = pk2(x1.x, x1.y); w.w = pk2(x1.z, x1.w);
            acc = __builtin_amdgcn_mfma_f32_16x16x32_bf16(wf[ks], __builtin_bit_cast(bf16x8, w), acc, 0, 0, 0); }
        u32x2 o; o.x = pk2(acc[0], acc[1]); o.y = pk2(acc[2], acc[3]);
        *(u32x2*)(M + (size_t)(b * 128 + nb * 16 + fr) * D + kt * 16 + fq * 4) = o;
    }
}

__device__ __forceinline__ void p0_prologue(const Args& a, LAS unsigned char* lds, int vcu, int G, int wave, int lane, int tid) {
    unsigned char* ws = a.ws;
    LAS float* scr = (LAS float*)(lds + wave * 16384);
    const int gw = vcu * NWAVES + wave, NGW = G * NWAVES;
    constexpr int I_IN = (D / 64) * (INW / 32), I_POOL1 = (256 / 64) * (512 / 32), I_G = (GWD / 64) * (D / 32), I_O = (D / 64) * (D / 32);
    constexpr int NITEMS = I_IN + 4 * I_POOL1 + I_G + I_O;
    for (int it = gw; it < NITEMS; it += NGW) {
        int r = it;
        if (r < I_IN) { p0_transpose_item(a.in[2], D, INW, (bf16_t*)(ws + WS_WIN), scr, r, lane); continue; } r -= I_IN;
        if (r < 4 * I_POOL1) { const int g = r / I_POOL1; p0_transpose_item(a.in[5] + (size_t)g * 256 * 512, 256, 512, (bf16_t*)(ws + WS_WPOOL) + (size_t)g * 512 * 256, scr, r % I_POOL1, lane); continue; } r -= 4 * I_POOL1;
        if (r < I_G) { p0_transpose_item(a.in[10], GWD, D, (bf16_t*)(ws + WS_WG), scr, r, lane); continue; } r -= I_G;
        p0_transpose_item(a.in[11], D, D, (bf16_t*)(ws + WS_WOUT), scr, r, lane);
    }
    for (int it = gw; it < 16 * (D / 16); it += NGW) p0_score_weights(a, it, lane);
    for (int m = gw; m < S; m += NGW) rms_row_to_bf16(a.in[0] + (size_t)m * D, a.in[1], (bf16_t*)(ws + WS_H) + (size_t)m * D, lane);
    const size_t gtid = (size_t)vcu * NTHR + tid, nthr = (size_t)G * NTHR;
    {
        const float* src = a.in[8]; bf16_t* dst = (bf16_t*)(ws + WS_WSM);
        for (size_t i = gtid; i < (size_t)8 * 128 * 128 / 8; i += nthr) { const int s0 = (int)(i & 15) * 8, t = (int)(i >> 4) & 127;
            const f32x4 x0 = ((const f32x4*)src)[2 * i], x1 = ((const f32x4*)src)[2 * i + 1];
            float v[8] = {x0.x, x0.y, x0.z, x0.w, x1.x, x1.y, x1.z, x1.w};
#pragma unroll
            for (int j = 0; j < 8; ++j) v[j] = (s0 + j <= t) ? v[j] : 0.f;
            u32x4 o; o.x = pk2(v[0], v[1]); o.y = pk2(v[2], v[3]); o.z = pk2(v[4], v[5]); o.w = pk2(v[6], v[7]); ((u32x4*)dst)[i] = o; }
    }
}

__device__ __forceinline__ void p2_pool(const Args& a, int vcu, int G, int tid) {
    const bf16_t* Z = (const bf16_t*)(a.ws + WS_Z); bf16_t* A2 = (bf16_t*)(a.ws + WS_A2); const float* psc = a.in[4];
    const size_t gtid = (size_t)vcu * NTHR + tid, nthr = (size_t)G * NTHR;
    for (size_t id = gtid; id < (size_t)(S / 8) * 128; id += nthr) {
        const int c8 = (int)(id & 127), t0 = (int)(id >> 7) * 8, g = c8 >> 5, w = 2 << g;
        u32x4 row[23];
#pragma unroll
        for (int r = 0; r < 23; ++r) { const int t = t0 - 15 + r; const bool need = (r >= 16 - w) && (t >= 0);
            row[r] = need ? *(const u32x4*)(Z + (size_t)t * INW + c8 * 8) : (u32x4){0u, 0u, 0u, 0u}; }
        const f32x4 p0 = *(const f32x4*)(psc + c8 * 8), p1 = *(const f32x4*)(psc + c8 * 8 + 4);
        const float ps[8] = {p0.x, p0.y, p0.z, p0.w, p1.x, p1.y, p1.z, p1.w};
        float s[8] = {0.f, 0.f, 0.f, 0.f, 0.f, 0.f, 0.f, 0.f};
#pragma unroll
        for (int r = 0; r < 15; ++r) { const u32x4 q = row[r];
            s[0] += bflo(q.x); s[1] += bfhi(q.x); s[2] += bflo(q.y); s[3] += bfhi(q.y); s[4] += bflo(q.z); s[5] += bfhi(q.z); s[6] += bflo(q.w); s[7] += bfhi(q.w); }
#pragma unroll
        for (int i = 0; i < 8; ++i) {
            const u32x4 q = row[15 + i];
            const float at[8] = {bflo(q.x), bfhi(q.x), bflo(q.y), bfhi(q.y), bflo(q.z), bfhi(q.z), bflo(q.w), bfhi(q.w)};
#pragma unroll
            for (int c = 0; c < 8; ++c) s[c] += at[c];
            const int t = t0 + i; const int cnt = (t + 1) < w ? (t + 1) : w; const float inv = 1.0f / (float)cnt;
            float o[8];
#pragma unroll
            for (int c = 0; c < 8; ++c) o[c] = (s[c] * inv - at[c]) * ps[c];
            u32x4 w4; w4.x = pk2(o[0], o[1]); w4.y = pk2(o[2], o[3]); w4.z = pk2(o[4], o[5]); w4.w = pk2(o[6], o[7]);
            *(u32x4*)(A2 + (size_t)t * D + c8 * 8) = w4;
            const u32x4 d2 = row[15 + i - 1], d4 = row[15 + i - 3], d8 = row[15 + i - 7], d16 = row[15 + i - 15];
            const u32x4 dq = g == 0 ? d2 : (g == 1 ? d4 : (g == 2 ? d8 : d16));
            s[0] -= bflo(dq.x); s[1] -= bfhi(dq.x); s[2] -= bflo(dq.y); s[3] -= bfhi(dq.y); s[4] -= bflo(dq.z); s[5] -= bfhi(dq.z); s[6] -= bflo(dq.w); s[7] -= bfhi(dq.w);
        }
    }
}
constexpr int VT_LD = 136;
__device__ __forceinline__ void p2_sgu(const Args& a, LAS unsigned char* lds, int item0, int item1, int istep, int wave, int lane, int tid) {
    const bf16_t* Z = (const bf16_t*)(a.ws + WS_Z); bf16_t* A2 = (bf16_t*)(a.ws + WS_A2); const bf16_t* WSM = (const bf16_t*)(a.ws + WS_WSM);
    const float* lng = a.in[6]; const float* lnb = a.in[7]; const float* bs = a.in[9];
    LAS float* st = (LAS float*)lds; LAS bf16_t* Vt = (LAS bf16_t*)(lds + 1024);
    const int fr = lane & 15, fq = lane >> 4;
    int prev_c = -1;
    for (int item = item0; item < item1; item += istep) {
        const int c = item >> 3, h = item & 7, t0 = c * 128; const bool need_stats = (c != prev_c); prev_c = c;
        u32x4 raw[4][8];
        if (need_stats) {
#pragma unroll
        for (int p = 0; p < 4; ++p) { const bf16_t* rp = Z + (size_t)(t0 + wave * 16 + p * 4 + fq) * INW + 2048 + fr * 8;
#pragma unroll
            for (int j = 0; j < 8; ++j) raw[p][j] = *(const u32x4*)(rp + j * 128); } }
        u32x4 rawB[4];
#pragma unroll
        for (int q = 0; q < 4; ++q) { const int id = tid + q * NTHR, sr = id & 127, dc = id >> 7; rawB[q] = *(const u32x4*)(Z + (size_t)(t0 + sr) * INW + 2048 + h * 128 + dc * 8); }
        bf16x8 bW[4];
#pragma unroll
        for (int ks = 0; ks < 4; ++ks) bW[ks] = *(const bf16x8*)(WSM + (size_t)(h * 128 + wave * 16 + fr) * 128 + ks * 32 + fq * 8);
        u32x2 ur[8];
#pragma unroll
        for (int db = 0; db < 8; ++db) ur[db] = *(const u32x2*)(Z + (size_t)(t0 + wave * 16 + fr) * INW + 1024 + h * 128 + db * 16 + fq * 4);
        const float bias = bs[h * 128 + wave * 16 + fr];
        if (need_stats) {
#pragma unroll
        for (int p = 0; p < 4; ++p) { float s = 0.f, q = 0.f;
#pragma unroll
            for (int j = 0; j < 8; ++j)
#pragma unroll
                for (int w = 0; w < 4; ++w) { const float a0 = bflo(raw[p][j][w]), a1 = bfhi(raw[p][j][w]); s += a0 + a1; q += a0 * a0 + a1 * a1; }
            s = row_sum_f32(s); q = row_sum_f32(q);
            if (fr == 0) { const float mean = s * (1.0f / 1024.0f); const float var = fmaxf(q * (1.0f / 1024.0f) - mean * mean, 0.f);
                const int sr = wave * 16 + p * 4 + fq; st[2 * sr] = mean; st[2 * sr + 1] = 1.0f / sqrtf(var + EPS); } }
        __syncthreads();
        }
#pragma unroll
        for (int q = 0; q < 4; ++q) { const int id = tid + q * NTHR, sr = id & 127, dc = id >> 7;
            const u32x4 rw = rawB[q];
            const float mean = st[2 * sr], rstd = st[2 * sr + 1];
            const float v[8] = {bflo(rw.x), bfhi(rw.x), bflo(rw.y), bfhi(rw.y), bflo(rw.z), bfhi(rw.z), bflo(rw.w), bfhi(rw.w)};
            const f32x4 g0 = *(const f32x4*)(lng + h * 128 + dc * 8), g1 = *(const f32x4*)(lng + h * 128 + dc * 8 + 4), b0 = *(const f32x4*)(lnb + h * 128 + dc * 8), b1 = *(const f32x4*)(lnb + h * 128 + dc * 8 + 4);
            const float gg[8] = {g0.x, g0.y, g0.z, g0.w, g1.x, g1.y, g1.z, g1.w}, bb[8] = {b0.x, b0.y, b0.z, b0.w, b1.x, b1.y, b1.z, b1.w};
#pragma unroll
            for (int i = 0; i < 8; ++i) { const int d = dc * 8 + i; const float y = (v[i] - mean) * rstd * gg[i] + bb[i]; Vt[d * VT_LD + sr] = (bf16_t)f2bf(y); } }
        __syncthreads();
        f32x4 acc[8];
#pragma unroll
        for (int db = 0; db < 8; ++db) acc[db] = (f32x4){0.f, 0.f, 0.f, 0.f};
        const int nks = (wave * 16 + 15) / 32 + 1;
#pragma unroll
        for (int ks = 0; ks < 4; ++ks) if (ks < nks) {
#pragma unroll
            for (int db = 0; db < 8; ++db) { const bf16x8 aV = *(const LAS bf16x8*)(Vt + (db * 16 + fr) * VT_LD + ks * 32 + fq * 8);
                acc[db] = __builtin_amdgcn_mfma_f32_16x16x32_bf16(aV, bW[ks], acc[db], 0, 0, 0); }
        }
        { const int t = t0 + wave * 16 + fr;
#pragma unroll
          for (int db = 0; db < 8; ++db) { const int col = h * 128 + db * 16 + fq * 4;
              u32x2 o; o.x = pk2(bflo(ur[db].x) * (acc[db][0] + bias), bfhi(ur[db].x) * (acc[db][1] + bias)); o.y = pk2(bflo(ur[db].y) * (acc[db][2] + bias), bfhi(ur[db].y) * (acc[db][3] + bias));
              *(u32x2*)(A2 + (size_t)t * D + 1024 + col) = o; } }
        __syncthreads();
    }
}

__device__ __forceinline__ unsigned f2key(float f) { const unsigned b = __builtin_bit_cast(unsigned, f); return (b & 0x80000000u) ? ~b : (b | 0x80000000u); }
__device__ __forceinline__ float key2f(unsigned k) { const unsigned b = (k & 0x80000000u) ? (k ^ 0x80000000u) : ~k; return __builtin_bit_cast(float, b); }
template <int CTRL> __device__ __forceinline__ unsigned dpp_max_u32(unsigned v) { const unsigned o = (unsigned)__builtin_amdgcn_update_dpp(0, (int)v, CTRL, 0xF, 0xF, true); return v > o ? v : o; }
__device__ __forceinline__ unsigned row_max_u32(unsigned v) { v = dpp_max_u32<0xB1>(v); v = dpp_max_u32<0x4E>(v); v = dpp_max_u32<0x141>(v); v = dpp_max_u32<0x140>(v); return v; }
__device__ __forceinline__ void ce_desc(unsigned& a, unsigned& b) { const unsigned hi = a > b ? a : b, lo = a > b ? b : a; a = hi; b = lo; }
__device__ __forceinline__ void sort8_desc(unsigned (&k)[8]) {
    ce_desc(k[0], k[1]); ce_desc(k[2], k[3]); ce_desc(k[4], k[5]); ce_desc(k[6], k[7]);
    ce_desc(k[0], k[2]); ce_desc(k[1], k[3]); ce_desc(k[4], k[6]); ce_desc(k[5], k[7]);
    ce_desc(k[1], k[2]); ce_desc(k[5], k[6]);
    ce_desc(k[0], k[4]); ce_desc(k[1], k[5]); ce_desc(k[2], k[6]); ce_desc(k[3], k[7]);
    ce_desc(k[2], k[4]); ce_desc(k[3], k[5]);
    ce_desc(k[1], k[2]); ce_desc(k[3], k[4]); ce_desc(k[5], k[6]);
}
__device__ __forceinline__ void sort4_desc(unsigned (&k)[4]) { ce_desc(k[0], k[1]); ce_desc(k[2], k[3]); ce_desc(k[0], k[2]); ce_desc(k[1], k[3]); ce_desc(k[1], k[2]); }
template <int NV> __device__ __forceinline__ unsigned row_top16_sorted(unsigned (&k)[NV], int fr) {
    unsigned tk = 0u;
    for (int it = 0; it < 16; ++it) {
        const unsigned m = row_max_u32(k[0]);
        const unsigned wm = (k[0] == m) ? 0xffffffffu : 0u;
#pragma unroll
        for (int i = 0; i + 1 < NV; ++i) k[i] = (k[i + 1] & wm) | (k[i] & ~wm);
        k[NV - 1] = k[NV - 1] & ~wm;
        tk = (fr == it) ? m : tk;
    }
    return tk;
}
__device__ __forceinline__ unsigned cand_table(int fr) {
    constexpr unsigned T[16] = {0x03020100u, 0x07060504u, 0x0b0a0908u, 0x0f0e0d0cu, 0x13121110u, 0x17161514u, 0x23222120u, 0x32313024u, 0x42414033u, 0x61605150u, 0x90807170u, 0xd0c0b0a0u, 0xfffff0e0u, 0xffffffffu, 0xffffffffu, 0xffffffffu};
    unsigned w = T[0];
#pragma unroll
    for (int i = 1; i < 16; ++i) w = (fr == i) ? T[i] : w;
    return w;
}
constexpr int SC_LD = 132;
__device__ __forceinline__ void p7_topk(const Args& a, LAS unsigned char* lds, int vcu, int G, int wave, int lane_) {
    int lane = lane_; asm volatile("" : "+v"(lane));
    const bf16_t* Q = (const bf16_t*)(a.ws + WS_Q);
    int* IDX = (int*)(a.ws + WS_IDX); float* GATE = (float*)(a.ws + WS_GATE);
    LAS float* SL = (LAS float*)(lds + wave * (16 * SC_LD * 4));
    const int gw = vcu * NWAVES + wave, NGW = G * NWAVES; const int fr = lane & 15, fq = lane >> 4;
    const unsigned ctab = cand_table(fr);
    int erow = gw;
    f32x4 er0[8], er1[8]; int e0 = 2 * NEXP, e1 = 2 * NEXP;
#define ER_LOAD() do { e0 = erow; e1 = erow + NGW; erow += 2 * NGW; \
        if (e0 < 2 * NEXP) expert_row_load(a.in[15 + (e0 >= NEXP)] + (size_t)(e0 & (NEXP - 1)) * D, er0, lane); \
        if (e1 < 2 * NEXP) expert_row_load(a.in[15 + (e1 >= NEXP)] + (size_t)(e1 & (NEXP - 1)) * D, er1, lane); } while (0)
#define ER_STORE() do { \
        if (e0 < NEXP) expert_row_gain(er0, a.in[12], lane); if (e1 < NEXP) expert_row_gain(er1, a.in[12], lane); \
        if (e0 < 2 * NEXP) expert_row_store(er0, a.ws + ((e0 >= NEXP) ? WS_EV : WS_EU) + (size_t)(e0 & (NEXP - 1)) * D, (float*)(a.ws + WS_ESC) + e0, lane); \
        if (e1 < 2 * NEXP) expert_row_store(er1, a.ws + ((e1 >= NEXP) ? WS_EV : WS_EU) + (size_t)(e1 & (NEXP - 1)) * D, (float*)(a.ws + WS_ESC) + e1, lane); } while (0)
    pg8::StaticOrder so7; so7.init(S, D, G, (int)blockIdx.x); pg8::Unit u7;
    for (int ui = 0; so7.next(ui >> 1, u7); ++ui) {
        const int h = u7.pn, t0 = u7.pm * 256 + ((ui & 1) * 8 + wave) * 16;
        unsigned tk[8];
#pragma unroll
        for (int i = 0; i < 8; ++i) tk[i] = 0u;
#pragma unroll 1
        for (int p = 0; p < 2; ++p) {
            {
                u32x4 sc[4];
#pragma unroll
                for (int i = 0; i < 4; ++i) sc[i] = *(const u32x4*)(Q + (size_t)(t0 + i * 4 + fq) * D + h * 256 + p * 128 + fr * 8);
#pragma unroll
                for (int i = 0; i < 4; ++i) { LAS float* d = SL + (i * 4 + fq) * SC_LD + fr * 8;
                    *(LAS f32x4*)d = (f32x4){bflo(sc[i].x), bfhi(sc[i].x), bflo(sc[i].y), bfhi(sc[i].y)}; *(LAS f32x4*)(d + 4) = (f32x4){bflo(sc[i].z), bfhi(sc[i].z), bflo(sc[i].w), bfhi(sc[i].w)}; }
                asm volatile("" ::: "memory");
            }
            ER_LOAD();
#pragma unroll 1
            for (int j = 0; j < 4; ++j) {
                unsigned k[8];
#pragma unroll
                for (int nb = 0; nb < 8; ++nb) k[nb] = (f2key(SL[(fq * 4 + j) * SC_LD + nb * 16 + fr]) & ~127u) | (127u - (unsigned)(nb * 16 + fr));
                sort8_desc(k);
                const unsigned r = row_top16_sorted<8>(k, fr);
#pragma unroll
                for (int i = 0; i < 8; ++i) tk[i] = (i == p * 4 + j) ? r : tk[i];
            }
            ER_STORE();
        }
#pragma unroll 1
        for (int j = 0; j < 4; ++j) {
            if ((j & 1) == 0) ER_LOAD();
            const unsigned tk1 = j == 0 ? tk[0] : (j == 1 ? tk[1] : (j == 2 ? tk[2] : tk[3])), tk2 = j == 0 ? tk[4] : (j == 1 ? tk[5] : (j == 2 ? tk[6] : tk[7]));
            const float t1 = key2f(tk1 & ~127u), t2 = key2f(tk2 & ~127u); const int i1 = 127 - (int)(tk1 & 127u), i2 = 127 - (int)(tk2 & 127u);
            unsigned kc[4];
#pragma unroll
            for (int e = 0; e < 4; ++e) { const unsigned ab = (ctab >> (8 * e)) & 255u; const int ca = (int)(ab >> 4), cb = (int)(ab & 15u);
                const float c = __shfl(t1, (lane & 48) + ca) + __shfl(t2, (lane & 48) + cb);
                kc[e] = (ab == 255u) ? 0u : ((f2key(c) & ~255u) | (255u - ab)); }
            sort4_desc(kc);
            const unsigned tkc = row_top16_sorted<4>(kc, fr);
            const float ts = key2f(tkc & ~255u); const int ci = 255 - (int)(tkc & 255u);
            const int ia = __shfl(i1, (lane & 48) + (ci >> 4)), ib = __shfl(i2, (lane & 48) + (ci & 15));
            const float tmax = __shfl(ts, lane & 48);
            const float e = __expf(ts - tmax); float sum = e;
            sum += __shfl_xor(sum, 1); sum += __shfl_xor(sum, 2); sum += __shfl_xor(sum, 4); sum += __shfl_xor(sum, 8);
            const int t = t0 + fq * 4 + j;
            IDX[(size_t)t * 128 + h * 16 + fr] = ia * 128 + ib;
            GATE[(size_t)t * 128 + h * 16 + fr] = e / sum;
            if ((j & 1) == 1) ER_STORE();
        }
    }
    for (; erow < 2 * NEXP; erow += NGW) { expert_row_load(a.in[15 + (erow >= NEXP)] + (size_t)(erow & (NEXP - 1)) * D, er0, lane); if (erow < NEXP) expert_row_gain(er0, a.in[12], lane);
        expert_row_store(er0, a.ws + ((erow >= NEXP) ? WS_EV : WS_EU) + (size_t)(erow & (NEXP - 1)) * D, (float*)(a.ws + WS_ESC) + erow, lane); }
#undef ER_LOAD
#undef ER_STORE
}

typedef float f32x2 __attribute__((ext_vector_type(2)));
__device__ __forceinline__ u32x4 bl128(__amdgpu_buffer_rsrc_t r, unsigned voff, unsigned soff) { return __builtin_amdgcn_raw_buffer_load_b128(r, voff, soff, 0); }
__device__ __forceinline__ u32x2 bl64(__amdgpu_buffer_rsrc_t r, unsigned voff, unsigned soff) { return __builtin_amdgcn_raw_buffer_load_b64(r, voff, soff, 0); }
__device__ __forceinline__ unsigned bl32(__amdgpu_buffer_rsrc_t r, unsigned voff, unsigned soff) { return __builtin_amdgcn_raw_buffer_load_b32(r, voff, soff, 0); }
__device__ __forceinline__ float wave_sum_dpp(float v) {
    v = dpp_add_f32<0xB1>(v); v = dpp_add_f32<0x4E>(v); v = dpp_add_f32<0x141>(v); v = dpp_add_f32<0x140>(v);
    v += __builtin_bit_cast(float, __builtin_amdgcn_update_dpp(0, __builtin_bit_cast(int, v), 0x142, 0xA, 0xF, false));
    v += __builtin_bit_cast(float, __builtin_amdgcn_update_dpp(0, __builtin_bit_cast(int, v), 0x143, 0xC, 0xF, false));
    return __builtin_bit_cast(float, __builtin_amdgcn_readlane(__builtin_bit_cast(int, v), 63));
}
__device__ __forceinline__ float wave_sum_fast(float v) {
    v = dpp_add_f32<0xB1>(v); v = dpp_add_f32<0x4E>(v); v = dpp_add_f32<0x141>(v); v = dpp_add_f32<0x140>(v);
    v += __shfl_xor(v, 16); v += __shfl_xor(v, 32); return v;
}
constexpr int TPW = 4, NSL = 16, SL_SHIFT = 10, RING = 8, SLOT = 2048;
typedef __bf16 bf16x2_t __attribute__((ext_vector_type(2)));
__device__ __forceinline__ float dot2bf(unsigned a, unsigned b, float c) { return __builtin_amdgcn_fdot2_f32_bf16(__builtin_bit_cast(bf16x2_t, a), __builtin_bit_cast(bf16x2_t, b), c, false); }
constexpr int NROWS = TPW * 128;
#define P8_ISSUE(TBASE) do { const unsigned ro_ = (unsigned)__builtin_amdgcn_readlane(lch_, ii_ & 63) * (unsigned)D; \
        const char* src_ = (const char*)a.ws + (TBASE) + ro_ + l16; LAS unsigned char* dstl_ = ring + (ii_ & (RING - 1)) * SLOT; \
        __builtin_amdgcn_global_load_lds((const unsigned*)src_, (LAS unsigned*)dstl_, 16, 0, 0); \
        __builtin_amdgcn_global_load_lds((const unsigned*)(src_ + 1024), (LAS unsigned*)(dstl_ + 1024), 16, 0, 0); \
        ++ii_; if ((ii_ & 63) == 0) lch_ = (int)LST[ii_ + lane]; } while (0)
#define P8_RING_READ(r0, r1) do { r0 = *(const LAS u32x4*)(ring + (ci_ & (RING - 1)) * SLOT + l16); r1 = *(const LAS u32x4*)(ring + (ci_ & (RING - 1)) * SLOT + 1024 + l16); } while (0)
#define P8_STREAM_INIT(TBASE, r0, r1) int ci_ = 0, ii_ = 0; int lch_ = (int)LST[lane]; \
        asm volatile("s_waitcnt vmcnt(0) lgkmcnt(0)" ::: "memory"); \
        _Pragma("unroll 1") for (int q_ = 0; q_ < RING; ++q_) P8_ISSUE(TBASE); \
        asm volatile("s_waitcnt vmcnt(14)" ::: "memory"); P8_RING_READ(r0, r1)
#define P8_ROW_READY() asm volatile("s_waitcnt lgkmcnt(0)" ::: "memory")
#define P8_ROW_ADVANCE(TBASE, r0, r1) do { ++ci_; P8_ISSUE(TBASE); asm volatile("s_waitcnt vmcnt(14)" ::: "memory"); P8_RING_READ(r0, r1); } while (0)
#define P8_STREAM_END() asm volatile("s_waitcnt vmcnt(0) lgkmcnt(0)" ::: "memory")
static_assert(RING == 8, "the counted wait above is vmcnt(2 * (RING - 1))");
__device__ __forceinline__ void p8_peer(const Args& a, LAS unsigned char* lds, float* dst, int vcu, int G, int wave, int lane_) {
    int lane = lane_; asm volatile("" : "+v"(lane));
    const __amdgpu_buffer_rsrc_t rws = __builtin_amdgcn_make_buffer_rsrc((void*)a.ws, (short)0, (int)WS_END, 0x00020000);
    const __amdgpu_buffer_rsrc_t rdst = __builtin_amdgcn_make_buffer_rsrc((void*)dst, (short)0, S * D * 4, 0x00020000);
    const __amdgpu_buffer_rsrc_t rfg = __builtin_amdgcn_make_buffer_rsrc((void*)a.in[17], (short)0, D * 4, 0x00020000);
    LAS unsigned char* ring = lds + wave * (RING * SLOT);
    LAS unsigned* SLW = (LAS unsigned*)(lds + 132096 + wave * 1280);
    LAS unsigned short* LST = (LAS unsigned short*)SLW;
    const int gw = vcu * NWAVES + wave, NGW = G * NWAVES;
    const unsigned l16 = (unsigned)lane * 16u, l8 = (unsigned)lane * 8u, l4 = (unsigned)lane * 4u;
#pragma unroll 1
    for (int tb = gw; tb < S; tb += TPW * NGW) {
        int sid[TPW][2], offv[TPW]; float act[TPW][2]; int cntv = 0;
#pragma unroll
        for (int k = 0; k < TPW; ++k) {
            const int t = (tb + k * NGW) < S ? (tb + k * NGW) : (S - 1);
            const unsigned oi = (unsigned)(WS_IDX + (size_t)t * 512);
            const int id0 = (int)bl32(rws, l4, oi), id1 = (int)bl32(rws, l4 + 256u, oi);
            const int sl0 = id0 >> SL_SHIFT, sl1 = id1 >> SL_SHIFT;
            int pos0 = 0, pos1 = 0, basec = 0, offacc = 0;
#pragma unroll
            for (int s = 0; s < NSL; ++s) {
                const unsigned long long m0 = __ballot(sl0 == s), m1 = __ballot(sl1 == s);
                const int c0 = __popcll(m0), c1 = __popcll(m1);
                const int b0 = (int)__builtin_amdgcn_mbcnt_hi((unsigned)(m0 >> 32), __builtin_amdgcn_mbcnt_lo((unsigned)m0, 0u));
                const int b1 = (int)__builtin_amdgcn_mbcnt_hi((unsigned)(m1 >> 32), __builtin_amdgcn_mbcnt_lo((unsigned)m1, 0u));
                pos0 = (sl0 == s) ? basec + b0 : pos0; pos1 = (sl1 == s) ? basec + c0 + b1 : pos1;
                basec += c0 + c1; offacc = (lane == s + 1) ? basec : offacc; cntv = (lane == s * TPW + k) ? (c0 + c1) : cntv;
            }
            offv[k] = offacc;
            SLW[pos0] = (unsigned)id0; SLW[pos1] = (unsigned)id1; SLW[128 + pos0] = (unsigned)lane; SLW[128 + pos1] = (unsigned)(64 + lane);
            asm volatile("s_waitcnt lgkmcnt(0)" ::: "memory");
            sid[k][0] = (int)SLW[lane]; sid[k][1] = (int)SLW[64 + lane];
            act[k][0] = __builtin_bit_cast(float, SLW[128 + lane]); act[k][1] = __builtin_bit_cast(float, SLW[192 + lane]);
            asm volatile("s_waitcnt lgkmcnt(0)" ::: "memory");
        }
        {
            int incl = cntv;
#pragma unroll
            for (int o = 1; o < 64; o <<= 1) { const int up = __shfl_up(incl, o); incl += (lane >= o) ? up : 0; }
            const int gb = incl - cntv;
            asm volatile("s_waitcnt lgkmcnt(0)" ::: "memory");
#pragma unroll
            for (int k = 0; k < TPW; ++k)
#pragma unroll
                for (int h = 0; h < 2; ++h) { const int sl = sid[k][h] >> SL_SHIFT;
                    const int p = __shfl(gb, sl * TPW + k) + (h * 64 + lane) - __shfl(offv[k], sl);
                    LST[p] = (unsigned short)sid[k][h]; }
            if (lane < RING) LST[NROWS + lane] = (unsigned short)0;
            asm volatile("s_waitcnt lgkmcnt(0)" ::: "memory");
        }
        int orig[TPW][2];
#pragma unroll
        for (int k = 0; k < TPW; ++k) { orig[k][0] = __builtin_bit_cast(int, act[k][0]); orig[k][1] = __builtin_bit_cast(int, act[k][1]); act[k][0] = 0.f; act[k][1] = 0.f; }
        {
            f32x2 hf[TPW][16];
#pragma unroll
            for (int k = 0; k < TPW; ++k) { const int t = (tb + k * NGW) < S ? (tb + k * NGW) : (S - 1);
#pragma unroll
                for (int kk = 0; kk < 8; ++kk) { const u32x2 w = bl64(rws, l8 + (unsigned)(kk * 512), (unsigned)(WS_XB + (size_t)t * (D * 2)));
                    hf[k][kk * 2] = (f32x2){bflo(w.x), bfhi(w.x)}; hf[k][kk * 2 + 1] = (f32x2){bflo(w.y), bfhi(w.y)}; } }
            u32x4 r0, r1;
            P8_STREAM_INIT(WS_EU, r0, r1);
#pragma unroll 1
            for (int s = 0; s < NSL; ++s) {
#pragma unroll
                for (int k = 0; k < TPW; ++k) {
                    const int lo = __builtin_amdgcn_readlane(offv[k], s), hi = __builtin_amdgcn_readlane(offv[k], s + 1);
#pragma unroll 1
                    for (int e = lo; e < hi; ++e) {
                        P8_ROW_READY();
                        f32x2 dd0 = {0.f, 0.f}, dd1 = {0.f, 0.f};
#pragma unroll
                        for (int kk = 0; kk < 4; ++kk) {
                            { const unsigned w = r0[kk]; const f32x2 lo2 = __builtin_amdgcn_cvt_pk_f32_fp8((int)w, false), hi2 = __builtin_amdgcn_cvt_pk_f32_fp8((int)w, true);
                              dd0 = __builtin_elementwise_fma(lo2, hf[k][kk * 2], dd0); dd1 = __builtin_elementwise_fma(hi2, hf[k][kk * 2 + 1], dd1); }
                            { const unsigned w = r1[kk]; const f32x2 lo2 = __builtin_amdgcn_cvt_pk_f32_fp8((int)w, false), hi2 = __builtin_amdgcn_cvt_pk_f32_fp8((int)w, true);
                              dd0 = __builtin_elementwise_fma(lo2, hf[k][8 + kk * 2], dd0); dd1 = __builtin_elementwise_fma(hi2, hf[k][8 + kk * 2 + 1], dd1); } }
                        asm volatile("" : "+v"(dd0), "+v"(dd1));
                        P8_ROW_ADVANCE(WS_EU, r0, r1);
                        const float d = wave_sum_dpp((dd0.x + dd0.y) + (dd1.x + dd1.y));
                        act[k][0] = (lane == e) ? d : act[k][0]; act[k][1] = (lane == e - 64) ? d : act[k][1];
                    }
                }
            }
            P8_STREAM_END();
        }
#pragma unroll
        for (int k = 0; k < TPW; ++k) {
            const int t = (tb + k * NGW) < S ? (tb + k * NGW) : (S - 1);
            const float ssp = lane < 32 ? __builtin_bit_cast(float, bl32(rws, l4, (unsigned)(WS_SS + (size_t)t * 128))) : 0.f;
            const float rstd2 = 1.0f / sqrtf(wave_sum(ssp) * (1.0f / D) + EPS);
            const unsigned og = (unsigned)(WS_GATE + (size_t)t * 512);
#pragma unroll
            for (int h = 0; h < 2; ++h) {
                const float gate = __builtin_bit_cast(float, bl32(rws, (unsigned)orig[k][h] * 4u, og));
                const float su = __builtin_bit_cast(float, bl32(rws, (unsigned)sid[k][h] * 4u, (unsigned)WS_ESC)) * rstd2;
                const float sv = __builtin_bit_cast(float, bl32(rws, (unsigned)sid[k][h] * 4u, (unsigned)(WS_ESC + NEXP * 4)));
                act[k][h] = gelu_tanh(act[k][h] * su) * gate * sv; }
        }
        {
            float acc[TPW][32];
#pragma unroll
            for (int k = 0; k < TPW; ++k)
#pragma unroll
                for (int i = 0; i < 32; ++i) acc[k][i] = 0.f;
            u32x4 r0, r1;
            P8_STREAM_INIT(WS_EV, r0, r1);
#pragma unroll 1
            for (int s = 0; s < NSL; ++s) {
#pragma unroll
                for (int k = 0; k < TPW; ++k) {
                    const int lo = __builtin_amdgcn_readlane(offv[k], s), hi = __builtin_amdgcn_readlane(offv[k], s + 1);
#pragma unroll 1
                    for (int e = lo; e < hi; ++e) {
                        const int a0_ = __builtin_amdgcn_readlane(__builtin_bit_cast(int, act[k][0]), e & 63), a1_ = __builtin_amdgcn_readlane(__builtin_bit_cast(int, act[k][1]), e & 63);
                        const float aw = __builtin_bit_cast(float, e < 64 ? a0_ : a1_);
                        P8_ROW_READY();
#pragma unroll
                        for (int kk = 0; kk < 4; ++kk) {
                            { const unsigned w = r0[kk]; const int bb = kk * 4; const f32x2 lo2 = __builtin_amdgcn_cvt_pk_f32_fp8((int)w, false), hi2 = __builtin_amdgcn_cvt_pk_f32_fp8((int)w, true);
                              acc[k][bb + 0] += aw * lo2.x; acc[k][bb + 1] += aw * lo2.y; acc[k][bb + 2] += aw * hi2.x; acc[k][bb + 3] += aw * hi2.y; }
                            { const unsigned w = r1[kk]; const int bb = 16 + kk * 4; const f32x2 lo2 = __builtin_amdgcn_cvt_pk_f32_fp8((int)w, false), hi2 = __builtin_amdgcn_cvt_pk_f32_fp8((int)w, true);
                              acc[k][bb + 0] += aw * lo2.x; acc[k][bb + 1] += aw * lo2.y; acc[k][bb + 2] += aw * hi2.x; acc[k][bb + 3] += aw * hi2.y; } }
                        asm volatile("" : "+v"(acc[k][0]), "+v"(acc[k][16]));
                        P8_ROW_ADVANCE(WS_EV, r0, r1);
                    }
                }
            }
            P8_STREAM_END();
#pragma unroll
            for (int k = 0; k < TPW; ++k) { const int t = tb + k * NGW;
                if (t < S) {
                    float ss = 0.f; const unsigned ot = (unsigned)t * (unsigned)(D * 4);
#pragma unroll
                    for (int kk = 0; kk < 8; ++kk) { const u32x2 xw = bl64(rws, l8 + (unsigned)(kk * 512), (unsigned)(WS_XB + (size_t)t * (D * 2)));
                        acc[k][kk * 4 + 0] += bflo(xw.x); acc[k][kk * 4 + 1] += bfhi(xw.x); acc[k][kk * 4 + 2] += bflo(xw.y); acc[k][kk * 4 + 3] += bfhi(xw.y);
                        ss += (acc[k][kk * 4 + 0] * acc[k][kk * 4 + 0] + acc[k][kk * 4 + 1] * acc[k][kk * 4 + 1]) + (acc[k][kk * 4 + 2] * acc[k][kk * 4 + 2] + acc[k][kk * 4 + 3] * acc[k][kk * 4 + 3]); }
                    const float rstd = 1.0f / sqrtf(wave_sum(ss) * (1.0f / D) + EPS);
#pragma unroll
                    for (int kk = 0; kk < 8; ++kk) { const f32x4 f0 = __builtin_bit_cast(f32x4, bl128(rfg, l16 + (unsigned)((kk & 3) * 1024), (unsigned)((kk >> 2) * 4096)));
                        f32x4 o0; o0.x = acc[k][kk * 4 + 0] * rstd * f0.x; o0.y = acc[k][kk * 4 + 1] * rstd * f0.y; o0.z = acc[k][kk * 4 + 2] * rstd * f0.z; o0.w = acc[k][kk * 4 + 3] * rstd * f0.w;
                        __builtin_amdgcn_raw_buffer_store_b128(__builtin_bit_cast(u32x4, o0), rdst, l16 + (unsigned)((kk & 3) * 1024), ot + (unsigned)((kk >> 2) * 4096), 0); }
                }
            }
        }
    }
}

#define XB_TMO      128
#define XB_XCNT(j)  (256  + 64 * (j))
#define XB_XSUB(j)  (1280 + 64 * (j))
#define XB_XGEN(j)  (2304 + 64 * (j))
#define XB_TOP      3328
#define XB_TOPGEN   3392
#define XCD_BAR_WORDS 3456
#define XB_SPIN_CAP (1u << 22)
__device__ __forceinline__ unsigned xb_ld(unsigned* p)              { return __hip_atomic_load(p, __ATOMIC_RELAXED, __HIP_MEMORY_SCOPE_AGENT); }
__device__ __forceinline__ unsigned xb_add(unsigned* p, unsigned v) { return __hip_atomic_fetch_add(p, v, __ATOMIC_RELAXED, __HIP_MEMORY_SCOPE_AGENT); }
__device__ __forceinline__ unsigned xb_xcc_id() { return (unsigned)__builtin_amdgcn_s_getreg((3 << 11) | 20) & 0xFu; }
#define XB_SPIN(cond, bar) do { unsigned _sp = 0; while (cond) { __builtin_amdgcn_s_sleep(1); \
    if ((++_sp & 255u) == 0u) { if (xb_ld(&(bar)[XB_TMO])) break; if (_sp > XB_SPIN_CAP) { atomicAdd(&(bar)[XB_TMO], 1u); break; } } } } while (0)
struct XcdBarrier { unsigned* bar; unsigned x; volatile LAS unsigned* st; };
__device__ __forceinline__ XcdBarrier xcd_barrier_post(unsigned* bar, volatile LAS unsigned* st) {
    XcdBarrier b; b.bar = bar; b.x = xb_xcc_id(); b.st = st;
    if (threadIdx.x == 0) (void)xb_add(&bar[XB_XCNT(b.x)], 1u);
    return b;
}
__device__ __forceinline__ void xcd_barrier_complete(unsigned* bar, unsigned x, unsigned G, unsigned& nloc, unsigned& nx) {
    unsigned sum, cnt, mine, sp = 0u;
    for (;;) {
        sum = 0u; cnt = 0u; mine = 0u;
#pragma unroll
        for (unsigned j = 0; j < 16; ++j) { const unsigned c = xb_ld(&bar[XB_XCNT(j)]); sum += c; cnt += (c > 0u) ? 1u : 0u; mine = (j == x) ? c : mine; }
        if (sum == G) break;
        __builtin_amdgcn_s_sleep(1);
        if ((++sp & 255u) == 0u) { if (xb_ld(&bar[XB_TMO])) break; if (sp > XB_SPIN_CAP) { atomicAdd(&bar[XB_TMO], 1u); break; } }
    }
    nloc = mine > 0u ? mine : 1u; nx = cnt > 0u ? cnt : 1u;
}
__device__ __forceinline__ void xcd_barrier(const XcdBarrier& b, unsigned G) {
    asm volatile("s_waitcnt vmcnt(0)" ::: "memory");
    __syncthreads();
    if (threadIdx.x == 0) {
        unsigned* bar = b.bar;
        __builtin_amdgcn_s_waitcnt(0);
        unsigned nloc = b.st[0], nx = b.st[1];
        if (nloc == 0u) { xcd_barrier_complete(bar, b.x, G, nloc, nx); b.st[0] = nloc; b.st[1] = nx; }
        const unsigned old = xb_add(&bar[XB_XSUB(b.x)], 1u);
        const unsigned gen = old / nloc;
        if (old + 1u == (gen + 1u) * nloc) {
            __builtin_amdgcn_fence(__ATOMIC_RELEASE, "agent");
            asm volatile("s_waitcnt vmcnt(0)" ::: "memory");
            const unsigned og = xb_add(&bar[XB_TOP], 1u);
            const unsigned tg = og / nx;
            if (og + 1u == (tg + 1u) * nx) xb_add(&bar[XB_TOPGEN], 1u);
            else XB_SPIN(xb_ld(&bar[XB_TOPGEN]) == tg, bar);
            __builtin_amdgcn_fence(__ATOMIC_ACQUIRE, "agent");
            xb_add(&bar[XB_XGEN(b.x)], 1u);
            asm volatile("s_waitcnt vmcnt(0)" ::: "memory");
        } else {
            XB_SPIN(xb_ld(&bar[XB_XGEN(b.x)]) == gen, bar);
            __builtin_amdgcn_fence(__ATOMIC_ACQUIRE, "agent");
            asm volatile("s_waitcnt vmcnt(0)" ::: "memory");
        }
    }
    __syncthreads();
}

constexpr int N_PHASES = 9;
#ifndef DUP_MASK
#define DUP_MASK 0
#endif
#define REP(k) for (int rep_ = 0; rep_ < 1 + ((DUP_MASK >> (k)) & 1); ++rep_)
__global__ void __launch_bounds__(NTHR, 2) fwd(Args args) {
    extern __shared__ __attribute__((aligned(16))) unsigned char lds_raw[];
    LAS unsigned char* lds = (LAS unsigned char*)lds_raw;
    const int tid = threadIdx.x, lane = tid & 63, wave = __builtin_amdgcn_readfirstlane(tid >> 6);
    const int G = gridDim.x; const int bx = blockIdx.x; const int vcu = (G % 8 == 0) ? (bx % 8) * (G / 8) + bx / 8 : bx;
    unsigned char* ws = args.ws;
    const int lo = args.ph_lo, hi = args.ph_hi;
#define IN(k) (lo <= (k) && (k) < hi)
    volatile LAS unsigned* MISC = (volatile LAS unsigned*)(lds + MISC_OFF);
    if (tid < 32) MISC[tid] = 0u;
    __syncthreads();
#if USE_CG_SYNC
    if (IN(0) && bx * NTHR + tid < XCD_BAR_WORDS) __hip_atomic_store((unsigned*)(ws + WS_CTL) + bx * NTHR + tid, 0u, __ATOMIC_RELAXED, __HIP_MEMORY_SCOPE_AGENT);
    XcdBarrier bar; bar.bar = (unsigned*)(ws + WS_CTL); bar.x = 0; bar.st = MISC + 8;
#else
    XcdBarrier bar = xcd_barrier_post((unsigned*)(ws + WS_CTL), MISC + 8);
#endif
#if USE_CG_SYNC
#define SEAM(k) do { if (IN(k) && IN((k) + ((k) == 4 ? 2 : 1))) { if ((k) == 0) { cg::this_grid().sync(); bar = xcd_barrier_post((unsigned*)(ws + WS_CTL), MISC + 8); } else xcd_barrier(bar, (unsigned)G); } } while (0)
#else
#define SEAM(k) do { if (IN(k) && IN((k) + ((k) == 4 ? 2 : 1))) { xcd_barrier(bar, (unsigned)G); } } while (0)
#endif

    if (IN(0)) REP(0) { p0_prologue(args, lds, vcu, G, wave, lane, tid); }
    SEAM(0);
    constexpr int P1_TILES = 24;
    if (IN(1)) REP(1) {
        pg8::Gemm g{(const bf16_t*)(ws + WS_H), (const bf16_t*)(ws + WS_WIN), S, P1_TILES * 256, D, D, D, 0}; pg8::StaticOrder so; so.init(S, P1_TILES * 256, G, bx);
        pg8::EpiZ E{(bf16_t*)(ws + WS_Z), args.in[3]};
        pg8::gemm_phase<pg8::EpiZ>(lds, g, so, E);
    }
    SEAM(1);
    if (IN(2)) REP(2) {
        const int G2 = G / 2;
        if (G2 >= 1 && bx < G2) {
            pg8::Gemm g{(const bf16_t*)(ws + WS_H), (const bf16_t*)(ws + WS_WIN), S, INW, D, D, D, 0}; pg8::StaticOrder so; so.init(S, (28 - P1_TILES) * 256, G2, bx, P1_TILES);
            pg8::EpiZ E{(bf16_t*)(ws + WS_Z), args.in[3]};
            pg8::gemm_phase<pg8::EpiZ>(lds, g, so, E);
        } else {
            for (int bi = bx - G2; bi < 128; bi += G - G2) { const int it0 = (bi >> 1) * 8 + (bi & 1) * 4; p2_sgu(args, lds, it0, it0 + 4, 1, wave, lane, tid); }
        }
        p2_pool(args, vcu, G, tid);
    }
    SEAM(2);
    if (IN(3)) REP(3) {
        pg8::StaticOrder so; so.init(S, D, G, bx);
        { pg8::Gemm g{(const bf16_t*)(ws + WS_A2), (const bf16_t*)(ws + WS_WPOOL), S, D, 256, D, 256, 1};
          pg8::EpiPool E{(bf16_t*)(ws + WS_T), (const bf16_t*)(ws + WS_Z)};
          pg8::gemm_phase<pg8::EpiPool>(lds, g, so, E); }
        asm volatile("s_waitcnt vmcnt(0)" ::: "memory"); __syncthreads();
        { pg8::Gemm g{(const bf16_t*)(ws + WS_A2) + 1024, (const bf16_t*)(ws + WS_WG), S, D, GWD, D, GWD, 0};
          pg8::EpiMerge E{(const bf16_t*)(ws + WS_T), (const bf16_t*)(ws + WS_Z), (bf16_t*)(ws + WS_MRG)};
          pg8::gemm_phase<pg8::EpiMerge>(lds, g, so, E); }
    }
    SEAM(3);
    if (IN(4)) REP(4) {
        pg8::Gemm g{(const bf16_t*)(ws + WS_MRG), (const bf16_t*)(ws + WS_WOUT), S, D, D, D, D, 0}; pg8::StaticOrder so; so.init(S, D, G, bx);
        pg8::EpiX1 E{args.in[0], (bf16_t*)(ws + WS_XB), (float*)(ws + WS_SS)};
        pg8::gemm_phase<pg8::EpiX1>(lds, g, so, E);
    }
    SEAM(4);
    if (IN(6)) REP(6) {
        pg8::Gemm g{(const bf16_t*)(ws + WS_XB), (const bf16_t*)(ws + WS_WQ), S, D, D, D, D, 0}; pg8::StaticOrder so; so.init(S, D, G, bx);
        pg8::EpiQ E{(bf16_t*)(ws + WS_Q), (const float*)(ws + WS_SS)};
        pg8::gemm_phase<pg8::EpiQ>(lds, g, so, E);
    }
    if (IN(6) && IN(7)) { asm volatile("s_waitcnt vmcnt(0)" ::: "memory"); __syncthreads(); }
    if (IN(7)) REP(7) { p7_topk(args, lds, vcu, G, wave, lane); }
    SEAM(7);
    if (IN(8)) REP(8) { float* dst8 = (rep_ < ((DUP_MASK >> 8) & 1)) ? (float*)(ws + WS_T) : args.out; p8_peer(args, lds, dst8, vcu, G, wave, lane); }
#undef IN
#undef SEAM
}

extern "C" void kernel_launch(void* const* d_in, const int* in_sizes, int n_in, void* d_out, int out_size, void* d_ws, size_t ws_size, hipStream_t stream) {
    static int grid = 0;
    if (grid == 0) {
        if (n_in != 18 || out_size != S * D || ws_size < WS_END) { fprintf(stderr, "kernel_launch: unexpected shapes (n_in %d, out %d, ws %zu)\n", n_in, out_size, ws_size); grid = -1; return; }
        int dev = 0, cus = 0, per_cu = 0;
        if (hipGetDevice(&dev) != hipSuccess || hipDeviceGetAttribute(&cus, hipDeviceAttributeMultiprocessorCount, dev) != hipSuccess) { grid = -1; return; }
        if (hipFuncSetAttribute((const void*)fwd, hipFuncAttributeMaxDynamicSharedMemorySize, LDS_BYTES) != hipSuccess) { fprintf(stderr, "kernel_launch: hipFuncSetAttribute failed\n"); grid = -1; return; }
        if (hipOccupancyMaxActiveBlocksPerMultiprocessor(&per_cu, (const void*)fwd, NTHR, LDS_BYTES) != hipSuccess || per_cu < 1) { fprintf(stderr, "kernel_launch: occupancy query says %d\n", per_cu); per_cu = 1; }
        (void)hipGetLastError();
        grid = cus;
    }
    if (grid < 0) return;
#if !USE_CG_SYNC
    if (hipMemsetAsync((char*)d_ws + WS_CTL, 0, 16384, stream) != hipSuccess) { fprintf(stderr, "kernel_launch: memset failed\n"); return; }
#endif
    Args a{};
    for (int i = 0; i < 18; ++i) a.in[i] = (const float*)d_in[i];
    a.out = (float*)d_out; a.ws = (unsigned char*)d_ws;
#if MK_N_LAUNCHES == 1
    a.ph_lo = 0; a.ph_hi = N_PHASES;
    void* kargs[] = {&a};
    hipError_t e = hipLaunchCooperativeKernel((const void*)fwd, dim3(grid), dim3(NTHR), kargs, LDS_BYTES, stream);
    if (e != hipSuccess) fprintf(stderr, "kernel_launch: cooperative launch failed: %s (grid %d)\n", hipGetErrorString(e), grid);
#else
    for (int p = 0; p < N_PHASES; ++p) {
        a.ph_lo = p; a.ph_hi = p + 1;
        hipLaunchKernelGGL(fwd, dim3(grid), dim3(NTHR), LDS_BYTES, stream, a);
    }
#endif
}
```

```cpp
#include <hip/hip_runtime.h>
#include <hip/hip_cooperative_groups.h>
#include <cstdio>
#include <cstdint>
namespace cg = cooperative_groups;

#ifndef USE_CG_SYNC
#define USE_CG_SYNC 1
#endif
#ifndef MK_N_LAUNCHES
#define MK_N_LAUNCHES 1
#endif

#define LAS __attribute__((address_space(3)))
typedef unsigned short bf16_t;
typedef short bf16x8 __attribute__((ext_vector_type(8)));
typedef float f32x4 __attribute__((ext_vector_type(4)));
typedef unsigned u32x4 __attribute__((ext_vector_type(4)));
typedef unsigned u32x2 __attribute__((ext_vector_type(2)));

constexpr int S = 8192, D = 2048, INW = 7168, PW = 1024, GWD = 1024;
constexpr int NEXP = 16384;
constexpr float EPS = 1e-6f;
constexpr int NWAVES = 8, NTHR = 512;

constexpr size_t MiB = 1u << 20;
constexpr size_t WS_CTL = 0;
constexpr size_t WS_WIN = 1 * MiB;
constexpr size_t WS_WPOOL = 30 * MiB;
constexpr size_t WS_WG = 31 * MiB;
constexpr size_t WS_WOUT = 35 * MiB;
constexpr size_t WS_WQ = 43 * MiB;
constexpr size_t WS_KEYS = 51 * MiB;
constexpr size_t WS_WSM = 52 * MiB;
constexpr size_t WS_H = 53 * MiB;
constexpr size_t WS_Z = 85 * MiB;
constexpr size_t WS_A2 = 197 * MiB;
constexpr size_t WS_T = 229 * MiB;
constexpr size_t WS_MRG = 293 * MiB;
constexpr size_t WS_Q = 325 * MiB;
constexpr size_t WS_IDX = 357 * MiB;
constexpr size_t WS_GATE = 361 * MiB;
constexpr size_t WS_SS = 365 * MiB;
constexpr size_t WS_ESC = 369 * MiB;
constexpr size_t WS_EU = 370 * MiB;
constexpr size_t WS_EV = 402 * MiB;
constexpr size_t WS_XB = 434 * MiB;
constexpr size_t WS_END = 466 * MiB;

constexpr int LDS_BYTES = 147456;
constexpr int MISC_OFF = 131072 + 320;

__device__ __forceinline__ unsigned f2bf(float f) { unsigned u = __builtin_bit_cast(unsigned, f); return (u + 0x7fffu + ((u >> 16) & 1u)) >> 16; }
__device__ __forceinline__ unsigned pk2(float lo, float hi) { return f2bf(lo) | (f2bf(hi) << 16); }
__device__ __forceinline__ float bflo(unsigned w) { return __builtin_bit_cast(float, w << 16); }
__device__ __forceinline__ float bfhi(unsigned w) { return __builtin_bit_cast(float, w & 0xffff0000u); }
__device__ __forceinline__ float wave_sum(float v) {
#pragma unroll
    for (int o = 1; o < 64; o <<= 1) v += __shfl_xor(v, o);
    return v;
}
template <int CTRL> __device__ __forceinline__ float dpp_add_f32(float v) { return v + __builtin_bit_cast(float, __builtin_amdgcn_update_dpp(0, __builtin_bit_cast(int, v), CTRL, 0xF, 0xF, true)); }
__device__ __forceinline__ float row_sum_f32(float v) { v = dpp_add_f32<0xB1>(v); v = dpp_add_f32<0x4E>(v); v = dpp_add_f32<0x141>(v); v = dpp_add_f32<0x140>(v); return v; }
__device__ __forceinline__ float gelu_tanh(float x) {
    const float y = 1.5957691216057308f * (x + 0.044715f * x * x * x);
    const float e = __builtin_amdgcn_exp2f(-y * 1.4426950408889634f);
    return x * __builtin_amdgcn_rcpf(1.0f + e);
}
__device__ __forceinline__ float sigmoidf_(float x) { return __builtin_amdgcn_rcpf(1.0f + __builtin_amdgcn_exp2f(-x * 1.4426950408889634f)); }

namespace pg8 {
constexpr int BM = 256, BK = 64, HALF = 128, HTB = HALF * BK * 2, STAGE_BYTES = 8 * HTB, NXCD = 8, WGM = 1;
__host__ __device__ __forceinline__ int lds_byte(int r, int c) { const int st = (r >> 4) * 2 + (c >> 5), rr = r & 15, cc = c & 31, ob = rr * 64 + cc * 2; return st * 1024 + (ob ^ (((ob >> 9) & 1) << 5)); }
__host__ __device__ __forceinline__ void stage_rc(int b, int& R, int& C) { const int st = b / 1024, sb = b % 1024, swz = sb ^ (((sb >> 9) & 1) << 5); R = (st >> 1) * 16 + swz / 64; C = (st & 1) * 32 + (swz % 64) / 2; }
__host__ __device__ __forceinline__ int perm32(int rho) { const int n = rho >> 4, i = rho & 15; return 8 * (i >> 2) + 4 * n + (i & 3); }

struct Unit { int pm, pn; };
struct Gemm { const bf16_t* A; const bf16_t* Bt; int M, N, K, lda, ldb, mode; };
__device__ __forceinline__ const char* a_ptr(const Gemm& g, const Unit& u) {
    size_t off = (size_t)u.pm * BM * g.lda; if (g.mode == 1) off += (size_t)(u.pn >> 1) * 256; return (const char*)(g.A + off); }
__device__ __forceinline__ const char* b_ptr(const Gemm& g, const Unit& u) {
    size_t off = (g.mode == 1) ? ((size_t)(u.pn >> 1) * 512 * 256 + (size_t)(u.pn & 1) * 256 * 256) : (size_t)u.pn * BM * g.ldb; return (const char*)(g.Bt + off); }

struct StaticOrder {
    int nM, nN, nwg, G, c, pn0;
    __host__ __device__ void init(int M, int N, int G_, int c_, int pn0_ = 0) { nM = M / BM; nN = N / BM; nwg = nM * nN; G = G_; c = c_; pn0 = pn0_; }
    __host__ __device__ bool next(int i, Unit& u) const {
        const long L = (long)i * G + c; if (L >= nwg) return false;
        int wgid = (int)L; { const int q = nwg / NXCD, r = nwg % NXCD, xcd = wgid % NXCD, off = wgid / NXCD; wgid = (xcd < r ? xcd * (q + 1) : r * (q + 1) + (xcd - r) * q) + off; }
        const int nig = WGM * nN, gid = wgid / nig, fm = gid * WGM, gsz = (nM - fm) < WGM ? (nM - fm) : WGM;
        u.pm = fm + ((wgid % nig) % gsz); u.pn = pn0 + (wgid % nig) / gsz; return true;
    }
};

__device__ __forceinline__ unsigned cvt_pk_bf16(float lo, float hi) { unsigned r; asm volatile("v_cvt_pk_bf16_f32 %0, %1, %2" : "=v"(r) : "v"(lo), "v"(hi)); return r; }


struct EpiZ {
    static constexpr bool PERM = true;
    bf16_t* Z; const float* b_gate;
    __device__ __forceinline__ void operator()(const f32x4 (&acc)[2][2][4][2], const Unit& u, int wr, int wc, int fr, int fq) const {
        const int row0 = u.pm * BM + wr * 64 + fr, col0 = u.pn * BM + wc * 32 + 8 * fq;
        const int mode = u.pn < 4 ? 0 : (u.pn < 12 ? 1 : 2);
        f32x4 bv[2][2];
#pragma unroll
        for (int bj = 0; bj < 2; ++bj)
#pragma unroll
            for (int n = 0; n < 2; ++n) bv[bj][n] = (mode == 2) ? *(const f32x4*)(b_gate + (col0 - 3072) + bj * HALF + 4 * n) : (f32x4){0.f, 0.f, 0.f, 0.f};
#pragma unroll
        for (int ai = 0; ai < 2; ++ai)
#pragma unroll
            for (int m = 0; m < 4; ++m) { bf16_t* rowp = Z + (size_t)(row0 + ai * HALF + m * 16) * INW + col0;
#pragma unroll
                for (int bj = 0; bj < 2; ++bj) { f32x4 v0 = acc[ai][bj][m][0], v1 = acc[ai][bj][m][1];
                    if (mode == 1) {
#pragma unroll
                        for (int j = 0; j < 4; ++j) { v0[j] = gelu_tanh(v0[j]); v1[j] = gelu_tanh(v1[j]); } }
                    if (mode == 2) { v0 += bv[bj][0]; v1 += bv[bj][1];
#pragma unroll
                        for (int j = 0; j < 4; ++j) { v0[j] = sigmoidf_(v0[j]); v1[j] = sigmoidf_(v1[j]); } }
                    u32x4 w; w.x = cvt_pk_bf16(v0[0], v0[1]); w.y = cvt_pk_bf16(v0[2], v0[3]); w.z = cvt_pk_bf16(v1[0], v1[1]); w.w = cvt_pk_bf16(v1[2], v1[3]);
                    *(u32x4*)(rowp + bj * HALF) = w; } }
    }
};
struct EpiPool {
    static constexpr bool PERM = true;
    bf16_t* T; const bf16_t* Z;
    __device__ __forceinline__ void operator()(const f32x4 (&acc)[2][2][4][2], const Unit& u, int wr, int wc, int fr, int fq) const {
        const int row0 = u.pm * BM + wr * 64 + fr, col0 = u.pn * BM + wc * 32 + 8 * fq;
#pragma unroll
        for (int ai = 0; ai < 2; ++ai)
#pragma unroll
            for (int m = 0; m < 4; ++m) { const size_t row = (size_t)(row0 + ai * HALF + m * 16);
#pragma unroll
                for (int bj = 0; bj < 2; ++bj) { const int c = col0 + bj * HALF;
                    const u32x4 g = *(const u32x4*)(Z + row * INW + 3072 + c);
                    const f32x4 a0 = acc[ai][bj][m][0], a1 = acc[ai][bj][m][1];
                    u32x4 w; w.x = cvt_pk_bf16(bflo(g.x) * a0[0], bfhi(g.x) * a0[1]); w.y = cvt_pk_bf16(bflo(g.y) * a0[2], bfhi(g.y) * a0[3]);
                    w.z = cvt_pk_bf16(bflo(g.z) * a1[0], bfhi(g.z) * a1[1]); w.w = cvt_pk_bf16(bflo(g.w) * a1[2], bfhi(g.w) * a1[3]);
                    *(u32x4*)(T + row * D + c) = w; asm volatile("" ::: "memory"); } }
    }
};
struct EpiMerge {
    static constexpr bool PERM = true;
    const bf16_t* T; const bf16_t* Z; bf16_t* O;
    __device__ __forceinline__ void operator()(const f32x4 (&acc)[2][2][4][2], const Unit& u, int wr, int wc, int fr, int fq) const {
        const int row0 = u.pm * BM + wr * 64 + fr, col0 = u.pn * BM + wc * 32 + 8 * fq;
#pragma unroll
        for (int ai = 0; ai < 2; ++ai)
#pragma unroll
            for (int m = 0; m < 4; ++m) { const size_t row = (size_t)(row0 + ai * HALF + m * 16);
#pragma unroll
                for (int bj = 0; bj < 2; ++bj) { const int c = col0 + bj * HALF;
                    const u32x4 g = *(const u32x4*)(Z + row * INW + 5120 + c);
                    const u32x4 t = *(const u32x4*)(T + row * D + c);
                    const f32x4 a0 = acc[ai][bj][m][0], a1 = acc[ai][bj][m][1];
                    u32x4 w; w.x = cvt_pk_bf16(bflo(t.x) + bflo(g.x) * a0[0], bfhi(t.x) + bfhi(g.x) * a0[1]); w.y = cvt_pk_bf16(bflo(t.y) + bflo(g.y) * a0[2], bfhi(t.y) + bfhi(g.y) * a0[3]);
                    w.z = cvt_pk_bf16(bflo(t.z) + bflo(g.z) * a1[0], bfhi(t.z) + bfhi(g.z) * a1[1]); w.w = cvt_pk_bf16(bflo(t.w) + bflo(g.w) * a1[2], bfhi(t.w) + bfhi(g.w) * a1[3]);
                    *(u32x4*)(O + row * D + c) = w; asm volatile("" ::: "memory"); } }
    }
};
struct EpiX1 {
    static constexpr bool PERM = true;
    const float* X; bf16_t* XB; float* SS;
    __device__ __forceinline__ void operator()(const f32x4 (&acc)[2][2][4][2], const Unit& u, int wr, int wc, int fr, int fq) const {
        const int row0 = u.pm * BM + wr * 64 + fr, col0 = u.pn * BM + wc * 32 + 8 * fq;
#pragma unroll
        for (int ai = 0; ai < 2; ++ai)
#pragma unroll
            for (int m = 0; m < 4; ++m) { const size_t row = (size_t)(row0 + ai * HALF + m * 16); float ss = 0.f;
#pragma unroll
                for (int bj = 0; bj < 2; ++bj) { const size_t off = row * D + col0 + bj * HALF;
                    const f32x4 x0 = *(const f32x4*)(X + off) + acc[ai][bj][m][0], x1 = *(const f32x4*)(X + off + 4) + acc[ai][bj][m][1];
                    ss += (x0[0] * x0[0] + x0[1] * x0[1]) + (x0[2] * x0[2] + x0[3] * x0[3]) + (x1[0] * x1[0] + x1[1] * x1[1]) + (x1[2] * x1[2] + x1[3] * x1[3]);
                    u32x4 w; w.x = cvt_pk_bf16(x0[0], x0[1]); w.y = cvt_pk_bf16(x0[2], x0[3]); w.z = cvt_pk_bf16(x1[0], x1[1]); w.w = cvt_pk_bf16(x1[2], x1[3]);
                    *(u32x4*)(XB + off) = w; }
                ss += __shfl_xor(ss, 16); ss += __shfl_xor(ss, 32);
                if (fq == 0) SS[row * 32 + u.pn * 4 + wc] = ss;
                asm volatile("" ::: "memory"); }
    }
};
struct EpiQ {
    static constexpr bool PERM = true;
    bf16_t* O; const float* SS;
    __device__ __forceinline__ void operator()(const f32x4 (&acc)[2][2][4][2], const Unit& u, int wr, int wc, int fr, int fq) const {
        const int row0 = u.pm * BM + wr * 64 + fr, col0 = u.pn * BM + wc * 32 + 8 * fq;
#pragma unroll
        for (int ai = 0; ai < 2; ++ai)
#pragma unroll
            for (int m = 0; m < 4; ++m) { const size_t row = (size_t)(row0 + ai * HALF + m * 16);
                const f32x4 p0 = *(const f32x4*)(SS + row * 32 + fq * 8), p1 = *(const f32x4*)(SS + row * 32 + fq * 8 + 4);
                float ss = ((p0[0] + p0[1]) + (p0[2] + p0[3])) + ((p1[0] + p1[1]) + (p1[2] + p1[3]));
                ss += __shfl_xor(ss, 16); ss += __shfl_xor(ss, 32);
                const float rstd = 1.0f / sqrtf(ss * (1.0f / D) + EPS);
                bf16_t* rowp = O + row * D + col0;
#pragma unroll
                for (int bj = 0; bj < 2; ++bj) { const f32x4 v0 = acc[ai][bj][m][0] * rstd, v1 = acc[ai][bj][m][1] * rstd;
                    u32x4 w; w.x = cvt_pk_bf16(v0[0], v0[1]); w.y = cvt_pk_bf16(v0[2], v0[3]); w.z = cvt_pk_bf16(v1[0], v1[1]); w.w = cvt_pk_bf16(v1[2], v1[3]);
                    *(u32x4*)(rowp + bj * HALF) = w; } }
    }
};

template <class Epi, bool ALIGN_EPI = true>
__device__ __forceinline__ void gemm_phase(LAS unsigned char* lds, const Gemm g, const StaticOrder& S_, const Epi& E) {
    int tid_ = threadIdx.x; asm volatile("" : "+v"(tid_));
    const int tid = tid_, wid = __builtin_amdgcn_readfirstlane(tid >> 6), lane = tid & 63, wr = wid >> 2, wc = wid & 3, fr = lane & 15, fq = lane >> 4;
    const int K = g.K, nt = K / BK;
    unsigned voffA[2], voffB[2];
#pragma unroll
    for (int i = 0; i < 2; ++i) { int R, C; stage_rc(tid * 16 + i * 8192, R, C); const int Rb = Epi::PERM ? ((R & ~31) + perm32(R & 31)) : R;
        voffA[i] = (unsigned)(R * g.lda + C) * 2u; voffB[i] = (unsigned)(Rb * g.ldb + C) * 2u; }
    const size_t kstep = (size_t)(BK * 2);
    const size_t hstepA = (size_t)HALF * g.lda * 2, hstepB = (size_t)HALF * g.ldb * 2;
    const unsigned ldsw = (unsigned)wid * 1024u;
    const int aoff = lds_byte(wr * 64 + fr, fq * 8), boff = lds_byte(wc * 32 + fr, fq * 8);
#define PG8_SA(b, h) (((b) * 2 + (h)) * HTB)
#define PG8_SB(b, h) ((4 + (b) * 2 + (h)) * HTB)
#define PG8_STAGE(bufoff, gbase, voff) do { _Pragma("unroll") for (int _i = 0; _i < 2; ++_i) \
        __builtin_amdgcn_global_load_lds((const unsigned*)((const char*)(gbase) + (voff)[_i]), (LAS unsigned*)(lds + (bufoff) + ldsw + _i * 8192), 16, 0, 0); } while (0)
#define PG8_LDA(dst, b, h) do { _Pragma("unroll") for (int m = 0; m < 4; ++m) _Pragma("unroll") for (int k = 0; k < 2; ++k) dst[m][k] = *(const LAS bf16x8*)(lds + PG8_SA(b, h) + aoff + m * 2048 + k * 1024); } while (0)
#define PG8_LDB(dst, b, h) do { _Pragma("unroll") for (int n = 0; n < 2; ++n) _Pragma("unroll") for (int k = 0; k < 2; ++k) dst[n][k] = *(const LAS bf16x8*)(lds + PG8_SB(b, h) + boff + n * 2048 + k * 1024); } while (0)
#define PG8_MMA(ai, bj, At, Bt) do { __builtin_amdgcn_s_setprio(1); _Pragma("unroll") for (int m = 0; m < 4; ++m) _Pragma("unroll") for (int n = 0; n < 2; ++n) _Pragma("unroll") for (int k = 0; k < 2; ++k) \
        acc[ai][bj][m][n] = __builtin_amdgcn_mfma_f32_16x16x32_bf16(Bt[n][k], At[m][k], acc[ai][bj][m][n], 0, 0, 0); __builtin_amdgcn_s_setprio(0); } while (0)
#define PG8_WAIT_V(n) asm volatile("s_waitcnt vmcnt(" #n ")" ::: "memory")
#define PG8_WAIT_L(n) asm volatile("s_waitcnt lgkmcnt(" #n ")" ::: "memory")
#define PG8_BAR __builtin_amdgcn_s_barrier()
#define PG8_SCHED __builtin_amdgcn_sched_barrier(0)
    Unit cur, nxt; int ui = 0;
    if (!S_.next(0, cur)) return;
    f32x4 acc[2][2][4][2];
#pragma unroll
    for (int a = 0; a < 2; ++a)
#pragma unroll
        for (int b = 0; b < 2; ++b)
#pragma unroll
            for (int m = 0; m < 4; ++m)
#pragma unroll
                for (int n = 0; n < 2; ++n) acc[a][b][m][n] = (f32x4){0.f, 0.f, 0.f, 0.f};
    bf16x8 At[4][2], B0[2][2], B1[2][2];
    const char* cA = a_ptr(g, cur); const char* cB = b_ptr(g, cur);
    PG8_STAGE(PG8_SB(0, 0), cB, voffB); PG8_STAGE(PG8_SB(0, 1), cB + hstepB, voffB); PG8_STAGE(PG8_SA(0, 0), cA, voffA); PG8_STAGE(PG8_SA(0, 1), cA + hstepA, voffA);
    if (wr == 1) PG8_BAR;
    PG8_WAIT_V(2); PG8_BAR;
    PG8_STAGE(PG8_SB(1, 0), cB + kstep, voffB); PG8_STAGE(PG8_SA(1, 0), cA + kstep, voffA); PG8_STAGE(PG8_SB(1, 1), cB + hstepB + kstep, voffB);
    PG8_WAIT_V(6); PG8_BAR;
    for (;;) {
        const bool has_next = S_.next(ui + 1, nxt);
        const char* nA = has_next ? a_ptr(g, nxt) : cA; const char* nB = has_next ? b_ptr(g, nxt) : cB;
        for (int t = 0; t < nt; t += 2) {
            const bool last = (t == nt - 2);
            const char* a1 = cA + (size_t)(t + 1) * kstep;
            const char* a2 = last ? nA : cA + (size_t)(t + 2) * kstep; const char* b2 = last ? nB : cB + (size_t)(t + 2) * kstep;
            const char* a3 = a2 + kstep; const char* b3 = b2 + kstep;
            PG8_LDB(B0, 0, 0); PG8_LDB(B1, 0, 1); PG8_SCHED; PG8_LDA(At, 0, 0); PG8_STAGE(PG8_SA(1, 1), a1 + hstepA, voffA);
            PG8_WAIT_V(8); PG8_WAIT_L(0); PG8_BAR; PG8_MMA(0, 0, At, B0); PG8_MMA(0, 1, At, B1); PG8_BAR; PG8_SCHED;
            PG8_LDA(At, 0, 1); PG8_STAGE(PG8_SB(0, 0), b2, voffB); PG8_STAGE(PG8_SB(0, 1), b2 + hstepB, voffB); PG8_STAGE(PG8_SA(0, 0), a2, voffA);
            PG8_WAIT_V(8); PG8_WAIT_L(0); PG8_BAR; PG8_MMA(1, 0, At, B0); PG8_MMA(1, 1, At, B1); PG8_BAR; PG8_SCHED;
            PG8_LDB(B0, 1, 0); PG8_LDB(B1, 1, 1); PG8_SCHED; PG8_LDA(At, 1, 0); PG8_STAGE(PG8_SA(0, 1), a2 + hstepA, voffA);
            PG8_WAIT_V(8); PG8_WAIT_L(0); PG8_BAR; PG8_MMA(0, 0, At, B0); PG8_MMA(0, 1, At, B1); PG8_BAR; PG8_SCHED;
            PG8_LDA(At, 1, 1); PG8_STAGE(PG8_SB(1, 0), b3, voffB); PG8_STAGE(PG8_SB(1, 1), b3 + hstepB, voffB); PG8_STAGE(PG8_SA(1, 0), a3, voffA);
            PG8_WAIT_V(8); PG8_WAIT_L(0); PG8_BAR; PG8_MMA(1, 0, At, B0); PG8_MMA(1, 1, At, B1); PG8_BAR; PG8_SCHED;
        }
        if constexpr (ALIGN_EPI) { if (wr == 0) PG8_BAR; }
        { int ln_ = threadIdx.x & 63; asm volatile("" : "+v"(ln_));
          E(acc, cur, wr, wc, ln_ & 15, ln_ >> 4); }
        if (!has_next) break;
#pragma unroll
        for (int a = 0; a < 2; ++a)
#pragma unroll
            for (int b = 0; b < 2; ++b)
#pragma unroll
                for (int m = 0; m < 4; ++m)
#pragma unroll
                    for (int n = 0; n < 2; ++n) acc[a][b][m][n] = (f32x4){0.f, 0.f, 0.f, 0.f};
        cur = nxt; cA = nA; cB = nB; ++ui;
        if constexpr (ALIGN_EPI) { if (wr == 1) PG8_BAR; }
    }
    PG8_WAIT_V(0);
    if constexpr (!ALIGN_EPI) { if (wr == 0) PG8_BAR; }
    PG8_BAR;
#undef PG8_SA
#undef PG8_SB
#undef PG8_STAGE
#undef PG8_LDA
#undef PG8_LDB
#undef PG8_MMA
#undef PG8_WAIT_V
#undef PG8_WAIT_L
#undef PG8_BAR
#undef PG8_SCHED
}
}

struct Args { const float* in[18]; float* out; unsigned char* ws; int ph_lo, ph_hi; };

__device__ __forceinline__ void p0_transpose_item(const float* W, int K, int N, bf16_t* WT, LAS float* scr, int item, int lane, const float* kgain = nullptr) {
    const int nblk = N / 32, kb = item / nblk, nb = item % nblk, k0 = 64 * kb, n0 = 32 * nb;
    { f32x4 wv[8];
#pragma unroll
      for (int i = 0; i < 8; ++i) wv[i] = *(const f32x4*)(W + (size_t)(k0 + 8 * i + (lane >> 3)) * N + n0 + 4 * (lane & 7));
#pragma unroll
      for (int i = 0; i < 8; ++i) { const int kk = 8 * i + (lane >> 3); const float gk = kgain ? kgain[k0 + kk] : 1.0f; LAS float* sp = scr + kk * 33 + 4 * (lane & 7);
          sp[0] = gk * wv[i].x; sp[1] = gk * wv[i].y; sp[2] = gk * wv[i].z; sp[3] = gk * wv[i].w; } }
    asm volatile("s_waitcnt lgkmcnt(0)" ::: "memory");
    const int c = lane & 7;
#pragma unroll
    for (int j = 0; j < 4; ++j) { const int n = (lane >> 3) + 8 * j; const LAS float* s = scr + (8 * c) * 33 + n;
        u32x4 o; o.x = pk2(s[0 * 33], s[1 * 33]); o.y = pk2(s[2 * 33], s[3 * 33]); o.z = pk2(s[4 * 33], s[5 * 33]); o.w = pk2(s[6 * 33], s[7 * 33]);
        *(u32x4*)(WT + (size_t)(n0 + n) * K + k0 + 8 * c) = o; }
    asm volatile("s_waitcnt lgkmcnt(0)" ::: "memory");
}
__device__ __forceinline__ void rms_row_to_bf16(const float* xrow, const float* g, bf16_t* orow, int lane) {
    const f32x4* xr = (const f32x4*)xrow + lane;
    f32x4 v[8]; float s = 0.f;
#pragma unroll
    for (int j = 0; j < 8; ++j) { v[j] = xr[64 * j]; s += (v[j].x * v[j].x + v[j].y * v[j].y) + (v[j].z * v[j].z + v[j].w * v[j].w); }
    const float rstd = 1.0f / sqrtf(wave_sum(s) * (1.0f / D) + EPS);
    const f32x4* gr = (const f32x4*)g + lane;
    u32x2* o8 = (u32x2*)orow + lane;
#pragma unroll
    for (int j = 0; j < 8; ++j) { const f32x4 gv = gr[64 * j]; u32x2 o; o.x = pk2(v[j].x * rstd * gv.x, v[j].y * rstd * gv.y); o.y = pk2(v[j].z * rstd * gv.z, v[j].w * rstd * gv.w); o8[64 * j] = o; }
}
__device__ __forceinline__ void cvt_stream(const float* src, bf16_t* dst, size_t n8, size_t gtid, size_t nthr) {
    for (size_t i = gtid; i < n8; i += nthr) { const f32x4 a = ((const f32x4*)src)[2 * i], b = ((const f32x4*)src)[2 * i + 1];
        u32x4 o; o.x = pk2(a.x, a.y); o.y = pk2(a.z, a.w); o.z = pk2(b.x, b.y); o.w = pk2(b.z, b.w); ((u32x4*)dst)[i] = o; }
}

constexpr int EROW = 1536;
typedef unsigned u32x6 __attribute__((ext_vector_type(6)));
typedef float f32x16 __attribute__((ext_vector_type(16)));
typedef float f32x32 __attribute__((ext_vector_type(32)));
#ifndef FP6_ENC_INTERLEAVED
#define FP6_ENC_INTERLEAVED 1
#endif
__device__ __forceinline__ void expert_row_load(const float* src, f32x4 (&v)[8], int lane) {
    const f32x4* xr = (const f32x4*)src + lane;
#pragma unroll
    for (int k = 0; k < 8; ++k) v[k] = xr[64 * k];
}
__device__ __forceinline__ void expert_row_gain(f32x4 (&v)[8], const float* g, int lane) {
    const f32x4* gr = (const f32x4*)g + lane;
#pragma unroll
    for (int k = 0; k < 8; ++k) v[k] = v[k] * gr[64 * k];
}
__device__ __forceinline__ void expert_row_store(const f32x4 (&v)[8], unsigned char* dst, float* isc, int lane) {
    float am = 0.f;
#pragma unroll
    for (int k = 0; k < 8; ++k) am = fmaxf(am, fmaxf(fmaxf(fabsf(v[k].x), fabsf(v[k].y)), fmaxf(fabsf(v[k].z), fabsf(v[k].w))));
#pragma unroll
    for (int o = 1; o < 64; o <<= 1) am = fmaxf(am, __shfl_xor(am, o));
    float sc = 1.0f, inv = 1.0f;
    if (am > 0.f) { const float amc = fminf(fmaxf(am, 1.0e-30f), 1.0e30f); sc = 7.5f / amc; inv = amc * (1.0f / 7.5f); }
    f32x16 ea, eb;
#pragma unroll
    for (int j = 0; j < 16; ++j) {
#if FP6_ENC_INTERLEAVED
        const int ja = 2 * j, jb = 2 * j + 1;
#else
        const int ja = j, jb = 16 + j;
#endif
        ea[j] = v[ja >> 2][ja & 3] * sc; eb[j] = v[jb >> 2][jb & 3] * sc; }
    const u32x6 o = __builtin_amdgcn_cvt_scalef32_2xpk16_fp6_f32(ea, eb, 1.0f);
    u32x4 o0; o0.x = o[0]; o0.y = o[1]; o0.z = o[2]; o0.w = o[3]; u32x2 o1; o1.x = o[4]; o1.y = o[5];
    *(u32x4*)(dst + lane * 16) = o0; *(u32x2*)(dst + 1024 + lane * 8) = o1;
    if (lane == 0) *isc = inv;
}

__device__ __forceinline__ void p0_score_weights(const Args& a, int item, int lane) {
    const float* wq = a.in[13]; const float* g2 = a.in[12]; const float* keys = a.in[14]; bf16_t* M = (bf16_t*)(a.ws + WS_WQ);
    const int b = item >> 7, kt = item & 127, fr = lane & 15, fq = lane >> 4;
    const int k = kt * 16 + fr; const float gk = g2[k];
    bf16x8 wf[4];
#pragma unroll
    for (int ks = 0; ks < 4; ++ks) { const float* p = wq + (size_t)k * D + b * 128 + ks * 32 + fq * 8; const f32x4 x0 = *(const f32x4*)p, x1 = *(const f32x4*)(p + 4);
        u32x4 w; w.x = pk2(gk * x0.x, gk * x0.y); w.y = pk2(gk * x0.z, gk * x0.w); w.z = pk2(gk * x1.x, gk * x1.y); w.w = pk2(gk * x1.z, gk * x1.w); wf[ks] = __builtin_bit_cast(bf16x8, w); }
#pragma unroll 2
    for (int nb = 0; nb < 8; ++nb) {
        f32x4 acc = {0.f, 0.f, 0.f, 0.f};
#pragma unroll
        for (int ks = 0; ks < 4; ++ks) { const float* p = keys + (size_t)(b * 128 + nb * 16 + fr) * 128 + ks * 32 + fq * 8; const f32x4 x0 = *(const f32x4*)p, x1 = *(const f32x4*)(p + 4);
            u32x4 w; w.x = pk2(x0.x, x0.y); w.y = pk2(x0.z, x0.w); w.z = pk2(x1.x, x1.y); w.w = pk2(x1.z, x1.w);
            acc = __builtin_amdgcn_mfma_f32_16x16x32_bf16(wf[ks], __builtin_bit_cast(bf16x8, w), acc, 0, 0, 0); }
        u32x2 o; o.x = pk2(acc[0], acc[1]); o.y = pk2(acc[2], acc[3]);
        *(u32x2*)(M + (size_t)(b * 128 + nb * 16 + fr) * D + kt * 16 + fq * 4) = o;
    }
}

__device__ __forceinline__ void p0_prologue(const Args& a, LAS unsigned char* lds, int vcu, int G, int wave, int lane, int tid) {
    unsigned char* ws = a.ws;
    LAS float* scr = (LAS float*)(lds + wave * 16384);
    const int gw = vcu * NWAVES + wave, NGW = G * NWAVES;
    constexpr int I_IN = (D / 64) * (INW / 32), I_POOL1 = (256 / 64) * (512 / 32), I_G = (GWD / 64) * (D / 32), I_O = (D / 64) * (D / 32);
    constexpr int NITEMS = I_IN + 4 * I_POOL1 + I_G + I_O;
    for (int it = gw; it < NITEMS; it += NGW) {
        int r = it;
        if (r < I_IN) { p0_transpose_item(a.in[2], D, INW, (bf16_t*)(ws + WS_WIN), scr, r, lane); continue; } r -= I_IN;
        if (r < 4 * I_POOL1) { const int g = r / I_POOL1; p0_transpose_item(a.in[5] + (size_t)g * 256 * 512, 256, 512, (bf16_t*)(ws + WS_WPOOL) + (size_t)g * 512 * 256, scr, r % I_POOL1, lane); continue; } r -= 4 * I_POOL1;
        if (r < I_G) { p0_transpose_item(a.in[10], GWD, D, (bf16_t*)(ws + WS_WG), scr, r, lane); continue; } r -= I_G;
        p0_transpose_item(a.in[11], D, D, (bf16_t*)(ws + WS_WOUT), scr, r, lane);
    }
    for (int it = gw; it < 16 * (D / 16); it += NGW) p0_score_weights(a, it, lane);
    for (int m = gw; m < S; m += NGW) rms_row_to_bf16(a.in[0] + (size_t)m * D, a.in[1], (bf16_t*)(ws + WS_H) + (size_t)m * D, lane);
    unsigned tq_ = (unsigned)tid; asm volatile("" : "+v"(tq_));
    const size_t gtid = (size_t)vcu * NTHR + tq_, nthr = (size_t)G * NTHR;
    {
        const float* src = a.in[8]; bf16_t* dst = (bf16_t*)(ws + WS_WSM);
        for (size_t i = gtid; i < (size_t)8 * 128 * 128 / 8; i += nthr) { const int s0 = (int)(i & 15) * 8, t = (int)(i >> 4) & 127;
            const f32x4 x0 = ((const f32x4*)src)[2 * i], x1 = ((const f32x4*)src)[2 * i + 1];
            float v[8] = {x0.x, x0.y, x0.z, x0.w, x1.x, x1.y, x1.z, x1.w};
#pragma unroll
            for (int j = 0; j < 8; ++j) v[j] = (s0 + j <= t) ? v[j] : 0.f;
            u32x4 o; o.x = pk2(v[0], v[1]); o.y = pk2(v[2], v[3]); o.z = pk2(v[4], v[5]); o.w = pk2(v[6], v[7]); ((u32x4*)dst)[i] = o; }
    }
}

__device__ __forceinline__ void p2_pool(const Args& a, int vcu, int G, int tid) {
    const bf16_t* Z = (const bf16_t*)(a.ws + WS_Z); bf16_t* A2 = (bf16_t*)(a.ws + WS_A2); const float* psc = a.in[4];
    unsigned tq_ = (unsigned)tid; asm volatile("" : "+v"(tq_));
    const size_t gtid = (size_t)vcu * NTHR + tq_, nthr = (size_t)G * NTHR;
    for (size_t id = gtid; id < (size_t)(S / 8) * 128; id += nthr) {
        const int c8 = (int)(id & 127), t0 = (int)(id >> 7) * 8, g = c8 >> 5, w = 2 << g;
        u32x4 row[23];
#pragma unroll
        for (int r = 0; r < 23; ++r) { const int t = t0 - 15 + r; const bool need = (r >= 16 - w) && (t >= 0);
            row[r] = need ? *(const u32x4*)(Z + (size_t)t * INW + c8 * 8) : (u32x4){0u, 0u, 0u, 0u}; }
        const f32x4 p0 = *(const f32x4*)(psc + c8 * 8), p1 = *(const f32x4*)(psc + c8 * 8 + 4);
        const float ps[8] = {p0.x, p0.y, p0.z, p0.w, p1.x, p1.y, p1.z, p1.w};
        float s[8] = {0.f, 0.f, 0.f, 0.f, 0.f, 0.f, 0.f, 0.f};
#pragma unroll
        for (int r = 0; r < 15; ++r) { const u32x4 q = row[r];
            s[0] += bflo(q.x); s[1] += bfhi(q.x); s[2] += bflo(q.y); s[3] += bfhi(q.y); s[4] += bflo(q.z); s[5] += bfhi(q.z); s[6] += bflo(q.w); s[7] += bfhi(q.w); }
#pragma unroll
        for (int i = 0; i < 8; ++i) {
            const u32x4 q = row[15 + i];
            const float at[8] = {bflo(q.x), bfhi(q.x), bflo(q.y), bfhi(q.y), bflo(q.z), bfhi(q.z), bflo(q.w), bfhi(q.w)};
#pragma unroll
            for (int c = 0; c < 8; ++c) s[c] += at[c];
            const int t = t0 + i; const int cnt = (t + 1) < w ? (t + 1) : w; const float inv = 1.0f / (float)cnt;
            float o[8];
#pragma unroll
            for (int c = 0; c < 8; ++c) o[c] = (s[c] * inv - at[c]) * ps[c];
            u32x4 w4; w4.x = pk2(o[0], o[1]); w4.y = pk2(o[2], o[3]); w4.z = pk2(o[4], o[5]); w4.w = pk2(o[6], o[7]);
            *(u32x4*)(A2 + (size_t)t * D + c8 * 8) = w4;
            const u32x4 d2 = row[15 + i - 1], d4 = row[15 + i - 3], d8 = row[15 + i - 7], d16 = row[15 + i - 15];
            const u32x4 dq = g == 0 ? d2 : (g == 1 ? d4 : (g == 2 ? d8 : d16));
            s[0] -= bflo(dq.x); s[1] -= bfhi(dq.x); s[2] -= bflo(dq.y); s[3] -= bfhi(dq.y); s[4] -= bflo(dq.z); s[5] -= bfhi(dq.z); s[6] -= bflo(dq.w); s[7] -= bfhi(dq.w);
        }
    }
}
constexpr int VT_LD = 136;
__device__ __forceinline__ void p2_sgu(const Args& a, LAS unsigned char* lds, int item0, int item1, int istep, int wave, int lane, int tid) {
    const bf16_t* Z = (const bf16_t*)(a.ws + WS_Z); bf16_t* A2 = (bf16_t*)(a.ws + WS_A2); const bf16_t* WSM = (const bf16_t*)(a.ws + WS_WSM);
    const float* lng = a.in[6]; const float* lnb = a.in[7]; const float* bs = a.in[9];
    LAS float* st = (LAS float*)lds; LAS bf16_t* Vt = (LAS bf16_t*)(lds + 1024);
    const int fr = lane & 15, fq = lane >> 4;
    int prev_c = -1;
    for (int item = item0; item < item1; item += istep) {
        const int c = item >> 3, h = item & 7, t0 = c * 128; const bool need_stats = (c != prev_c); prev_c = c;
        u32x4 raw[4][8];
        if (need_stats) {
#pragma unroll
        for (int p = 0; p < 4; ++p) { const bf16_t* rp = Z + (size_t)(t0 + wave * 16 + p * 4 + fq) * INW + 2048 + fr * 8;
#pragma unroll
            for (int j = 0; j < 8; ++j) raw[p][j] = *(const u32x4*)(rp + j * 128); } }
        u32x4 rawB[4];
#pragma unroll
        for (int q = 0; q < 4; ++q) { const int id = tid + q * NTHR, sr = id & 127, dc = id >> 7; rawB[q] = *(const u32x4*)(Z + (size_t)(t0 + sr) * INW + 2048 + h * 128 + dc * 8); }
        bf16x8 bW[4];
#pragma unroll
        for (int ks = 0; ks < 4; ++ks) bW[ks] = *(const bf16x8*)(WSM + (size_t)(h * 128 + wave * 16 + fr) * 128 + ks * 32 + fq * 8);
        u32x2 ur[8];
#pragma unroll
        for (int db = 0; db < 8; ++db) ur[db] = *(const u32x2*)(Z + (size_t)(t0 + wave * 16 + fr) * INW + 1024 + h * 128 + db * 16 + fq * 4);
        const float bias = bs[h * 128 + wave * 16 + fr];
        if (need_stats) {
#pragma unroll
        for (int p = 0; p < 4; ++p) { float s = 0.f, q = 0.f;
#pragma unroll
            for (int j = 0; j < 8; ++j)
#pragma unroll
                for (int w = 0; w < 4; ++w) { const float a0 = bflo(raw[p][j][w]), a1 = bfhi(raw[p][j][w]); s += a0 + a1; q += a0 * a0 + a1 * a1; }
            s = row_sum_f32(s); q = row_sum_f32(q);
            if (fr == 0) { const float mean = s * (1.0f / 1024.0f); const float var = fmaxf(q * (1.0f / 1024.0f) - mean * mean, 0.f);
                const int sr = wave * 16 + p * 4 + fq; st[2 * sr] = mean; st[2 * sr + 1] = 1.0f / sqrtf(var + EPS); } }
        __syncthreads();
        }
#pragma unroll
        for (int q = 0; q < 4; ++q) { const int id = tid + q * NTHR, sr = id & 127, dc = id >> 7;
            const u32x4 rw = rawB[q];
            const float mean = st[2 * sr], rstd = st[2 * sr + 1];
            const float v[8] = {bflo(rw.x), bfhi(rw.x), bflo(rw.y), bfhi(rw.y), bflo(rw.z), bfhi(rw.z), bflo(rw.w), bfhi(rw.w)};
            const f32x4 g0 = *(const f32x4*)(lng + h * 128 + dc * 8), g1 = *(const f32x4*)(lng + h * 128 + dc * 8 + 4), b0 = *(const f32x4*)(lnb + h * 128 + dc * 8), b1 = *(const f32x4*)(lnb + h * 128 + dc * 8 + 4);
            const float gg[8] = {g0.x, g0.y, g0.z, g0.w, g1.x, g1.y, g1.z, g1.w}, bb[8] = {b0.x, b0.y, b0.z, b0.w, b1.x, b1.y, b1.z, b1.w};
#pragma unroll
            for (int i = 0; i < 8; ++i) { const int d = dc * 8 + i; const float y = (v[i] - mean) * rstd * gg[i] + bb[i]; Vt[d * VT_LD + sr] = (bf16_t)f2bf(y); } }
        __syncthreads();
        f32x4 acc[8];
#pragma unroll
        for (int db = 0; db < 8; ++db) acc[db] = (f32x4){0.f, 0.f, 0.f, 0.f};
        const int nks = (wave * 16 + 15) / 32 + 1;
#pragma unroll
        for (int ks = 0; ks < 4; ++ks) if (ks < nks) {
#pragma unroll
            for (int db = 0; db < 8; ++db) { const bf16x8 aV = *(const LAS bf16x8*)(Vt + (db * 16 + fr) * VT_LD + ks * 32 + fq * 8);
                acc[db] = __builtin_amdgcn_mfma_f32_16x16x32_bf16(aV, bW[ks], acc[db], 0, 0, 0); }
        }
        { const int t = t0 + wave * 16 + fr;
#pragma unroll
          for (int db = 0; db < 8; ++db) { const int col = h * 128 + db * 16 + fq * 4;
              u32x2 o; o.x = pk2(bflo(ur[db].x) * (acc[db][0] + bias), bfhi(ur[db].x) * (acc[db][1] + bias)); o.y = pk2(bflo(ur[db].y) * (acc[db][2] + bias), bfhi(ur[db].y) * (acc[db][3] + bias));
              *(u32x2*)(A2 + (size_t)t * D + 1024 + col) = o; } }
        __syncthreads();
    }
}

__device__ __forceinline__ unsigned f2key(float f) { const unsigned b = __builtin_bit_cast(unsigned, f); return (b & 0x80000000u) ? ~b : (b | 0x80000000u); }
__device__ __forceinline__ float key2f(unsigned k) { const unsigned b = (k & 0x80000000u) ? (k ^ 0x80000000u) : ~k; return __builtin_bit_cast(float, b); }
template <int CTRL> __device__ __forceinline__ unsigned dpp_max_u32(unsigned v) { const unsigned o = (unsigned)__builtin_amdgcn_update_dpp(0, (int)v, CTRL, 0xF, 0xF, true); return v > o ? v : o; }
__device__ __forceinline__ unsigned row_max_u32(unsigned v) { v = dpp_max_u32<0xB1>(v); v = dpp_max_u32<0x4E>(v); v = dpp_max_u32<0x141>(v); v = dpp_max_u32<0x140>(v); return v; }
__device__ __forceinline__ void ce_desc(unsigned& a, unsigned& b) { const unsigned hi = a > b ? a : b, lo = a > b ? b : a; a = hi; b = lo; }
__device__ __forceinline__ void sort8_desc(unsigned (&k)[8]) {
    ce_desc(k[0], k[1]); ce_desc(k[2], k[3]); ce_desc(k[4], k[5]); ce_desc(k[6], k[7]);
    ce_desc(k[0], k[2]); ce_desc(k[1], k[3]); ce_desc(k[4], k[6]); ce_desc(k[5], k[7]);
    ce_desc(k[1], k[2]); ce_desc(k[5], k[6]);
    ce_desc(k[0], k[4]); ce_desc(k[1], k[5]); ce_desc(k[2], k[6]); ce_desc(k[3], k[7]);
    ce_desc(k[2], k[4]); ce_desc(k[3], k[5]);
    ce_desc(k[1], k[2]); ce_desc(k[3], k[4]); ce_desc(k[5], k[6]);
}
__device__ __forceinline__ void sort4_desc(unsigned (&k)[4]) { ce_desc(k[0], k[1]); ce_desc(k[2], k[3]); ce_desc(k[0], k[2]); ce_desc(k[1], k[3]); ce_desc(k[1], k[2]); }
template <int NV> __device__ __forceinline__ unsigned row_top16_sorted(unsigned (&k)[NV], int fr) {
    unsigned tk = 0u;
    for (int it = 0; it < 16; ++it) {
        const unsigned m = row_max_u32(k[0]);
        const unsigned wm = (k[0] == m) ? 0xffffffffu : 0u;
#pragma unroll
        for (int i = 0; i + 1 < NV; ++i) k[i] = (k[i + 1] & wm) | (k[i] & ~wm);
        k[NV - 1] = k[NV - 1] & ~wm;
        tk = (fr == it) ? m : tk;
    }
    return tk;
}
__device__ __forceinline__ unsigned cand_table(int fr) {
    constexpr unsigned T[16] = {0x03020100u, 0x07060504u, 0x0b0a0908u, 0x0f0e0d0cu, 0x13121110u, 0x17161514u, 0x23222120u, 0x32313024u, 0x42414033u, 0x61605150u, 0x90807170u, 0xd0c0b0a0u, 0xfffff0e0u, 0xffffffffu, 0xffffffffu, 0xffffffffu};
    unsigned w = T[0];
#pragma unroll
    for (int i = 1; i < 16; ++i) w = (fr == i) ? T[i] : w;
    return w;
}
constexpr int SC_LD = 132;
__device__ __forceinline__ void p7_topk(const Args& a, LAS unsigned char* lds, int vcu, int G, int wave, int lane_) {
    int lane = lane_; asm volatile("" : "+v"(lane));
    const bf16_t* Q = (const bf16_t*)(a.ws + WS_Q);
    int* IDX = (int*)(a.ws + WS_IDX); float* GATE = (float*)(a.ws + WS_GATE);
    LAS float* SL = (LAS float*)(lds + wave * (16 * SC_LD * 4));
    const int gw = vcu * NWAVES + wave, NGW = G * NWAVES; const int fr = lane & 15, fq = lane >> 4;
    const unsigned ctab = cand_table(fr);
    int erow = gw;
    f32x4 er0[8], er1[8]; int e0 = 2 * NEXP, e1 = 2 * NEXP;
#define ER_LOAD() do { e0 = erow; e1 = erow + NGW; erow += 2 * NGW; \
        if (e0 < 2 * NEXP) expert_row_load(a.in[15 + (e0 >= NEXP)] + (size_t)(e0 & (NEXP - 1)) * D, er0, lane); \
        if (e1 < 2 * NEXP) expert_row_load(a.in[15 + (e1 >= NEXP)] + (size_t)(e1 & (NEXP - 1)) * D, er1, lane); } while (0)
#define ER_STORE() do { \
        if (e0 < NEXP) expert_row_gain(er0, a.in[12], lane); if (e1 < NEXP) expert_row_gain(er1, a.in[12], lane); \
        if (e0 < 2 * NEXP) expert_row_store(er0, a.ws + ((e0 >= NEXP) ? WS_EV : WS_EU) + (size_t)(e0 & (NEXP - 1)) * EROW, (float*)(a.ws + WS_ESC) + e0, lane); \
        if (e1 < 2 * NEXP) expert_row_store(er1, a.ws + ((e1 >= NEXP) ? WS_EV : WS_EU) + (size_t)(e1 & (NEXP - 1)) * EROW, (float*)(a.ws + WS_ESC) + e1, lane); } while (0)
    pg8::StaticOrder so7; so7.init(S, D, G, (int)blockIdx.x); pg8::Unit u7;
    for (int ui = 0; so7.next(ui >> 1, u7); ++ui) {
        const int h = u7.pn, t0 = u7.pm * 256 + ((ui & 1) * 8 + wave) * 16;
        unsigned tk[8];
#pragma unroll
        for (int i = 0; i < 8; ++i) tk[i] = 0u;
#pragma unroll 1
        for (int p = 0; p < 2; ++p) {
            {
                u32x4 sc[4];
#pragma unroll
                for (int i = 0; i < 4; ++i) sc[i] = *(const u32x4*)(Q + (size_t)(t0 + i * 4 + fq) * D + h * 256 + p * 128 + fr * 8);
#pragma unroll
                for (int i = 0; i < 4; ++i) { LAS float* d = SL + (i * 4 + fq) * SC_LD + fr * 8;
                    *(LAS f32x4*)d = (f32x4){bflo(sc[i].x), bfhi(sc[i].x), bflo(sc[i].y), bfhi(sc[i].y)}; *(LAS f32x4*)(d + 4) = (f32x4){bflo(sc[i].z), bfhi(sc[i].z), bflo(sc[i].w), bfhi(sc[i].w)}; }
                asm volatile("" ::: "memory");
            }
            ER_LOAD();
#pragma unroll 1
            for (int j = 0; j < 4; ++j) {
                unsigned k[8];
#pragma unroll
                for (int nb = 0; nb < 8; ++nb) k[nb] = (f2key(SL[(fq * 4 + j) * SC_LD + nb * 16 + fr]) & ~127u) | (127u - (unsigned)(nb * 16 + fr));
                sort8_desc(k);
                const unsigned r = row_top16_sorted<8>(k, fr);
#pragma unroll
                for (int i = 0; i < 8; ++i) tk[i] = (i == p * 4 + j) ? r : tk[i];
            }
            ER_STORE();
        }
#pragma unroll 1
        for (int j = 0; j < 4; ++j) {
            if ((j & 1) == 0) ER_LOAD();
            const unsigned tk1 = j == 0 ? tk[0] : (j == 1 ? tk[1] : (j == 2 ? tk[2] : tk[3])), tk2 = j == 0 ? tk[4] : (j == 1 ? tk[5] : (j == 2 ? tk[6] : tk[7]));
            const float t1 = key2f(tk1 & ~127u), t2 = key2f(tk2 & ~127u); const int i1 = 127 - (int)(tk1 & 127u), i2 = 127 - (int)(tk2 & 127u);
            unsigned kc[4];
#pragma unroll
            for (int e = 0; e < 4; ++e) { const unsigned ab = (ctab >> (8 * e)) & 255u; const int ca = (int)(ab >> 4), cb = (int)(ab & 15u);
                const float c = __shfl(t1, (lane & 48) + ca) + __shfl(t2, (lane & 48) + cb);
                kc[e] = (ab == 255u) ? 0u : ((f2key(c) & ~255u) | (255u - ab)); }
            sort4_desc(kc);
            const unsigned tkc = row_top16_sorted<4>(kc, fr);
            const float ts = key2f(tkc & ~255u); const int ci = 255 - (int)(tkc & 255u);
            const int ia = __shfl(i1, (lane & 48) + (ci >> 4)), ib = __shfl(i2, (lane & 48) + (ci & 15));
            const float tmax = __shfl(ts, lane & 48);
            const float e = __expf(ts - tmax); float sum = e;
            sum += __shfl_xor(sum, 1); sum += __shfl_xor(sum, 2); sum += __shfl_xor(sum, 4); sum += __shfl_xor(sum, 8);
            const int t = t0 + fq * 4 + j;
            IDX[(size_t)t * 128 + h * 16 + fr] = ia * 128 + ib;
            GATE[(size_t)t * 128 + h * 16 + fr] = e / sum;
            if ((j & 1) == 1) ER_STORE();
        }
    }
    for (; erow < 2 * NEXP; erow += NGW) { expert_row_load(a.in[15 + (erow >= NEXP)] + (size_t)(erow & (NEXP - 1)) * D, er0, lane); if (erow < NEXP) expert_row_gain(er0, a.in[12], lane);
        expert_row_store(er0, a.ws + ((erow >= NEXP) ? WS_EV : WS_EU) + (size_t)(erow & (NEXP - 1)) * EROW, (float*)(a.ws + WS_ESC) + erow, lane); }
#undef ER_LOAD
#undef ER_STORE
}

typedef float f32x2 __attribute__((ext_vector_type(2)));
__device__ __forceinline__ u32x4 bl128(__amdgpu_buffer_rsrc_t r, unsigned voff, unsigned soff) { return __builtin_amdgcn_raw_buffer_load_b128(r, voff, soff, 0); }
__device__ __forceinline__ u32x2 bl64(__amdgpu_buffer_rsrc_t r, unsigned voff, unsigned soff) { return __builtin_amdgcn_raw_buffer_load_b64(r, voff, soff, 0); }
__device__ __forceinline__ unsigned bl32(__amdgpu_buffer_rsrc_t r, unsigned voff, unsigned soff) { return __builtin_amdgcn_raw_buffer_load_b32(r, voff, soff, 0); }
__device__ __forceinline__ float wave_sum_dpp(float v) {
    v = dpp_add_f32<0xB1>(v); v = dpp_add_f32<0x4E>(v); v = dpp_add_f32<0x141>(v); v = dpp_add_f32<0x140>(v);
    v += __builtin_bit_cast(float, __builtin_amdgcn_update_dpp(0, __builtin_bit_cast(int, v), 0x142, 0xA, 0xF, false));
    v += __builtin_bit_cast(float, __builtin_amdgcn_update_dpp(0, __builtin_bit_cast(int, v), 0x143, 0xC, 0xF, false));
    return __builtin_bit_cast(float, __builtin_amdgcn_readlane(__builtin_bit_cast(int, v), 63));
}
__device__ __forceinline__ float wave_sum_fast(float v) {
    v = dpp_add_f32<0xB1>(v); v = dpp_add_f32<0x4E>(v); v = dpp_add_f32<0x141>(v); v = dpp_add_f32<0x140>(v);
    v += __shfl_xor(v, 16); v += __shfl_xor(v, 32); return v;
}
constexpr int TPW = 4, NSL = 16, SL_SHIFT = 10, RING = 8, SLOT = 2048;
typedef __bf16 bf16x2_t __attribute__((ext_vector_type(2)));
__device__ __forceinline__ float dot2bf(unsigned a, unsigned b, float c) { return __builtin_amdgcn_fdot2_f32_bf16(__builtin_bit_cast(bf16x2_t, a), __builtin_bit_cast(bf16x2_t, b), c, false); }
constexpr int NROWS = TPW * 128;
#define P8_ISSUE(TBASE) do { const unsigned ro_ = (unsigned)__builtin_amdgcn_readlane(lch_, ii_ & 63) * (unsigned)EROW; \
        const char* src_ = (const char*)a.ws + (TBASE) + ro_; LAS unsigned char* dstl_ = ring + (ii_ & (RING - 1)) * SLOT; \
        __builtin_amdgcn_global_load_lds((const unsigned*)(src_ + l16), (LAS unsigned*)dstl_, 16, 0, 0); \
        __builtin_amdgcn_global_load_lds((const unsigned*)(src_ + l16b), (LAS unsigned*)(dstl_ + 1024), 16, 0, 0); \
        ++ii_; if ((ii_ & 63) == 0) lch_ = (int)LST[ii_ + lane]; } while (0)
#define P8_RING_READ(r0, r1) do { r0 = *(const LAS u32x4*)(ring + (ci_ & (RING - 1)) * SLOT + l16); r1 = *(const LAS u32x2*)(ring + (ci_ & (RING - 1)) * SLOT + 1024 + l8); } while (0)
#define P8_DECODE(r0, r1) __builtin_amdgcn_cvt_scalef32_pk32_f32_fp6((u32x6){r0.x, r0.y, r0.z, r0.w, r1.x, r1.y}, 1.0f)
#define P8_STREAM_INIT(TBASE, r0, r1) int ci_ = 0, ii_ = 0; int lch_ = (int)LST[lane]; \
        asm volatile("s_waitcnt vmcnt(0) lgkmcnt(0)" ::: "memory"); \
        _Pragma("unroll 1") for (int q_ = 0; q_ < RING; ++q_) P8_ISSUE(TBASE); \
        asm volatile("s_waitcnt vmcnt(14)" ::: "memory"); P8_RING_READ(r0, r1)
#define P8_ROW_READY() asm volatile("s_waitcnt lgkmcnt(0)" ::: "memory")
#define P8_ROW_ADVANCE(TBASE, r0, r1) do { ++ci_; P8_ISSUE(TBASE); asm volatile("s_waitcnt vmcnt(14)" ::: "memory"); P8_RING_READ(r0, r1); } while (0)
#define P8_STREAM_END() asm volatile("s_waitcnt vmcnt(0) lgkmcnt(0)" ::: "memory")
static_assert(RING == 8, "the counted wait above is vmcnt(2 * (RING - 1))");
__device__ __forceinline__ void p8_peer(const Args& a, LAS unsigned char* lds, float* dst, int vcu, int G, int wave, int lane_) {
    int lane = lane_; asm volatile("" : "+v"(lane));
    const __amdgpu_buffer_rsrc_t rws = __builtin_amdgcn_make_buffer_rsrc((void*)a.ws, (short)0, (int)WS_END, 0x00020000);
    const __amdgpu_buffer_rsrc_t rdst = __builtin_amdgcn_make_buffer_rsrc((void*)dst, (short)0, S * D * 4, 0x00020000);
    const __amdgpu_buffer_rsrc_t rfg = __builtin_amdgcn_make_buffer_rsrc((void*)a.in[17], (short)0, D * 4, 0x00020000);
    LAS unsigned char* ring = lds + wave * (RING * SLOT);
    LAS unsigned* SLW = (LAS unsigned*)(lds + 132096 + wave * 1280);
    LAS unsigned short* LST = (LAS unsigned short*)SLW;
    const int gw = vcu * NWAVES + wave, NGW = G * NWAVES;
    const unsigned l16 = (unsigned)lane * 16u, l8 = (unsigned)lane * 8u, l4 = (unsigned)lane * 4u;
    const unsigned l16b = 1024u + (unsigned)(lane & 31) * 16u;
#pragma unroll 1
    for (int tb = gw; tb < S; tb += TPW * NGW) {
        int sid[TPW][2], offv[TPW]; float act[TPW][2]; int cntv = 0;
#pragma unroll
        for (int k = 0; k < TPW; ++k) {
            const int t = (tb + k * NGW) < S ? (tb + k * NGW) : (S - 1);
            const unsigned oi = (unsigned)(WS_IDX + (size_t)t * 512);
            const int id0 = (int)bl32(rws, l4, oi), id1 = (int)bl32(rws, l4 + 256u, oi);
            const int sl0 = id0 >> SL_SHIFT, sl1 = id1 >> SL_SHIFT;
            int pos0 = 0, pos1 = 0, basec = 0, offacc = 0;
#pragma unroll
            for (int s = 0; s < NSL; ++s) {
                const unsigned long long m0 = __ballot(sl0 == s), m1 = __ballot(sl1 == s);
                const int c0 = __popcll(m0), c1 = __popcll(m1);
                const int b0 = (int)__builtin_amdgcn_mbcnt_hi((unsigned)(m0 >> 32), __builtin_amdgcn_mbcnt_lo((unsigned)m0, 0u));
                const int b1 = (int)__builtin_amdgcn_mbcnt_hi((unsigned)(m1 >> 32), __builtin_amdgcn_mbcnt_lo((unsigned)m1, 0u));
                pos0 = (sl0 == s) ? basec + b0 : pos0; pos1 = (sl1 == s) ? basec + c0 + b1 : pos1;
                basec += c0 + c1; offacc = (lane == s + 1) ? basec : offacc; cntv = (lane == s * TPW + k) ? (c0 + c1) : cntv;
            }
            offv[k] = offacc;
            SLW[pos0] = (unsigned)id0; SLW[pos1] = (unsigned)id1; SLW[128 + pos0] = (unsigned)lane; SLW[128 + pos1] = (unsigned)(64 + lane);
            asm volatile("s_waitcnt lgkmcnt(0)" ::: "memory");
            sid[k][0] = (int)SLW[lane]; sid[k][1] = (int)SLW[64 + lane];
            act[k][0] = __builtin_bit_cast(float, SLW[128 + lane]); act[k][1] = __builtin_bit_cast(float, SLW[192 + lane]);
            asm volatile("s_waitcnt lgkmcnt(0)" ::: "memory");
        }
        {
            int incl = cntv;
#pragma unroll
            for (int o = 1; o < 64; o <<= 1) { const int up = __shfl_up(incl, o); incl += (lane >= o) ? up : 0; }
            const int gb = incl - cntv;
            asm volatile("s_waitcnt lgkmcnt(0)" ::: "memory");
#pragma unroll
            for (int k = 0; k < TPW; ++k)
#pragma unroll
                for (int h = 0; h < 2; ++h) { const int sl = sid[k][h] >> SL_SHIFT;
                    const int p = __shfl(gb, sl * TPW + k) + (h * 64 + lane) - __shfl(offv[k], sl);
                    LST[p] = (unsigned short)sid[k][h]; }
            if (lane < RING) LST[NROWS + lane] = (unsigned short)0;
            asm volatile("s_waitcnt lgkmcnt(0)" ::: "memory");
        }
        int orig[TPW][2];
#pragma unroll
        for (int k = 0; k < TPW; ++k) { orig[k][0] = __builtin_bit_cast(int, act[k][0]); orig[k][1] = __builtin_bit_cast(int, act[k][1]); act[k][0] = 0.f; act[k][1] = 0.f; }
        {
            f32x2 hf[TPW][16];
#pragma unroll
            for (int k = 0; k < TPW; ++k) { const int t = (tb + k * NGW) < S ? (tb + k * NGW) : (S - 1);
#pragma unroll
                for (int kk = 0; kk < 8; ++kk) { const u32x2 w = bl64(rws, l8 + (unsigned)(kk * 512), (unsigned)(WS_XB + (size_t)t * (D * 2)));
                    hf[k][kk * 2] = (f32x2){bflo(w.x), bfhi(w.x)}; hf[k][kk * 2 + 1] = (f32x2){bflo(w.y), bfhi(w.y)}; } }
            u32x4 r0; u32x2 r1;
            P8_STREAM_INIT(WS_EU, r0, r1);
#pragma unroll 1
            for (int s = 0; s < NSL; ++s) {
#pragma unroll
                for (int k = 0; k < TPW; ++k) {
                    const int lo = __builtin_amdgcn_readlane(offv[k], s), hi = __builtin_amdgcn_readlane(offv[k], s + 1);
#pragma unroll 1
                    for (int e = lo; e < hi; ++e) {
                        P8_ROW_READY();
                        f32x2 dd0 = {0.f, 0.f}, dd1 = {0.f, 0.f};
                        { const f32x32 f = P8_DECODE(r0, r1);
#pragma unroll
                          for (int q = 0; q < 8; ++q) { dd0 = __builtin_elementwise_fma((f32x2){f[4 * q], f[4 * q + 1]}, hf[k][2 * q], dd0);
                              dd1 = __builtin_elementwise_fma((f32x2){f[4 * q + 2], f[4 * q + 3]}, hf[k][2 * q + 1], dd1); } }
                        asm volatile("" : "+v"(dd0), "+v"(dd1));
                        P8_ROW_ADVANCE(WS_EU, r0, r1);
                        const float d = wave_sum_dpp((dd0.x + dd0.y) + (dd1.x + dd1.y));
                        act[k][0] = (lane == e) ? d : act[k][0]; act[k][1] = (lane == e - 64) ? d : act[k][1];
                    }
                }
            }
            P8_STREAM_END();
        }
#pragma unroll
        for (int k = 0; k < TPW; ++k) {
            const int t = (tb + k * NGW) < S ? (tb + k * NGW) : (S - 1);
            const float ssp = lane < 32 ? __builtin_bit_cast(float, bl32(rws, l4, (unsigned)(WS_SS + (size_t)t * 128))) : 0.f;
            const float rstd2 = 1.0f / sqrtf(wave_sum(ssp) * (1.0f / D) + EPS);
            const unsigned og = (unsigned)(WS_GATE + (size_t)t * 512);
#pragma unroll
            for (int h = 0; h < 2; ++h) {
                const float gate = __builtin_bit_cast(float, bl32(rws, (unsigned)orig[k][h] * 4u, og));
                const float su = __builtin_bit_cast(float, bl32(rws, (unsigned)sid[k][h] * 4u, (unsigned)WS_ESC)) * rstd2;
                const float sv = __builtin_bit_cast(float, bl32(rws, (unsigned)sid[k][h] * 4u, (unsigned)(WS_ESC + NEXP * 4)));
                act[k][h] = gelu_tanh(act[k][h] * su) * gate * sv; }
        }
        {
            float acc[TPW][32];
#pragma unroll
            for (int k = 0; k < TPW; ++k)
#pragma unroll
                for (int i = 0; i < 32; ++i) acc[k][i] = 0.f;
            u32x4 r0; u32x2 r1;
            P8_STREAM_INIT(WS_EV, r0, r1);
#pragma unroll 1
            for (int s = 0; s < NSL; ++s) {
#pragma unroll
                for (int k = 0; k < TPW; ++k) {
                    const int lo = __builtin_amdgcn_readlane(offv[k], s), hi = __builtin_amdgcn_readlane(offv[k], s + 1);
#pragma unroll 1
                    for (int e = lo; e < hi; ++e) {
                        const int a0_ = __builtin_amdgcn_readlane(__builtin_bit_cast(int, act[k][0]), e & 63), a1_ = __builtin_amdgcn_readlane(__builtin_bit_cast(int, act[k][1]), e & 63);
                        const float aw = __builtin_bit_cast(float, e < 64 ? a0_ : a1_);
                        P8_ROW_READY();
                        { const f32x32 f = P8_DECODE(r0, r1);
#pragma unroll
                          for (int j = 0; j < 32; ++j) acc[k][j] += aw * f[j]; }
                        asm volatile("" : "+v"(acc[k][0]), "+v"(acc[k][16]));
                        P8_ROW_ADVANCE(WS_EV, r0, r1);
                    }
                }
            }
            P8_STREAM_END();
#pragma unroll
            for (int k = 0; k < TPW; ++k) { const int t = tb + k * NGW;
                if (t < S) {
                    float ss = 0.f; const unsigned ot = (unsigned)t * (unsigned)(D * 4);
#pragma unroll
                    for (int kk = 0; kk < 8; ++kk) { const u32x2 xw = bl64(rws, l8 + (unsigned)(kk * 512), (unsigned)(WS_XB + (size_t)t * (D * 2)));
                        acc[k][kk * 4 + 0] += bflo(xw.x); acc[k][kk * 4 + 1] += bfhi(xw.x); acc[k][kk * 4 + 2] += bflo(xw.y); acc[k][kk * 4 + 3] += bfhi(xw.y);
                        ss += (acc[k][kk * 4 + 0] * acc[k][kk * 4 + 0] + acc[k][kk * 4 + 1] * acc[k][kk * 4 + 1]) + (acc[k][kk * 4 + 2] * acc[k][kk * 4 + 2] + acc[k][kk * 4 + 3] * acc[k][kk * 4 + 3]); }
                    const float rstd = 1.0f / sqrtf(wave_sum(ss) * (1.0f / D) + EPS);
#pragma unroll
                    for (int kk = 0; kk < 8; ++kk) { const f32x4 f0 = __builtin_bit_cast(f32x4, bl128(rfg, l16 + (unsigned)((kk & 3) * 1024), (unsigned)((kk >> 2) * 4096)));
                        f32x4 o0; o0.x = acc[k][kk * 4 + 0] * rstd * f0.x; o0.y = acc[k][kk * 4 + 1] * rstd * f0.y; o0.z = acc[k][kk * 4 + 2] * rstd * f0.z; o0.w = acc[k][kk * 4 + 3] * rstd * f0.w;
                        __builtin_amdgcn_raw_buffer_store_b128(__builtin_bit_cast(u32x4, o0), rdst, l16 + (unsigned)((kk & 3) * 1024), ot + (unsigned)((kk >> 2) * 4096), 0); }
                }
            }
        }
    }
}

#define XB_TMO      128
#define XB_XCNT(j)  (256  + 64 * (j))
#define XB_XSUB(j)  (1280 + 64 * (j))
#define XB_XGEN(j)  (2304 + 64 * (j))
#define XB_TOP      3328
#define XB_TOPGEN   3392
#define XCD_BAR_WORDS 3456
#define XB_SPIN_CAP (1u << 22)
__device__ __forceinline__ unsigned xb_ld(unsigned* p)              { return __hip_atomic_load(p, __ATOMIC_RELAXED, __HIP_MEMORY_SCOPE_AGENT); }
__device__ __forceinline__ unsigned xb_add(unsigned* p, unsigned v) { return __hip_atomic_fetch_add(p, v, __ATOMIC_RELAXED, __HIP_MEMORY_SCOPE_AGENT); }
__device__ __forceinline__ unsigned xb_xcc_id() { return (unsigned)__builtin_amdgcn_s_getreg((3 << 11) | 20) & 0xFu; }
#define XB_SPIN(cond, bar) do { unsigned _sp = 0; while (cond) { __builtin_amdgcn_s_sleep(1); \
    if ((++_sp & 255u) == 0u) { if (xb_ld(&(bar)[XB_TMO])) break; if (_sp > XB_SPIN_CAP) { atomicAdd(&(bar)[XB_TMO], 1u); break; } } } } while (0)
struct XcdBarrier { unsigned* bar; unsigned x; volatile LAS unsigned* st; };
__device__ __forceinline__ XcdBarrier xcd_barrier_post(unsigned* bar, volatile LAS unsigned* st) {
    XcdBarrier b; b.bar = bar; b.x = xb_xcc_id(); b.st = st;
    if (threadIdx.x == 0) (void)xb_add(&bar[XB_XCNT(b.x)], 1u);
    return b;
}
__device__ __forceinline__ void xcd_barrier_complete(unsigned* bar, unsigned x, unsigned G, unsigned& nloc, unsigned& nx) {
    unsigned sum, cnt, mine, sp = 0u;
    for (;;) {
        sum = 0u; cnt = 0u; mine = 0u;
#pragma unroll
        for (unsigned j = 0; j < 16; ++j) { const unsigned c = xb_ld(&bar[XB_XCNT(j)]); sum += c; cnt += (c > 0u) ? 1u : 0u; mine = (j == x) ? c : mine; }
        if (sum == G) break;
        __builtin_amdgcn_s_sleep(1);
        if ((++sp & 255u) == 0u) { if (xb_ld(&bar[XB_TMO])) break; if (sp > XB_SPIN_CAP) { atomicAdd(&bar[XB_TMO], 1u); break; } }
    }
    nloc = mine > 0u ? mine : 1u; nx = cnt > 0u ? cnt : 1u;
}
__device__ __forceinline__ void xcd_barrier(const XcdBarrier& b, unsigned G) {
    asm volatile("s_waitcnt vmcnt(0)" ::: "memory");
    __syncthreads();
    if (threadIdx.x == 0) {
        unsigned* bar = b.bar;
        __builtin_amdgcn_s_waitcnt(0);
        unsigned nloc = b.st[0], nx = b.st[1];
        if (nloc == 0u) { xcd_barrier_complete(bar, b.x, G, nloc, nx); b.st[0] = nloc; b.st[1] = nx; }
        const unsigned old = xb_add(&bar[XB_XSUB(b.x)], 1u);
        const unsigned gen = old / nloc;
        if (old + 1u == (gen + 1u) * nloc) {
            __builtin_amdgcn_fence(__ATOMIC_RELEASE, "agent");
            asm volatile("s_waitcnt vmcnt(0)" ::: "memory");
            const unsigned og = xb_add(&bar[XB_TOP], 1u);
            const unsigned tg = og / nx;
            if (og + 1u == (tg + 1u) * nx) xb_add(&bar[XB_TOPGEN], 1u);
            else XB_SPIN(xb_ld(&bar[XB_TOPGEN]) == tg, bar);
            __builtin_amdgcn_fence(__ATOMIC_ACQUIRE, "agent");
            xb_add(&bar[XB_XGEN(b.x)], 1u);
            asm volatile("s_waitcnt vmcnt(0)" ::: "memory");
        } else {
            XB_SPIN(xb_ld(&bar[XB_XGEN(b.x)]) == gen, bar);
            __builtin_amdgcn_fence(__ATOMIC_ACQUIRE, "agent");
            asm volatile("s_waitcnt vmcnt(0)" ::: "memory");
        }
    }
    __syncthreads();
}

constexpr int N_PHASES = 9;
#ifndef DUP_MASK
#define DUP_MASK 0
#endif
#define REP(k) for (int rep_ = 0; rep_ < 1 + ((DUP_MASK >> (k)) & 1); ++rep_)
__global__ void __launch_bounds__(NTHR, 2) fwd(Args args) {
    extern __shared__ __attribute__((aligned(16))) unsigned char lds_raw[];
    LAS unsigned char* lds = (LAS unsigned char*)lds_raw;
    const int tid = threadIdx.x, lane = tid & 63, wave = __builtin_amdgcn_readfirstlane(tid >> 6);
    const int G = gridDim.x; const int bx = blockIdx.x; const int vcu = (G % 8 == 0) ? (bx % 8) * (G / 8) + bx / 8 : bx;
    unsigned char* ws = args.ws;
    const int lo = args.ph_lo, hi = args.ph_hi;
#define IN(k) (lo <= (k) && (k) < hi)
    volatile LAS unsigned* MISC = (volatile LAS unsigned*)(lds + MISC_OFF);
    if (tid < 32) MISC[tid] = 0u;
    __syncthreads();
#if USE_CG_SYNC
    if (IN(0) && bx * NTHR + tid < XCD_BAR_WORDS) __hip_atomic_store((unsigned*)(ws + WS_CTL) + bx * NTHR + tid, 0u, __ATOMIC_RELAXED, __HIP_MEMORY_SCOPE_AGENT);
    XcdBarrier bar; bar.bar = (unsigned*)(ws + WS_CTL); bar.x = 0; bar.st = MISC + 8;
#else
    XcdBarrier bar = xcd_barrier_post((unsigned*)(ws + WS_CTL), MISC + 8);
#endif
#if USE_CG_SYNC
#define SEAM(k) do { if (IN(k) && IN((k) + ((k) == 4 ? 2 : 1))) { if ((k) == 0) { cg::this_grid().sync(); bar = xcd_barrier_post((unsigned*)(ws + WS_CTL), MISC + 8); } else xcd_barrier(bar, (unsigned)G); } } while (0)
#else
#define SEAM(k) do { if (IN(k) && IN((k) + ((k) == 4 ? 2 : 1))) { xcd_barrier(bar, (unsigned)G); } } while (0)
#endif

    if (IN(0)) REP(0) { p0_prologue(args, lds, vcu, G, wave, lane, tid); }
    SEAM(0);
    constexpr int P1_TILES = 24;
    if (IN(1)) REP(1) {
        pg8::Gemm g{(const bf16_t*)(ws + WS_H), (const bf16_t*)(ws + WS_WIN), S, P1_TILES * 256, D, D, D, 0}; pg8::StaticOrder so; so.init(S, P1_TILES * 256, G, bx);
        pg8::EpiZ E{(bf16_t*)(ws + WS_Z), args.in[3]};
        pg8::gemm_phase<pg8::EpiZ>(lds, g, so, E);
    }
    SEAM(1);
    if (IN(2)) REP(2) {
        const int G2 = G / 2;
        if (G2 >= 1 && bx < G2) {
            pg8::Gemm g{(const bf16_t*)(ws + WS_H), (const bf16_t*)(ws + WS_WIN), S, INW, D, D, D, 0}; pg8::StaticOrder so; so.init(S, (28 - P1_TILES) * 256, G2, bx, P1_TILES);
            pg8::EpiZ E{(bf16_t*)(ws + WS_Z), args.in[3]};
            pg8::gemm_phase<pg8::EpiZ>(lds, g, so, E);
        } else {
            for (int bi = bx - G2; bi < 128; bi += G - G2) { const int it0 = (bi >> 1) * 8 + (bi & 1) * 4; p2_sgu(args, lds, it0, it0 + 4, 1, wave, lane, tid); }
        }
        p2_pool(args, vcu, G, tid);
    }
    SEAM(2);
    if (IN(3)) REP(3) {
        pg8::StaticOrder so; so.init(S, D, G, bx);
        { pg8::Gemm g{(const bf16_t*)(ws + WS_A2), (const bf16_t*)(ws + WS_WPOOL), S, D, 256, D, 256, 1};
          pg8::EpiPool E{(bf16_t*)(ws + WS_T), (const bf16_t*)(ws + WS_Z)};
          pg8::gemm_phase<pg8::EpiPool>(lds, g, so, E); }
        asm volatile("s_waitcnt vmcnt(0)" ::: "memory"); __syncthreads();
        { pg8::Gemm g{(const bf16_t*)(ws + WS_A2) + 1024, (const bf16_t*)(ws + WS_WG), S, D, GWD, D, GWD, 0};
          pg8::EpiMerge E{(const bf16_t*)(ws + WS_T), (const bf16_t*)(ws + WS_Z), (bf16_t*)(ws + WS_MRG)};
          pg8::gemm_phase<pg8::EpiMerge>(lds, g, so, E); }
    }
    SEAM(3);
    if (IN(4)) REP(4) {
        pg8::Gemm g{(const bf16_t*)(ws + WS_MRG), (const bf16_t*)(ws + WS_WOUT), S, D, D, D, D, 0}; pg8::StaticOrder so; so.init(S, D, G, bx);
        pg8::EpiX1 E{args.in[0], (bf16_t*)(ws + WS_XB), (float*)(ws + WS_SS)};
        pg8::gemm_phase<pg8::EpiX1>(lds, g, so, E);
    }
    SEAM(4);
    if (IN(6)) REP(6) {
        pg8::Gemm g{(const bf16_t*)(ws + WS_XB), (const bf16_t*)(ws + WS_WQ), S, D, D, D, D, 0}; pg8::StaticOrder so; so.init(S, D, G, bx);
        pg8::EpiQ E{(bf16_t*)(ws + WS_Q), (const float*)(ws + WS_SS)};
        pg8::gemm_phase<pg8::EpiQ>(lds, g, so, E);
    }
    if (IN(6) && IN(7)) { asm volatile("s_waitcnt vmcnt(0)" ::: "memory"); __syncthreads(); }
    if (IN(7)) REP(7) { p7_topk(args, lds, vcu, G, wave, lane); }
    SEAM(7);
    if (IN(8)) REP(8) { float* dst8 = (rep_ < ((DUP_MASK >> 8) & 1)) ? (float*)(ws + WS_T) : args.out; p8_peer(args, lds, dst8, vcu, G, wave, lane); }
#undef IN
#undef SEAM
}

extern "C" void kernel_launch(void* const* d_in, const int* in_sizes, int n_in, void* d_out, int out_size, void* d_ws, size_t ws_size, hipStream_t stream) {
    static int grid = 0;
    if (grid == 0) {
        if (n_in != 18 || out_size != S * D || ws_size < WS_END) { fprintf(stderr, "kernel_launch: unexpected shapes (n_in %d, out %d, ws %zu)\n", n_in, out_size, ws_size); grid = -1; return; }
        int dev = 0, cus = 0, per_cu = 0;
        if (hipGetDevice(&dev) != hipSuccess || hipDeviceGetAttribute(&cus, hipDeviceAttributeMultiprocessorCount, dev) != hipSuccess) { grid = -1; return; }
        if (hipFuncSetAttribute((const void*)fwd, hipFuncAttributeMaxDynamicSharedMemorySize, LDS_BYTES) != hipSuccess) { fprintf(stderr, "kernel_launch: hipFuncSetAttribute failed\n"); grid = -1; return; }
        if (hipOccupancyMaxActiveBlocksPerMultiprocessor(&per_cu, (const void*)fwd, NTHR, LDS_BYTES) != hipSuccess || per_cu < 1) { fprintf(stderr, "kernel_launch: occupancy query says %d\n", per_cu); per_cu = 1; }
        (void)hipGetLastError();
        grid = cus;
    }
    if (grid < 0) return;
#if !USE_CG_SYNC
    if (hipMemsetAsync((char*)d_ws + WS_CTL, 0, 16384, stream) != hipSuccess) { fprintf(stderr, "kernel_launch: memset failed\n"); return; }
#endif
    Args a{};
    for (int i = 0; i < 18; ++i) a.in[i] = (const float*)d_in[i];
    a.out = (float*)d_out; a.ws = (unsigned char*)d_ws;
#if MK_N_LAUNCHES == 1
    a.ph_lo = 0; a.ph_hi = N_PHASES;
    void* kargs[] = {&a};
    hipError_t e = hipLaunchCooperativeKernel((const void*)fwd, dim3(grid), dim3(NTHR), kargs, LDS_BYTES, stream);
    if (e != hipSuccess) fprintf(stderr, "kernel_launch: cooperative launch failed: %s (grid %d)\n", hipGetErrorString(e), grid);
#else
    for (int p = 0; p < N_PHASES; ++p) {
        a.ph_lo = p; a.ph_hi = p + 1;
        hipLaunchKernelGGL(fwd, dim3(grid), dim3(NTHR), LDS_BYTES, stream, a);
    }
#endif
}
```

```cpp
#include <hip/hip_runtime.h>
#include <hip/hip_cooperative_groups.h>
#include <cstdio>
#include <cstdint>
namespace cg = cooperative_groups;

#ifndef USE_CG_SYNC
#define USE_CG_SYNC 1
#endif
#ifndef MK_N_LAUNCHES
#define MK_N_LAUNCHES 1
#endif

#define LAS __attribute__((address_space(3)))
typedef unsigned short bf16_t;
typedef short bf16x8 __attribute__((ext_vector_type(8)));
typedef float f32x4 __attribute__((ext_vector_type(4)));
typedef unsigned u32x4 __attribute__((ext_vector_type(4)));
typedef unsigned u32x2 __attribute__((ext_vector_type(2)));

constexpr int S = 8192, D = 2048, INW = 7168, PW = 1024, GWD = 1024;
constexpr int NEXP = 16384;
constexpr float EPS = 1e-6f;
constexpr int NWAVES = 8, NTHR = 512;

constexpr size_t MiB = 1u << 20;
constexpr size_t WS_CTL = 0;
constexpr size_t WS_WIN = 1 * MiB;
constexpr size_t WS_WPOOL = 30 * MiB;
constexpr size_t WS_WG = 31 * MiB;
constexpr size_t WS_WOUT = 35 * MiB;
constexpr size_t WS_WQ = 43 * MiB;
constexpr size_t WS_KEYS = 51 * MiB;
constexpr size_t WS_WSM = 52 * MiB;
constexpr size_t WS_H = 53 * MiB;
constexpr size_t WS_Z = 85 * MiB;
constexpr size_t WS_A2 = 197 * MiB;
constexpr size_t WS_T = 229 * MiB;
constexpr size_t WS_MRG = 293 * MiB;
constexpr size_t WS_Q = 325 * MiB;
constexpr size_t WS_IDX = 357 * MiB;
constexpr size_t WS_GATE = 361 * MiB;
constexpr size_t WS_SS = 365 * MiB;
constexpr size_t WS_ESC = 369 * MiB;
constexpr size_t WS_EU = 370 * MiB;
constexpr size_t WS_EV = 402 * MiB;
constexpr size_t WS_XB = 434 * MiB;
constexpr size_t WS_END = 466 * MiB;

constexpr int LDS_BYTES = 147456;
constexpr int MISC_OFF = 131072 + 320;

__device__ __forceinline__ unsigned f2bf(float f) { unsigned u = __builtin_bit_cast(unsigned, f); return (u + 0x7fffu + ((u >> 16) & 1u)) >> 16; }
__device__ __forceinline__ unsigned pk2(float lo, float hi) { return f2bf(lo) | (f2bf(hi) << 16); }
__device__ __forceinline__ float bflo(unsigned w) { return __builtin_bit_cast(float, w << 16); }
__device__ __forceinline__ float bfhi(unsigned w) { return __builtin_bit_cast(float, w & 0xffff0000u); }
__device__ __forceinline__ float wave_sum(float v) {
#pragma unroll
    for (int o = 1; o < 64; o <<= 1) v += __shfl_xor(v, o);
    return v;
}
template <int CTRL> __device__ __forceinline__ float dpp_add_f32(float v) { return v + __builtin_bit_cast(float, __builtin_amdgcn_update_dpp(0, __builtin_bit_cast(int, v), CTRL, 0xF, 0xF, true)); }
__device__ __forceinline__ float row_sum_f32(float v) { v = dpp_add_f32<0xB1>(v); v = dpp_add_f32<0x4E>(v); v = dpp_add_f32<0x141>(v); v = dpp_add_f32<0x140>(v); return v; }
__device__ __forceinline__ float gelu_tanh(float x) {
    const float y = 1.5957691216057308f * (x + 0.044715f * x * x * x);
    const float e = __builtin_amdgcn_exp2f(-y * 1.4426950408889634f);
    return x * __builtin_amdgcn_rcpf(1.0f + e);
}
__device__ __forceinline__ float sigmoidf_(float x) { return __builtin_amdgcn_rcpf(1.0f + __builtin_amdgcn_exp2f(-x * 1.4426950408889634f)); }

namespace pg8 {
constexpr int BM = 256, BK = 64, HALF = 128, HTB = HALF * BK * 2, STAGE_BYTES = 8 * HTB, NXCD = 8, WGM = 1;
__host__ __device__ __forceinline__ int lds_byte(int r, int c) { const int st = (r >> 4) * 2 + (c >> 5), rr = r & 15, cc = c & 31, ob = rr * 64 + cc * 2; return st * 1024 + (ob ^ (((ob >> 9) & 1) << 5)); }
__host__ __device__ __forceinline__ void stage_rc(int b, int& R, int& C) { const int st = b / 1024, sb = b % 1024, swz = sb ^ (((sb >> 9) & 1) << 5); R = (st >> 1) * 16 + swz / 64; C = (st & 1) * 32 + (swz % 64) / 2; }
__host__ __device__ __forceinline__ int perm32(int rho) { const int n = rho >> 4, i = rho & 15; return 8 * (i >> 2) + 4 * n + (i & 3); }

struct Unit { int pm, pn; };
struct Gemm { const bf16_t* A; const bf16_t* Bt; int M, N, K, lda, ldb, mode; };
__device__ __forceinline__ const char* a_ptr(const Gemm& g, const Unit& u) {
    size_t off = (size_t)u.pm * BM * g.lda; if (g.mode == 1) off += (size_t)(u.pn >> 1) * 256; return (const char*)(g.A + off); }
__device__ __forceinline__ const char* b_ptr(const Gemm& g, const Unit& u) {
    size_t off = (g.mode == 1) ? ((size_t)(u.pn >> 1) * 512 * 256 + (size_t)(u.pn & 1) * 256 * 256) : (size_t)u.pn * BM * g.ldb; return (const char*)(g.Bt + off); }

struct StaticOrder {
    int nM, nN, nwg, G, c, pn0;
    __host__ __device__ void init(int M, int N, int G_, int c_, int pn0_ = 0) { nM = M / BM; nN = N / BM; nwg = nM * nN; G = G_; c = c_; pn0 = pn0_; }
    __host__ __device__ bool next(int i, Unit& u) const {
        const long L = (long)i * G + c; if (L >= nwg) return false;
        int wgid = (int)L; { const int q = nwg / NXCD, r = nwg % NXCD, xcd = wgid % NXCD, off = wgid / NXCD; wgid = (xcd < r ? xcd * (q + 1) : r * (q + 1) + (xcd - r) * q) + off; }
        const int nig = WGM * nN, gid = wgid / nig, fm = gid * WGM, gsz = (nM - fm) < WGM ? (nM - fm) : WGM;
        u.pm = fm + ((wgid % nig) % gsz); u.pn = pn0 + (wgid % nig) / gsz; return true;
    }
};

__device__ __forceinline__ unsigned cvt_pk_bf16(float lo, float hi) { unsigned r; asm volatile("v_cvt_pk_bf16_f32 %0, %1, %2" : "=v"(r) : "v"(lo), "v"(hi)); return r; }


struct EpiZ {
    static constexpr bool PERM = true;
    bf16_t* Z; const float* b_gate;
    __device__ __forceinline__ void operator()(const f32x4 (&acc)[2][2][4][2], const Unit& u, int wr, int wc, int fr, int fq) const {
        const int row0 = u.pm * BM + wr * 64 + fr, col0 = u.pn * BM + wc * 32 + 8 * fq;
        const int mode = u.pn < 4 ? 0 : (u.pn < 12 ? 1 : 2);
        f32x4 bv[2][2];
#pragma unroll
        for (int bj = 0; bj < 2; ++bj)
#pragma unroll
            for (int n = 0; n < 2; ++n) bv[bj][n] = (mode == 2) ? *(const f32x4*)(b_gate + (col0 - 3072) + bj * HALF + 4 * n) : (f32x4){0.f, 0.f, 0.f, 0.f};
#pragma unroll
        for (int ai = 0; ai < 2; ++ai)
#pragma unroll
            for (int m = 0; m < 4; ++m) { bf16_t* rowp = Z + (size_t)(row0 + ai * HALF + m * 16) * INW + col0;
#pragma unroll
                for (int bj = 0; bj < 2; ++bj) { f32x4 v0 = acc[ai][bj][m][0], v1 = acc[ai][bj][m][1];
                    if (mode == 1) {
#pragma unroll
                        for (int j = 0; j < 4; ++j) { v0[j] = gelu_tanh(v0[j]); v1[j] = gelu_tanh(v1[j]); } }
                    if (mode == 2) { v0 += bv[bj][0]; v1 += bv[bj][1];
#pragma unroll
                        for (int j = 0; j < 4; ++j) { v0[j] = sigmoidf_(v0[j]); v1[j] = sigmoidf_(v1[j]); } }
                    u32x4 w; w.x = cvt_pk_bf16(v0[0], v0[1]); w.y = cvt_pk_bf16(v0[2], v0[3]); w.z = cvt_pk_bf16(v1[0], v1[1]); w.w = cvt_pk_bf16(v1[2], v1[3]);
                    *(u32x4*)(rowp + bj * HALF) = w; } }
    }
};
struct EpiPool {
    static constexpr bool PERM = true;
    bf16_t* T; const bf16_t* Z;
    __device__ __forceinline__ void operator()(const f32x4 (&acc)[2][2][4][2], const Unit& u, int wr, int wc, int fr, int fq) const {
        const int row0 = u.pm * BM + wr * 64 + fr, col0 = u.pn * BM + wc * 32 + 8 * fq;
#pragma unroll
        for (int ai = 0; ai < 2; ++ai)
#pragma unroll
            for (int m = 0; m < 4; ++m) { const size_t row = (size_t)(row0 + ai * HALF + m * 16);
#pragma unroll
                for (int bj = 0; bj < 2; ++bj) { const int c = col0 + bj * HALF;
                    const u32x4 g = *(const u32x4*)(Z + row * INW + 3072 + c);
                    const f32x4 a0 = acc[ai][bj][m][0], a1 = acc[ai][bj][m][1];
                    u32x4 w; w.x = cvt_pk_bf16(bflo(g.x) * a0[0], bfhi(g.x) * a0[1]); w.y = cvt_pk_bf16(bflo(g.y) * a0[2], bfhi(g.y) * a0[3]);
                    w.z = cvt_pk_bf16(bflo(g.z) * a1[0], bfhi(g.z) * a1[1]); w.w = cvt_pk_bf16(bflo(g.w) * a1[2], bfhi(g.w) * a1[3]);
                    *(u32x4*)(T + row * D + c) = w; asm volatile("" ::: "memory"); } }
    }
};
struct EpiMerge {
    static constexpr bool PERM = true;
    const bf16_t* T; const bf16_t* Z; bf16_t* O;
    __device__ __forceinline__ void operator()(const f32x4 (&acc)[2][2][4][2], const Unit& u, int wr, int wc, int fr, int fq) const {
        const int row0 = u.pm * BM + wr * 64 + fr, col0 = u.pn * BM + wc * 32 + 8 * fq;
#pragma unroll
        for (int ai = 0; ai < 2; ++ai)
#pragma unroll
            for (int m = 0; m < 4; ++m) { const size_t row = (size_t)(row0 + ai * HALF + m * 16);
#pragma unroll
                for (int bj = 0; bj < 2; ++bj) { const int c = col0 + bj * HALF;
                    const u32x4 g = *(const u32x4*)(Z + row * INW + 5120 + c);
                    const u32x4 t = *(const u32x4*)(T + row * D + c);
                    const f32x4 a0 = acc[ai][bj][m][0], a1 = acc[ai][bj][m][1];
                    u32x4 w; w.x = cvt_pk_bf16(bflo(t.x) + bflo(g.x) * a0[0], bfhi(t.x) + bfhi(g.x) * a0[1]); w.y = cvt_pk_bf16(bflo(t.y) + bflo(g.y) * a0[2], bfhi(t.y) + bfhi(g.y) * a0[3]);
                    w.z = cvt_pk_bf16(bflo(t.z) + bflo(g.z) * a1[0], bfhi(t.z) + bfhi(g.z) * a1[1]); w.w = cvt_pk_bf16(bflo(t.w) + bflo(g.w) * a1[2], bfhi(t.w) + bfhi(g.w) * a1[3]);
                    *(u32x4*)(O + row * D + c) = w; asm volatile("" ::: "memory"); } }
    }
};
struct EpiX1 {
    static constexpr bool PERM = true;
    const float* X; bf16_t* XB; float* SS;
    __device__ __forceinline__ void operator()(const f32x4 (&acc)[2][2][4][2], const Unit& u, int wr, int wc, int fr, int fq) const {
        const int row0 = u.pm * BM + wr * 64 + fr, col0 = u.pn * BM + wc * 32 + 8 * fq;
#pragma unroll
        for (int ai = 0; ai < 2; ++ai)
#pragma unroll
            for (int m = 0; m < 4; ++m) { const size_t row = (size_t)(row0 + ai * HALF + m * 16); float ss = 0.f;
#pragma unroll
                for (int bj = 0; bj < 2; ++bj) { const size_t off = row * D + col0 + bj * HALF;
                    const f32x4 x0 = *(const f32x4*)(X + off) + acc[ai][bj][m][0], x1 = *(const f32x4*)(X + off + 4) + acc[ai][bj][m][1];
                    ss += (x0[0] * x0[0] + x0[1] * x0[1]) + (x0[2] * x0[2] + x0[3] * x0[3]) + (x1[0] * x1[0] + x1[1] * x1[1]) + (x1[2] * x1[2] + x1[3] * x1[3]);
                    u32x4 w; w.x = cvt_pk_bf16(x0[0], x0[1]); w.y = cvt_pk_bf16(x0[2], x0[3]); w.z = cvt_pk_bf16(x1[0], x1[1]); w.w = cvt_pk_bf16(x1[2], x1[3]);
                    *(u32x4*)(XB + off) = w; }
                ss += __shfl_xor(ss, 16); ss += __shfl_xor(ss, 32);
                if (fq == 0) SS[row * 32 + u.pn * 4 + wc] = ss;
                asm volatile("" ::: "memory"); }
    }
};
struct EpiQ {
    static constexpr bool PERM = true;
    bf16_t* O; const float* SS;
    __device__ __forceinline__ void operator()(const f32x4 (&acc)[2][2][4][2], const Unit& u, int wr, int wc, int fr, int fq) const {
        const int row0 = u.pm * BM + wr * 64 + fr, col0 = u.pn * BM + wc * 32 + 8 * fq;
#pragma unroll
        for (int ai = 0; ai < 2; ++ai)
#pragma unroll
            for (int m = 0; m < 4; ++m) { const size_t row = (size_t)(row0 + ai * HALF + m * 16);
                const f32x4 p0 = *(const f32x4*)(SS + row * 32 + fq * 8), p1 = *(const f32x4*)(SS + row * 32 + fq * 8 + 4);
                float ss = ((p0[0] + p0[1]) + (p0[2] + p0[3])) + ((p1[0] + p1[1]) + (p1[2] + p1[3]));
                ss += __shfl_xor(ss, 16); ss += __shfl_xor(ss, 32);
                const float rstd = 1.0f / sqrtf(ss * (1.0f / D) + EPS);
                bf16_t* rowp = O + row * D + col0;
#pragma unroll
                for (int bj = 0; bj < 2; ++bj) { const f32x4 v0 = acc[ai][bj][m][0] * rstd, v1 = acc[ai][bj][m][1] * rstd;
                    u32x4 w; w.x = cvt_pk_bf16(v0[0], v0[1]); w.y = cvt_pk_bf16(v0[2], v0[3]); w.z = cvt_pk_bf16(v1[0], v1[1]); w.w = cvt_pk_bf16(v1[2], v1[3]);
                    *(u32x4*)(rowp + bj * HALF) = w; } }
    }
};

template <class Epi, bool ALIGN_EPI = true>
__device__ __forceinline__ void gemm_phase(LAS unsigned char* lds, const Gemm g, const StaticOrder& S_, const Epi& E) {
    int tid_ = threadIdx.x; asm volatile("" : "+v"(tid_));
    const int tid = tid_, wid = __builtin_amdgcn_readfirstlane(tid >> 6), lane = tid & 63, wr = wid >> 2, wc = wid & 3, fr = lane & 15, fq = lane >> 4;
    const int K = g.K, nt = K / BK;
    unsigned voffA[2], voffB[2];
#pragma unroll
    for (int i = 0; i < 2; ++i) { int R, C; stage_rc(tid * 16 + i * 8192, R, C); const int Rb = Epi::PERM ? ((R & ~31) + perm32(R & 31)) : R;
        voffA[i] = (unsigned)(R * g.lda + C) * 2u; voffB[i] = (unsigned)(Rb * g.ldb + C) * 2u; }
    const size_t kstep = (size_t)(BK * 2);
    const size_t hstepA = (size_t)HALF * g.lda * 2, hstepB = (size_t)HALF * g.ldb * 2;
    const unsigned ldsw = (unsigned)wid * 1024u;
    const int aoff = lds_byte(wr * 64 + fr, fq * 8), boff = lds_byte(wc * 32 + fr, fq * 8);
#define PG8_SA(b, h) (((b) * 2 + (h)) * HTB)
#define PG8_SB(b, h) ((4 + (b) * 2 + (h)) * HTB)
#define PG8_STAGE(bufoff, gbase, voff) do { _Pragma("unroll") for (int _i = 0; _i < 2; ++_i) \
        __builtin_amdgcn_global_load_lds((const unsigned*)((const char*)(gbase) + (voff)[_i]), (LAS unsigned*)(lds + (bufoff) + ldsw + _i * 8192), 16, 0, 0); } while (0)
#define PG8_LDA(dst, b, h) do { _Pragma("unroll") for (int m = 0; m < 4; ++m) _Pragma("unroll") for (int k = 0; k < 2; ++k) dst[m][k] = *(const LAS bf16x8*)(lds + PG8_SA(b, h) + aoff + m * 2048 + k * 1024); } while (0)
#define PG8_LDB(dst, b, h) do { _Pragma("unroll") for (int n = 0; n < 2; ++n) _Pragma("unroll") for (int k = 0; k < 2; ++k) dst[n][k] = *(const LAS bf16x8*)(lds + PG8_SB(b, h) + boff + n * 2048 + k * 1024); } while (0)
#define PG8_MMA(ai, bj, At, Bt) do { __builtin_amdgcn_s_setprio(1); _Pragma("unroll") for (int m = 0; m < 4; ++m) _Pragma("unroll") for (int n = 0; n < 2; ++n) _Pragma("unroll") for (int k = 0; k < 2; ++k) \
        acc[ai][bj][m][n] = __builtin_amdgcn_mfma_f32_16x16x32_bf16(Bt[n][k], At[m][k], acc[ai][bj][m][n], 0, 0, 0); __builtin_amdgcn_s_setprio(0); } while (0)
#define PG8_WAIT_V(n) asm volatile("s_waitcnt vmcnt(" #n ")" ::: "memory")
#define PG8_WAIT_L(n) asm volatile("s_waitcnt lgkmcnt(" #n ")" ::: "memory")
#define PG8_BAR __builtin_amdgcn_s_barrier()
#define PG8_SCHED __builtin_amdgcn_sched_barrier(0)
    Unit cur, nxt; int ui = 0;
    if (!S_.next(0, cur)) return;
    f32x4 acc[2][2][4][2];
#pragma unroll
    for (int a = 0; a < 2; ++a)
#pragma unroll
        for (int b = 0; b < 2; ++b)
#pragma unroll
            for (int m = 0; m < 4; ++m)
#pragma unroll
                for (int n = 0; n < 2; ++n) acc[a][b][m][n] = (f32x4){0.f, 0.f, 0.f, 0.f};
    bf16x8 At[4][2], B0[2][2], B1[2][2];
    const char* cA = a_ptr(g, cur); const char* cB = b_ptr(g, cur);
    PG8_STAGE(PG8_SB(0, 0), cB, voffB); PG8_STAGE(PG8_SB(0, 1), cB + hstepB, voffB); PG8_STAGE(PG8_SA(0, 0), cA, voffA); PG8_STAGE(PG8_SA(0, 1), cA + hstepA, voffA);
    if (wr == 1) PG8_BAR;
    PG8_WAIT_V(2); PG8_BAR;
    PG8_STAGE(PG8_SB(1, 0), cB + kstep, voffB); PG8_STAGE(PG8_SA(1, 0), cA + kstep, voffA); PG8_STAGE(PG8_SB(1, 1), cB + hstepB + kstep, voffB);
    PG8_WAIT_V(6); PG8_BAR;
    for (;;) {
        const bool has_next = S_.next(ui + 1, nxt);
        const char* nA = has_next ? a_ptr(g, nxt) : cA; const char* nB = has_next ? b_ptr(g, nxt) : cB;
        for (int t = 0; t < nt; t += 2) {
            const bool last = (t == nt - 2);
            const char* a1 = cA + (size_t)(t + 1) * kstep;
            const char* a2 = last ? nA : cA + (size_t)(t + 2) * kstep; const char* b2 = last ? nB : cB + (size_t)(t + 2) * kstep;
            const char* a3 = a2 + kstep; const char* b3 = b2 + kstep;
            PG8_LDB(B0, 0, 0); PG8_LDB(B1, 0, 1); PG8_SCHED; PG8_LDA(At, 0, 0); PG8_STAGE(PG8_SA(1, 1), a1 + hstepA, voffA);
            PG8_WAIT_V(8); PG8_WAIT_L(0); PG8_BAR; PG8_MMA(0, 0, At, B0); PG8_MMA(0, 1, At, B1); PG8_BAR; PG8_SCHED;
            PG8_LDA(At, 0, 1); PG8_STAGE(PG8_SB(0, 0), b2, voffB); PG8_STAGE(PG8_SB(0, 1), b2 + hstepB, voffB); PG8_STAGE(PG8_SA(0, 0), a2, voffA);
            PG8_WAIT_V(8); PG8_WAIT_L(0); PG8_BAR; PG8_MMA(1, 0, At, B0); PG8_MMA(1, 1, At, B1); PG8_BAR; PG8_SCHED;
            PG8_LDB(B0, 1, 0); PG8_LDB(B1, 1, 1); PG8_SCHED; PG8_LDA(At, 1, 0); PG8_STAGE(PG8_SA(0, 1), a2 + hstepA, voffA);
            PG8_WAIT_V(8); PG8_WAIT_L(0); PG8_BAR; PG8_MMA(0, 0, At, B0); PG8_MMA(0, 1, At, B1); PG8_BAR; PG8_SCHED;
            PG8_LDA(At, 1, 1); PG8_STAGE(PG8_SB(1, 0), b3, voffB); PG8_STAGE(PG8_SB(1, 1), b3 + hstepB, voffB); PG8_STAGE(PG8_SA(1, 0), a3, voffA);
            PG8_WAIT_V(8); PG8_WAIT_L(0); PG8_BAR; PG8_MMA(1, 0, At, B0); PG8_MMA(1, 1, At, B1); PG8_BAR; PG8_SCHED;
        }
        if constexpr (ALIGN_EPI) { if (wr == 0) PG8_BAR; }
        { int ln_ = threadIdx.x & 63; asm volatile("" : "+v"(ln_));
          E(acc, cur, wr, wc, ln_ & 15, ln_ >> 4); }
        if (!has_next) break;
#pragma unroll
        for (int a = 0; a < 2; ++a)
#pragma unroll
            for (int b = 0; b < 2; ++b)
#pragma unroll
                for (int m = 0; m < 4; ++m)
#pragma unroll
                    for (int n = 0; n < 2; ++n) acc[a][b][m][n] = (f32x4){0.f, 0.f, 0.f, 0.f};
        cur = nxt; cA = nA; cB = nB; ++ui;
        if constexpr (ALIGN_EPI) { if (wr == 1) PG8_BAR; }
    }
    PG8_WAIT_V(0);
    if constexpr (!ALIGN_EPI) { if (wr == 0) PG8_BAR; }
    PG8_BAR;
#undef PG8_SA
#undef PG8_SB
#undef PG8_STAGE
#undef PG8_LDA
#undef PG8_LDB
#undef PG8_MMA
#undef PG8_WAIT_V
#undef PG8_WAIT_L
#undef PG8_BAR
#undef PG8_SCHED
}
}

struct Args { const float* in[18]; float* out; unsigned char* ws; int ph_lo, ph_hi; };

__device__ __forceinline__ void p0_transpose_item(const float* W, int K, int N, bf16_t* WT, LAS float* scr, int item, int lane, const float* kgain = nullptr) {
    const int nblk = N / 32, kb = item / nblk, nb = item % nblk, k0 = 64 * kb, n0 = 32 * nb;
    { f32x4 wv[8];
#pragma unroll
      for (int i = 0; i < 8; ++i) wv[i] = *(const f32x4*)(W + (size_t)(k0 + 8 * i + (lane >> 3)) * N + n0 + 4 * (lane & 7));
#pragma unroll
      for (int i = 0; i < 8; ++i) { const int kk = 8 * i + (lane >> 3); const float gk = kgain ? kgain[k0 + kk] : 1.0f; LAS float* sp = scr + kk * 33 + 4 * (lane & 7);
          sp[0] = gk * wv[i].x; sp[1] = gk * wv[i].y; sp[2] = gk * wv[i].z; sp[3] = gk * wv[i].w; } }
    asm volatile("s_waitcnt lgkmcnt(0)" ::: "memory");
    const int c = lane & 7;
#pragma unroll
    for (int j = 0; j < 4; ++j) { const int n = (lane >> 3) + 8 * j; const LAS float* s = scr + (8 * c) * 33 + n;
        u32x4 o; o.x = pk2(s[0 * 33], s[1 * 33]); o.y = pk2(s[2 * 33], s[3 * 33]); o.z = pk2(s[4 * 33], s[5 * 33]); o.w = pk2(s[6 * 33], s[7 * 33]);
        *(u32x4*)(WT + (size_t)(n0 + n) * K + k0 + 8 * c) = o; }
    asm volatile("s_waitcnt lgkmcnt(0)" ::: "memory");
}
__device__ __forceinline__ void rms_row_to_bf16(const float* xrow, const float* g, bf16_t* orow, int lane) {
    const f32x4* xr = (const f32x4*)xrow + lane;
    f32x4 v[8]; float s = 0.f;
#pragma unroll
    for (int j = 0; j < 8; ++j) { v[j] = xr[64 * j]; s += (v[j].x * v[j].x + v[j].y * v[j].y) + (v[j].z * v[j].z + v[j].w * v[j].w); }
    const float rstd = 1.0f / sqrtf(wave_sum(s) * (1.0f / D) + EPS);
    const f32x4* gr = (const f32x4*)g + lane;
    u32x2* o8 = (u32x2*)orow + lane;
#pragma unroll
    for (int j = 0; j < 8; ++j) { const f32x4 gv = gr[64 * j]; u32x2 o; o.x = pk2(v[j].x * rstd * gv.x, v[j].y * rstd * gv.y); o.y = pk2(v[j].z * rstd * gv.z, v[j].w * rstd * gv.w); o8[64 * j] = o; }
}
__device__ __forceinline__ void cvt_stream(const float* src, bf16_t* dst, size_t n8, size_t gtid, size_t nthr) {
    for (size_t i = gtid; i < n8; i += nthr) { const f32x4 a = ((const f32x4*)src)[2 * i], b = ((const f32x4*)src)[2 * i + 1];
        u32x4 o; o.x = pk2(a.x, a.y); o.y = pk2(a.z, a.w); o.z = pk2(b.x, b.y); o.w = pk2(b.z, b.w); ((u32x4*)dst)[i] = o; }
}

constexpr int EROW = 1536;
typedef unsigned u32x6 __attribute__((ext_vector_type(6)));
typedef float f32x16 __attribute__((ext_vector_type(16)));
typedef float f32x32 __attribute__((ext_vector_type(32)));
#ifndef FP6_ENC_INTERLEAVED
#define FP6_ENC_INTERLEAVED 1
#endif
__device__ __forceinline__ void expert_row_load(const float* src, f32x4 (&v)[8], int lane) {
    const f32x4* xr = (const f32x4*)src + lane;
#pragma unroll
    for (int k = 0; k < 8; ++k) v[k] = xr[64 * k];
}
__device__ __forceinline__ void expert_row_gain(f32x4 (&v)[8], const float* g, int lane) {
    const f32x4* gr = (const f32x4*)g + lane;
#pragma unroll
    for (int k = 0; k < 8; ++k) v[k] = v[k] * gr[64 * k];
}
__device__ __forceinline__ void expert_row_store(const f32x4 (&v)[8], unsigned char* dst, float* isc, int lane) {
    float am = 0.f;
#pragma unroll
    for (int k = 0; k < 8; ++k) am = fmaxf(am, fmaxf(fmaxf(fabsf(v[k].x), fabsf(v[k].y)), fmaxf(fabsf(v[k].z), fabsf(v[k].w))));
#pragma unroll
    for (int o = 1; o < 64; o <<= 1) am = fmaxf(am, __shfl_xor(am, o));
    float sc = 1.0f, inv = 1.0f;
    if (am > 0.f) { const float amc = fminf(fmaxf(am, 1.0e-30f), 1.0e30f); sc = 7.5f / amc; inv = amc * (1.0f / 7.5f); }
    f32x16 ea, eb;
#pragma unroll
    for (int j = 0; j < 16; ++j) {
#if FP6_ENC_INTERLEAVED
        const int ja = 2 * j, jb = 2 * j + 1;
#else
        const int ja = j, jb = 16 + j;
#endif
        ea[j] = v[ja >> 2][ja & 3] * sc; eb[j] = v[jb >> 2][jb & 3] * sc; }
    const u32x6 o = __builtin_amdgcn_cvt_scalef32_2xpk16_fp6_f32(ea, eb, 1.0f);
    u32x4 o0; o0.x = o[0]; o0.y = o[1]; o0.z = o[2]; o0.w = o[3]; u32x2 o1; o1.x = o[4]; o1.y = o[5];
    *(u32x4*)(dst + lane * 16) = o0; *(u32x2*)(dst + 1024 + lane * 8) = o1;
    if (lane == 0) *isc = inv;
}

__device__ __forceinline__ void p0_score_weights(const Args& a, int item, int lane) {
    const float* wq = a.in[13]; const float* g2 = a.in[12]; const float* keys = a.in[14]; bf16_t* M = (bf16_t*)(a.ws + WS_WQ);
    const int b = item >> 7, kt = item & 127, fr = lane & 15, fq = lane >> 4;
    const int k = kt * 16 + fr; const float gk = g2[k];
    bf16x8 wf[4];
#pragma unroll
    for (int ks = 0; ks < 4; ++ks) { const float* p = wq + (size_t)k * D + b * 128 + ks * 32 + fq * 8; const f32x4 x0 = *(const f32x4*)p, x1 = *(const f32x4*)(p + 4);
        u32x4 w; w.x = pk2(gk * x0.x, gk * x0.y); w.y = pk2(gk * x0.z, gk * x0.w); w.z = pk2(gk * x1.x, gk * x1.y); w.w = pk2(gk * x1.z, gk * x1.w); wf[ks] = __builtin_bit_cast(bf16x8, w); }
#pragma unroll 2
    for (int nb = 0; nb < 8; ++nb) {
        f32x4 acc = {0.f, 0.f, 0.f, 0.f};
#pragma unroll
        for (int ks = 0; ks < 4; ++ks) { const float* p = keys + (size_t)(b * 128 + nb * 16 + fr) * 128 + ks * 32 + fq * 8; const f32x4 x0 = *(const f32x4*)p, x1 = *(const f32x4*)(p + 4);
            u32x4 w; w.x = pk2(x0.x, x0.y); w.y = pk2(x0.z, x0.w); w.z = pk2(x1.x, x1.y); w.w = pk2(x1.z, x1.w);
            acc = __builtin_amdgcn_mfma_f32_16x16x32_bf16(wf[ks], __builtin_bit_cast(bf16x8, w), acc, 0, 0, 0); }
        u32x2 o; o.x = pk2(acc[0], acc[1]); o.y = pk2(acc[2], acc[3]);
        *(u32x2*)(M + (size_t)(b * 128 + nb * 16 + fr) * D + kt * 16 + fq * 4) = o;
    }
}

__device__ __forceinline__ void p0_prologue(const Args& a, LAS unsigned char* lds, int vcu, int G, int wave, int lane, int tid) {
    unsigned char* ws = a.ws;
    LAS float* scr = (LAS float*)(lds + wave * 16384);
    const int gw = vcu * NWAVES + wave, NGW = G * NWAVES;
    constexpr int I_IN = (D / 64) * (INW / 32), I_POOL1 = (256 / 64) * (512 / 32), I_G = (GWD / 64) * (D / 32), I_O = (D / 64) * (D / 32);
    constexpr int NITEMS = I_IN + 4 * I_POOL1 + I_G + I_O;
    for (int it = gw; it < NITEMS; it += NGW) {
        int r = it;
        if (r < I_IN) { p0_transpose_item(a.in[2], D, INW, (bf16_t*)(ws + WS_WIN), scr, r, lane); continue; } r -= I_IN;
        if (r < 4 * I_POOL1) { const int g = r / I_POOL1; p0_transpose_item(a.in[5] + (size_t)g * 256 * 512, 256, 512, (bf16_t*)(ws + WS_WPOOL) + (size_t)g * 512 * 256, scr, r % I_POOL1, lane); continue; } r -= 4 * I_POOL1;
        if (r < I_G) { p0_transpose_item(a.in[10], GWD, D, (bf16_t*)(ws + WS_WG), scr, r, lane); continue; } r -= I_G;
        p0_transpose_item(a.in[11], D, D, (bf16_t*)(ws + WS_WOUT), scr, r, lane);
    }
    for (int it = gw; it < 16 * (D / 16); it += NGW) p0_score_weights(a, it, lane);
    for (int m = gw; m < S; m += NGW) rms_row_to_bf16(a.in[0] + (size_t)m * D, a.in[1], (bf16_t*)(ws + WS_H) + (size_t)m * D, lane);
    unsigned tq_ = (unsigned)tid; asm volatile("" : "+v"(tq_));
    const size_t gtid = (size_t)vcu * NTHR + tq_, nthr = (size_t)G * NTHR;
    {
        const float* src = a.in[8]; bf16_t* dst = (bf16_t*)(ws + WS_WSM);
        for (size_t i = gtid; i < (size_t)8 * 128 * 128 / 8; i += nthr) { const int s0 = (int)(i & 15) * 8, t = (int)(i >> 4) & 127;
            const f32x4 x0 = ((const f32x4*)src)[2 * i], x1 = ((const f32x4*)src)[2 * i + 1];
            float v[8] = {x0.x, x0.y, x0.z, x0.w, x1.x, x1.y, x1.z, x1.w};
#pragma unroll
            for (int j = 0; j < 8; ++j) v[j] = (s0 + j <= t) ? v[j] : 0.f;
            u32x4 o; o.x = pk2(v[0], v[1]); o.y = pk2(v[2], v[3]); o.z = pk2(v[4], v[5]); o.w = pk2(v[6], v[7]); ((u32x4*)dst)[i] = o; }
    }
}

__device__ __forceinline__ void p2_pool(const Args& a, int vcu, int G, int tid) {
    const bf16_t* Z = (const bf16_t*)(a.ws + WS_Z); bf16_t* A2 = (bf16_t*)(a.ws + WS_A2); const float* psc = a.in[4];
    unsigned tq_ = (unsigned)tid; asm volatile("" : "+v"(tq_));
    const size_t gtid = (size_t)vcu * NTHR + tq_, nthr = (size_t)G * NTHR;
    for (size_t id = gtid; id < (size_t)(S / 8) * 128; id += nthr) {
        const int c8 = (int)(id & 127), t0 = (int)(id >> 7) * 8, g = c8 >> 5, w = 2 << g;
        u32x4 row[23];
#pragma unroll
        for (int r = 0; r < 23; ++r) { const int t = t0 - 15 + r; const bool need = (r >= 16 - w) && (t >= 0);
            row[r] = need ? *(const u32x4*)(Z + (size_t)t * INW + c8 * 8) : (u32x4){0u, 0u, 0u, 0u}; }
        const f32x4 p0 = *(const f32x4*)(psc + c8 * 8), p1 = *(const f32x4*)(psc + c8 * 8 + 4);
        const float ps[8] = {p0.x, p0.y, p0.z, p0.w, p1.x, p1.y, p1.z, p1.w};
        float s[8] = {0.f, 0.f, 0.f, 0.f, 0.f, 0.f, 0.f, 0.f};
#pragma unroll
        for (int r = 0; r < 15; ++r) { const u32x4 q = row[r];
            s[0] += bflo(q.x); s[1] += bfhi(q.x); s[2] += bflo(q.y); s[3] += bfhi(q.y); s[4] += bflo(q.z); s[5] += bfhi(q.z); s[6] += bflo(q.w); s[7] += bfhi(q.w); }
#pragma unroll
        for (int i = 0; i < 8; ++i) {
            const u32x4 q = row[15 + i];
            const float at[8] = {bflo(q.x), bfhi(q.x), bflo(q.y), bfhi(q.y), bflo(q.z), bfhi(q.z), bflo(q.w), bfhi(q.w)};
#pragma unroll
            for (int c = 0; c < 8; ++c) s[c] += at[c];
            const int t = t0 + i; const int cnt = (t + 1) < w ? (t + 1) : w; const float inv = 1.0f / (float)cnt;
            float o[8];
#pragma unroll
            for (int c = 0; c < 8; ++c) o[c] = (s[c] * inv - at[c]) * ps[c];
            u32x4 w4; w4.x = pk2(o[0], o[1]); w4.y = pk2(o[2], o[3]); w4.z = pk2(o[4], o[5]); w4.w = pk2(o[6], o[7]);
            *(u32x4*)(A2 + (size_t)t * D + c8 * 8) = w4;
            const u32x4 d2 = row[15 + i - 1], d4 = row[15 + i - 3], d8 = row[15 + i - 7], d16 = row[15 + i - 15];
            const u32x4 dq = g == 0 ? d2 : (g == 1 ? d4 : (g == 2 ? d8 : d16));
            s[0] -= bflo(dq.x); s[1] -= bfhi(dq.x); s[2] -= bflo(dq.y); s[3] -= bfhi(dq.y); s[4] -= bflo(dq.z); s[5] -= bfhi(dq.z); s[6] -= bflo(dq.w); s[7] -= bfhi(dq.w);
        }
    }
}
constexpr int VT_LD = 136;
__device__ __forceinline__ void p2_sgu(const Args& a, LAS unsigned char* lds, int item0, int item1, int istep, int wave, int lane, int tid) {
    const bf16_t* Z = (const bf16_t*)(a.ws + WS_Z); bf16_t* A2 = (bf16_t*)(a.ws + WS_A2); const bf16_t* WSM = (const bf16_t*)(a.ws + WS_WSM);
    const float* lng = a.in[6]; const float* lnb = a.in[7]; const float* bs = a.in[9];
    LAS float* st = (LAS float*)lds; LAS bf16_t* Vt = (LAS bf16_t*)(lds + 1024);
    const int fr = lane & 15, fq = lane >> 4;
    int prev_c = -1;
    for (int item = item0; item < item1; item += istep) {
        const int c = item >> 3, h = item & 7, t0 = c * 128; const bool need_stats = (c != prev_c); prev_c = c;
        u32x4 raw[4][8];
        if (need_stats) {
#pragma unroll
        for (int p = 0; p < 4; ++p) { const bf16_t* rp = Z + (size_t)(t0 + wave * 16 + p * 4 + fq) * INW + 2048 + fr * 8;
#pragma unroll
            for (int j = 0; j < 8; ++j) raw[p][j] = *(const u32x4*)(rp + j * 128); } }
        u32x4 rawB[4];
#pragma unroll
        for (int q = 0; q < 4; ++q) { const int id = tid + q * NTHR, sr = id & 127, dc = id >> 7; rawB[q] = *(const u32x4*)(Z + (size_t)(t0 + sr) * INW + 2048 + h * 128 + dc * 8); }
        bf16x8 bW[4];
#pragma unroll
        for (int ks = 0; ks < 4; ++ks) bW[ks] = *(const bf16x8*)(WSM + (size_t)(h * 128 + wave * 16 + fr) * 128 + ks * 32 + fq * 8);
        u32x2 ur[8];
#pragma unroll
        for (int db = 0; db < 8; ++db) ur[db] = *(const u32x2*)(Z + (size_t)(t0 + wave * 16 + fr) * INW + 1024 + h * 128 + db * 16 + fq * 4);
        const float bias = bs[h * 128 + wave * 16 + fr];
        if (need_stats) {
#pragma unroll
        for (int p = 0; p < 4; ++p) { float s = 0.f, q = 0.f;
#pragma unroll
            for (int j = 0; j < 8; ++j)
#pragma unroll
                for (int w = 0; w < 4; ++w) { const float a0 = bflo(raw[p][j][w]), a1 = bfhi(raw[p][j][w]); s += a0 + a1; q += a0 * a0 + a1 * a1; }
            s = row_sum_f32(s); q = row_sum_f32(q);
            if (fr == 0) { const float mean = s * (1.0f / 1024.0f); const float var = fmaxf(q * (1.0f / 1024.0f) - mean * mean, 0.f);
                const int sr = wave * 16 + p * 4 + fq; st[2 * sr] = mean; st[2 * sr + 1] = 1.0f / sqrtf(var + EPS); } }
        __syncthreads();
        }
#pragma unroll
        for (int q = 0; q < 4; ++q) { const int id = tid + q * NTHR, sr = id & 127, dc = id >> 7;
            const u32x4 rw = rawB[q];
            const float mean = st[2 * sr], rstd = st[2 * sr + 1];
            const float v[8] = {bflo(rw.x), bfhi(rw.x), bflo(rw.y), bfhi(rw.y), bflo(rw.z), bfhi(rw.z), bflo(rw.w), bfhi(rw.w)};
            const f32x4 g0 = *(const f32x4*)(lng + h * 128 + dc * 8), g1 = *(const f32x4*)(lng + h * 128 + dc * 8 + 4), b0 = *(const f32x4*)(lnb + h * 128 + dc * 8), b1 = *(const f32x4*)(lnb + h * 128 + dc * 8 + 4);
            const float gg[8] = {g0.x, g0.y, g0.z, g0.w, g1.x, g1.y, g1.z, g1.w}, bb[8] = {b0.x, b0.y, b0.z, b0.w, b1.x, b1.y, b1.z, b1.w};
#pragma unroll
            for (int i = 0; i < 8; ++i) { const int d = dc * 8 + i; const float y = (v[i] - mean) * rstd * gg[i] + bb[i]; Vt[d * VT_LD + sr] = (bf16_t)f2bf(y); } }
        __syncthreads();
        f32x4 acc[8];
#pragma unroll
        for (int db = 0; db < 8; ++db) acc[db] = (f32x4){0.f, 0.f, 0.f, 0.f};
        const int nks = (wave * 16 + 15) / 32 + 1;
#pragma unroll
        for (int ks = 0; ks < 4; ++ks) if (ks < nks) {
#pragma unroll
            for (int db = 0; db < 8; ++db) { const bf16x8 aV = *(const LAS bf16x8*)(Vt + (db * 16 + fr) * VT_LD + ks * 32 + fq * 8);
                acc[db] = __builtin_amdgcn_mfma_f32_16x16x32_bf16(aV, bW[ks], acc[db], 0, 0, 0); }
        }
        { const int t = t0 + wave * 16 + fr;
#pragma unroll
          for (int db = 0; db < 8; ++db) { const int col = h * 128 + db * 16 + fq * 4;
              u32x2 o; o.x = pk2(bflo(ur[db].x) * (acc[db][0] + bias), bfhi(ur[db].x) * (acc[db][1] + bias)); o.y = pk2(bflo(ur[db].y) * (acc[db][2] + bias), bfhi(ur[db].y) * (acc[db][3] + bias));
              *(u32x2*)(A2 + (size_t)t * D + 1024 + col) = o; } }
        __syncthreads();
    }
}

__device__ __forceinline__ unsigned f2key(float f) { const unsigned b = __builtin_bit_cast(unsigned, f); return (b & 0x80000000u) ? ~b : (b | 0x80000000u); }
__device__ __forceinline__ float key2f(unsigned k) { const unsigned b = (k & 0x80000000u) ? (k ^ 0x80000000u) : ~k; return __builtin_bit_cast(float, b); }
template <int CTRL> __device__ __forceinline__ unsigned dpp_max_u32(unsigned v) { const unsigned o = (unsigned)__builtin_amdgcn_update_dpp(0, (int)v, CTRL, 0xF, 0xF, true); return v > o ? v : o; }
__device__ __forceinline__ unsigned row_max_u32(unsigned v) { v = dpp_max_u32<0xB1>(v); v = dpp_max_u32<0x4E>(v); v = dpp_max_u32<0x141>(v); v = dpp_max_u32<0x140>(v); return v; }
__device__ __forceinline__ void ce_desc(unsigned& a, unsigned& b) { const unsigned hi = a > b ? a : b, lo = a > b ? b : a; a = hi; b = lo; }
__device__ __forceinline__ void sort8_desc(unsigned (&k)[8]) {
    ce_desc(k[0], k[1]); ce_desc(k[2], k[3]); ce_desc(k[4], k[5]); ce_desc(k[6], k[7]);
    ce_desc(k[0], k[2]); ce_desc(k[1], k[3]); ce_desc(k[4], k[6]); ce_desc(k[5], k[7]);
    ce_desc(k[1], k[2]); ce_desc(k[5], k[6]);
    ce_desc(k[0], k[4]); ce_desc(k[1], k[5]); ce_desc(k[2], k[6]); ce_desc(k[3], k[7]);
    ce_desc(k[2], k[4]); ce_desc(k[3], k[5]);
    ce_desc(k[1], k[2]); ce_desc(k[3], k[4]); ce_desc(k[5], k[6]);
}
__device__ __forceinline__ void sort4_desc(unsigned (&k)[4]) { ce_desc(k[0], k[1]); ce_desc(k[2], k[3]); ce_desc(k[0], k[2]); ce_desc(k[1], k[3]); ce_desc(k[1], k[2]); }
template <int NV> __device__ __forceinline__ unsigned row_top16_sorted(unsigned (&k)[NV], int fr) {
    unsigned tk = 0u;
    for (int it = 0; it < 16; ++it) {
        const unsigned m = row_max_u32(k[0]);
        const unsigned wm = (k[0] == m) ? 0xffffffffu : 0u;
#pragma unroll
        for (int i = 0; i + 1 < NV; ++i) k[i] = (k[i + 1] & wm) | (k[i] & ~wm);
        k[NV - 1] = k[NV - 1] & ~wm;
        tk = (fr == it) ? m : tk;
    }
    return tk;
}
__device__ __forceinline__ unsigned cand_table(int fr) {
    constexpr unsigned T[16] = {0x03020100u, 0x07060504u, 0x0b0a0908u, 0x0f0e0d0cu, 0x13121110u, 0x17161514u, 0x23222120u, 0x32313024u, 0x42414033u, 0x61605150u, 0x90807170u, 0xd0c0b0a0u, 0xfffff0e0u, 0xffffffffu, 0xffffffffu, 0xffffffffu};
    unsigned w = T[0];
#pragma unroll
    for (int i = 1; i < 16; ++i) w = (fr == i) ? T[i] : w;
    return w;
}
constexpr int SC_LD = 132;
__device__ __forceinline__ void p7_topk(const Args& a, LAS unsigned char* lds, int vcu, int G, int wave, int lane_) {
    int lane = lane_; asm volatile("" : "+v"(lane));
    const bf16_t* Q = (const bf16_t*)(a.ws + WS_Q);
    int* IDX = (int*)(a.ws + WS_IDX); float* GATE = (float*)(a.ws + WS_GATE);
    LAS float* SL = (LAS float*)(lds + wave * (16 * SC_LD * 4));
    const int gw = vcu * NWAVES + wave, NGW = G * NWAVES; const int fr = lane & 15, fq = lane >> 4;
    const unsigned ctab = cand_table(fr);
    int erow = gw;
    f32x4 er0[8], er1[8]; int e0 = 2 * NEXP, e1 = 2 * NEXP;
#define ER_LOAD() do { e0 = erow; e1 = erow + NGW; erow += 2 * NGW; \
        if (e0 < 2 * NEXP) expert_row_load(a.in[15 + (e0 >= NEXP)] + (size_t)(e0 & (NEXP - 1)) * D, er0, lane); \
        if (e1 < 2 * NEXP) expert_row_load(a.in[15 + (e1 >= NEXP)] + (size_t)(e1 & (NEXP - 1)) * D, er1, lane); } while (0)
#define ER_STORE() do { \
        if (e0 < NEXP) expert_row_gain(er0, a.in[12], lane); if (e1 < NEXP) expert_row_gain(er1, a.in[12], lane); \
        if (e0 < 2 * NEXP) expert_row_store(er0, a.ws + ((e0 >= NEXP) ? WS_EV : WS_EU) + (size_t)(e0 & (NEXP - 1)) * EROW, (float*)(a.ws + WS_ESC) + e0, lane); \
        if (e1 < 2 * NEXP) expert_row_store(er1, a.ws + ((e1 >= NEXP) ? WS_EV : WS_EU) + (size_t)(e1 & (NEXP - 1)) * EROW, (float*)(a.ws + WS_ESC) + e1, lane); } while (0)
    pg8::StaticOrder so7; so7.init(S, D, G, (int)blockIdx.x); pg8::Unit u7;
    for (int ui = 0; so7.next(ui >> 1, u7); ++ui) {
        const int h = u7.pn, t0 = u7.pm * 256 + ((ui & 1) * 8 + wave) * 16;
        unsigned tk[8];
#pragma unroll
        for (int i = 0; i < 8; ++i) tk[i] = 0u;
#pragma unroll 1
        for (int p = 0; p < 2; ++p) {
            {
                u32x4 sc[4];
#pragma unroll
                for (int i = 0; i < 4; ++i) sc[i] = *(const u32x4*)(Q + (size_t)(t0 + i * 4 + fq) * D + h * 256 + p * 128 + fr * 8);
#pragma unroll
                for (int i = 0; i < 4; ++i) { LAS float* d = SL + (i * 4 + fq) * SC_LD + fr * 8;
                    *(LAS f32x4*)d = (f32x4){bflo(sc[i].x), bfhi(sc[i].x), bflo(sc[i].y), bfhi(sc[i].y)}; *(LAS f32x4*)(d + 4) = (f32x4){bflo(sc[i].z), bfhi(sc[i].z), bflo(sc[i].w), bfhi(sc[i].w)}; }
                asm volatile("" ::: "memory");
            }
            ER_LOAD();
#pragma unroll 1
            for (int j = 0; j < 4; ++j) {
                unsigned k[8];
#pragma unroll
                for (int nb = 0; nb < 8; ++nb) k[nb] = (f2key(SL[(fq * 4 + j) * SC_LD + nb * 16 + fr]) & ~127u) | (127u - (unsigned)(nb * 16 + fr));
                sort8_desc(k);
                const unsigned r = row_top16_sorted<8>(k, fr);
#pragma unroll
                for (int i = 0; i < 8; ++i) tk[i] = (i == p * 4 + j) ? r : tk[i];
            }
            ER_STORE();
        }
#pragma unroll 1
        for (int j = 0; j < 4; ++j) {
            if ((j & 1) == 0) ER_LOAD();
            const unsigned tk1 = j == 0 ? tk[0] : (j == 1 ? tk[1] : (j == 2 ? tk[2] : tk[3])), tk2 = j == 0 ? tk[4] : (j == 1 ? tk[5] : (j == 2 ? tk[6] : tk[7]));
            const float t1 = key2f(tk1 & ~127u), t2 = key2f(tk2 & ~127u); const int i1 = 127 - (int)(tk1 & 127u), i2 = 127 - (int)(tk2 & 127u);
            unsigned kc[4];
#pragma unroll
            for (int e = 0; e < 4; ++e) { const unsigned ab = (ctab >> (8 * e)) & 255u; const int ca = (int)(ab >> 4), cb = (int)(ab & 15u);
                const float c = __shfl(t1, (lane & 48) + ca) + __shfl(t2, (lane & 48) + cb);
                kc[e] = (ab == 255u) ? 0u : ((f2key(c) & ~255u) | (255u - ab)); }
            sort4_desc(kc);
            const unsigned tkc = row_top16_sorted<4>(kc, fr);
            const float ts = key2f(tkc & ~255u); const int ci = 255 - (int)(tkc & 255u);
            const int ia = __shfl(i1, (lane & 48) + (ci >> 4)), ib = __shfl(i2, (lane & 48) + (ci & 15));
            const float tmax = __shfl(ts, lane & 48);
            const float e = __expf(ts - tmax); float sum = e;
            sum += __shfl_xor(sum, 1); sum += __shfl_xor(sum, 2); sum += __shfl_xor(sum, 4); sum += __shfl_xor(sum, 8);
            const int t = t0 + fq * 4 + j;
            IDX[(size_t)t * 128 + h * 16 + fr] = ia * 128 + ib;
            GATE[(size_t)t * 128 + h * 16 + fr] = e / sum;
            if ((j & 1) == 1) ER_STORE();
        }
    }
    for (; erow < 2 * NEXP; erow += NGW) { expert_row_load(a.in[15 + (erow >= NEXP)] + (size_t)(erow & (NEXP - 1)) * D, er0, lane); if (erow < NEXP) expert_row_gain(er0, a.in[12], lane);
        expert_row_store(er0, a.ws + ((erow >= NEXP) ? WS_EV : WS_EU) + (size_t)(erow & (NEXP - 1)) * EROW, (float*)(a.ws + WS_ESC) + erow, lane); }
#undef ER_LOAD
#undef ER_STORE
}

typedef float f32x2 __attribute__((ext_vector_type(2)));
__device__ __forceinline__ u32x4 bl128(__amdgpu_buffer_rsrc_t r, unsigned voff, unsigned soff) { return __builtin_amdgcn_raw_buffer_load_b128(r, voff, soff, 0); }
__device__ __forceinline__ u32x2 bl64(__amdgpu_buffer_rsrc_t r, unsigned voff, unsigned soff) { return __builtin_amdgcn_raw_buffer_load_b64(r, voff, soff, 0); }
__device__ __forceinline__ unsigned bl32(__amdgpu_buffer_rsrc_t r, unsigned voff, unsigned soff) { return __builtin_amdgcn_raw_buffer_load_b32(r, voff, soff, 0); }
__device__ __forceinline__ float wave_sum_dpp(float v) {
    v = dpp_add_f32<0xB1>(v); v = dpp_add_f32<0x4E>(v); v = dpp_add_f32<0x141>(v); v = dpp_add_f32<0x140>(v);
    v += __builtin_bit_cast(float, __builtin_amdgcn_update_dpp(0, __builtin_bit_cast(int, v), 0x142, 0xA, 0xF, false));
    v += __builtin_bit_cast(float, __builtin_amdgcn_update_dpp(0, __builtin_bit_cast(int, v), 0x143, 0xC, 0xF, false));
    return __builtin_bit_cast(float, __builtin_amdgcn_readlane(__builtin_bit_cast(int, v), 63));
}
__device__ __forceinline__ float wave_sum_fast(float v) {
    v = dpp_add_f32<0xB1>(v); v = dpp_add_f32<0x4E>(v); v = dpp_add_f32<0x141>(v); v = dpp_add_f32<0x140>(v);
    v += __shfl_xor(v, 16); v += __shfl_xor(v, 32); return v;
}
constexpr int TPW = 4, NSL = 16, SL_SHIFT = 10, RING = 8, SLOT = 2048;
typedef __bf16 bf16x2_t __attribute__((ext_vector_type(2)));
__device__ __forceinline__ float dot2bf(unsigned a, unsigned b, float c) { return __builtin_amdgcn_fdot2_f32_bf16(__builtin_bit_cast(bf16x2_t, a), __builtin_bit_cast(bf16x2_t, b), c, false); }
constexpr int NROWS = TPW * 128;
#define P8_ISSUE(TBASE) do { const unsigned ro_ = (unsigned)__builtin_amdgcn_readlane(lch_, ii_ & 63) * (unsigned)EROW; \
        const char* src_ = (const char*)a.ws + (TBASE) + ro_ + l16; const char* src2_ = src_ + 1024; const unsigned dl_ = ring_lo + (unsigned)(ii_ & (RING - 1)) * SLOT; \
        asm volatile("s_mov_b32 m0, %2\n\ts_nop 0\n\tglobal_load_lds_dwordx4 %0, off\n\ts_mov_b32 m0, %3\n\ts_mov_b64 exec, %4\n\tglobal_load_lds_dwordx4 %1, off\n\ts_mov_b64 exec, -1" \
                     :: "v"(src_), "v"(src2_), "s"(dl_), "s"(dl_ + 1024u), "s"(half_) : "memory"); \
        ++ii_; if ((ii_ & 63) == 0) lch_ = (int)LST[ii_ + lane]; } while (0)
#define P8_RING_READ(r0, r1) do { r0 = *(const LAS u32x4*)(ring + (ci_ & (RING - 1)) * SLOT + l16); r1 = *(const LAS u32x2*)(ring + (ci_ & (RING - 1)) * SLOT + 1024 + l8); } while (0)
#define P8_DECODE(r0, r1) __builtin_amdgcn_cvt_scalef32_pk32_f32_fp6((u32x6){r0.x, r0.y, r0.z, r0.w, r1.x, r1.y}, 1.0f)
#define P8_STREAM_INIT(TBASE, r0, r1) int ci_ = 0, ii_ = 0; int lch_ = (int)LST[lane]; \
        asm volatile("s_waitcnt vmcnt(0) lgkmcnt(0)" ::: "memory"); \
        _Pragma("unroll 1") for (int q_ = 0; q_ < RING; ++q_) P8_ISSUE(TBASE); \
        asm volatile("s_waitcnt vmcnt(14)" ::: "memory"); P8_RING_READ(r0, r1)
#define P8_ROW_READY() asm volatile("s_waitcnt lgkmcnt(0)" ::: "memory")
#define P8_ROW_ADVANCE(TBASE, r0, r1) do { ++ci_; P8_ISSUE(TBASE); asm volatile("s_waitcnt vmcnt(14)" ::: "memory"); P8_RING_READ(r0, r1); } while (0)
#define P8_STREAM_END() asm volatile("s_waitcnt vmcnt(0) lgkmcnt(0)" ::: "memory")
static_assert(RING == 8, "the counted wait above is vmcnt(2 * (RING - 1))");
__device__ __forceinline__ void p8_peer(const Args& a, LAS unsigned char* lds, float* dst, int vcu, int G, int wave, int lane_) {
    int lane = lane_; asm volatile("" : "+v"(lane));
    const __amdgpu_buffer_rsrc_t rws = __builtin_amdgcn_make_buffer_rsrc((void*)a.ws, (short)0, (int)WS_END, 0x00020000);
    const __amdgpu_buffer_rsrc_t rdst = __builtin_amdgcn_make_buffer_rsrc((void*)dst, (short)0, S * D * 4, 0x00020000);
    const __amdgpu_buffer_rsrc_t rfg = __builtin_amdgcn_make_buffer_rsrc((void*)a.in[17], (short)0, D * 4, 0x00020000);
    LAS unsigned char* ring = lds + wave * (RING * SLOT);
    LAS unsigned* SLW = (LAS unsigned*)(lds + 132096 + wave * 1280);
    LAS unsigned short* LST = (LAS unsigned short*)SLW;
    const int gw = vcu * NWAVES + wave, NGW = G * NWAVES;
    const unsigned l16 = (unsigned)lane * 16u, l8 = (unsigned)lane * 8u, l4 = (unsigned)lane * 4u;
    const unsigned long long half_ = 0xffffffffull;
    const unsigned ring_lo = (unsigned)(size_t)(lds + wave * (RING * SLOT));
#pragma unroll 1
    for (int tb = gw; tb < S; tb += TPW * NGW) {
        int sid[TPW][2], offv[TPW]; float act[TPW][2]; int cntv = 0;
#pragma unroll
        for (int k = 0; k < TPW; ++k) {
            const int t = (tb + k * NGW) < S ? (tb + k * NGW) : (S - 1);
            const unsigned oi = (unsigned)(WS_IDX + (size_t)t * 512);
            const int id0 = (int)bl32(rws, l4, oi), id1 = (int)bl32(rws, l4 + 256u, oi);
            const int sl0 = id0 >> SL_SHIFT, sl1 = id1 >> SL_SHIFT;
            int pos0 = 0, pos1 = 0, basec = 0, offacc = 0;
#pragma unroll
            for (int s = 0; s < NSL; ++s) {
                const unsigned long long m0 = __ballot(sl0 == s), m1 = __ballot(sl1 == s);
                const int c0 = __popcll(m0), c1 = __popcll(m1);
                const int b0 = (int)__builtin_amdgcn_mbcnt_hi((unsigned)(m0 >> 32), __builtin_amdgcn_mbcnt_lo((unsigned)m0, 0u));
                const int b1 = (int)__builtin_amdgcn_mbcnt_hi((unsigned)(m1 >> 32), __builtin_amdgcn_mbcnt_lo((unsigned)m1, 0u));
                pos0 = (sl0 == s) ? basec + b0 : pos0; pos1 = (sl1 == s) ? basec + c0 + b1 : pos1;
                basec += c0 + c1; offacc = (lane == s + 1) ? basec : offacc; cntv = (lane == s * TPW + k) ? (c0 + c1) : cntv;
            }
            offv[k] = offacc;
            SLW[pos0] = (unsigned)id0; SLW[pos1] = (unsigned)id1; SLW[128 + pos0] = (unsigned)lane; SLW[128 + pos1] = (unsigned)(64 + lane);
            asm volatile("s_waitcnt lgkmcnt(0)" ::: "memory");
            sid[k][0] = (int)SLW[lane]; sid[k][1] = (int)SLW[64 + lane];
            act[k][0] = __builtin_bit_cast(float, SLW[128 + lane]); act[k][1] = __builtin_bit_cast(float, SLW[192 + lane]);
            asm volatile("s_waitcnt lgkmcnt(0)" ::: "memory");
        }
        {
            int incl = cntv;
#pragma unroll
            for (int o = 1; o < 64; o <<= 1) { const int up = __shfl_up(incl, o); incl += (lane >= o) ? up : 0; }
            const int gb = incl - cntv;
            asm volatile("s_waitcnt lgkmcnt(0)" ::: "memory");
#pragma unroll
            for (int k = 0; k < TPW; ++k)
#pragma unroll
                for (int h = 0; h < 2; ++h) { const int sl = sid[k][h] >> SL_SHIFT;
                    const int p = __shfl(gb, sl * TPW + k) + (h * 64 + lane) - __shfl(offv[k], sl);
                    LST[p] = (unsigned short)sid[k][h]; }
            if (lane < RING) LST[NROWS + lane] = (unsigned short)0;
            asm volatile("s_waitcnt lgkmcnt(0)" ::: "memory");
        }
        int orig[TPW][2];
#pragma unroll
        for (int k = 0; k < TPW; ++k) { orig[k][0] = __builtin_bit_cast(int, act[k][0]); orig[k][1] = __builtin_bit_cast(int, act[k][1]); act[k][0] = 0.f; act[k][1] = 0.f; }
        {
            f32x2 hf[TPW][16];
#pragma unroll
            for (int k = 0; k < TPW; ++k) { const int t = (tb + k * NGW) < S ? (tb + k * NGW) : (S - 1);
#pragma unroll
                for (int kk = 0; kk < 8; ++kk) { const u32x2 w = bl64(rws, l8 + (unsigned)(kk * 512), (unsigned)(WS_XB + (size_t)t * (D * 2)));
                    hf[k][kk * 2] = (f32x2){bflo(w.x), bfhi(w.x)}; hf[k][kk * 2 + 1] = (f32x2){bflo(w.y), bfhi(w.y)}; } }
            u32x4 r0; u32x2 r1;
            P8_STREAM_INIT(WS_EU, r0, r1);
#pragma unroll 1
            for (int s = 0; s < NSL; ++s) {
#pragma unroll
                for (int k = 0; k < TPW; ++k) {
                    const int lo = __builtin_amdgcn_readlane(offv[k], s), hi = __builtin_amdgcn_readlane(offv[k], s + 1);
#pragma unroll 1
                    for (int e = lo; e < hi; ++e) {
                        P8_ROW_READY();
                        f32x2 dd0 = {0.f, 0.f}, dd1 = {0.f, 0.f};
                        { const f32x32 f = P8_DECODE(r0, r1);
#pragma unroll
                          for (int q = 0; q < 8; ++q) { dd0 = __builtin_elementwise_fma((f32x2){f[4 * q], f[4 * q + 1]}, hf[k][2 * q], dd0);
                              dd1 = __builtin_elementwise_fma((f32x2){f[4 * q + 2], f[4 * q + 3]}, hf[k][2 * q + 1], dd1); } }
                        asm volatile("" : "+v"(dd0), "+v"(dd1));
                        P8_ROW_ADVANCE(WS_EU, r0, r1);
                        const float d = wave_sum_dpp((dd0.x + dd0.y) + (dd1.x + dd1.y));
                        act[k][0] = (lane == e) ? d : act[k][0]; act[k][1] = (lane == e - 64) ? d : act[k][1];
                    }
                }
            }
            P8_STREAM_END();
        }
#pragma unroll
        for (int k = 0; k < TPW; ++k) {
            const int t = (tb + k * NGW) < S ? (tb + k * NGW) : (S - 1);
            const float ssp = lane < 32 ? __builtin_bit_cast(float, bl32(rws, l4, (unsigned)(WS_SS + (size_t)t * 128))) : 0.f;
            const float rstd2 = 1.0f / sqrtf(wave_sum(ssp) * (1.0f / D) + EPS);
            const unsigned og = (unsigned)(WS_GATE + (size_t)t * 512);
#pragma unroll
            for (int h = 0; h < 2; ++h) {
                const float gate = __builtin_bit_cast(float, bl32(rws, (unsigned)orig[k][h] * 4u, og));
                const float su = __builtin_bit_cast(float, bl32(rws, (unsigned)sid[k][h] * 4u, (unsigned)WS_ESC)) * rstd2;
                const float sv = __builtin_bit_cast(float, bl32(rws, (unsigned)sid[k][h] * 4u, (unsigned)(WS_ESC + NEXP * 4)));
                act[k][h] = gelu_tanh(act[k][h] * su) * gate * sv; }
        }
        {
            float acc[TPW][32];
#pragma unroll
            for (int k = 0; k < TPW; ++k)
#pragma unroll
                for (int i = 0; i < 32; ++i) acc[k][i] = 0.f;
            u32x4 r0; u32x2 r1;
            P8_STREAM_INIT(WS_EV, r0, r1);
#pragma unroll 1
            for (int s = 0; s < NSL; ++s) {
#pragma unroll
                for (int k = 0; k < TPW; ++k) {
                    const int lo = __builtin_amdgcn_readlane(offv[k], s), hi = __builtin_amdgcn_readlane(offv[k], s + 1);
#pragma unroll 1
                    for (int e = lo; e < hi; ++e) {
                        const int a0_ = __builtin_amdgcn_readlane(__builtin_bit_cast(int, act[k][0]), e & 63), a1_ = __builtin_amdgcn_readlane(__builtin_bit_cast(int, act[k][1]), e & 63);
                        const float aw = __builtin_bit_cast(float, e < 64 ? a0_ : a1_);
                        P8_ROW_READY();
                        { const f32x32 f = P8_DECODE(r0, r1);
#pragma unroll
                          for (int j = 0; j < 32; ++j) acc[k][j] += aw * f[j]; }
                        asm volatile("" : "+v"(acc[k][0]), "+v"(acc[k][16]));
                        P8_ROW_ADVANCE(WS_EV, r0, r1);
                    }
                }
            }
            P8_STREAM_END();
#pragma unroll
            for (int k = 0; k < TPW; ++k) { const int t = tb + k * NGW;
                if (t < S) {
                    float ss = 0.f; const unsigned ot = (unsigned)t * (unsigned)(D * 4);
#pragma unroll
                    for (int kk = 0; kk < 8; ++kk) { const u32x2 xw = bl64(rws, l8 + (unsigned)(kk * 512), (unsigned)(WS_XB + (size_t)t * (D * 2)));
                        acc[k][kk * 4 + 0] += bflo(xw.x); acc[k][kk * 4 + 1] += bfhi(xw.x); acc[k][kk * 4 + 2] += bflo(xw.y); acc[k][kk * 4 + 3] += bfhi(xw.y);
                        ss += (acc[k][kk * 4 + 0] * acc[k][kk * 4 + 0] + acc[k][kk * 4 + 1] * acc[k][kk * 4 + 1]) + (acc[k][kk * 4 + 2] * acc[k][kk * 4 + 2] + acc[k][kk * 4 + 3] * acc[k][kk * 4 + 3]); }
                    const float rstd = 1.0f / sqrtf(wave_sum(ss) * (1.0f / D) + EPS);
#pragma unroll
                    for (int kk = 0; kk < 8; ++kk) { const f32x4 f0 = __builtin_bit_cast(f32x4, bl128(rfg, l16 + (unsigned)((kk & 3) * 1024), (unsigned)((kk >> 2) * 4096)));
                        f32x4 o0; o0.x = acc[k][kk * 4 + 0] * rstd * f0.x; o0.y = acc[k][kk * 4 + 1] * rstd * f0.y; o0.z = acc[k][kk * 4 + 2] * rstd * f0.z; o0.w = acc[k][kk * 4 + 3] * rstd * f0.w;
                        __builtin_amdgcn_raw_buffer_store_b128(__builtin_bit_cast(u32x4, o0), rdst, l16 + (unsigned)((kk & 3) * 1024), ot + (unsigned)((kk >> 2) * 4096), 0); }
                }
            }
        }
    }
}

#define XB_TMO      128
#define XB_XCNT(j)  (256  + 64 * (j))
#define XB_XSUB(j)  (1280 + 64 * (j))
#define XB_XGEN(j)  (2304 + 64 * (j))
#define XB_TOP      3328
#define XB_TOPGEN   3392
#define XCD_BAR_WORDS 3456
#define XB_SPIN_CAP (1u << 22)
__device__ __forceinline__ unsigned xb_ld(unsigned* p)              { return __hip_atomic_load(p, __ATOMIC_RELAXED, __HIP_MEMORY_SCOPE_AGENT); }
__device__ __forceinline__ unsigned xb_add(unsigned* p, unsigned v) { return __hip_atomic_fetch_add(p, v, __ATOMIC_RELAXED, __HIP_MEMORY_SCOPE_AGENT); }
__device__ __forceinline__ unsigned xb_xcc_id() { return (unsigned)__builtin_amdgcn_s_getreg((3 << 11) | 20) & 0xFu; }
#define XB_SPIN(cond, bar) do { unsigned _sp = 0; while (cond) { __builtin_amdgcn_s_sleep(1); \
    if ((++_sp & 255u) == 0u) { if (xb_ld(&(bar)[XB_TMO])) break; if (_sp > XB_SPIN_CAP) { atomicAdd(&(bar)[XB_TMO], 1u); break; } } } } while (0)
struct XcdBarrier { unsigned* bar; unsigned x; volatile LAS unsigned* st; };
__device__ __forceinline__ XcdBarrier xcd_barrier_post(unsigned* bar, volatile LAS unsigned* st) {
    XcdBarrier b; b.bar = bar; b.x = xb_xcc_id(); b.st = st;
    if (threadIdx.x == 0) (void)xb_add(&bar[XB_XCNT(b.x)], 1u);
    return b;
}
__device__ __forceinline__ void xcd_barrier_complete(unsigned* bar, unsigned x, unsigned G, unsigned& nloc, unsigned& nx) {
    unsigned sum, cnt, mine, sp = 0u;
    for (;;) {
        sum = 0u; cnt = 0u; mine = 0u;
#pragma unroll
        for (unsigned j = 0; j < 16; ++j) { const unsigned c = xb_ld(&bar[XB_XCNT(j)]); sum += c; cnt += (c > 0u) ? 1u : 0u; mine = (j == x) ? c : mine; }
        if (sum == G) break;
        __builtin_amdgcn_s_sleep(1);
        if ((++sp & 255u) == 0u) { if (xb_ld(&bar[XB_TMO])) break; if (sp > XB_SPIN_CAP) { atomicAdd(&bar[XB_TMO], 1u); break; } }
    }
    nloc = mine > 0u ? mine : 1u; nx = cnt > 0u ? cnt : 1u;
}
__device__ __forceinline__ void xcd_barrier(const XcdBarrier& b, unsigned G) {
    asm volatile("s_waitcnt vmcnt(0)" ::: "memory");
    __syncthreads();
    if (threadIdx.x == 0) {
        unsigned* bar = b.bar;
        __builtin_amdgcn_s_waitcnt(0);
        unsigned nloc = b.st[0], nx = b.st[1];
        if (nloc == 0u) { xcd_barrier_complete(bar, b.x, G, nloc, nx); b.st[0] = nloc; b.st[1] = nx; }
        const unsigned old = xb_add(&bar[XB_XSUB(b.x)], 1u);
        const unsigned gen = old / nloc;
        if (old + 1u == (gen + 1u) * nloc) {
            __builtin_amdgcn_fence(__ATOMIC_RELEASE, "agent");
            asm volatile("s_waitcnt vmcnt(0)" ::: "memory");
            const unsigned og = xb_add(&bar[XB_TOP], 1u);
            const unsigned tg = og / nx;
            if (og + 1u == (tg + 1u) * nx) xb_add(&bar[XB_TOPGEN], 1u);
            else XB_SPIN(xb_ld(&bar[XB_TOPGEN]) == tg, bar);
            __builtin_amdgcn_fence(__ATOMIC_ACQUIRE, "agent");
            xb_add(&bar[XB_XGEN(b.x)], 1u);
            asm volatile("s_waitcnt vmcnt(0)" ::: "memory");
        } else {
            XB_SPIN(xb_ld(&bar[XB_XGEN(b.x)]) == gen, bar);
            __builtin_amdgcn_fence(__ATOMIC_ACQUIRE, "agent");
            asm volatile("s_waitcnt vmcnt(0)" ::: "memory");
        }
    }
    __syncthreads();
}

constexpr int N_PHASES = 9;
#ifndef DUP_MASK
#define DUP_MASK 0
#endif
#define REP(k) for (int rep_ = 0; rep_ < 1 + ((DUP_MASK >> (k)) & 1); ++rep_)
__global__ void __launch_bounds__(NTHR, 2) fwd(Args args) {
    extern __shared__ __attribute__((aligned(16))) unsigned char lds_raw[];
    LAS unsigned char* lds = (LAS unsigned char*)lds_raw;
    const int tid = threadIdx.x, lane = tid & 63, wave = __builtin_amdgcn_readfirstlane(tid >> 6);
    const int G = gridDim.x; const int bx = blockIdx.x; const int vcu = (G % 8 == 0) ? (bx % 8) * (G / 8) + bx / 8 : bx;
    unsigned char* ws = args.ws;
    const int lo = args.ph_lo, hi = args.ph_hi;
#define IN(k) (lo <= (k) && (k) < hi)
    volatile LAS unsigned* MISC = (volatile LAS unsigned*)(lds + MISC_OFF);
    if (tid < 32) MISC[tid] = 0u;
    __syncthreads();
#if USE_CG_SYNC
    if (IN(0) && bx * NTHR + tid < XCD_BAR_WORDS) __hip_atomic_store((unsigned*)(ws + WS_CTL) + bx * NTHR + tid, 0u, __ATOMIC_RELAXED, __HIP_MEMORY_SCOPE_AGENT);
    XcdBarrier bar; bar.bar = (unsigned*)(ws + WS_CTL); bar.x = 0; bar.st = MISC + 8;
#else
    XcdBarrier bar = xcd_barrier_post((unsigned*)(ws + WS_CTL), MISC + 8);
#endif
#if USE_CG_SYNC
#define SEAM(k) do { if (IN(k) && IN((k) + ((k) == 4 ? 2 : 1))) { if ((k) == 0) { cg::this_grid().sync(); bar = xcd_barrier_post((unsigned*)(ws + WS_CTL), MISC + 8); } else xcd_barrier(bar, (unsigned)G); } } while (0)
#else
#define SEAM(k) do { if (IN(k) && IN((k) + ((k) == 4 ? 2 : 1))) { xcd_barrier(bar, (unsigned)G); } } while (0)
#endif

    if (IN(0)) REP(0) { p0_prologue(args, lds, vcu, G, wave, lane, tid); }
    SEAM(0);
    constexpr int P1_TILES = 24;
    if (IN(1)) REP(1) {
        pg8::Gemm g{(const bf16_t*)(ws + WS_H), (const bf16_t*)(ws + WS_WIN), S, P1_TILES * 256, D, D, D, 0}; pg8::StaticOrder so; so.init(S, P1_TILES * 256, G, bx);
        pg8::EpiZ E{(bf16_t*)(ws + WS_Z), args.in[3]};
        pg8::gemm_phase<pg8::EpiZ>(lds, g, so, E);
    }
    SEAM(1);
    if (IN(2)) REP(2) {
        const int G2 = G / 2;
        if (G2 >= 1 && bx < G2) {
            pg8::Gemm g{(const bf16_t*)(ws + WS_H), (const bf16_t*)(ws + WS_WIN), S, INW, D, D, D, 0}; pg8::StaticOrder so; so.init(S, (28 - P1_TILES) * 256, G2, bx, P1_TILES);
            pg8::EpiZ E{(bf16_t*)(ws + WS_Z), args.in[3]};
            pg8::gemm_phase<pg8::EpiZ>(lds, g, so, E);
        } else {
            for (int bi = bx - G2; bi < 128; bi += G - G2) { const int it0 = (bi >> 1) * 8 + (bi & 1) * 4; p2_sgu(args, lds, it0, it0 + 4, 1, wave, lane, tid); }
        }
        p2_pool(args, vcu, G, tid);
    }
    SEAM(2);
    if (IN(3)) REP(3) {
        pg8::StaticOrder so; so.init(S, D, G, bx);
        { pg8::Gemm g{(const bf16_t*)(ws + WS_A2), (const bf16_t*)(ws + WS_WPOOL), S, D, 256, D, 256, 1};
          pg8::EpiPool E{(bf16_t*)(ws + WS_T), (const bf16_t*)(ws + WS_Z)};
          pg8::gemm_phase<pg8::EpiPool>(lds, g, so, E); }
        asm volatile("s_waitcnt vmcnt(0)" ::: "memory"); __syncthreads();
        { pg8::Gemm g{(const bf16_t*)(ws + WS_A2) + 1024, (const bf16_t*)(ws + WS_WG), S, D, GWD, D, GWD, 0};
          pg8::EpiMerge E{(const bf16_t*)(ws + WS_T), (const bf16_t*)(ws + WS_Z), (bf16_t*)(ws + WS_MRG)};
          pg8::gemm_phase<pg8::EpiMerge>(lds, g, so, E); }
    }
    SEAM(3);
    if (IN(4)) REP(4) {
        pg8::Gemm g{(const bf16_t*)(ws + WS_MRG), (const bf16_t*)(ws + WS_WOUT), S, D, D, D, D, 0}; pg8::StaticOrder so; so.init(S, D, G, bx);
        pg8::EpiX1 E{args.in[0], (bf16_t*)(ws + WS_XB), (float*)(ws + WS_SS)};
        pg8::gemm_phase<pg8::EpiX1>(lds, g, so, E);
    }
    SEAM(4);
    if (IN(6)) REP(6) {
        pg8::Gemm g{(const bf16_t*)(ws + WS_XB), (const bf16_t*)(ws + WS_WQ), S, D, D, D, D, 0}; pg8::StaticOrder so; so.init(S, D, G, bx);
        pg8::EpiQ E{(bf16_t*)(ws + WS_Q), (const float*)(ws + WS_SS)};
        pg8::gemm_phase<pg8::EpiQ>(lds, g, so, E);
    }
    if (IN(6) && IN(7)) { asm volatile("s_waitcnt vmcnt(0)" ::: "memory"); __syncthreads(); }
    if (IN(7)) REP(7) { p7_topk(args, lds, vcu, G, wave, lane); }
    SEAM(7);
    if (IN(8)) REP(8) { float* dst8 = (rep_ < ((DUP_MASK >> 8) & 1)) ? (float*)(ws + WS_T) : args.out; p8_peer(args, lds, dst8, vcu, G, wave, lane); }
#undef IN
#undef SEAM
}

extern "C" void kernel_launch(void* const* d_in, const int* in_sizes, int n_in, void* d_out, int out_size, void* d_ws, size_t ws_size, hipStream_t stream) {
    static int grid = 0;
    if (grid == 0) {
        if (n_in != 18 || out_size != S * D || ws_size < WS_END) { fprintf(stderr, "kernel_launch: unexpected shapes (n_in %d, out %d, ws %zu)\n", n_in, out_size, ws_size); grid = -1; return; }
        int dev = 0, cus = 0, per_cu = 0;
        if (hipGetDevice(&dev) != hipSuccess || hipDeviceGetAttribute(&cus, hipDeviceAttributeMultiprocessorCount, dev) != hipSuccess) { grid = -1; return; }
        if (hipFuncSetAttribute((const void*)fwd, hipFuncAttributeMaxDynamicSharedMemorySize, LDS_BYTES) != hipSuccess) { fprintf(stderr, "kernel_launch: hipFuncSetAttribute failed\n"); grid = -1; return; }
        if (hipOccupancyMaxActiveBlocksPerMultiprocessor(&per_cu, (const void*)fwd, NTHR, LDS_BYTES) != hipSuccess || per_cu < 1) { fprintf(stderr, "kernel_launch: occupancy query says %d\n", per_cu); per_cu = 1; }
        (void)hipGetLastError();
        grid = cus;
    }
    if (grid < 0) return;
#if !USE_CG_SYNC
    if (hipMemsetAsync((char*)d_ws + WS_CTL, 0, 16384, stream) != hipSuccess) { fprintf(stderr, "kernel_launch: memset failed\n"); return; }
#endif
    Args a{};
    for (int i = 0; i < 18; ++i) a.in[i] = (const float*)d_in[i];
    a.out = (float*)d_out; a.ws = (unsigned char*)d_ws;
#if MK_N_LAUNCHES == 1
    a.ph_lo = 0; a.ph_hi = N_PHASES;
    void* kargs[] = {&a};
    hipError_t e = hipLaunchCooperativeKernel((const void*)fwd, dim3(grid), dim3(NTHR), kargs, LDS_BYTES, stream);
    if (e != hipSuccess) fprintf(stderr, "kernel_launch: cooperative launch failed: %s (grid %d)\n", hipGetErrorString(e), grid);
#else
    for (int p = 0; p < N_PHASES; ++p) {
        a.ph_lo = p; a.ph_hi = p + 1;
        hipLaunchKernelGGL(fwd, dim3(grid), dim3(NTHR), LDS_BYTES, stream, a);
    }
#endif
}
```

```cpp
#include <hip/hip_runtime.h>
#include <hip/hip_cooperative_groups.h>
#include <cstdio>
#include <cstdint>
namespace cg = cooperative_groups;

#ifndef USE_CG_SYNC
#define USE_CG_SYNC 1
#endif
#ifndef MK_N_LAUNCHES
#define MK_N_LAUNCHES 1
#endif

#define LAS __attribute__((address_space(3)))
typedef unsigned short bf16_t;
typedef short bf16x8 __attribute__((ext_vector_type(8)));
typedef float f32x4 __attribute__((ext_vector_type(4)));
typedef unsigned u32x4 __attribute__((ext_vector_type(4)));
typedef unsigned u32x2 __attribute__((ext_vector_type(2)));

constexpr int S = 8192, D = 2048, INW = 7168, PW = 1024, GWD = 1024;
constexpr int NEXP = 16384;
constexpr float EPS = 1e-6f;
constexpr int NWAVES = 8, NTHR = 512;

constexpr size_t MiB = 1u << 20;
constexpr size_t WS_CTL = 0;
constexpr size_t WS_WIN = 1 * MiB;
constexpr size_t WS_WPOOL = 21 * MiB;
constexpr size_t WS_WG = 31 * MiB;
constexpr size_t WS_WOUT = 35 * MiB;
constexpr size_t WS_WQ = 43 * MiB;
constexpr size_t WS_KEYS = 51 * MiB;
constexpr size_t WS_WSM = 52 * MiB;
constexpr size_t WS_H = 53 * MiB;
constexpr size_t WS_Z = 85 * MiB;
constexpr size_t WS_A2 = 197 * MiB;
constexpr size_t WS_T = 229 * MiB;
constexpr size_t WS_MRG = 293 * MiB;
constexpr size_t WS_Q = 325 * MiB;
constexpr size_t WS_IDX = 357 * MiB;
constexpr size_t WS_GATE = 361 * MiB;
constexpr size_t WS_SS = 365 * MiB;
constexpr size_t WS_ESC = 369 * MiB;
constexpr size_t WS_EU = 370 * MiB;
constexpr size_t WS_EV = 402 * MiB;
constexpr size_t WS_XB = 434 * MiB;
constexpr size_t WS_END = 466 * MiB;
constexpr size_t WS_W8 = WS_WIN + 6 * MiB;
constexpr size_t WS_H8 = WS_Q;
constexpr float W8_SCALE = 256.0f, H8_SCALE = 4.0f;

constexpr int LDS_BYTES = 147456;
constexpr int MISC_OFF = 131072 + 320;

__device__ __forceinline__ unsigned f2bf(float f) { unsigned u = __builtin_bit_cast(unsigned, f); return (u + 0x7fffu + ((u >> 16) & 1u)) >> 16; }
__device__ __forceinline__ unsigned pk2(float lo, float hi) { return f2bf(lo) | (f2bf(hi) << 16); }
__device__ __forceinline__ float bflo(unsigned w) { return __builtin_bit_cast(float, w << 16); }
__device__ __forceinline__ float bfhi(unsigned w) { return __builtin_bit_cast(float, w & 0xffff0000u); }
__device__ __forceinline__ float wave_sum(float v) {
#pragma unroll
    for (int o = 1; o < 64; o <<= 1) v += __shfl_xor(v, o);
    return v;
}
template <int CTRL> __device__ __forceinline__ float dpp_add_f32(float v) { return v + __builtin_bit_cast(float, __builtin_amdgcn_update_dpp(0, __builtin_bit_cast(int, v), CTRL, 0xF, 0xF, true)); }
__device__ __forceinline__ float row_sum_f32(float v) { v = dpp_add_f32<0xB1>(v); v = dpp_add_f32<0x4E>(v); v = dpp_add_f32<0x141>(v); v = dpp_add_f32<0x140>(v); return v; }
__device__ __forceinline__ float gelu_tanh(float x) {
    const float y = 1.5957691216057308f * (x + 0.044715f * x * x * x);
    const float e = __builtin_amdgcn_exp2f(-y * 1.4426950408889634f);
    return x * __builtin_amdgcn_rcpf(1.0f + e);
}
__device__ __forceinline__ float sigmoidf_(float x) { return __builtin_amdgcn_rcpf(1.0f + __builtin_amdgcn_exp2f(-x * 1.4426950408889634f)); }

namespace pg8 {
constexpr int BM = 256, BK = 64, HALF = 128, HTB = HALF * BK * 2, STAGE_BYTES = 8 * HTB, NXCD = 8, WGM = 1;
__host__ __device__ __forceinline__ int lds_byte(int r, int c) { const int st = (r >> 4) * 2 + (c >> 5), rr = r & 15, cc = c & 31, ob = rr * 64 + cc * 2; return st * 1024 + (ob ^ (((ob >> 9) & 1) << 5)); }
__host__ __device__ __forceinline__ void stage_rc(int b, int& R, int& C) { const int st = b / 1024, sb = b % 1024, swz = sb ^ (((sb >> 9) & 1) << 5); R = (st >> 1) * 16 + swz / 64; C = (st & 1) * 32 + (swz % 64) / 2; }
__host__ __device__ __forceinline__ int perm32(int rho) { const int n = rho >> 4, i = rho & 15; return 8 * (i >> 2) + 4 * n + (i & 3); }

struct Unit { int pm, pn, sub; };
struct Gemm { const bf16_t* A; const bf16_t* Bt; int M, N, K, lda, ldb, mode; const bf16_t* A0; const bf16_t* Bt0; int K0; };
__device__ __forceinline__ const char* a_ptr(const Gemm& g, const Unit& u) {
    const size_t off = (size_t)u.pm * BM * g.lda; if (g.mode == 2 && u.sub == 0) return (const char*)(g.A0 + off + (size_t)(u.pn >> 1) * 256); return (const char*)(g.A + off); }
__device__ __forceinline__ const char* b_ptr(const Gemm& g, const Unit& u) {
    const size_t off = (size_t)u.pn * BM * g.ldb; return (const char*)(((g.mode == 2 && u.sub == 0) ? g.Bt0 : g.Bt) + off); }

struct StaticOrder {
    int nM, nN, nwg, G, c, pn0, split, chain;
    __host__ __device__ void init(int M, int N, int G_, int c_, int pn0_ = 0, int split_ = 0, int chain_ = 0) { nM = M / BM; nN = N / BM; nwg = nM * nN; G = G_; c = c_; pn0 = pn0_; split = (split_ && nwg == 2 * G_ && (G_ & 1) == 0) ? 1 : 0; chain = chain_; }
    __host__ __device__ bool next(int i_, Unit& u) const {
        const int i = chain ? (i_ >> 1) : i_; u.sub = chain ? (i_ & 1) : 0;
        long L;
        if (split) { const int hG = G / 2; if (c < hG) { if (i > 0) return false; L = c; } else { if (i > 2) return false; L = (long)c + (long)hG * i; } }
        else L = (long)i * G + c;
        if (L >= nwg) return false;
        int wgid = (int)L; { const int q = nwg / NXCD, r = nwg % NXCD, xcd = wgid % NXCD, off = wgid / NXCD; wgid = (xcd < r ? xcd * (q + 1) : r * (q + 1) + (xcd - r) * q) + off; }
        const int nig = WGM * nN, gid = wgid / nig, fm = gid * WGM, gsz = (nM - fm) < WGM ? (nM - fm) : WGM;
        u.pm = fm + ((wgid % nig) % gsz); u.pn = pn0 + (wgid % nig) / gsz; return true;
    }
};

__device__ __forceinline__ unsigned cvt_pk_bf16(float lo, float hi) { unsigned r; asm volatile("v_cvt_pk_bf16_f32 %0, %1, %2" : "=v"(r) : "v"(lo), "v"(hi)); return r; }


struct EpiZ {
    static constexpr bool PERM = true;
    bf16_t* Z; const float* b_gate; float zs;
    __device__ __forceinline__ void operator()(const f32x4 (&acc)[2][2][4][2], const Unit& u, int wr, int wc, int fr, int fq) const {
        const int row0 = u.pm * BM + wr * 64 + fr, col0 = u.pn * BM + wc * 32 + 8 * fq;
        const int mode = u.pn < 4 ? 0 : (u.pn < 12 ? 1 : 2);
        f32x4 bv[2][2];
#pragma unroll
        for (int bj = 0; bj < 2; ++bj)
#pragma unroll
            for (int n = 0; n < 2; ++n) bv[bj][n] = (mode == 2) ? *(const f32x4*)(b_gate + (col0 - 3072) + bj * HALF + 4 * n) : (f32x4){0.f, 0.f, 0.f, 0.f};
#pragma unroll
        for (int ai = 0; ai < 2; ++ai)
#pragma unroll
            for (int m = 0; m < 4; ++m) { bf16_t* rowp = Z + (size_t)(row0 + ai * HALF + m * 16) * INW + col0;
#pragma unroll
                for (int bj = 0; bj < 2; ++bj) { f32x4 v0 = acc[ai][bj][m][0], v1 = acc[ai][bj][m][1];
                    if (mode == 1) {
#pragma unroll
                        for (int j = 0; j < 4; ++j) { v0[j] = gelu_tanh(v0[j]); v1[j] = gelu_tanh(v1[j]); } }
                    if (mode == 2) { v0 = v0 * zs + bv[bj][0]; v1 = v1 * zs + bv[bj][1];
#pragma unroll
                        for (int j = 0; j < 4; ++j) { v0[j] = sigmoidf_(v0[j]); v1[j] = sigmoidf_(v1[j]); } }
                    u32x4 w; w.x = cvt_pk_bf16(v0[0], v0[1]); w.y = cvt_pk_bf16(v0[2], v0[3]); w.z = cvt_pk_bf16(v1[0], v1[1]); w.w = cvt_pk_bf16(v1[2], v1[3]);
                    *(u32x4*)(rowp + bj * HALF) = w; } }
    }
};
struct EpiChain {
    static constexpr bool PERM = true;
    const bf16_t* Z; bf16_t* O;
    __device__ __forceinline__ void operator()(f32x4 (&acc)[2][2][4][2], const Unit& u, int wr, int wc, int fr, int fq) const {
        const int row0 = u.pm * BM + wr * 64 + fr, col0 = u.pn * BM + wc * 32 + 8 * fq;
        if (u.sub == 0) {
#pragma unroll
            for (int ai = 0; ai < 2; ++ai)
#pragma unroll
                for (int m = 0; m < 4; ++m) { const size_t row = (size_t)(row0 + ai * HALF + m * 16);
#pragma unroll
                    for (int bj = 0; bj < 2; ++bj) { const int c = col0 + bj * HALF;
                        const u32x4 ga = *(const u32x4*)(Z + row * INW + 3072 + c), gb = *(const u32x4*)(Z + row * INW + 5120 + c);
                        f32x4 r0, r1;
                        r0[0] = bflo(ga.x) * __builtin_amdgcn_rcpf(fmaxf(bflo(gb.x), 1.0e-30f)); r0[1] = bfhi(ga.x) * __builtin_amdgcn_rcpf(fmaxf(bfhi(gb.x), 1.0e-30f));
                        r0[2] = bflo(ga.y) * __builtin_amdgcn_rcpf(fmaxf(bflo(gb.y), 1.0e-30f)); r0[3] = bfhi(ga.y) * __builtin_amdgcn_rcpf(fmaxf(bfhi(gb.y), 1.0e-30f));
                        r1[0] = bflo(ga.z) * __builtin_amdgcn_rcpf(fmaxf(bflo(gb.z), 1.0e-30f)); r1[1] = bfhi(ga.z) * __builtin_amdgcn_rcpf(fmaxf(bfhi(gb.z), 1.0e-30f));
                        r1[2] = bflo(ga.w) * __builtin_amdgcn_rcpf(fmaxf(bflo(gb.w), 1.0e-30f)); r1[3] = bfhi(ga.w) * __builtin_amdgcn_rcpf(fmaxf(bfhi(gb.w), 1.0e-30f));
                        acc[ai][bj][m][0] *= r0; acc[ai][bj][m][1] *= r1; asm volatile("" ::: "memory"); } }
        } else {
#pragma unroll
            for (int ai = 0; ai < 2; ++ai)
#pragma unroll
                for (int m = 0; m < 4; ++m) { const size_t row = (size_t)(row0 + ai * HALF + m * 16);
#pragma unroll
                    for (int bj = 0; bj < 2; ++bj) { const int c = col0 + bj * HALF;
                        const u32x4 g = *(const u32x4*)(Z + row * INW + 5120 + c);
                        const f32x4 a0 = acc[ai][bj][m][0], a1 = acc[ai][bj][m][1];
                        u32x4 w; w.x = cvt_pk_bf16(fmaxf(bflo(g.x), 1.0e-30f) * a0[0], fmaxf(bfhi(g.x), 1.0e-30f) * a0[1]); w.y = cvt_pk_bf16(fmaxf(bflo(g.y), 1.0e-30f) * a0[2], fmaxf(bfhi(g.y), 1.0e-30f) * a0[3]);
                        w.z = cvt_pk_bf16(fmaxf(bflo(g.z), 1.0e-30f) * a1[0], fmaxf(bfhi(g.z), 1.0e-30f) * a1[1]); w.w = cvt_pk_bf16(fmaxf(bflo(g.w), 1.0e-30f) * a1[2], fmaxf(bfhi(g.w), 1.0e-30f) * a1[3]);
                        *(u32x4*)(O + row * D + c) = w; asm volatile("" ::: "memory"); } }
        }
    }
};
struct EpiX1 {
    static constexpr bool PERM = true;
    const float* X; bf16_t* XB; float* SS;
    __device__ __forceinline__ void operator()(const f32x4 (&acc)[2][2][4][2], const Unit& u, int wr, int wc, int fr, int fq) const {
        const int row0 = u.pm * BM + wr * 64 + fr, col0 = u.pn * BM + wc * 32 + 8 * fq;
#pragma unroll
        for (int ai = 0; ai < 2; ++ai)
#pragma unroll
            for (int m = 0; m < 4; ++m) { const size_t row = (size_t)(row0 + ai * HALF + m * 16); float ss = 0.f;
#pragma unroll
                for (int bj = 0; bj < 2; ++bj) { const size_t off = row * D + col0 + bj * HALF;
                    const f32x4 x0 = *(const f32x4*)(X + off) + acc[ai][bj][m][0], x1 = *(const f32x4*)(X + off + 4) + acc[ai][bj][m][1];
                    ss += (x0[0] * x0[0] + x0[1] * x0[1]) + (x0[2] * x0[2] + x0[3] * x0[3]) + (x1[0] * x1[0] + x1[1] * x1[1]) + (x1[2] * x1[2] + x1[3] * x1[3]);
                    u32x4 w; w.x = cvt_pk_bf16(x0[0], x0[1]); w.y = cvt_pk_bf16(x0[2], x0[3]); w.z = cvt_pk_bf16(x1[0], x1[1]); w.w = cvt_pk_bf16(x1[2], x1[3]);
                    *(u32x4*)(XB + off) = w; }
                ss += __shfl_xor(ss, 16); ss += __shfl_xor(ss, 32);
                if (fq == 0) SS[row * 32 + u.pn * 4 + wc] = ss;
                asm volatile("" ::: "memory"); }
    }
};
struct EpiQ {
    static constexpr bool PERM = true;
    bf16_t* O; const float* SS;
    __device__ __forceinline__ void operator()(const f32x4 (&acc)[2][2][4][2], const Unit& u, int wr, int wc, int fr, int fq) const {
        const int row0 = u.pm * BM + wr * 64 + fr, col0 = u.pn * BM + wc * 32 + 8 * fq;
#pragma unroll
        for (int ai = 0; ai < 2; ++ai)
#pragma unroll
            for (int m = 0; m < 4; ++m) { const size_t row = (size_t)(row0 + ai * HALF + m * 16);
                const f32x4 p0 = *(const f32x4*)(SS + row * 32 + fq * 8), p1 = *(const f32x4*)(SS + row * 32 + fq * 8 + 4);
                float ss = ((p0[0] + p0[1]) + (p0[2] + p0[3])) + ((p1[0] + p1[1]) + (p1[2] + p1[3]));
                ss += __shfl_xor(ss, 16); ss += __shfl_xor(ss, 32);
                const float rstd = 1.0f / sqrtf(ss * (1.0f / D) + EPS);
                bf16_t* rowp = O + row * D + col0;
#pragma unroll
                for (int bj = 0; bj < 2; ++bj) { const f32x4 v0 = acc[ai][bj][m][0] * rstd, v1 = acc[ai][bj][m][1] * rstd;
                    u32x4 w; w.x = cvt_pk_bf16(v0[0], v0[1]); w.y = cvt_pk_bf16(v0[2], v0[3]); w.z = cvt_pk_bf16(v1[0], v1[1]); w.w = cvt_pk_bf16(v1[2], v1[3]);
                    *(u32x4*)(rowp + bj * HALF) = w; } }
    }
};

typedef int i32x8 __attribute__((ext_vector_type(8)));
template <class Epi, bool ALIGN_EPI = true, bool FP8 = false>
__device__ __forceinline__ void gemm_phase(LAS unsigned char* lds, const Gemm g, const StaticOrder& S_, const Epi& E) {
    int tid_ = threadIdx.x; asm volatile("" : "+v"(tid_));
    const int tid = tid_, wid = __builtin_amdgcn_readfirstlane(tid >> 6), lane = tid & 63, wr = wid >> 2, wc = wid & 3, fr = lane & 15, fq = lane >> 4;
    const int K = g.K, nt1 = K / BK, nt0 = g.K0 / BK;
    unsigned voffA[2], voffB[2];
#pragma unroll
    for (int i = 0; i < 2; ++i) { int R, C; stage_rc(tid * 16 + i * 8192, R, C); const int Rb = Epi::PERM ? ((R & ~31) + perm32(R & 31)) : R;
        voffA[i] = (unsigned)(R * g.lda + C) * 2u; voffB[i] = (unsigned)(Rb * g.ldb + C) * 2u; }
    const size_t kstep = (size_t)(BK * 2);
    const size_t hstepA = (size_t)HALF * g.lda * 2, hstepB = (size_t)HALF * g.ldb * 2;
    const unsigned ldsw = (unsigned)wid * 1024u;
    const int aoff = lds_byte(wr * 64 + fr, fq * 8), boff = lds_byte(wc * 32 + fr, fq * 8);
#define PG8_SA(b, h) (((b) * 2 + (h)) * HTB)
#define PG8_SB(b, h) ((4 + (b) * 2 + (h)) * HTB)
#define PG8_STAGE(bufoff, gbase, voff) do { _Pragma("unroll") for (int _i = 0; _i < 2; ++_i) \
        __builtin_amdgcn_global_load_lds((const unsigned*)((const char*)(gbase) + (voff)[_i]), (LAS unsigned*)(lds + (bufoff) + ldsw + _i * 8192), 16, 0, 0); } while (0)
#define PG8_LDA(dst, b, h) do { _Pragma("unroll") for (int m = 0; m < 4; ++m) _Pragma("unroll") for (int k = 0; k < 2; ++k) dst[m][k] = *(const LAS bf16x8*)(lds + PG8_SA(b, h) + aoff + m * 2048 + k * 1024); } while (0)
#define PG8_LDB(dst, b, h) do { _Pragma("unroll") for (int n = 0; n < 2; ++n) _Pragma("unroll") for (int k = 0; k < 2; ++k) dst[n][k] = *(const LAS bf16x8*)(lds + PG8_SB(b, h) + boff + n * 2048 + k * 1024); } while (0)
#define PG8_CAT(x) __builtin_bit_cast(i32x8, __builtin_shufflevector(x[0], x[1], 0, 1, 2, 3, 4, 5, 6, 7, 8, 9, 10, 11, 12, 13, 14, 15))
#define PG8_MMA(ai, bj, At, Bt) do { __builtin_amdgcn_s_setprio(1); _Pragma("unroll") for (int m = 0; m < 4; ++m) _Pragma("unroll") for (int n = 0; n < 2; ++n) { \
        if constexpr (FP8) asm volatile("v_mfma_f32_16x16x128_f8f6f4 %0, %1, %2, %0" : "+v"(acc[ai][bj][m][n]) : "v"(PG8_CAT(Bt[n])), "v"(PG8_CAT(At[m])));   \
        else { _Pragma("unroll") for (int k = 0; k < 2; ++k) acc[ai][bj][m][n] = __builtin_amdgcn_mfma_f32_16x16x32_bf16(Bt[n][k], At[m][k], acc[ai][bj][m][n], 0, 0, 0); } } \
        __builtin_amdgcn_s_setprio(0); } while (0)
#define PG8_WAIT_V(n) asm volatile("s_waitcnt vmcnt(" #n ")" ::: "memory")
#define PG8_WAIT_L(n) asm volatile("s_waitcnt lgkmcnt(" #n ")" ::: "memory")
#define PG8_BAR __builtin_amdgcn_s_barrier()
#define PG8_SCHED __builtin_amdgcn_sched_barrier(0)
    Unit cur, nxt; int ui = 0;
    if (!S_.next(0, cur)) return;
    f32x4 acc[2][2][4][2];
#pragma unroll
    for (int a = 0; a < 2; ++a)
#pragma unroll
        for (int b = 0; b < 2; ++b)
#pragma unroll
            for (int m = 0; m < 4; ++m)
#pragma unroll
                for (int n = 0; n < 2; ++n) acc[a][b][m][n] = (f32x4){0.f, 0.f, 0.f, 0.f};
    bf16x8 At[4][2], B0[2][2], B1[2][2];
    const char* cA = a_ptr(g, cur); const char* cB = b_ptr(g, cur);
    PG8_STAGE(PG8_SB(0, 0), cB, voffB); PG8_STAGE(PG8_SB(0, 1), cB + hstepB, voffB); PG8_STAGE(PG8_SA(0, 0), cA, voffA); PG8_STAGE(PG8_SA(0, 1), cA + hstepA, voffA);
    if (wr == 1) PG8_BAR;
    PG8_WAIT_V(2); PG8_BAR;
    PG8_STAGE(PG8_SB(1, 0), cB + kstep, voffB); PG8_STAGE(PG8_SA(1, 0), cA + kstep, voffA); PG8_STAGE(PG8_SB(1, 1), cB + hstepB + kstep, voffB);
    PG8_WAIT_V(6); PG8_BAR;
    for (;;) {
        const bool has_next = S_.next(ui + 1, nxt);
        const char* nA = has_next ? a_ptr(g, nxt) : cA; const char* nB = has_next ? b_ptr(g, nxt) : cB;
        const int nt = (g.mode == 2 && cur.sub == 0) ? nt0 : nt1;
        for (int t = 0; t < nt; t += 2) {
            const bool last = (t == nt - 2);
            const char* a1 = cA + (size_t)(t + 1) * kstep;
            const char* a2 = last ? nA : cA + (size_t)(t + 2) * kstep; const char* b2 = last ? nB : cB + (size_t)(t + 2) * kstep;
            const char* a3 = a2 + kstep; const char* b3 = b2 + kstep;
            PG8_LDB(B0, 0, 0); PG8_LDB(B1, 0, 1); PG8_SCHED; PG8_LDA(At, 0, 0); PG8_STAGE(PG8_SA(1, 1), a1 + hstepA, voffA);
            PG8_WAIT_V(8); PG8_WAIT_L(0); PG8_BAR; PG8_MMA(0, 0, At, B0); PG8_MMA(0, 1, At, B1); PG8_BAR; PG8_SCHED;
            PG8_LDA(At, 0, 1); PG8_STAGE(PG8_SB(0, 0), b2, voffB); PG8_STAGE(PG8_SB(0, 1), b2 + hstepB, voffB); PG8_STAGE(PG8_SA(0, 0), a2, voffA);
            PG8_WAIT_V(8); PG8_WAIT_L(0); PG8_BAR; PG8_MMA(1, 0, At, B0); PG8_MMA(1, 1, At, B1); PG8_BAR; PG8_SCHED;
            PG8_LDB(B0, 1, 0); PG8_LDB(B1, 1, 1); PG8_SCHED; PG8_LDA(At, 1, 0); PG8_STAGE(PG8_SA(0, 1), a2 + hstepA, voffA);
            PG8_WAIT_V(8); PG8_WAIT_L(0); PG8_BAR; PG8_MMA(0, 0, At, B0); PG8_MMA(0, 1, At, B1); PG8_BAR; PG8_SCHED;
            PG8_LDA(At, 1, 1); PG8_STAGE(PG8_SB(1, 0), b3, voffB); PG8_STAGE(PG8_SB(1, 1), b3 + hstepB, voffB); PG8_STAGE(PG8_SA(1, 0), a3, voffA);
            PG8_WAIT_V(8); PG8_WAIT_L(0); PG8_BAR; PG8_MMA(1, 0, At, B0); PG8_MMA(1, 1, At, B1); PG8_BAR; PG8_SCHED;
        }
        if constexpr (ALIGN_EPI) { if (wr == 0) PG8_BAR; }
        if constexpr (FP8) asm volatile("s_nop 15\n\ts_nop 15" ::: "memory");
        { int ln_ = threadIdx.x & 63; asm volatile("" : "+v"(ln_));
          E(acc, cur, wr, wc, ln_ & 15, ln_ >> 4); }
        if (!has_next) break;
        if (!(g.mode == 2 && cur.sub == 0))
#pragma unroll
        for (int a = 0; a < 2; ++a)
#pragma unroll
            for (int b = 0; b < 2; ++b)
#pragma unroll
                for (int m = 0; m < 4; ++m)
#pragma unroll
                    for (int n = 0; n < 2; ++n) acc[a][b][m][n] = (f32x4){0.f, 0.f, 0.f, 0.f};
        cur = nxt; cA = nA; cB = nB; ++ui;
        if constexpr (ALIGN_EPI) { if (wr == 1) PG8_BAR; }
    }
    PG8_WAIT_V(0);
    if constexpr (!ALIGN_EPI) { if (wr == 0) PG8_BAR; }
    PG8_BAR;
#undef PG8_SA
#undef PG8_SB
#undef PG8_STAGE
#undef PG8_LDA
#undef PG8_LDB
#undef PG8_MMA
#undef PG8_CAT
#undef PG8_WAIT_V
#undef PG8_WAIT_L
#undef PG8_BAR
#undef PG8_SCHED
}
}

struct Args { const float* in[18]; float* out; unsigned char* ws; int ph_lo, ph_hi; };

__device__ __forceinline__ void p0_transpose_item(const float* W, int K, int N, bf16_t* WT, LAS float* scr, int item, int lane, const float* kgain = nullptr, unsigned char* W8 = nullptr, int n8 = 0, float s8 = 1.0f, int ldwt = 0) {
    const int nblk = N / 32, kb = item / nblk, nb = item % nblk, k0 = 64 * kb, n0 = 32 * nb;
    { f32x4 wv[8];
#pragma unroll
      for (int i = 0; i < 8; ++i) wv[i] = *(const f32x4*)(W + (size_t)(k0 + 8 * i + (lane >> 3)) * N + n0 + 4 * (lane & 7));
#pragma unroll
      for (int i = 0; i < 8; ++i) { const int kk = 8 * i + (lane >> 3); const float gk = kgain ? kgain[k0 + kk] : 1.0f; LAS float* sp = scr + kk * 33 + 4 * (lane & 7);
          sp[0] = gk * wv[i].x; sp[1] = gk * wv[i].y; sp[2] = gk * wv[i].z; sp[3] = gk * wv[i].w; } }
    asm volatile("s_waitcnt lgkmcnt(0)" ::: "memory");
    const int c = lane & 7;
    if (W8 != nullptr && n0 >= n8) {
#pragma unroll
        for (int j = 0; j < 4; ++j) { const int n = (lane >> 3) + 8 * j; const LAS float* s = scr + (8 * c) * 33 + n;
            int w0 = __builtin_amdgcn_cvt_pk_fp8_f32(s[0 * 33] * s8, s[1 * 33] * s8, 0, false); w0 = __builtin_amdgcn_cvt_pk_fp8_f32(s[2 * 33] * s8, s[3 * 33] * s8, w0, true);
            int w1 = __builtin_amdgcn_cvt_pk_fp8_f32(s[4 * 33] * s8, s[5 * 33] * s8, 0, false); w1 = __builtin_amdgcn_cvt_pk_fp8_f32(s[6 * 33] * s8, s[7 * 33] * s8, w1, true);
            u32x2 o; o.x = (unsigned)w0; o.y = (unsigned)w1; *(u32x2*)(W8 + (size_t)(n0 + n) * K + k0 + 8 * c) = o; }
    } else {
#pragma unroll
    for (int j = 0; j < 4; ++j) { const int n = (lane >> 3) + 8 * j; const LAS float* s = scr + (8 * c) * 33 + n;
        u32x4 o; o.x = pk2(s[0 * 33], s[1 * 33]); o.y = pk2(s[2 * 33], s[3 * 33]); o.z = pk2(s[4 * 33], s[5 * 33]); o.w = pk2(s[6 * 33], s[7 * 33]);
        *(u32x4*)(WT + (size_t)(n0 + n) * (ldwt ? ldwt : K) + k0 + 8 * c) = o; }
    }
    asm volatile("s_waitcnt lgkmcnt(0)" ::: "memory");
}
__device__ __forceinline__ void rms_row_to_bf16(const float* xrow, const float* g, bf16_t* orow, int lane, unsigned char* o8row = nullptr, float s8 = 1.0f) {
    const f32x4* xr = (const f32x4*)xrow + lane;
    f32x4 v[8]; float s = 0.f;
#pragma unroll
    for (int j = 0; j < 8; ++j) { v[j] = xr[64 * j]; s += (v[j].x * v[j].x + v[j].y * v[j].y) + (v[j].z * v[j].z + v[j].w * v[j].w); }
    const float rstd = 1.0f / sqrtf(wave_sum(s) * (1.0f / D) + EPS);
    const f32x4* gr = (const f32x4*)g + lane;
    u32x2* o8 = (u32x2*)orow + lane;
#pragma unroll
    for (int j = 0; j < 8; ++j) { const f32x4 gv = gr[64 * j]; const float h0 = v[j].x * rstd * gv.x, h1 = v[j].y * rstd * gv.y, h2 = v[j].z * rstd * gv.z, h3 = v[j].w * rstd * gv.w;
        u32x2 o; o.x = pk2(h0, h1); o.y = pk2(h2, h3); o8[64 * j] = o;
        if (o8row != nullptr) { int w = __builtin_amdgcn_cvt_pk_fp8_f32(h0 * s8, h1 * s8, 0, false); w = __builtin_amdgcn_cvt_pk_fp8_f32(h2 * s8, h3 * s8, w, true); ((unsigned*)o8row)[64 * j + lane] = (unsigned)w; } }
}
__device__ __forceinline__ void cvt_stream(const float* src, bf16_t* dst, size_t n8, size_t gtid, size_t nthr) {
    for (size_t i = gtid; i < n8; i += nthr) { const f32x4 a = ((const f32x4*)src)[2 * i], b = ((const f32x4*)src)[2 * i + 1];
        u32x4 o; o.x = pk2(a.x, a.y); o.y = pk2(a.z, a.w); o.z = pk2(b.x, b.y); o.w = pk2(b.z, b.w); ((u32x4*)dst)[i] = o; }
}

constexpr int EROW = 1536;
typedef unsigned u32x6 __attribute__((ext_vector_type(6)));
typedef float f32x16 __attribute__((ext_vector_type(16)));
typedef float f32x32 __attribute__((ext_vector_type(32)));
typedef unsigned u32x16 __attribute__((ext_vector_type(16)));
#ifndef FP6_ENC_INTERLEAVED
#define FP6_ENC_INTERLEAVED 1
#endif
__device__ __forceinline__ void expert_row_load(const float* src, f32x4 (&v)[8], int lane) {
    const f32x4* xr = (const f32x4*)src + lane;
#pragma unroll
    for (int k = 0; k < 8; ++k) v[k] = xr[64 * k];
}
__device__ __forceinline__ void expert_row_gain(f32x4 (&v)[8], const float* g, int lane) {
    const f32x4* gr = (const f32x4*)g + lane;
#pragma unroll
    for (int k = 0; k < 8; ++k) v[k] = v[k] * gr[64 * k];
}
__device__ __forceinline__ void expert_row_store(const f32x4 (&v)[8], unsigned char* dst, float* isc, int lane) {
    float am = 0.f;
#pragma unroll
    for (int k = 0; k < 8; ++k) am = fmaxf(am, fmaxf(fmaxf(fabsf(v[k].x), fabsf(v[k].y)), fmaxf(fabsf(v[k].z), fabsf(v[k].w))));
#pragma unroll
    for (int o = 1; o < 64; o <<= 1) am = fmaxf(am, __shfl_xor(am, o));
    float sc = 1.0f, inv = 1.0f;
    if (am > 0.f) { const float amc = fminf(fmaxf(am, 1.0e-30f), 1.0e30f); sc = 7.5f / amc; inv = amc * (1.0f / 7.5f); }
    f32x16 ea, eb;
#pragma unroll
    for (int j = 0; j < 16; ++j) {
#if FP6_ENC_INTERLEAVED
        const int ja = 2 * j, jb = 2 * j + 1;
#else
        const int ja = j, jb = 16 + j;
#endif
        ea[j] = v[ja >> 2][ja & 3] * sc; eb[j] = v[jb >> 2][jb & 3] * sc; }
    const u32x6 o = __builtin_amdgcn_cvt_scalef32_2xpk16_fp6_f32(ea, eb, 1.0f);
    u32x4 o0; o0.x = o[0]; o0.y = o[1]; o0.z = o[2]; o0.w = o[3]; u32x2 o1; o1.x = o[4]; o1.y = o[5];
    *(u32x4*)(dst + lane * 16) = o0; *(u32x2*)(dst + 1024 + lane * 8) = o1;
    if (lane == 0) *isc = inv;
}

__device__ __forceinline__ void p0_score_weights(const Args& a, int item, int lane) {
    const float* wq = a.in[13]; const float* g2 = a.in[12]; const float* keys = a.in[14]; bf16_t* M = (bf16_t*)(a.ws + WS_WQ);
    const int b = item >> 7, kt = item & 127, fr = lane & 15, fq = lane >> 4;
    const int k = kt * 16 + fr; const float gk = g2[k];
    bf16x8 wf[4];
#pragma unroll
    for (int ks = 0; ks < 4; ++ks) { const float* p = wq + (size_t)k * D + b * 128 + ks * 32 + fq * 8; const f32x4 x0 = *(const f32x4*)p, x1 = *(const f32x4*)(p + 4);
        u32x4 w; w.x = pk2(gk * x0.x, gk * x0.y); w.y = pk2(gk * x0.z, gk * x0.w); w.z = pk2(gk * x1.x, gk * x1.y); w.w = pk2(gk * x1.z, gk * x1.w); wf[ks] = __builtin_bit_cast(bf16x8, w); }
#pragma unroll 2
    for (int nb = 0; nb < 8; ++nb) {
        f32x4 acc = {0.f, 0.f, 0.f, 0.f};
#pragma unroll
        for (int ks = 0; ks < 4; ++ks) { const float* p = keys + (size_t)(b * 128 + nb * 16 + fr) * 128 + ks * 32 + fq * 8; const f32x4 x0 = *(const f32x4*)p, x1 = *(const f32x4*)(p + 4);
            u32x4 w; w.x = pk2(x0.x, x0.y); w.y = pk2(x0.z, x0.w); w.z = pk2(x1.x, x1.y); w.w = pk2(x1.z, x1.w);
            acc = __builtin_amdgcn_mfma_f32_16x16x32_bf16(wf[ks], __builtin_bit_cast(bf16x8, w), acc, 0, 0, 0); }
        u32x2 o; o.x = pk2(acc[0], acc[1]); o.y = pk2(acc[2], acc[3]);
        *(u32x2*)(M + (size_t)(b * 128 + nb * 16 + fr) * D + kt * 16 + fq * 4) = o;
    }
}

__device__ __forceinline__ void p0_prologue(const Args& a, LAS unsigned char* lds, int vcu, int G, int wave, int lane, int tid) {
    unsigned char* ws = a.ws;
    LAS float* scr = (LAS float*)(lds + wave * 16384);
    const int gw = vcu * NWAVES + wave, NGW = G * NWAVES;
    constexpr int I_IN = (D / 64) * (INW / 32), I_POOL1 = (256 / 64) * (512 / 32), I_G = (GWD / 64) * (D / 32), I_O = (D / 64) * (D / 32);
    constexpr int NITEMS = I_IN + 4 * I_POOL1 + I_G + I_O;
    for (int it = gw; it < NITEMS; it += NGW) {
        int r = it;
        if (r < I_IN) { p0_transpose_item(a.in[2], D, INW, (bf16_t*)(ws + WS_WIN), scr, r, lane, nullptr, ws + WS_W8, 3072, W8_SCALE); continue; } r -= I_IN;
        if (r < 4 * I_POOL1) { const int g = r / I_POOL1; p0_transpose_item(a.in[5] + (size_t)g * 256 * 512, 256, 512, (bf16_t*)(ws + WS_WPOOL) + (size_t)g * 512 * GWD, scr, r % I_POOL1, lane, nullptr, nullptr, 0, 1.0f, GWD); continue; } r -= 4 * I_POOL1;
        if (r < I_G) { p0_transpose_item(a.in[10], GWD, D, (bf16_t*)(ws + WS_WG), scr, r, lane); continue; } r -= I_G;
        p0_transpose_item(a.in[11], D, D, (bf16_t*)(ws + WS_WOUT), scr, r, lane);
    }
    for (int it = gw; it < 16 * (D / 16); it += NGW) p0_score_weights(a, it, lane);
    for (int m = gw; m < S; m += NGW) rms_row_to_bf16(a.in[0] + (size_t)m * D, a.in[1], (bf16_t*)(ws + WS_H) + (size_t)m * D, lane, ws + WS_H8 + (size_t)m * D, H8_SCALE);
    unsigned tq_ = (unsigned)tid; asm volatile("" : "+v"(tq_));
    const size_t gtid = (size_t)vcu * NTHR + tq_, nthr = (size_t)G * NTHR;
    {
        const float* src = a.in[8]; bf16_t* dst = (bf16_t*)(ws + WS_WSM);
        for (size_t i = gtid; i < (size_t)8 * 128 * 128 / 8; i += nthr) { const int s0 = (int)(i & 15) * 8, t = (int)(i >> 4) & 127;
            const f32x4 x0 = ((const f32x4*)src)[2 * i], x1 = ((const f32x4*)src)[2 * i + 1];
            float v[8] = {x0.x, x0.y, x0.z, x0.w, x1.x, x1.y, x1.z, x1.w};
#pragma unroll
            for (int j = 0; j < 8; ++j) v[j] = (s0 + j <= t) ? v[j] : 0.f;
            u32x4 o; o.x = pk2(v[0], v[1]); o.y = pk2(v[2], v[3]); o.z = pk2(v[4], v[5]); o.w = pk2(v[6], v[7]); ((u32x4*)dst)[i] = o; }
    }
}

__device__ __forceinline__ void p2_pool(const Args& a, int vcu, int G, int tid) {
    const bf16_t* Z = (const bf16_t*)(a.ws + WS_Z); bf16_t* A2 = (bf16_t*)(a.ws + WS_A2); const float* psc = a.in[4];
    unsigned tq_ = (unsigned)tid; asm volatile("" : "+v"(tq_));
    const size_t gtid = (size_t)vcu * NTHR + tq_, nthr = (size_t)G * NTHR;
    for (size_t id = gtid; id < (size_t)(S / 8) * 128; id += nthr) {
        const int c8 = (int)(id & 127), t0 = (int)(id >> 7) * 8, g = c8 >> 5, w = 2 << g;
        u32x4 row[23];
#pragma unroll
        for (int r = 0; r < 23; ++r) { const int t = t0 - 15 + r; const bool need = (r >= 16 - w) && (t >= 0);
            row[r] = need ? *(const u32x4*)(Z + (size_t)t * INW + c8 * 8) : (u32x4){0u, 0u, 0u, 0u}; }
        const f32x4 p0 = *(const f32x4*)(psc + c8 * 8), p1 = *(const f32x4*)(psc + c8 * 8 + 4);
        const float ps[8] = {p0.x, p0.y, p0.z, p0.w, p1.x, p1.y, p1.z, p1.w};
        float s[8] = {0.f, 0.f, 0.f, 0.f, 0.f, 0.f, 0.f, 0.f};
#pragma unroll
        for (int r = 0; r < 15; ++r) { const u32x4 q = row[r];
            s[0] += bflo(q.x); s[1] += bfhi(q.x); s[2] += bflo(q.y); s[3] += bfhi(q.y); s[4] += bflo(q.z); s[5] += bfhi(q.z); s[6] += bflo(q.w); s[7] += bfhi(q.w); }
#pragma unroll
        for (int i = 0; i < 8; ++i) {
            const u32x4 q = row[15 + i];
            const float at[8] = {bflo(q.x), bfhi(q.x), bflo(q.y), bfhi(q.y), bflo(q.z), bfhi(q.z), bflo(q.w), bfhi(q.w)};
#pragma unroll
            for (int c = 0; c < 8; ++c) s[c] += at[c];
            const int t = t0 + i; const int cnt = (t + 1) < w ? (t + 1) : w; const float inv = 1.0f / (float)cnt;
            float o[8];
#pragma unroll
            for (int c = 0; c < 8; ++c) o[c] = (s[c] * inv - at[c]) * ps[c];
            u32x4 w4; w4.x = pk2(o[0], o[1]); w4.y = pk2(o[2], o[3]); w4.z = pk2(o[4], o[5]); w4.w = pk2(o[6], o[7]);
            *(u32x4*)(A2 + (size_t)t * D + c8 * 8) = w4;
            const u32x4 d2 = row[15 + i - 1], d4 = row[15 + i - 3], d8 = row[15 + i - 7], d16 = row[15 + i - 15];
            const u32x4 dq = g == 0 ? d2 : (g == 1 ? d4 : (g == 2 ? d8 : d16));
            s[0] -= bflo(dq.x); s[1] -= bfhi(dq.x); s[2] -= bflo(dq.y); s[3] -= bfhi(dq.y); s[4] -= bflo(dq.z); s[5] -= bfhi(dq.z); s[6] -= bflo(dq.w); s[7] -= bfhi(dq.w);
        }
    }
}
constexpr int VT_LD = 136;
__device__ __forceinline__ void p2_sgu(const Args& a, LAS unsigned char* lds, int item0, int item1, int istep, int wave, int lane, int tid) {
    const bf16_t* Z = (const bf16_t*)(a.ws + WS_Z); bf16_t* A2 = (bf16_t*)(a.ws + WS_A2); const bf16_t* WSM = (const bf16_t*)(a.ws + WS_WSM);
    const float* lng = a.in[6]; const float* lnb = a.in[7]; const float* bs = a.in[9];
    LAS float* st = (LAS float*)lds; LAS bf16_t* Vt = (LAS bf16_t*)(lds + 1024);
    const int fr = lane & 15, fq = lane >> 4;
    int prev_c = -1;
    for (int item = item0; item < item1; item += istep) {
        const int c = item >> 3, h = item & 7, t0 = c * 128; const bool need_stats = (c != prev_c); prev_c = c;
        u32x4 raw[4][8];
        if (need_stats) {
#pragma unroll
        for (int p = 0; p < 4; ++p) { const bf16_t* rp = Z + (size_t)(t0 + wave * 16 + p * 4 + fq) * INW + 2048 + fr * 8;
#pragma unroll
            for (int j = 0; j < 8; ++j) raw[p][j] = *(const u32x4*)(rp + j * 128); } }
        u32x4 rawB[4];
#pragma unroll
        for (int q = 0; q < 4; ++q) { const int id = tid + q * NTHR, sr = id & 127, dc = id >> 7; rawB[q] = *(const u32x4*)(Z + (size_t)(t0 + sr) * INW + 2048 + h * 128 + dc * 8); }
        bf16x8 bW[4];
#pragma unroll
        for (int ks = 0; ks < 4; ++ks) bW[ks] = *(const bf16x8*)(WSM + (size_t)(h * 128 + wave * 16 + fr) * 128 + ks * 32 + fq * 8);
        u32x2 ur[8];
#pragma unroll
        for (int db = 0; db < 8; ++db) ur[db] = *(const u32x2*)(Z + (size_t)(t0 + wave * 16 + fr) * INW + 1024 + h * 128 + db * 16 + fq * 4);
        const float bias = bs[h * 128 + wave * 16 + fr];
        if (need_stats) {
#pragma unroll
        for (int p = 0; p < 4; ++p) { float s = 0.f, q = 0.f;
#pragma unroll
            for (int j = 0; j < 8; ++j)
#pragma unroll
                for (int w = 0; w < 4; ++w) { const float a0 = bflo(raw[p][j][w]), a1 = bfhi(raw[p][j][w]); s += a0 + a1; q += a0 * a0 + a1 * a1; }
            s = row_sum_f32(s); q = row_sum_f32(q);
            if (fr == 0) { const float mean = s * (1.0f / 1024.0f); const float var = fmaxf(q * (1.0f / 1024.0f) - mean * mean, 0.f);
                const int sr = wave * 16 + p * 4 + fq; st[2 * sr] = mean; st[2 * sr + 1] = 1.0f / sqrtf(var + EPS); } }
        __syncthreads();
        }
#pragma unroll
        for (int q = 0; q < 4; ++q) { const int id = tid + q * NTHR, sr = id & 127, dc = id >> 7;
            const u32x4 rw = rawB[q];
            const float mean = st[2 * sr], rstd = st[2 * sr + 1];
            const float v[8] = {bflo(rw.x), bfhi(rw.x), bflo(rw.y), bfhi(rw.y), bflo(rw.z), bfhi(rw.z), bflo(rw.w), bfhi(rw.w)};
            const f32x4 g0 = *(const f32x4*)(lng + h * 128 + dc * 8), g1 = *(const f32x4*)(lng + h * 128 + dc * 8 + 4), b0 = *(const f32x4*)(lnb + h * 128 + dc * 8), b1 = *(const f32x4*)(lnb + h * 128 + dc * 8 + 4);
            const float gg[8] = {g0.x, g0.y, g0.z, g0.w, g1.x, g1.y, g1.z, g1.w}, bb[8] = {b0.x, b0.y, b0.z, b0.w, b1.x, b1.y, b1.z, b1.w};
#pragma unroll
            for (int i = 0; i < 8; ++i) { const int d = dc * 8 + i; const float y = (v[i] - mean) * rstd * gg[i] + bb[i]; Vt[d * VT_LD + sr] = (bf16_t)f2bf(y); } }
        __syncthreads();
        f32x4 acc[8];
#pragma unroll
        for (int db = 0; db < 8; ++db) acc[db] = (f32x4){0.f, 0.f, 0.f, 0.f};
        const int nks = (wave * 16 + 15) / 32 + 1;
#pragma unroll
        for (int ks = 0; ks < 4; ++ks) if (ks < nks) {
#pragma unroll
            for (int db = 0; db < 8; ++db) { const bf16x8 aV = *(const LAS bf16x8*)(Vt + (db * 16 + fr) * VT_LD + ks * 32 + fq * 8);
                acc[db] = __builtin_amdgcn_mfma_f32_16x16x32_bf16(aV, bW[ks], acc[db], 0, 0, 0); }
        }
        { const int t = t0 + wave * 16 + fr;
#pragma unroll
          for (int db = 0; db < 8; ++db) { const int col = h * 128 + db * 16 + fq * 4;
              u32x2 o; o.x = pk2(bflo(ur[db].x) * (acc[db][0] + bias), bfhi(ur[db].x) * (acc[db][1] + bias)); o.y = pk2(bflo(ur[db].y) * (acc[db][2] + bias), bfhi(ur[db].y) * (acc[db][3] + bias));
              *(u32x2*)(A2 + (size_t)t * D + 1024 + col) = o; } }
        __syncthreads();
    }
}

__device__ __forceinline__ unsigned f2key(float f) { const unsigned b = __builtin_bit_cast(unsigned, f); return (b & 0x80000000u) ? ~b : (b | 0x80000000u); }
__device__ __forceinline__ float key2f(unsigned k) { const unsigned b = (k & 0x80000000u) ? (k ^ 0x80000000u) : ~k; return __builtin_bit_cast(float, b); }
template <int CTRL> __device__ __forceinline__ unsigned dpp_max_u32(unsigned v) { const unsigned o = (unsigned)__builtin_amdgcn_update_dpp(0, (int)v, CTRL, 0xF, 0xF, true); return v > o ? v : o; }
__device__ __forceinline__ unsigned row_max_u32(unsigned v) { v = dpp_max_u32<0xB1>(v); v = dpp_max_u32<0x4E>(v); v = dpp_max_u32<0x141>(v); v = dpp_max_u32<0x140>(v); return v; }
__device__ __forceinline__ void ce_desc(unsigned& a, unsigned& b) { const unsigned hi = a > b ? a : b, lo = a > b ? b : a; a = hi; b = lo; }
__device__ __forceinline__ void sort8_desc(unsigned (&k)[8]) {
    ce_desc(k[0], k[1]); ce_desc(k[2], k[3]); ce_desc(k[4], k[5]); ce_desc(k[6], k[7]);
    ce_desc(k[0], k[2]); ce_desc(k[1], k[3]); ce_desc(k[4], k[6]); ce_desc(k[5], k[7]);
    ce_desc(k[1], k[2]); ce_desc(k[5], k[6]);
    ce_desc(k[0], k[4]); ce_desc(k[1], k[5]); ce_desc(k[2], k[6]); ce_desc(k[3], k[7]);
    ce_desc(k[2], k[4]); ce_desc(k[3], k[5]);
    ce_desc(k[1], k[2]); ce_desc(k[3], k[4]); ce_desc(k[5], k[6]);
}
__device__ __forceinline__ void sort4_desc(unsigned (&k)[4]) { ce_desc(k[0], k[1]); ce_desc(k[2], k[3]); ce_desc(k[0], k[2]); ce_desc(k[1], k[3]); ce_desc(k[1], k[2]); }
template <int NV> __device__ __forceinline__ unsigned row_top16_sorted(unsigned (&k)[NV], int fr) {
    unsigned tk = 0u;
    for (int it = 0; it < 16; ++it) {
        const unsigned m = row_max_u32(k[0]);
        const unsigned wm = (k[0] == m) ? 0xffffffffu : 0u;
#pragma unroll
        for (int i = 0; i + 1 < NV; ++i) k[i] = (k[i + 1] & wm) | (k[i] & ~wm);
        k[NV - 1] = k[NV - 1] & ~wm;
        tk = (fr == it) ? m : tk;
    }
    return tk;
}
__device__ __forceinline__ unsigned cand_table(int fr) {
    constexpr unsigned T[16] = {0x03020100u, 0x07060504u, 0x0b0a0908u, 0x0f0e0d0cu, 0x13121110u, 0x17161514u, 0x23222120u, 0x32313024u, 0x42414033u, 0x61605150u, 0x90807170u, 0xd0c0b0a0u, 0xfffff0e0u, 0xffffffffu, 0xffffffffu, 0xffffffffu};
    unsigned w = T[0];
#pragma unroll
    for (int i = 1; i < 16; ++i) w = (fr == i) ? T[i] : w;
    return w;
}
constexpr int SC_LD = 132;
__device__ __forceinline__ void p7_topk(const Args& a, LAS unsigned char* lds, int vcu, int G, int wave, int lane_) {
    int lane = lane_; asm volatile("" : "+v"(lane));
    const bf16_t* Q = (const bf16_t*)(a.ws + WS_Q);
    int* IDX = (int*)(a.ws + WS_IDX); float* GATE = (float*)(a.ws + WS_GATE);
    LAS float* SL = (LAS float*)(lds + wave * (16 * SC_LD * 4));
    const int gw = vcu * NWAVES + wave, NGW = G * NWAVES; const int fr = lane & 15, fq = lane >> 4;
    const unsigned ctab = cand_table(fr);
    int erow = gw;
    f32x4 er0[8], er1[8]; int e0 = 2 * NEXP, e1 = 2 * NEXP;
#define ER_LOAD() do { e0 = erow; e1 = erow + NGW; erow += 2 * NGW; \
        if (e0 < 2 * NEXP) expert_row_load(a.in[15 + (e0 >= NEXP)] + (size_t)(e0 & (NEXP - 1)) * D, er0, lane); \
        if (e1 < 2 * NEXP) expert_row_load(a.in[15 + (e1 >= NEXP)] + (size_t)(e1 & (NEXP - 1)) * D, er1, lane); } while (0)
#define ER_STORE() do { \
        if (e0 < NEXP) expert_row_gain(er0, a.in[12], lane); if (e1 < NEXP) expert_row_gain(er1, a.in[12], lane); \
        if (e0 < 2 * NEXP) expert_row_store(er0, a.ws + ((e0 >= NEXP) ? WS_EV : WS_EU) + (size_t)(e0 & (NEXP - 1)) * EROW, (float*)(a.ws + WS_ESC) + e0, lane); \
        if (e1 < 2 * NEXP) expert_row_store(er1, a.ws + ((e1 >= NEXP) ? WS_EV : WS_EU) + (size_t)(e1 & (NEXP - 1)) * EROW, (float*)(a.ws + WS_ESC) + e1, lane); } while (0)
    pg8::StaticOrder so7; so7.init(S, D, G, (int)blockIdx.x); pg8::Unit u7;
    u32x4 scn[4];
#define SC_LOAD(uu, uidx, pp) do { const int t0n_ = (uu).pm * 256 + (((uidx) & 1) * 8 + wave) * 16; _Pragma("unroll") for (int i = 0; i < 4; ++i) \
        scn[i] = *(const u32x4*)(Q + (size_t)(t0n_ + i * 4 + fq) * D + (uu).pn * 256 + (pp) * 128 + fr * 8); } while (0)
    if (so7.next(0, u7)) SC_LOAD(u7, 0, 0);
    for (int ui = 0; so7.next(ui >> 1, u7); ++ui) {
        const int h = u7.pn, t0 = u7.pm * 256 + ((ui & 1) * 8 + wave) * 16;
        unsigned tk[8];
#pragma unroll
        for (int i = 0; i < 8; ++i) tk[i] = 0u;
#pragma unroll 1
        for (int p = 0; p < 2; ++p) {
            {
#pragma unroll
                for (int i = 0; i < 4; ++i) { LAS float* d = SL + (i * 4 + fq) * SC_LD + fr * 8;
                    *(LAS f32x4*)d = (f32x4){bflo(scn[i].x), bfhi(scn[i].x), bflo(scn[i].y), bfhi(scn[i].y)}; *(LAS f32x4*)(d + 4) = (f32x4){bflo(scn[i].z), bfhi(scn[i].z), bflo(scn[i].w), bfhi(scn[i].w)}; }
                asm volatile("" ::: "memory");
                if (p == 0) SC_LOAD(u7, ui, 1); else { pg8::Unit u7n; if (so7.next((ui + 1) >> 1, u7n)) SC_LOAD(u7n, ui + 1, 0); }
            }
            ER_LOAD();
#pragma unroll 1
            for (int j = 0; j < 4; ++j) {
                unsigned k[8];
#pragma unroll
                for (int nb = 0; nb < 8; ++nb) k[nb] = (f2key(SL[(fq * 4 + j) * SC_LD + nb * 16 + fr]) & ~127u) | (127u - (unsigned)(nb * 16 + fr));
                sort8_desc(k);
                const unsigned r = row_top16_sorted<8>(k, fr);
#pragma unroll
                for (int i = 0; i < 8; ++i) tk[i] = (i == p * 4 + j) ? r : tk[i];
            }
            ER_STORE();
        }
#pragma unroll 1
        for (int j = 0; j < 4; ++j) {
            if ((j & 1) == 0) ER_LOAD();
            const unsigned tk1 = j == 0 ? tk[0] : (j == 1 ? tk[1] : (j == 2 ? tk[2] : tk[3])), tk2 = j == 0 ? tk[4] : (j == 1 ? tk[5] : (j == 2 ? tk[6] : tk[7]));
            const float t1 = key2f(tk1 & ~127u), t2 = key2f(tk2 & ~127u); const int i1 = 127 - (int)(tk1 & 127u), i2 = 127 - (int)(tk2 & 127u);
            unsigned kc[4];
#pragma unroll
            for (int e = 0; e < 4; ++e) { const unsigned ab = (ctab >> (8 * e)) & 255u; const int ca = (int)(ab >> 4), cb = (int)(ab & 15u);
                const float c = __shfl(t1, (lane & 48) + ca) + __shfl(t2, (lane & 48) + cb);
                kc[e] = (ab == 255u) ? 0u : ((f2key(c) & ~255u) | (255u - ab)); }
            sort4_desc(kc);
            const unsigned tkc = row_top16_sorted<4>(kc, fr);
            const float ts = key2f(tkc & ~255u); const int ci = 255 - (int)(tkc & 255u);
            const int ia = __shfl(i1, (lane & 48) + (ci >> 4)), ib = __shfl(i2, (lane & 48) + (ci & 15));
            const float tmax = __shfl(ts, lane & 48);
            const float e = __expf(ts - tmax); float sum = e;
            sum += __shfl_xor(sum, 1); sum += __shfl_xor(sum, 2); sum += __shfl_xor(sum, 4); sum += __shfl_xor(sum, 8);
            const int t = t0 + fq * 4 + j;
            IDX[(size_t)t * 128 + h * 16 + fr] = ia * 128 + ib;
            GATE[(size_t)t * 128 + h * 16 + fr] = e / sum;
            if ((j & 1) == 1) ER_STORE();
        }
    }
    for (; erow < 2 * NEXP; erow += NGW) { expert_row_load(a.in[15 + (erow >= NEXP)] + (size_t)(erow & (NEXP - 1)) * D, er0, lane); if (erow < NEXP) expert_row_gain(er0, a.in[12], lane);
        expert_row_store(er0, a.ws + ((erow >= NEXP) ? WS_EV : WS_EU) + (size_t)(erow & (NEXP - 1)) * EROW, (float*)(a.ws + WS_ESC) + erow, lane); }
#undef ER_LOAD
#undef ER_STORE
#undef SC_LOAD
}

typedef float f32x2 __attribute__((ext_vector_type(2)));
__device__ __forceinline__ u32x4 bl128(__amdgpu_buffer_rsrc_t r, unsigned voff, unsigned soff) { return __builtin_amdgcn_raw_buffer_load_b128(r, voff, soff, 0); }
__device__ __forceinline__ u32x2 bl64(__amdgpu_buffer_rsrc_t r, unsigned voff, unsigned soff) { return __builtin_amdgcn_raw_buffer_load_b64(r, voff, soff, 0); }
__device__ __forceinline__ unsigned bl32(__amdgpu_buffer_rsrc_t r, unsigned voff, unsigned soff) { return __builtin_amdgcn_raw_buffer_load_b32(r, voff, soff, 0); }
__device__ __forceinline__ float wave_sum_dpp(float v) {
    v = dpp_add_f32<0xB1>(v); v = dpp_add_f32<0x4E>(v); v = dpp_add_f32<0x141>(v); v = dpp_add_f32<0x140>(v);
    v += __builtin_bit_cast(float, __builtin_amdgcn_update_dpp(0, __builtin_bit_cast(int, v), 0x142, 0xA, 0xF, false));
    v += __builtin_bit_cast(float, __builtin_amdgcn_update_dpp(0, __builtin_bit_cast(int, v), 0x143, 0xC, 0xF, false));
    return __builtin_bit_cast(float, __builtin_amdgcn_readlane(__builtin_bit_cast(int, v), 63));
}
__device__ __forceinline__ float wave_sum_fast(float v) {
    v = dpp_add_f32<0xB1>(v); v = dpp_add_f32<0x4E>(v); v = dpp_add_f32<0x141>(v); v = dpp_add_f32<0x140>(v);
    v += __shfl_xor(v, 16); v += __shfl_xor(v, 32); return v;
}
constexpr int TPW = 4, NSL = 8, SL_SHIFT = 11, RING = 10, SLOT = 1536;
#define P8_VMW 18
typedef __bf16 bf16x2_t __attribute__((ext_vector_type(2)));
__device__ __forceinline__ float dot2bf(unsigned a, unsigned b, float c) { return __builtin_amdgcn_fdot2_f32_bf16(__builtin_bit_cast(bf16x2_t, a), __builtin_bit_cast(bf16x2_t, b), c, false); }
constexpr int NROWS = TPW * 128;
#define P8_ISSUE(TBASE) do { const unsigned ro_ = (unsigned)__builtin_amdgcn_readlane(lch_, ii_ & 63) * (unsigned)EROW; \
        const char* sb_ = (const char*)a.ws + (TBASE) + ro_; const char* sb2_ = sb_ + 1024; const unsigned dl_ = ring_lo + (unsigned)is_ * SLOT; \
        asm volatile("s_mov_b32 m0, %3\n\ts_nop 0\n\tglobal_load_lds_dwordx4 %0, %1\n\ts_mov_b32 m0, %4\n\ts_mov_b64 exec, %5\n\tglobal_load_lds_dwordx4 %0, %2\n\ts_mov_b64 exec, -1" \
                     :: "v"(l16), "s"(sb_), "s"(sb2_), "s"(dl_), "s"(dl_ + 1024u), "s"(half_) : "memory"); \
        is_ = (is_ == RING - 1) ? 0 : is_ + 1; \
        ++ii_; if ((ii_ & 63) == 0) lch_ = (int)LST[ii_ + lane]; } while (0)
#define P8_RING_READ(r0, r1) do { r0 = *(const LAS u32x4*)(ring + cs_ * SLOT + l16); r1 = *(const LAS u32x2*)(ring + cs_ * SLOT + 1024 + l8); } while (0)
#define P8_DECODE(r0, r1) __builtin_amdgcn_cvt_scalef32_pk32_f32_fp6((u32x6){r0.x, r0.y, r0.z, r0.w, r1.x, r1.y}, 1.0f)
#define P8_STREAM_INIT(TBASE, r0, r1) int cs_ = 0, is_ = 0, ii_ = 0; int lch_ = (int)LST[lane]; \
        asm volatile("s_waitcnt vmcnt(0) lgkmcnt(0)" ::: "memory"); \
        _Pragma("unroll 1") for (int q_ = 0; q_ < RING; ++q_) P8_ISSUE(TBASE); \
        P8_WAIT_OLDEST(); P8_RING_READ(r0, r1)
#define P8_ROW_READY() asm volatile("s_waitcnt lgkmcnt(0)" ::: "memory")
#define P8_ROW_ADVANCE(TBASE, r0, r1) do { cs_ = (cs_ == RING - 1) ? 0 : cs_ + 1; P8_ISSUE(TBASE); P8_WAIT_OLDEST(); P8_RING_READ(r0, r1); } while (0)
#define P8_STREAM_END() asm volatile("s_waitcnt vmcnt(0) lgkmcnt(0)" ::: "memory")
#define P8_STR2(x) #x
#define P8_STR(x) P8_STR2(x)
#define P8_WAIT_OLDEST() asm volatile("s_waitcnt vmcnt(" P8_STR(P8_VMW) ")" ::: "memory")
static_assert(P8_VMW == 2 * (RING - 1) && RING * SLOT <= 16384, "the counted wait is vmcnt(2 * (RING - 1)); the ring is 16 KiB per wave");
__device__ __forceinline__ void p8_peer(const Args& a, LAS unsigned char* lds, float* dst, int vcu, int G, int wave, int lane_) {
    int lane = lane_; asm volatile("" : "+v"(lane));
    const __amdgpu_buffer_rsrc_t rws = __builtin_amdgcn_make_buffer_rsrc((void*)a.ws, (short)0, (int)WS_END, 0x00020000);
    const __amdgpu_buffer_rsrc_t rdst = __builtin_amdgcn_make_buffer_rsrc((void*)dst, (short)0, S * D * 4, 0x00020000);
    const __amdgpu_buffer_rsrc_t rfg = __builtin_amdgcn_make_buffer_rsrc((void*)a.in[17], (short)0, D * 4, 0x00020000);
    LAS unsigned char* ring = lds + wave * 16384;
    LAS unsigned* SLW = (LAS unsigned*)(lds + 132096 + wave * 1280);
    LAS unsigned short* LST = (LAS unsigned short*)SLW;
    const int gw = vcu * NWAVES + wave, NGW = G * NWAVES;
    const unsigned l16 = (unsigned)lane * 16u, l8 = (unsigned)lane * 8u, l4 = (unsigned)lane * 4u;
    const unsigned long long half_ = 0xffffffffull;
    const unsigned ring_lo = (unsigned)(size_t)(lds + wave * 16384);
#pragma unroll 1
    for (int tb = gw; tb < S; tb += TPW * NGW) {
        int sid[TPW][2], offv[TPW]; float act[TPW][2]; int cntv = 0;
#pragma unroll
        for (int k = 0; k < TPW; ++k) {
            const int t = (tb + k * NGW) < S ? (tb + k * NGW) : (S - 1);
            const unsigned oi = (unsigned)(WS_IDX + (size_t)t * 512);
            const int id0 = (int)bl32(rws, l4, oi), id1 = (int)bl32(rws, l4 + 256u, oi);
            const int sl0 = id0 >> SL_SHIFT, sl1 = id1 >> SL_SHIFT;
            int pos0 = 0, pos1 = 0, basec = 0, offacc = 0;
#pragma unroll
            for (int s = 0; s < NSL; ++s) {
                const unsigned long long m0 = __ballot(sl0 == s), m1 = __ballot(sl1 == s);
                const int c0 = __popcll(m0), c1 = __popcll(m1);
                const int b0 = (int)__builtin_amdgcn_mbcnt_hi((unsigned)(m0 >> 32), __builtin_amdgcn_mbcnt_lo((unsigned)m0, 0u));
                const int b1 = (int)__builtin_amdgcn_mbcnt_hi((unsigned)(m1 >> 32), __builtin_amdgcn_mbcnt_lo((unsigned)m1, 0u));
                pos0 = (sl0 == s) ? basec + b0 : pos0; pos1 = (sl1 == s) ? basec + c0 + b1 : pos1;
                basec += c0 + c1; offacc = (lane == s + 1) ? basec : offacc; cntv = (lane == s * TPW + k) ? (c0 + c1) : cntv;
            }
            offv[k] = offacc;
            SLW[pos0] = (unsigned)id0; SLW[pos1] = (unsigned)id1; SLW[128 + pos0] = (unsigned)lane; SLW[128 + pos1] = (unsigned)(64 + lane);
            asm volatile("s_waitcnt lgkmcnt(0)" ::: "memory");
            sid[k][0] = (int)SLW[lane]; sid[k][1] = (int)SLW[64 + lane];
            act[k][0] = __builtin_bit_cast(float, SLW[128 + lane]); act[k][1] = __builtin_bit_cast(float, SLW[192 + lane]);
            asm volatile("s_waitcnt lgkmcnt(0)" ::: "memory");
        }
        {
            int incl = cntv;
#pragma unroll
            for (int o = 1; o < 64; o <<= 1) { const int up = __shfl_up(incl, o); incl += (lane >= o) ? up : 0; }
            const int gb = incl - cntv;
            asm volatile("s_waitcnt lgkmcnt(0)" ::: "memory");
#pragma unroll
            for (int k = 0; k < TPW; ++k)
#pragma unroll
                for (int h = 0; h < 2; ++h) { const int sl = sid[k][h] >> SL_SHIFT;
                    const int p = __shfl(gb, sl * TPW + k) + (h * 64 + lane) - __shfl(offv[k], sl);
                    LST[p] = (unsigned short)sid[k][h]; }
            if (lane < RING) LST[NROWS + lane] = (unsigned short)0;
            asm volatile("s_waitcnt lgkmcnt(0)" ::: "memory");
        }
        int orig[TPW][2];
#pragma unroll
        for (int k = 0; k < TPW; ++k) { orig[k][0] = __builtin_bit_cast(int, act[k][0]); orig[k][1] = __builtin_bit_cast(int, act[k][1]); act[k][0] = 0.f; act[k][1] = 0.f; }
        {
            u32x2 hb[TPW][8];
#pragma unroll
            for (int k = 0; k < TPW; ++k) { const int t = (tb + k * NGW) < S ? (tb + k * NGW) : (S - 1);
#pragma unroll
                for (int kk = 0; kk < 8; ++kk) hb[k][kk] = bl64(rws, l8 + (unsigned)(kk * 512), (unsigned)(WS_XB + (size_t)t * (D * 2))); }
#pragma unroll
            for (int k = 0; k < TPW; ++k)
#pragma unroll
                for (int kk = 0; kk < 8; ++kk) asm volatile("" : "+v"(hb[k][kk]));
            float wd[4];
#pragma unroll
            for (int j = 0; j < 4; ++j) wd[j] = ((((lane & 15) >> 2) == (lane >> 4)) && ((lane & 3) == j)) ? 1.0f : 0.0f;
            u32x4 r0; u32x2 r1;
            P8_STREAM_INIT(WS_EU, r0, r1);
#pragma unroll 1
            for (int s = 0; s < NSL; ++s) {
#pragma unroll
                for (int k = 0; k < TPW; ++k) {
                    const int lo = __builtin_amdgcn_readlane(offv[k], s), hi = __builtin_amdgcn_readlane(offv[k], s + 1);
#pragma unroll 1
                    for (int e = lo; e < hi; ++e) {
                        P8_ROW_READY();
                        float tr;
                        { const u32x16 fb = __builtin_bit_cast(u32x16, __builtin_amdgcn_cvt_scalef32_pk32_bf16_fp6((u32x6){r0.x, r0.y, r0.z, r0.w, r1.x, r1.y}, 1.0f));
                          f32x4 dg = {0.f, 0.f, 0.f, 0.f};
#pragma unroll
                          for (int c = 0; c < 4; ++c) { const u32x4 av = {fb[4 * c], fb[4 * c + 1], fb[4 * c + 2], fb[4 * c + 3]};
                              const u32x4 bv = {hb[k][2 * c].x, hb[k][2 * c].y, hb[k][2 * c + 1].x, hb[k][2 * c + 1].y};
                              dg = __builtin_amdgcn_mfma_f32_16x16x32_bf16(__builtin_bit_cast(bf16x8, av), __builtin_bit_cast(bf16x8, bv), dg, 0, 0, 0); }
                          tr = (dg[0] * wd[0] + dg[1] * wd[1]) + (dg[2] * wd[2] + dg[3] * wd[3]); }
                        asm volatile("" : "+v"(tr));
                        P8_ROW_ADVANCE(WS_EU, r0, r1);
                        const float d = wave_sum_dpp(tr);
                        act[k][0] = (lane == e) ? d : act[k][0]; act[k][1] = (lane == e - 64) ? d : act[k][1];
                    }
                }
            }
            P8_STREAM_END();
        }
#pragma unroll
        for (int k = 0; k < TPW; ++k) {
            const int t = (tb + k * NGW) < S ? (tb + k * NGW) : (S - 1);
            const float ssp = lane < 32 ? __builtin_bit_cast(float, bl32(rws, l4, (unsigned)(WS_SS + (size_t)t * 128))) : 0.f;
            const float rstd2 = 1.0f / sqrtf(wave_sum(ssp) * (1.0f / D) + EPS);
            const unsigned og = (unsigned)(WS_GATE + (size_t)t * 512);
#pragma unroll
            for (int h = 0; h < 2; ++h) {
                const float gate = __builtin_bit_cast(float, bl32(rws, (unsigned)orig[k][h] * 4u, og));
                const float su = __builtin_bit_cast(float, bl32(rws, (unsigned)sid[k][h] * 4u, (unsigned)WS_ESC)) * rstd2;
                const float sv = __builtin_bit_cast(float, bl32(rws, (unsigned)sid[k][h] * 4u, (unsigned)(WS_ESC + NEXP * 4)));
                act[k][h] = gelu_tanh(act[k][h] * su) * gate * sv; }
        }
        {
            float acc[TPW][32];
#pragma unroll
            for (int k = 0; k < TPW; ++k)
#pragma unroll
                for (int i = 0; i < 32; ++i) acc[k][i] = 0.f;
            u32x4 r0; u32x2 r1;
            P8_STREAM_INIT(WS_EV, r0, r1);
#pragma unroll 1
            for (int s = 0; s < NSL; ++s) {
#pragma unroll
                for (int k = 0; k < TPW; ++k) {
                    const int lo = __builtin_amdgcn_readlane(offv[k], s), hi = __builtin_amdgcn_readlane(offv[k], s + 1);
#pragma unroll 1
                    for (int e = lo; e < hi; ++e) {
                        const int a0_ = __builtin_amdgcn_readlane(__builtin_bit_cast(int, act[k][0]), e & 63), a1_ = __builtin_amdgcn_readlane(__builtin_bit_cast(int, act[k][1]), e & 63);
                        const float aw = __builtin_bit_cast(float, e < 64 ? a0_ : a1_);
                        P8_ROW_READY();
                        { const f32x32 f = P8_DECODE(r0, r1);
#pragma unroll
                          for (int j = 0; j < 32; ++j) acc[k][j] += aw * f[j]; }
                        asm volatile("" : "+v"(acc[k][0]), "+v"(acc[k][16]));
                        P8_ROW_ADVANCE(WS_EV, r0, r1);
                    }
                }
            }
            P8_STREAM_END();
#pragma unroll
            for (int k = 0; k < TPW; ++k) { const int t = tb + k * NGW;
                if (t < S) {
                    float ss = 0.f; const unsigned ot = (unsigned)t * (unsigned)(D * 4);
#pragma unroll
                    for (int kk = 0; kk < 8; ++kk) { const u32x2 xw = bl64(rws, l8 + (unsigned)(kk * 512), (unsigned)(WS_XB + (size_t)t * (D * 2)));
                        acc[k][kk * 4 + 0] += bflo(xw.x); acc[k][kk * 4 + 1] += bfhi(xw.x); acc[k][kk * 4 + 2] += bflo(xw.y); acc[k][kk * 4 + 3] += bfhi(xw.y);
                        ss += (acc[k][kk * 4 + 0] * acc[k][kk * 4 + 0] + acc[k][kk * 4 + 1] * acc[k][kk * 4 + 1]) + (acc[k][kk * 4 + 2] * acc[k][kk * 4 + 2] + acc[k][kk * 4 + 3] * acc[k][kk * 4 + 3]); }
                    const float rstd = 1.0f / sqrtf(wave_sum(ss) * (1.0f / D) + EPS);
#pragma unroll
                    for (int kk = 0; kk < 8; ++kk) { const f32x4 f0 = __builtin_bit_cast(f32x4, bl128(rfg, l16 + (unsigned)((kk & 3) * 1024), (unsigned)((kk >> 2) * 4096)));
                        f32x4 o0; o0.x = acc[k][kk * 4 + 0] * rstd * f0.x; o0.y = acc[k][kk * 4 + 1] * rstd * f0.y; o0.z = acc[k][kk * 4 + 2] * rstd * f0.z; o0.w = acc[k][kk * 4 + 3] * rstd * f0.w;
                        __builtin_amdgcn_raw_buffer_store_b128(__builtin_bit_cast(u32x4, o0), rdst, l16 + (unsigned)((kk & 3) * 1024), ot + (unsigned)((kk >> 2) * 4096), 0); }
                }
            }
        }
    }
}

#define XB_TMO      128
#define XB_XCNT(j)  (256  + 64 * (j))
#define XB_XSUB(j)  (1280 + 64 * (j))
#define XB_XGEN(j)  (2304 + 64 * (j))
#define XB_TOP      3328
#define XB_TOPGEN   3392
#define XCD_BAR_WORDS 3456
#define XB_SPIN_CAP (1u << 22)
__device__ __forceinline__ unsigned xb_ld(unsigned* p)              { return __hip_atomic_load(p, __ATOMIC_RELAXED, __HIP_MEMORY_SCOPE_AGENT); }
__device__ __forceinline__ unsigned xb_add(unsigned* p, unsigned v) { return __hip_atomic_fetch_add(p, v, __ATOMIC_RELAXED, __HIP_MEMORY_SCOPE_AGENT); }
__device__ __forceinline__ unsigned xb_xcc_id() { return (unsigned)__builtin_amdgcn_s_getreg((3 << 11) | 20) & 0xFu; }
#define XB_SPIN(cond, bar) do { unsigned _sp = 0; while (cond) { __builtin_amdgcn_s_sleep(1); \
    if ((++_sp & 255u) == 0u) { if (xb_ld(&(bar)[XB_TMO])) break; if (_sp > XB_SPIN_CAP) { atomicAdd(&(bar)[XB_TMO], 1u); break; } } } } while (0)
struct XcdBarrier { unsigned* bar; unsigned x; volatile LAS unsigned* st; };
__device__ __forceinline__ XcdBarrier xcd_barrier_post(unsigned* bar, volatile LAS unsigned* st) {
    XcdBarrier b; b.bar = bar; b.x = xb_xcc_id(); b.st = st;
    if (threadIdx.x == 0) (void)xb_add(&bar[XB_XCNT(b.x)], 1u);
    return b;
}
__device__ __forceinline__ void xcd_barrier_complete(unsigned* bar, unsigned x, unsigned G, unsigned& nloc, unsigned& nx) {
    unsigned sum, cnt, mine, sp = 0u;
    for (;;) {
        sum = 0u; cnt = 0u; mine = 0u;
#pragma unroll
        for (unsigned j = 0; j < 16; ++j) { const unsigned c = xb_ld(&bar[XB_XCNT(j)]); sum += c; cnt += (c > 0u) ? 1u : 0u; mine = (j == x) ? c : mine; }
        if (sum == G) break;
        __builtin_amdgcn_s_sleep(1);
        if ((++sp & 255u) == 0u) { if (xb_ld(&bar[XB_TMO])) break; if (sp > XB_SPIN_CAP) { atomicAdd(&bar[XB_TMO], 1u); break; } }
    }
    nloc = mine > 0u ? mine : 1u; nx = cnt > 0u ? cnt : 1u;
}
__device__ __forceinline__ void xcd_barrier(const XcdBarrier& b, unsigned G) {
    asm volatile("s_waitcnt vmcnt(0)" ::: "memory");
    __syncthreads();
    if (threadIdx.x == 0) {
        unsigned* bar = b.bar;
        __builtin_amdgcn_s_waitcnt(0);
        unsigned nloc = b.st[0], nx = b.st[1];
        if (nloc == 0u) { xcd_barrier_complete(bar, b.x, G, nloc, nx); b.st[0] = nloc; b.st[1] = nx; }
        const unsigned old = xb_add(&bar[XB_XSUB(b.x)], 1u);
        const unsigned gen = old / nloc;
        if (old + 1u == (gen + 1u) * nloc) {
            __builtin_amdgcn_fence(__ATOMIC_RELEASE, "agent");
            asm volatile("s_waitcnt vmcnt(0)" ::: "memory");
            const unsigned og = xb_add(&bar[XB_TOP], 1u);
            const unsigned tg = og / nx;
            if (og + 1u == (tg + 1u) * nx) xb_add(&bar[XB_TOPGEN], 1u);
            else XB_SPIN(xb_ld(&bar[XB_TOPGEN]) == tg, bar);
            __builtin_amdgcn_fence(__ATOMIC_ACQUIRE, "agent");
            xb_add(&bar[XB_XGEN(b.x)], 1u);
            asm volatile("s_waitcnt vmcnt(0)" ::: "memory");
        } else {
            XB_SPIN(xb_ld(&bar[XB_XGEN(b.x)]) == gen, bar);
            __builtin_amdgcn_fence(__ATOMIC_ACQUIRE, "agent");
            asm volatile("s_waitcnt vmcnt(0)" ::: "memory");
        }
    }
    __syncthreads();
}

constexpr int N_PHASES = 9;
#ifndef DUP_MASK
#define DUP_MASK 0
#endif
#define REP(k) for (int rep_ = 0; rep_ < 1 + ((DUP_MASK >> (k)) & 1); ++rep_)
__global__ void __launch_bounds__(NTHR, 2) fwd(Args args) {
    extern __shared__ __attribute__((aligned(16))) unsigned char lds_raw[];
    LAS unsigned char* lds = (LAS unsigned char*)lds_raw;
    const int tid = threadIdx.x, lane = tid & 63, wave = __builtin_amdgcn_readfirstlane(tid >> 6);
    const int G = gridDim.x; const int bx = blockIdx.x; const int vcu = (G % 8 == 0) ? (bx % 8) * (G / 8) + bx / 8 : bx;
    unsigned char* ws = args.ws;
    const int lo = args.ph_lo, hi = args.ph_hi;
#define IN(k) (lo <= (k) && (k) < hi)
    volatile LAS unsigned* MISC = (volatile LAS unsigned*)(lds + MISC_OFF);
    if (tid < 32) MISC[tid] = 0u;
    __syncthreads();
#if USE_CG_SYNC
    if (IN(0) && bx * NTHR + tid < XCD_BAR_WORDS) __hip_atomic_store((unsigned*)(ws + WS_CTL) + bx * NTHR + tid, 0u, __ATOMIC_RELAXED, __HIP_MEMORY_SCOPE_AGENT);
    XcdBarrier bar; bar.bar = (unsigned*)(ws + WS_CTL); bar.x = 0; bar.st = MISC + 8;
#else
    XcdBarrier bar = xcd_barrier_post((unsigned*)(ws + WS_CTL), MISC + 8);
#endif
#if USE_CG_SYNC
#define SEAM(k) do { if (IN(k) && IN((k) + ((k) == 4 ? 2 : 1))) { if ((k) == 0) { cg::this_grid().sync(); bar = xcd_barrier_post((unsigned*)(ws + WS_CTL), MISC + 8); } else xcd_barrier(bar, (unsigned)G); } } while (0)
#else
#define SEAM(k) do { if (IN(k) && IN((k) + ((k) == 4 ? 2 : 1))) { xcd_barrier(bar, (unsigned)G); } } while (0)
#endif

    if (IN(0)) REP(0) { p0_prologue(args, lds, vcu, G, wave, lane, tid); }
    SEAM(0);
    if (IN(1)) REP(1) {
        { pg8::Gemm g{(const bf16_t*)(ws + WS_H), (const bf16_t*)(ws + WS_WIN), S, 12 * 256, D, D, D, 0}; pg8::StaticOrder so; so.init(S, 12 * 256, G, bx);
          pg8::EpiZ E{(bf16_t*)(ws + WS_Z), args.in[3], 1.0f};
          pg8::gemm_phase<pg8::EpiZ>(lds, g, so, E); }
        asm volatile("s_waitcnt vmcnt(0)" ::: "memory"); __syncthreads();
        { pg8::Gemm g{(const bf16_t*)(ws + WS_H8), (const bf16_t*)(ws + WS_W8), S, 16 * 256, D / 2, D / 2, D / 2, 0}; pg8::StaticOrder so; so.init(S, 16 * 256, G, bx, 12, 1);
          pg8::EpiZ E{(bf16_t*)(ws + WS_Z), args.in[3], 1.0f / (W8_SCALE * H8_SCALE)};
          pg8::gemm_phase<pg8::EpiZ, true, true>(lds, g, so, E); }
    }
    SEAM(1);
    if (IN(2)) REP(2) {
        for (int bi = bx; bi < 256; bi += G) p2_sgu(args, lds, bi * 2, bi * 2 + 2, 1, wave, lane, tid);
        p2_pool(args, vcu, G, tid);
    }
    SEAM(2);
    if (IN(3)) REP(3) {
        pg8::StaticOrder so; so.init(S, D, G, bx, 0, 0, 1);
        pg8::Gemm g{(const bf16_t*)(ws + WS_A2) + 1024, (const bf16_t*)(ws + WS_WG), S, D, GWD, D, GWD, 2, (const bf16_t*)(ws + WS_A2), (const bf16_t*)(ws + WS_WPOOL), 256};
        pg8::EpiChain E{(const bf16_t*)(ws + WS_Z), (bf16_t*)(ws + WS_MRG)};
        pg8::gemm_phase<pg8::EpiChain>(lds, g, so, E);
    }
    SEAM(3);
    if (IN(4)) REP(4) {
        pg8::Gemm g{(const bf16_t*)(ws + WS_MRG), (const bf16_t*)(ws + WS_WOUT), S, D, D, D, D, 0}; pg8::StaticOrder so; so.init(S, D, G, bx);
        pg8::EpiX1 E{args.in[0], (bf16_t*)(ws + WS_XB), (float*)(ws + WS_SS)};
        pg8::gemm_phase<pg8::EpiX1>(lds, g, so, E);
    }
    SEAM(4);
    if (IN(6)) REP(6) {
        pg8::Gemm g{(const bf16_t*)(ws + WS_XB), (const bf16_t*)(ws + WS_WQ), S, D, D, D, D, 0}; pg8::StaticOrder so; so.init(S, D, G, bx);
        pg8::EpiQ E{(bf16_t*)(ws + WS_Q), (const float*)(ws + WS_SS)};
        pg8::gemm_phase<pg8::EpiQ>(lds, g, so, E);
    }
    if (IN(6) && IN(7)) { asm volatile("s_waitcnt vmcnt(0)" ::: "memory"); __syncthreads(); }
    if (IN(7)) REP(7) { p7_topk(args, lds, vcu, G, wave, lane); }
    SEAM(7);
    if (IN(8)) REP(8) { float* dst8 = (rep_ < ((DUP_MASK >> 8) & 1)) ? (float*)(ws + WS_T) : args.out; p8_peer(args, lds, dst8, vcu, G, wave, lane); }
#undef IN
#undef SEAM
}

extern "C" void kernel_launch(void* const* d_in, const int* in_sizes, int n_in, void* d_out, int out_size, void* d_ws, size_t ws_size, hipStream_t stream) {
    static int grid = 0;
    if (grid == 0) {
        if (n_in != 18 || out_size != S * D || ws_size < WS_END) { fprintf(stderr, "kernel_launch: unexpected shapes (n_in %d, out %d, ws %zu)\n", n_in, out_size, ws_size); grid = -1; return; }
        int dev = 0, cus = 0, per_cu = 0;
        if (hipGetDevice(&dev) != hipSuccess || hipDeviceGetAttribute(&cus, hipDeviceAttributeMultiprocessorCount, dev) != hipSuccess) { grid = -1; return; }
        if (hipFuncSetAttribute((const void*)fwd, hipFuncAttributeMaxDynamicSharedMemorySize, LDS_BYTES) != hipSuccess) { fprintf(stderr, "kernel_launch: hipFuncSetAttribute failed\n"); grid = -1; return; }
        if (hipOccupancyMaxActiveBlocksPerMultiprocessor(&per_cu, (const void*)fwd, NTHR, LDS_BYTES) != hipSuccess || per_cu < 1) { fprintf(stderr, "kernel_launch: occupancy query says %d\n", per_cu); per_cu = 1; }
        (void)hipGetLastError();
        grid = cus;
    }
    if (grid < 0) return;
#if !USE_CG_SYNC
    if (hipMemsetAsync((char*)d_ws + WS_CTL, 0, 16384, stream) != hipSuccess) { fprintf(stderr, "kernel_launch: memset failed\n"); return; }
#endif
    Args a{};
    for (int i = 0; i < 18; ++i) a.in[i] = (const float*)d_in[i];
    a.out = (float*)d_out; a.ws = (unsigned char*)d_ws;
#if MK_N_LAUNCHES == 1
    a.ph_lo = 0; a.ph_hi = N_PHASES;
    void* kargs[] = {&a};
    hipError_t e = hipLaunchCooperativeKernel((const void*)fwd, dim3(grid), dim3(NTHR), kargs, LDS_BYTES, stream);
    if (e != hipSuccess) fprintf(stderr, "kernel_launch: cooperative launch failed: %s (grid %d)\n", hipGetErrorString(e), grid);
#else
    for (int p = 0; p < N_PHASES; ++p) {
        a.ph_lo = p; a.ph_hi = p + 1;
        hipLaunchKernelGGL(fwd, dim3(grid), dim3(NTHR), LDS_BYTES, stream, a);
    }
#endif
}
```

```cpp
#include <hip/hip_runtime.h>
#include <hip/hip_cooperative_groups.h>
#include <cstdio>
#include <cstdint>
namespace cg = cooperative_groups;

#ifndef USE_CG_SYNC
#define USE_CG_SYNC 1
#endif
#ifndef MK_N_LAUNCHES
#define MK_N_LAUNCHES 1
#endif

#define LAS __attribute__((address_space(3)))
typedef unsigned short bf16_t;
typedef short bf16x8 __attribute__((ext_vector_type(8)));
typedef float f32x4 __attribute__((ext_vector_type(4)));
typedef unsigned u32x4 __attribute__((ext_vector_type(4)));
typedef unsigned u32x2 __attribute__((ext_vector_type(2)));

constexpr int S = 8192, D = 2048, INW = 7168, PW = 1024, GWD = 1024;
constexpr int NEXP = 16384;
constexpr float EPS = 1e-6f;
constexpr int NWAVES = 8, NTHR = 512;

constexpr size_t MiB = 1u << 20;
constexpr size_t WS_CTL = 0;
constexpr size_t WS_WIN = 1 * MiB;
constexpr size_t WS_WPOOL = 21 * MiB;
constexpr size_t WS_WG = 31 * MiB;
constexpr size_t WS_WOUT = 35 * MiB;
constexpr size_t WS_WQ = 43 * MiB;
constexpr size_t WS_KEYS = 51 * MiB;
constexpr size_t WS_WSM = 52 * MiB;
constexpr size_t WS_H = 53 * MiB;
constexpr size_t WS_Z = 85 * MiB;
constexpr size_t WS_A2 = 197 * MiB;
constexpr size_t WS_T = 229 * MiB;
constexpr size_t WS_MRG = 293 * MiB;
constexpr size_t WS_Q = 325 * MiB;
constexpr size_t WS_IDX = 357 * MiB;
constexpr size_t WS_GATE = 361 * MiB;
constexpr size_t WS_SS = 365 * MiB;
constexpr size_t WS_ESC = 369 * MiB;
constexpr size_t WS_EU = 370 * MiB;
constexpr size_t WS_EV = 402 * MiB;
constexpr size_t WS_XB = 434 * MiB;
constexpr size_t WS_END = 466 * MiB;
constexpr size_t WS_W8 = WS_WIN + 6 * MiB;
constexpr size_t WS_H8 = WS_Q;
constexpr float W8_SCALE = 256.0f, H8_SCALE = 4.0f;

constexpr int LDS_BYTES = 147456;
constexpr int MISC_OFF = 131072 + 320;

__device__ __forceinline__ unsigned f2bf(float f) { unsigned u = __builtin_bit_cast(unsigned, f); return (u + 0x7fffu + ((u >> 16) & 1u)) >> 16; }
__device__ __forceinline__ unsigned pk2(float lo, float hi) { return f2bf(lo) | (f2bf(hi) << 16); }
__device__ __forceinline__ float bflo(unsigned w) { return __builtin_bit_cast(float, w << 16); }
__device__ __forceinline__ float bfhi(unsigned w) { return __builtin_bit_cast(float, w & 0xffff0000u); }
__device__ __forceinline__ float wave_sum(float v) {
#pragma unroll
    for (int o = 1; o < 64; o <<= 1) v += __shfl_xor(v, o);
    return v;
}
template <int CTRL> __device__ __forceinline__ float dpp_add_f32(float v) { return v + __builtin_bit_cast(float, __builtin_amdgcn_update_dpp(0, __builtin_bit_cast(int, v), CTRL, 0xF, 0xF, true)); }
__device__ __forceinline__ float row_sum_f32(float v) { v = dpp_add_f32<0xB1>(v); v = dpp_add_f32<0x4E>(v); v = dpp_add_f32<0x141>(v); v = dpp_add_f32<0x140>(v); return v; }
__device__ __forceinline__ float gelu_tanh(float x) {
    const float y = 1.5957691216057308f * (x + 0.044715f * x * x * x);
    const float e = __builtin_amdgcn_exp2f(-y * 1.4426950408889634f);
    return x * __builtin_amdgcn_rcpf(1.0f + e);
}
__device__ __forceinline__ float sigmoidf_(float x) { return __builtin_amdgcn_rcpf(1.0f + __builtin_amdgcn_exp2f(-x * 1.4426950408889634f)); }

namespace pg8 {
constexpr int BM = 256, BK = 64, HALF = 128, HTB = HALF * BK * 2, STAGE_BYTES = 8 * HTB, NXCD = 8, WGM = 1;
__host__ __device__ __forceinline__ int lds_byte(int r, int c) { const int st = (r >> 4) * 2 + (c >> 5), rr = r & 15, cc = c & 31, ob = rr * 64 + cc * 2; return st * 1024 + (ob ^ (((ob >> 9) & 1) << 5)); }
__host__ __device__ __forceinline__ void stage_rc(int b, int& R, int& C) { const int st = b / 1024, sb = b % 1024, swz = sb ^ (((sb >> 9) & 1) << 5); R = (st >> 1) * 16 + swz / 64; C = (st & 1) * 32 + (swz % 64) / 2; }
__host__ __device__ __forceinline__ int perm32(int rho) { const int n = rho >> 4, i = rho & 15; return 8 * (i >> 2) + 4 * n + (i & 3); }

struct Unit { int pm, pn, sub; };
struct Gemm { const bf16_t* A; const bf16_t* Bt; int M, N, K, lda, ldb, mode; const bf16_t* A0; const bf16_t* Bt0; int K0; };
__device__ __forceinline__ const char* a_ptr(const Gemm& g, const Unit& u) {
    const size_t off = (size_t)u.pm * BM * g.lda; if (g.mode == 2 && u.sub == 0) return (const char*)(g.A0 + off + (size_t)(u.pn >> 1) * 256); return (const char*)(g.A + off); }
__device__ __forceinline__ const char* b_ptr(const Gemm& g, const Unit& u) {
    const size_t off = (size_t)u.pn * BM * g.ldb; return (const char*)(((g.mode == 2 && u.sub == 0) ? g.Bt0 : g.Bt) + off); }

struct StaticOrder {
    int nM, nN, nwg, G, c, pn0, split, chain;
    __host__ __device__ void init(int M, int N, int G_, int c_, int pn0_ = 0, int split_ = 0, int chain_ = 0) { nM = M / BM; nN = N / BM; nwg = nM * nN; G = G_; c = c_; pn0 = pn0_; split = (split_ && nwg == 2 * G_ && (G_ & 1) == 0) ? 1 : 0; chain = chain_; }
    __host__ __device__ bool next(int i_, Unit& u) const {
        const int i = chain ? (i_ >> 1) : i_; u.sub = chain ? (i_ & 1) : 0;
        long L;
        if (split) { const int hG = G / 2; if (c < hG) { if (i > 0) return false; L = c; } else { if (i > 2) return false; L = (long)c + (long)hG * i; } }
        else L = (long)i * G + c;
        if (L >= nwg) return false;
        int wgid = (int)L; { const int q = nwg / NXCD, r = nwg % NXCD, xcd = wgid % NXCD, off = wgid / NXCD; wgid = (xcd < r ? xcd * (q + 1) : r * (q + 1) + (xcd - r) * q) + off; }
        const int nig = WGM * nN, gid = wgid / nig, fm = gid * WGM, gsz = (nM - fm) < WGM ? (nM - fm) : WGM;
        u.pm = fm + ((wgid % nig) % gsz); u.pn = pn0 + (wgid % nig) / gsz; return true;
    }
};

__device__ __forceinline__ unsigned cvt_pk_bf16(float lo, float hi) { unsigned r; asm volatile("v_cvt_pk_bf16_f32 %0, %1, %2" : "=v"(r) : "v"(lo), "v"(hi)); return r; }


struct EpiZ {
    static constexpr bool PERM = true;
    bf16_t* Z; const float* b_gate; float zs;
    __device__ __forceinline__ void operator()(const f32x4 (&acc)[2][2][4][2], const Unit& u, int wr, int wc, int fr, int fq) const {
        const int row0 = u.pm * BM + wr * 64 + fr, col0 = u.pn * BM + wc * 32 + 8 * fq;
        const int mode = u.pn < 4 ? 0 : (u.pn < 12 ? 1 : 2);
        f32x4 bv[2][2];
#pragma unroll
        for (int bj = 0; bj < 2; ++bj)
#pragma unroll
            for (int n = 0; n < 2; ++n) bv[bj][n] = (mode == 2) ? *(const f32x4*)(b_gate + (col0 - 3072) + bj * HALF + 4 * n) : (f32x4){0.f, 0.f, 0.f, 0.f};
#pragma unroll
        for (int ai = 0; ai < 2; ++ai)
#pragma unroll
            for (int m = 0; m < 4; ++m) { bf16_t* rowp = Z + (size_t)(row0 + ai * HALF + m * 16) * INW + col0;
#pragma unroll
                for (int bj = 0; bj < 2; ++bj) { f32x4 v0 = acc[ai][bj][m][0], v1 = acc[ai][bj][m][1];
                    if (mode == 1) {
#pragma unroll
                        for (int j = 0; j < 4; ++j) { v0[j] = gelu_tanh(v0[j]); v1[j] = gelu_tanh(v1[j]); } }
                    if (mode == 2) { v0 = v0 * zs + bv[bj][0]; v1 = v1 * zs + bv[bj][1];
#pragma unroll
                        for (int j = 0; j < 4; ++j) { v0[j] = sigmoidf_(v0[j]); v1[j] = sigmoidf_(v1[j]); } }
                    u32x4 w; w.x = cvt_pk_bf16(v0[0], v0[1]); w.y = cvt_pk_bf16(v0[2], v0[3]); w.z = cvt_pk_bf16(v1[0], v1[1]); w.w = cvt_pk_bf16(v1[2], v1[3]);
                    *(u32x4*)(rowp + bj * HALF) = w; } }
    }
};
struct EpiChain {
    static constexpr bool PERM = true;
    const bf16_t* Z; bf16_t* O;
    __device__ __forceinline__ void operator()(f32x4 (&acc)[2][2][4][2], const Unit& u, int wr, int wc, int fr, int fq) const {
        const int row0 = u.pm * BM + wr * 64 + fr, col0 = u.pn * BM + wc * 32 + 8 * fq;
        if (u.sub == 0) {
#pragma unroll
            for (int ai = 0; ai < 2; ++ai)
#pragma unroll
                for (int m = 0; m < 4; ++m) { const size_t row = (size_t)(row0 + ai * HALF + m * 16);
#pragma unroll
                    for (int bj = 0; bj < 2; ++bj) { const int c = col0 + bj * HALF;
                        const u32x4 ga = *(const u32x4*)(Z + row * INW + 3072 + c), gb = *(const u32x4*)(Z + row * INW + 5120 + c);
                        f32x4 r0, r1;
                        r0[0] = bflo(ga.x) * __builtin_amdgcn_rcpf(fmaxf(bflo(gb.x), 1.0e-30f)); r0[1] = bfhi(ga.x) * __builtin_amdgcn_rcpf(fmaxf(bfhi(gb.x), 1.0e-30f));
                        r0[2] = bflo(ga.y) * __builtin_amdgcn_rcpf(fmaxf(bflo(gb.y), 1.0e-30f)); r0[3] = bfhi(ga.y) * __builtin_amdgcn_rcpf(fmaxf(bfhi(gb.y), 1.0e-30f));
                        r1[0] = bflo(ga.z) * __builtin_amdgcn_rcpf(fmaxf(bflo(gb.z), 1.0e-30f)); r1[1] = bfhi(ga.z) * __builtin_amdgcn_rcpf(fmaxf(bfhi(gb.z), 1.0e-30f));
                        r1[2] = bflo(ga.w) * __builtin_amdgcn_rcpf(fmaxf(bflo(gb.w), 1.0e-30f)); r1[3] = bfhi(ga.w) * __builtin_amdgcn_rcpf(fmaxf(bfhi(gb.w), 1.0e-30f));
                        acc[ai][bj][m][0] *= r0; acc[ai][bj][m][1] *= r1; asm volatile("" ::: "memory"); } }
        } else {
#pragma unroll
            for (int ai = 0; ai < 2; ++ai)
#pragma unroll
                for (int m = 0; m < 4; ++m) { const size_t row = (size_t)(row0 + ai * HALF + m * 16);
#pragma unroll
                    for (int bj = 0; bj < 2; ++bj) { const int c = col0 + bj * HALF;
                        const u32x4 g = *(const u32x4*)(Z + row * INW + 5120 + c);
                        const f32x4 a0 = acc[ai][bj][m][0], a1 = acc[ai][bj][m][1];
                        u32x4 w; w.x = cvt_pk_bf16(fmaxf(bflo(g.x), 1.0e-30f) * a0[0], fmaxf(bfhi(g.x), 1.0e-30f) * a0[1]); w.y = cvt_pk_bf16(fmaxf(bflo(g.y), 1.0e-30f) * a0[2], fmaxf(bfhi(g.y), 1.0e-30f) * a0[3]);
                        w.z = cvt_pk_bf16(fmaxf(bflo(g.z), 1.0e-30f) * a1[0], fmaxf(bfhi(g.z), 1.0e-30f) * a1[1]); w.w = cvt_pk_bf16(fmaxf(bflo(g.w), 1.0e-30f) * a1[2], fmaxf(bfhi(g.w), 1.0e-30f) * a1[3]);
                        *(u32x4*)(O + row * D + c) = w; asm volatile("" ::: "memory"); } }
        }
    }
};
struct EpiX1 {
    static constexpr bool PERM = true;
    const float* X; bf16_t* XB; float* SS;
    __device__ __forceinline__ void operator()(const f32x4 (&acc)[2][2][4][2], const Unit& u, int wr, int wc, int fr, int fq) const {
        const int row0 = u.pm * BM + wr * 64 + fr, col0 = u.pn * BM + wc * 32 + 8 * fq;
#pragma unroll
        for (int ai = 0; ai < 2; ++ai)
#pragma unroll
            for (int m = 0; m < 4; ++m) { const size_t row = (size_t)(row0 + ai * HALF + m * 16); float ss = 0.f;
#pragma unroll
                for (int bj = 0; bj < 2; ++bj) { const size_t off = row * D + col0 + bj * HALF;
                    const f32x4 x0 = *(const f32x4*)(X + off) + acc[ai][bj][m][0], x1 = *(const f32x4*)(X + off + 4) + acc[ai][bj][m][1];
                    ss += (x0[0] * x0[0] + x0[1] * x0[1]) + (x0[2] * x0[2] + x0[3] * x0[3]) + (x1[0] * x1[0] + x1[1] * x1[1]) + (x1[2] * x1[2] + x1[3] * x1[3]);
                    u32x4 w; w.x = cvt_pk_bf16(x0[0], x0[1]); w.y = cvt_pk_bf16(x0[2], x0[3]); w.z = cvt_pk_bf16(x1[0], x1[1]); w.w = cvt_pk_bf16(x1[2], x1[3]);
                    *(u32x4*)(XB + off) = w; }
                ss += __shfl_xor(ss, 16); ss += __shfl_xor(ss, 32);
                if (fq == 0) SS[row * 32 + u.pn * 4 + wc] = ss;
                asm volatile("" ::: "memory"); }
    }
};
struct EpiQ {
    static constexpr bool PERM = true;
    bf16_t* O; const float* SS;
    __device__ __forceinline__ void operator()(const f32x4 (&acc)[2][2][4][2], const Unit& u, int wr, int wc, int fr, int fq) const {
        const int row0 = u.pm * BM + wr * 64 + fr, col0 = u.pn * BM + wc * 32 + 8 * fq;
#pragma unroll
        for (int ai = 0; ai < 2; ++ai)
#pragma unroll
            for (int m = 0; m < 4; ++m) { const size_t row = (size_t)(row0 + ai * HALF + m * 16);
                const f32x4 p0 = *(const f32x4*)(SS + row * 32 + fq * 8), p1 = *(const f32x4*)(SS + row * 32 + fq * 8 + 4);
                float ss = ((p0[0] + p0[1]) + (p0[2] + p0[3])) + ((p1[0] + p1[1]) + (p1[2] + p1[3]));
                ss += __shfl_xor(ss, 16); ss += __shfl_xor(ss, 32);
                const float rstd = 1.0f / sqrtf(ss * (1.0f / D) + EPS);
                bf16_t* rowp = O + row * D + col0;
#pragma unroll
                for (int bj = 0; bj < 2; ++bj) { const f32x4 v0 = acc[ai][bj][m][0] * rstd, v1 = acc[ai][bj][m][1] * rstd;
                    u32x4 w; w.x = cvt_pk_bf16(v0[0], v0[1]); w.y = cvt_pk_bf16(v0[2], v0[3]); w.z = cvt_pk_bf16(v1[0], v1[1]); w.w = cvt_pk_bf16(v1[2], v1[3]);
                    *(u32x4*)(rowp + bj * HALF) = w; } }
    }
};

typedef int i32x8 __attribute__((ext_vector_type(8)));
template <class Epi, bool ALIGN_EPI = true, bool FP8 = false>
__device__ __forceinline__ void gemm_phase(LAS unsigned char* lds, const Gemm g, const StaticOrder& S_, const Epi& E) {
    int tid_ = threadIdx.x; asm volatile("" : "+v"(tid_));
    const int tid = tid_, wid = __builtin_amdgcn_readfirstlane(tid >> 6), lane = tid & 63, wr = wid >> 2, wc = wid & 3, fr = lane & 15, fq = lane >> 4;
    const int K = g.K, nt1 = K / BK, nt0 = g.K0 / BK;
    unsigned voffA[2], voffB[2];
#pragma unroll
    for (int i = 0; i < 2; ++i) { int R, C; stage_rc(tid * 16 + i * 8192, R, C); const int Rb = Epi::PERM ? ((R & ~31) + perm32(R & 31)) : R;
        voffA[i] = (unsigned)(R * g.lda + C) * 2u; voffB[i] = (unsigned)(Rb * g.ldb + C) * 2u; }
    const size_t kstep = (size_t)(BK * 2);
    const size_t hstepA = (size_t)HALF * g.lda * 2, hstepB = (size_t)HALF * g.ldb * 2;
    const unsigned ldsw = (unsigned)wid * 1024u;
    const int aoff = lds_byte(wr * 64 + fr, fq * 8), boff = lds_byte(wc * 32 + fr, fq * 8);
#define PG8_SA(b, h) (((b) * 2 + (h)) * HTB)
#define PG8_SB(b, h) ((4 + (b) * 2 + (h)) * HTB)
#define PG8_STAGE(bufoff, gbase, voff) do { _Pragma("unroll") for (int _i = 0; _i < 2; ++_i) \
        __builtin_amdgcn_global_load_lds((const unsigned*)((const char*)(gbase) + (voff)[_i]), (LAS unsigned*)(lds + (bufoff) + ldsw + _i * 8192), 16, 0, 0); } while (0)
#define PG8_LDA(dst, b, h) do { _Pragma("unroll") for (int m = 0; m < 4; ++m) _Pragma("unroll") for (int k = 0; k < 2; ++k) dst[m][k] = *(const LAS bf16x8*)(lds + PG8_SA(b, h) + aoff + m * 2048 + k * 1024); } while (0)
#define PG8_LDB(dst, b, h) do { _Pragma("unroll") for (int n = 0; n < 2; ++n) _Pragma("unroll") for (int k = 0; k < 2; ++k) dst[n][k] = *(const LAS bf16x8*)(lds + PG8_SB(b, h) + boff + n * 2048 + k * 1024); } while (0)
#define PG8_CAT(x) __builtin_bit_cast(i32x8, __builtin_shufflevector(x[0], x[1], 0, 1, 2, 3, 4, 5, 6, 7, 8, 9, 10, 11, 12, 13, 14, 15))
#define PG8_MMA(ai, bj, At, Bt) do { __builtin_amdgcn_s_setprio(1); _Pragma("unroll") for (int m = 0; m < 4; ++m) _Pragma("unroll") for (int n = 0; n < 2; ++n) { \
        if constexpr (FP8) asm volatile("v_mfma_f32_16x16x128_f8f6f4 %0, %1, %2, %0" : "+v"(acc[ai][bj][m][n]) : "v"(PG8_CAT(Bt[n])), "v"(PG8_CAT(At[m])));   \
        else { _Pragma("unroll") for (int k = 0; k < 2; ++k) acc[ai][bj][m][n] = __builtin_amdgcn_mfma_f32_16x16x32_bf16(Bt[n][k], At[m][k], acc[ai][bj][m][n], 0, 0, 0); } } \
        __builtin_amdgcn_s_setprio(0); } while (0)
#define PG8_WAIT_V(n) asm volatile("s_waitcnt vmcnt(" #n ")" ::: "memory")
#define PG8_WAIT_L(n) asm volatile("s_waitcnt lgkmcnt(" #n ")" ::: "memory")
#define PG8_BAR __builtin_amdgcn_s_barrier()
#define PG8_SCHED __builtin_amdgcn_sched_barrier(0)
    Unit cur, nxt; int ui = 0;
    if (!S_.next(0, cur)) return;
    f32x4 acc[2][2][4][2];
#pragma unroll
    for (int a = 0; a < 2; ++a)
#pragma unroll
        for (int b = 0; b < 2; ++b)
#pragma unroll
            for (int m = 0; m < 4; ++m)
#pragma unroll
                for (int n = 0; n < 2; ++n) acc[a][b][m][n] = (f32x4){0.f, 0.f, 0.f, 0.f};
    bf16x8 At[4][2], B0[2][2], B1[2][2];
    const char* cA = a_ptr(g, cur); const char* cB = b_ptr(g, cur);
    PG8_STAGE(PG8_SB(0, 0), cB, voffB); PG8_STAGE(PG8_SB(0, 1), cB + hstepB, voffB); PG8_STAGE(PG8_SA(0, 0), cA, voffA); PG8_STAGE(PG8_SA(0, 1), cA + hstepA, voffA);
    if (wr == 1) PG8_BAR;
    PG8_WAIT_V(2); PG8_BAR;
    PG8_STAGE(PG8_SB(1, 0), cB + kstep, voffB); PG8_STAGE(PG8_SA(1, 0), cA + kstep, voffA); PG8_STAGE(PG8_SB(1, 1), cB + hstepB + kstep, voffB);
    PG8_WAIT_V(6); PG8_BAR;
    for (;;) {
        const bool has_next = S_.next(ui + 1, nxt);
        const char* nA = has_next ? a_ptr(g, nxt) : cA; const char* nB = has_next ? b_ptr(g, nxt) : cB;
        const int nt = (g.mode == 2 && cur.sub == 0) ? nt0 : nt1;
        for (int t = 0; t < nt; t += 2) {
            const bool last = (t == nt - 2);
            const char* a1 = cA + (size_t)(t + 1) * kstep;
            const char* a2 = last ? nA : cA + (size_t)(t + 2) * kstep; const char* b2 = last ? nB : cB + (size_t)(t + 2) * kstep;
            const char* a3 = a2 + kstep; const char* b3 = b2 + kstep;
            PG8_LDB(B0, 0, 0); PG8_LDB(B1, 0, 1); PG8_SCHED; PG8_LDA(At, 0, 0); PG8_STAGE(PG8_SA(1, 1), a1 + hstepA, voffA);
            PG8_WAIT_V(8); PG8_WAIT_L(0); PG8_BAR; PG8_MMA(0, 0, At, B0); PG8_MMA(0, 1, At, B1); PG8_BAR; PG8_SCHED;
            PG8_LDA(At, 0, 1); PG8_STAGE(PG8_SB(0, 0), b2, voffB); PG8_STAGE(PG8_SB(0, 1), b2 + hstepB, voffB); PG8_STAGE(PG8_SA(0, 0), a2, voffA);
            PG8_WAIT_V(8); PG8_WAIT_L(0); PG8_BAR; PG8_MMA(1, 0, At, B0); PG8_MMA(1, 1, At, B1); PG8_BAR; PG8_SCHED;
            PG8_LDB(B0, 1, 0); PG8_LDB(B1, 1, 1); PG8_SCHED; PG8_LDA(At, 1, 0); PG8_STAGE(PG8_SA(0, 1), a2 + hstepA, voffA);
            PG8_WAIT_V(8); PG8_WAIT_L(0); PG8_BAR; PG8_MMA(0, 0, At, B0); PG8_MMA(0, 1, At, B1); PG8_BAR; PG8_SCHED;
            PG8_LDA(At, 1, 1); PG8_STAGE(PG8_SB(1, 0), b3, voffB); PG8_STAGE(PG8_SB(1, 1), b3 + hstepB, voffB); PG8_STAGE(PG8_SA(1, 0), a3, voffA);
            PG8_WAIT_V(8); PG8_WAIT_L(0); PG8_BAR; PG8_MMA(1, 0, At, B0); PG8_MMA(1, 1, At, B1); PG8_BAR; PG8_SCHED;
        }
        if constexpr (ALIGN_EPI) { if (wr == 0) PG8_BAR; }
        if constexpr (FP8) asm volatile("s_nop 15\n\ts_nop 15" ::: "memory");
        { int ln_ = threadIdx.x & 63; asm volatile("" : "+v"(ln_));
          E(acc, cur, wr, wc, ln_ & 15, ln_ >> 4); }
        if (!has_next) break;
        if (!(g.mode == 2 && cur.sub == 0))
#pragma unroll
        for (int a = 0; a < 2; ++a)
#pragma unroll
            for (int b = 0; b < 2; ++b)
#pragma unroll
                for (int m = 0; m < 4; ++m)
#pragma unroll
                    for (int n = 0; n < 2; ++n) acc[a][b][m][n] = (f32x4){0.f, 0.f, 0.f, 0.f};
        cur = nxt; cA = nA; cB = nB; ++ui;
        if constexpr (ALIGN_EPI) { if (wr == 1) PG8_BAR; }
    }
    PG8_WAIT_V(0);
    if constexpr (!ALIGN_EPI) { if (wr == 0) PG8_BAR; }
    PG8_BAR;
#undef PG8_SA
#undef PG8_SB
#undef PG8_STAGE
#undef PG8_LDA
#undef PG8_LDB
#undef PG8_MMA
#undef PG8_CAT
#undef PG8_WAIT_V
#undef PG8_WAIT_L
#undef PG8_BAR
#undef PG8_SCHED
}
}

struct Args { const float* in[18]; float* out; unsigned char* ws; int ph_lo, ph_hi; };

__device__ __forceinline__ void p0_transpose_item(const float* W, int K, int N, bf16_t* WT, LAS float* scr, int item, int lane, const float* kgain = nullptr, unsigned char* W8 = nullptr, int n8 = 0, float s8 = 1.0f, int ldwt = 0) {
    const int nblk = N / 32, kb = item / nblk, nb = item % nblk, k0 = 64 * kb, n0 = 32 * nb;
    { f32x4 wv[8];
#pragma unroll
      for (int i = 0; i < 8; ++i) wv[i] = *(const f32x4*)(W + (size_t)(k0 + 8 * i + (lane >> 3)) * N + n0 + 4 * (lane & 7));
#pragma unroll
      for (int i = 0; i < 8; ++i) { const int kk = 8 * i + (lane >> 3); const float gk = kgain ? kgain[k0 + kk] : 1.0f; LAS float* sp = scr + kk * 33 + 4 * (lane & 7);
          sp[0] = gk * wv[i].x; sp[1] = gk * wv[i].y; sp[2] = gk * wv[i].z; sp[3] = gk * wv[i].w; } }
    asm volatile("s_waitcnt lgkmcnt(0)" ::: "memory");
    const int c = lane & 7;
    if (W8 != nullptr && n0 >= n8) {
#pragma unroll
        for (int j = 0; j < 4; ++j) { const int n = (lane >> 3) + 8 * j; const LAS float* s = scr + (8 * c) * 33 + n;
            int w0 = __builtin_amdgcn_cvt_pk_fp8_f32(s[0 * 33] * s8, s[1 * 33] * s8, 0, false); w0 = __builtin_amdgcn_cvt_pk_fp8_f32(s[2 * 33] * s8, s[3 * 33] * s8, w0, true);
            int w1 = __builtin_amdgcn_cvt_pk_fp8_f32(s[4 * 33] * s8, s[5 * 33] * s8, 0, false); w1 = __builtin_amdgcn_cvt_pk_fp8_f32(s[6 * 33] * s8, s[7 * 33] * s8, w1, true);
            u32x2 o; o.x = (unsigned)w0; o.y = (unsigned)w1; *(u32x2*)(W8 + (size_t)(n0 + n) * K + k0 + 8 * c) = o; }
    } else {
#pragma unroll
    for (int j = 0; j < 4; ++j) { const int n = (lane >> 3) + 8 * j; const LAS float* s = scr + (8 * c) * 33 + n;
        u32x4 o; o.x = pk2(s[0 * 33], s[1 * 33]); o.y = pk2(s[2 * 33], s[3 * 33]); o.z = pk2(s[4 * 33], s[5 * 33]); o.w = pk2(s[6 * 33], s[7 * 33]);
        *(u32x4*)(WT + (size_t)(n0 + n) * (ldwt ? ldwt : K) + k0 + 8 * c) = o; }
    }
    asm volatile("s_waitcnt lgkmcnt(0)" ::: "memory");
}
__device__ __forceinline__ void rms_row_to_bf16(const float* xrow, const float* g, bf16_t* orow, int lane, unsigned char* o8row = nullptr, float s8 = 1.0f) {
    const f32x4* xr = (const f32x4*)xrow + lane;
    f32x4 v[8]; float s = 0.f;
#pragma unroll
    for (int j = 0; j < 8; ++j) { v[j] = xr[64 * j]; s += (v[j].x * v[j].x + v[j].y * v[j].y) + (v[j].z * v[j].z + v[j].w * v[j].w); }
    const float rstd = 1.0f / sqrtf(wave_sum(s) * (1.0f / D) + EPS);
    const f32x4* gr = (const f32x4*)g + lane;
    u32x2* o8 = (u32x2*)orow + lane;
#pragma unroll
    for (int j = 0; j < 8; ++j) { const f32x4 gv = gr[64 * j]; const float h0 = v[j].x * rstd * gv.x, h1 = v[j].y * rstd * gv.y, h2 = v[j].z * rstd * gv.z, h3 = v[j].w * rstd * gv.w;
        u32x2 o; o.x = pk2(h0, h1); o.y = pk2(h2, h3); o8[64 * j] = o;
        if (o8row != nullptr) { int w = __builtin_amdgcn_cvt_pk_fp8_f32(h0 * s8, h1 * s8, 0, false); w = __builtin_amdgcn_cvt_pk_fp8_f32(h2 * s8, h3 * s8, w, true); ((unsigned*)o8row)[64 * j + lane] = (unsigned)w; } }
}
__device__ __forceinline__ void cvt_stream(const float* src, bf16_t* dst, size_t n8, size_t gtid, size_t nthr) {
    for (size_t i = gtid; i < n8; i += nthr) { const f32x4 a = ((const f32x4*)src)[2 * i], b = ((const f32x4*)src)[2 * i + 1];
        u32x4 o; o.x = pk2(a.x, a.y); o.y = pk2(a.z, a.w); o.z = pk2(b.x, b.y); o.w = pk2(b.z, b.w); ((u32x4*)dst)[i] = o; }
}

constexpr int EROW = 1536;
typedef unsigned u32x6 __attribute__((ext_vector_type(6)));
typedef float f32x16 __attribute__((ext_vector_type(16)));
typedef float f32x32 __attribute__((ext_vector_type(32)));
typedef unsigned u32x16 __attribute__((ext_vector_type(16)));
#ifndef FP6_ENC_INTERLEAVED
#define FP6_ENC_INTERLEAVED 1
#endif
__device__ __forceinline__ void expert_row_load(const float* src, f32x4 (&v)[8], int lane) {
    const f32x4* xr = (const f32x4*)src + lane;
#pragma unroll
    for (int k = 0; k < 8; ++k) v[k] = xr[64 * k];
}
__device__ __forceinline__ void expert_row_gain(f32x4 (&v)[8], const float* g, int lane) {
    const f32x4* gr = (const f32x4*)g + lane;
#pragma unroll
    for (int k = 0; k < 8; ++k) v[k] = v[k] * gr[64 * k];
}
__device__ __forceinline__ void expert_row_store(const f32x4 (&v)[8], unsigned char* dst, float* isc, int lane) {
    float am = 0.f;
#pragma unroll
    for (int k = 0; k < 8; ++k) am = fmaxf(am, fmaxf(fmaxf(fabsf(v[k].x), fabsf(v[k].y)), fmaxf(fabsf(v[k].z), fabsf(v[k].w))));
#pragma unroll
    for (int o = 1; o < 64; o <<= 1) am = fmaxf(am, __shfl_xor(am, o));
    float sc = 1.0f, inv = 1.0f;
    if (am > 0.f) { const float amc = fminf(fmaxf(am, 1.0e-30f), 1.0e30f); sc = 7.5f / amc; inv = amc * (1.0f / 7.5f); }
    f32x16 ea, eb;
#pragma unroll
    for (int j = 0; j < 16; ++j) {
#if FP6_ENC_INTERLEAVED
        const int ja = 2 * j, jb = 2 * j + 1;
#else
        const int ja = j, jb = 16 + j;
#endif
        ea[j] = v[ja >> 2][ja & 3] * sc; eb[j] = v[jb >> 2][jb & 3] * sc; }
    const u32x6 o = __builtin_amdgcn_cvt_scalef32_2xpk16_fp6_f32(ea, eb, 1.0f);
    u32x4 o0; o0.x = o[0]; o0.y = o[1]; o0.z = o[2]; o0.w = o[3]; u32x2 o1; o1.x = o[4]; o1.y = o[5];
    *(u32x4*)(dst + lane * 16) = o0; *(u32x2*)(dst + 1024 + lane * 8) = o1;
    if (lane == 0) *isc = inv;
}

__device__ __forceinline__ void p0_score_weights(const Args& a, int item, int lane) {
    const float* wq = a.in[13]; const float* g2 = a.in[12]; const float* keys = a.in[14]; bf16_t* M = (bf16_t*)(a.ws + WS_WQ);
    const int b = item >> 7, kt = item & 127, fr = lane & 15, fq = lane >> 4;
    const int k = kt * 16 + fr; const float gk = g2[k];
    bf16x8 wf[4];
#pragma unroll
    for (int ks = 0; ks < 4; ++ks) { const float* p = wq + (size_t)k * D + b * 128 + ks * 32 + fq * 8; const f32x4 x0 = *(const f32x4*)p, x1 = *(const f32x4*)(p + 4);
        u32x4 w; w.x = pk2(gk * x0.x, gk * x0.y); w.y = pk2(gk * x0.z, gk * x0.w); w.z = pk2(gk * x1.x, gk * x1.y); w.w = pk2(gk * x1.z, gk * x1.w); wf[ks] = __builtin_bit_cast(bf16x8, w); }
#pragma unroll 2
    for (int nb = 0; nb < 8; ++nb) {
        f32x4 acc = {0.f, 0.f, 0.f, 0.f};
#pragma unroll
        for (int ks = 0; ks < 4; ++ks) { const float* p = keys + (size_t)(b * 128 + nb * 16 + fr) * 128 + ks * 32 + fq * 8; const f32x4 x0 = *(const f32x4*)p, x1 = *(const f32x4*)(p + 4);
            u32x4 w; w.x = pk2(x0.x, x0.y); w.y = pk2(x0.z, x0.w); w.z = pk2(x1.x, x1.y); w.w = pk2(x1.z, x1.w);
            acc = __builtin_amdgcn_mfma_f32_16x16x32_bf16(wf[ks], __builtin_bit_cast(bf16x8, w), acc, 0, 0, 0); }
        u32x2 o; o.x = pk2(acc[0], acc[1]); o.y = pk2(acc[2], acc[3]);
        *(u32x2*)(M + (size_t)(b * 128 + nb * 16 + fr) * D + kt * 16 + fq * 4) = o;
    }
}

__device__ __forceinline__ void p0_prologue(const Args& a, LAS unsigned char* lds, int vcu, int G, int wave, int lane, int tid) {
    unsigned char* ws = a.ws;
    LAS float* scr = (LAS float*)(lds + wave * 16384);
    const int gw = vcu * NWAVES + wave, NGW = G * NWAVES;
    constexpr int I_IN = (D / 64) * (INW / 32), I_POOL1 = (256 / 64) * (512 / 32), I_G = (GWD / 64) * (D / 32), I_O = (D / 64) * (D / 32);
    constexpr int NITEMS = I_IN + 4 * I_POOL1 + I_G + I_O;
    for (int it = gw; it < NITEMS; it += NGW) {
        int r = it;
        if (r < I_IN) { p0_transpose_item(a.in[2], D, INW, (bf16_t*)(ws + WS_WIN), scr, r, lane, nullptr, ws + WS_W8, 3072, W8_SCALE); continue; } r -= I_IN;
        if (r < 4 * I_POOL1) { const int g = r / I_POOL1; p0_transpose_item(a.in[5] + (size_t)g * 256 * 512, 256, 512, (bf16_t*)(ws + WS_WPOOL) + (size_t)g * 512 * GWD, scr, r % I_POOL1, lane, nullptr, nullptr, 0, 1.0f, GWD); continue; } r -= 4 * I_POOL1;
        if (r < I_G) { p0_transpose_item(a.in[10], GWD, D, (bf16_t*)(ws + WS_WG), scr, r, lane); continue; } r -= I_G;
        p0_transpose_item(a.in[11], D, D, (bf16_t*)(ws + WS_WOUT), scr, r, lane);
    }
    for (int it = gw; it < 16 * (D / 16); it += NGW) p0_score_weights(a, it, lane);
    for (int m = gw; m < S; m += NGW) rms_row_to_bf16(a.in[0] + (size_t)m * D, a.in[1], (bf16_t*)(ws + WS_H) + (size_t)m * D, lane, ws + WS_H8 + (size_t)m * D, H8_SCALE);
    unsigned tq_ = (unsigned)tid; asm volatile("" : "+v"(tq_));
    const size_t gtid = (size_t)vcu * NTHR + tq_, nthr = (size_t)G * NTHR;
    {
        const float* src = a.in[8]; bf16_t* dst = (bf16_t*)(ws + WS_WSM);
        for (size_t i = gtid; i < (size_t)8 * 128 * 128 / 8; i += nthr) { const int s0 = (int)(i & 15) * 8, t = (int)(i >> 4) & 127;
            const f32x4 x0 = ((const f32x4*)src)[2 * i], x1 = ((const f32x4*)src)[2 * i + 1];
            float v[8] = {x0.x, x0.y, x0.z, x0.w, x1.x, x1.y, x1.z, x1.w};
#pragma unroll
            for (int j = 0; j < 8; ++j) v[j] = (s0 + j <= t) ? v[j] : 0.f;
            u32x4 o; o.x = pk2(v[0], v[1]); o.y = pk2(v[2], v[3]); o.z = pk2(v[4], v[5]); o.w = pk2(v[6], v[7]); ((u32x4*)dst)[i] = o; }
    }
}

__device__ __forceinline__ void p2_pool(const Args& a, int vcu, int G, int tid) {
    const bf16_t* Z = (const bf16_t*)(a.ws + WS_Z); bf16_t* A2 = (bf16_t*)(a.ws + WS_A2); const float* psc = a.in[4];
    unsigned tq_ = (unsigned)tid; asm volatile("" : "+v"(tq_));
    const size_t gtid = (size_t)vcu * NTHR + tq_, nthr = (size_t)G * NTHR;
    for (size_t id = gtid; id < (size_t)(S / 8) * 128; id += nthr) {
        const int c8 = (int)(id & 127), t0 = (int)(id >> 7) * 8, g = c8 >> 5, w = 2 << g;
        u32x4 row[23];
#pragma unroll
        for (int r = 0; r < 23; ++r) { const int t = t0 - 15 + r; const bool need = (r >= 16 - w) && (t >= 0);
            row[r] = need ? *(const u32x4*)(Z + (size_t)t * INW + c8 * 8) : (u32x4){0u, 0u, 0u, 0u}; }
        const f32x4 p0 = *(const f32x4*)(psc + c8 * 8), p1 = *(const f32x4*)(psc + c8 * 8 + 4);
        const float ps[8] = {p0.x, p0.y, p0.z, p0.w, p1.x, p1.y, p1.z, p1.w};
        float s[8] = {0.f, 0.f, 0.f, 0.f, 0.f, 0.f, 0.f, 0.f};
#pragma unroll
        for (int r = 0; r < 15; ++r) { const u32x4 q = row[r];
            s[0] += bflo(q.x); s[1] += bfhi(q.x); s[2] += bflo(q.y); s[3] += bfhi(q.y); s[4] += bflo(q.z); s[5] += bfhi(q.z); s[6] += bflo(q.w); s[7] += bfhi(q.w); }
#pragma unroll
        for (int i = 0; i < 8; ++i) {
            const u32x4 q = row[15 + i];
            const float at[8] = {bflo(q.x), bfhi(q.x), bflo(q.y), bfhi(q.y), bflo(q.z), bfhi(q.z), bflo(q.w), bfhi(q.w)};
#pragma unroll
            for (int c = 0; c < 8; ++c) s[c] += at[c];
            const int t = t0 + i; const int cnt = (t + 1) < w ? (t + 1) : w; const float inv = 1.0f / (float)cnt;
            float o[8];
#pragma unroll
            for (int c = 0; c < 8; ++c) o[c] = (s[c] * inv - at[c]) * ps[c];
            u32x4 w4; w4.x = pk2(o[0], o[1]); w4.y = pk2(o[2], o[3]); w4.z = pk2(o[4], o[5]); w4.w = pk2(o[6], o[7]);
            *(u32x4*)(A2 + (size_t)t * D + c8 * 8) = w4;
            const u32x4 d2 = row[15 + i - 1], d4 = row[15 + i - 3], d8 = row[15 + i - 7], d16 = row[15 + i - 15];
            const u32x4 dq = g == 0 ? d2 : (g == 1 ? d4 : (g == 2 ? d8 : d16));
            s[0] -= bflo(dq.x); s[1] -= bfhi(dq.x); s[2] -= bflo(dq.y); s[3] -= bfhi(dq.y); s[4] -= bflo(dq.z); s[5] -= bfhi(dq.z); s[6] -= bflo(dq.w); s[7] -= bfhi(dq.w);
        }
    }
}
constexpr int VT_LD = 136;
__device__ __forceinline__ void p2_sgu(const Args& a, LAS unsigned char* lds, int item0, int item1, int istep, int wave, int lane, int tid) {
    const bf16_t* Z = (const bf16_t*)(a.ws + WS_Z); bf16_t* A2 = (bf16_t*)(a.ws + WS_A2); const bf16_t* WSM = (const bf16_t*)(a.ws + WS_WSM);
    const float* lng = a.in[6]; const float* lnb = a.in[7]; const float* bs = a.in[9];
    LAS float* st = (LAS float*)lds; LAS bf16_t* Vt = (LAS bf16_t*)(lds + 1024);
    const int fr = lane & 15, fq = lane >> 4;
    int prev_c = -1;
    for (int item = item0; item < item1; item += istep) {
        const int c = item >> 3, h = item & 7, t0 = c * 128; const bool need_stats = (c != prev_c); prev_c = c;
        u32x4 raw[4][8];
        if (need_stats) {
#pragma unroll
        for (int p = 0; p < 4; ++p) { const bf16_t* rp = Z + (size_t)(t0 + wave * 16 + p * 4 + fq) * INW + 2048 + fr * 8;
#pragma unroll
            for (int j = 0; j < 8; ++j) raw[p][j] = *(const u32x4*)(rp + j * 128); } }
        u32x4 rawB[4];
#pragma unroll
        for (int q = 0; q < 4; ++q) { const int id = tid + q * NTHR, sr = id & 127, dc = id >> 7; rawB[q] = *(const u32x4*)(Z + (size_t)(t0 + sr) * INW + 2048 + h * 128 + dc * 8); }
        bf16x8 bW[4];
#pragma unroll
        for (int ks = 0; ks < 4; ++ks) bW[ks] = *(const bf16x8*)(WSM + (size_t)(h * 128 + wave * 16 + fr) * 128 + ks * 32 + fq * 8);
        u32x2 ur[8];
#pragma unroll
        for (int db = 0; db < 8; ++db) ur[db] = *(const u32x2*)(Z + (size_t)(t0 + wave * 16 + fr) * INW + 1024 + h * 128 + db * 16 + fq * 4);
        const float bias = bs[h * 128 + wave * 16 + fr];
        if (need_stats) {
#pragma unroll
        for (int p = 0; p < 4; ++p) { float s = 0.f, q = 0.f;
#pragma unroll
            for (int j = 0; j < 8; ++j)
#pragma unroll
                for (int w = 0; w < 4; ++w) { const float a0 = bflo(raw[p][j][w]), a1 = bfhi(raw[p][j][w]); s += a0 + a1; q += a0 * a0 + a1 * a1; }
            s = row_sum_f32(s); q = row_sum_f32(q);
            if (fr == 0) { const float mean = s * (1.0f / 1024.0f); const float var = fmaxf(q * (1.0f / 1024.0f) - mean * mean, 0.f);
                const int sr = wave * 16 + p * 4 + fq; st[2 * sr] = mean; st[2 * sr + 1] = 1.0f / sqrtf(var + EPS); } }
        __syncthreads();
        }
#pragma unroll
        for (int q = 0; q < 4; ++q) { const int id = tid + q * NTHR, sr = id & 127, dc = id >> 7;
            const u32x4 rw = rawB[q];
            const float mean = st[2 * sr], rstd = st[2 * sr + 1];
            const float v[8] = {bflo(rw.x), bfhi(rw.x), bflo(rw.y), bfhi(rw.y), bflo(rw.z), bfhi(rw.z), bflo(rw.w), bfhi(rw.w)};
            const f32x4 g0 = *(const f32x4*)(lng + h * 128 + dc * 8), g1 = *(const f32x4*)(lng + h * 128 + dc * 8 + 4), b0 = *(const f32x4*)(lnb + h * 128 + dc * 8), b1 = *(const f32x4*)(lnb + h * 128 + dc * 8 + 4);
            const float gg[8] = {g0.x, g0.y, g0.z, g0.w, g1.x, g1.y, g1.z, g1.w}, bb[8] = {b0.x, b0.y, b0.z, b0.w, b1.x, b1.y, b1.z, b1.w};
#pragma unroll
            for (int i = 0; i < 8; ++i) { const int d = dc * 8 + i; const float y = (v[i] - mean) * rstd * gg[i] + bb[i]; Vt[d * VT_LD + sr] = (bf16_t)f2bf(y); } }
        __syncthreads();
        f32x4 acc[8];
#pragma unroll
        for (int db = 0; db < 8; ++db) acc[db] = (f32x4){0.f, 0.f, 0.f, 0.f};
        const int nks = (wave * 16 + 15) / 32 + 1;
#pragma unroll
        for (int ks = 0; ks < 4; ++ks) if (ks < nks) {
#pragma unroll
            for (int db = 0; db < 8; ++db) { const bf16x8 aV = *(const LAS bf16x8*)(Vt + (db * 16 + fr) * VT_LD + ks * 32 + fq * 8);
                acc[db] = __builtin_amdgcn_mfma_f32_16x16x32_bf16(aV, bW[ks], acc[db], 0, 0, 0); }
        }
        { const int t = t0 + wave * 16 + fr;
#pragma unroll
          for (int db = 0; db < 8; ++db) { const int col = h * 128 + db * 16 + fq * 4;
              u32x2 o; o.x = pk2(bflo(ur[db].x) * (acc[db][0] + bias), bfhi(ur[db].x) * (acc[db][1] + bias)); o.y = pk2(bflo(ur[db].y) * (acc[db][2] + bias), bfhi(ur[db].y) * (acc[db][3] + bias));
              *(u32x2*)(A2 + (size_t)t * D + 1024 + col) = o; } }
        __syncthreads();
    }
}

__device__ __forceinline__ unsigned f2key(float f) { const unsigned b = __builtin_bit_cast(unsigned, f); return (b & 0x80000000u) ? ~b : (b | 0x80000000u); }
__device__ __forceinline__ float key2f(unsigned k) { const unsigned b = (k & 0x80000000u) ? (k ^ 0x80000000u) : ~k; return __builtin_bit_cast(float, b); }
template <int CTRL> __device__ __forceinline__ unsigned dpp_max_u32(unsigned v) { const unsigned o = (unsigned)__builtin_amdgcn_update_dpp(0, (int)v, CTRL, 0xF, 0xF, true); return v > o ? v : o; }
__device__ __forceinline__ unsigned row_max_u32(unsigned v) { v = dpp_max_u32<0xB1>(v); v = dpp_max_u32<0x4E>(v); v = dpp_max_u32<0x141>(v); v = dpp_max_u32<0x140>(v); return v; }
__device__ __forceinline__ void ce_desc(unsigned& a, unsigned& b) { const unsigned hi = a > b ? a : b, lo = a > b ? b : a; a = hi; b = lo; }
__device__ __forceinline__ void sort8_desc(unsigned (&k)[8]) {
    ce_desc(k[0], k[1]); ce_desc(k[2], k[3]); ce_desc(k[4], k[5]); ce_desc(k[6], k[7]);
    ce_desc(k[0], k[2]); ce_desc(k[1], k[3]); ce_desc(k[4], k[6]); ce_desc(k[5], k[7]);
    ce_desc(k[1], k[2]); ce_desc(k[5], k[6]);
    ce_desc(k[0], k[4]); ce_desc(k[1], k[5]); ce_desc(k[2], k[6]); ce_desc(k[3], k[7]);
    ce_desc(k[2], k[4]); ce_desc(k[3], k[5]);
    ce_desc(k[1], k[2]); ce_desc(k[3], k[4]); ce_desc(k[5], k[6]);
}
__device__ __forceinline__ void sort4_desc(unsigned (&k)[4]) { ce_desc(k[0], k[1]); ce_desc(k[2], k[3]); ce_desc(k[0], k[2]); ce_desc(k[1], k[3]); ce_desc(k[1], k[2]); }
template <int NV> __device__ __forceinline__ unsigned row_top16_sorted(unsigned (&k)[NV], int fr) {
    unsigned tk = 0u;
    for (int it = 0; it < 16; ++it) {
        const unsigned m = row_max_u32(k[0]);
        const unsigned wm = (k[0] == m) ? 0xffffffffu : 0u;
#pragma unroll
        for (int i = 0; i + 1 < NV; ++i) k[i] = (k[i + 1] & wm) | (k[i] & ~wm);
        k[NV - 1] = k[NV - 1] & ~wm;
        tk = (fr == it) ? m : tk;
    }
    return tk;
}
__device__ __forceinline__ unsigned cand_table(int fr) {
    constexpr unsigned T[16] = {0x03020100u, 0x07060504u, 0x0b0a0908u, 0x0f0e0d0cu, 0x13121110u, 0x17161514u, 0x23222120u, 0x32313024u, 0x42414033u, 0x61605150u, 0x90807170u, 0xd0c0b0a0u, 0xfffff0e0u, 0xffffffffu, 0xffffffffu, 0xffffffffu};
    unsigned w = T[0];
#pragma unroll
    for (int i = 1; i < 16; ++i) w = (fr == i) ? T[i] : w;
    return w;
}
constexpr int SC_LD = 132;
__device__ __forceinline__ void p7_topk(const Args& a, LAS unsigned char* lds, int vcu, int G, int wave, int lane_) {
    int lane = lane_; asm volatile("" : "+v"(lane));
    const bf16_t* Q = (const bf16_t*)(a.ws + WS_Q);
    int* IDX = (int*)(a.ws + WS_IDX); float* GATE = (float*)(a.ws + WS_GATE);
    LAS float* SL = (LAS float*)(lds + wave * (16 * SC_LD * 4));
    const int gw = vcu * NWAVES + wave, NGW = G * NWAVES; const int fr = lane & 15, fq = lane >> 4;
    const unsigned ctab = cand_table(fr);
    int erow = gw;
    f32x4 er0[8], er1[8]; int e0 = 2 * NEXP, e1 = 2 * NEXP;
#define ER_LOAD() do { e0 = erow; e1 = erow + NGW; erow += 2 * NGW; \
        if (e0 < 2 * NEXP) expert_row_load(a.in[15 + (e0 >= NEXP)] + (size_t)(e0 & (NEXP - 1)) * D, er0, lane); \
        if (e1 < 2 * NEXP) expert_row_load(a.in[15 + (e1 >= NEXP)] + (size_t)(e1 & (NEXP - 1)) * D, er1, lane); } while (0)
#define ER_STORE() do { \
        if (e0 < NEXP) expert_row_gain(er0, a.in[12], lane); if (e1 < NEXP) expert_row_gain(er1, a.in[12], lane); \
        if (e0 < 2 * NEXP) expert_row_store(er0, a.ws + ((e0 >= NEXP) ? WS_EV : WS_EU) + (size_t)(e0 & (NEXP - 1)) * EROW, (float*)(a.ws + WS_ESC) + e0, lane); \
        if (e1 < 2 * NEXP) expert_row_store(er1, a.ws + ((e1 >= NEXP) ? WS_EV : WS_EU) + (size_t)(e1 & (NEXP - 1)) * EROW, (float*)(a.ws + WS_ESC) + e1, lane); } while (0)
    pg8::StaticOrder so7; so7.init(S, D, G, (int)blockIdx.x); pg8::Unit u7;
    for (int ui = 0; so7.next(ui >> 1, u7); ++ui) {
        const int h = u7.pn, t0 = u7.pm * 256 + ((ui & 1) * 8 + wave) * 16;
        unsigned tk[8];
#pragma unroll
        for (int i = 0; i < 8; ++i) tk[i] = 0u;
#pragma unroll 1
        for (int p = 0; p < 2; ++p) {
            {
                u32x4 sc[4];
#pragma unroll
                for (int i = 0; i < 4; ++i) sc[i] = *(const u32x4*)(Q + (size_t)(t0 + i * 4 + fq) * D + h * 256 + p * 128 + fr * 8);
#pragma unroll
                for (int i = 0; i < 4; ++i) { LAS float* d = SL + (i * 4 + fq) * SC_LD + fr * 8;
                    *(LAS f32x4*)d = (f32x4){bflo(sc[i].x), bfhi(sc[i].x), bflo(sc[i].y), bfhi(sc[i].y)}; *(LAS f32x4*)(d + 4) = (f32x4){bflo(sc[i].z), bfhi(sc[i].z), bflo(sc[i].w), bfhi(sc[i].w)}; }
                asm volatile("" ::: "memory");
            }
            ER_LOAD();
#pragma unroll 1
            for (int j = 0; j < 4; ++j) {
                unsigned k[8];
#pragma unroll
                for (int nb = 0; nb < 8; ++nb) k[nb] = (f2key(SL[(fq * 4 + j) * SC_LD + nb * 16 + fr]) & ~127u) | (127u - (unsigned)(nb * 16 + fr));
                sort8_desc(k);
                const unsigned r = row_top16_sorted<8>(k, fr);
#pragma unroll
                for (int i = 0; i < 8; ++i) tk[i] = (i == p * 4 + j) ? r : tk[i];
            }
            ER_STORE();
        }
#pragma unroll 1
        for (int j = 0; j < 4; ++j) {
            if ((j & 1) == 0) ER_LOAD();
            const unsigned tk1 = j == 0 ? tk[0] : (j == 1 ? tk[1] : (j == 2 ? tk[2] : tk[3])), tk2 = j == 0 ? tk[4] : (j == 1 ? tk[5] : (j == 2 ? tk[6] : tk[7]));
            const float t1 = key2f(tk1 & ~127u), t2 = key2f(tk2 & ~127u); const int i1 = 127 - (int)(tk1 & 127u), i2 = 127 - (int)(tk2 & 127u);
            unsigned kc[4];
#pragma unroll
            for (int e = 0; e < 4; ++e) { const unsigned ab = (ctab >> (8 * e)) & 255u; const int ca = (int)(ab >> 4), cb = (int)(ab & 15u);
                const float c = __shfl(t1, (lane & 48) + ca) + __shfl(t2, (lane & 48) + cb);
                kc[e] = (ab == 255u) ? 0u : ((f2key(c) & ~255u) | (255u - ab)); }
            sort4_desc(kc);
            const unsigned tkc = row_top16_sorted<4>(kc, fr);
            const float ts = key2f(tkc & ~255u); const int ci = 255 - (int)(tkc & 255u);
            const int ia = __shfl(i1, (lane & 48) + (ci >> 4)), ib = __shfl(i2, (lane & 48) + (ci & 15));
            const float tmax = __shfl(ts, lane & 48);
            const float e = __expf(ts - tmax); float sum = e;
            sum += __shfl_xor(sum, 1); sum += __shfl_xor(sum, 2); sum += __shfl_xor(sum, 4); sum += __shfl_xor(sum, 8);
            const int t = t0 + fq * 4 + j;
            IDX[(size_t)t * 128 + h * 16 + fr] = ia * 128 + ib;
            GATE[(size_t)t * 128 + h * 16 + fr] = e / sum;
            if ((j & 1) == 1) ER_STORE();
        }
    }
    for (; erow < 2 * NEXP; erow += NGW) { expert_row_load(a.in[15 + (erow >= NEXP)] + (size_t)(erow & (NEXP - 1)) * D, er0, lane); if (erow < NEXP) expert_row_gain(er0, a.in[12], lane);
        expert_row_store(er0, a.ws + ((erow >= NEXP) ? WS_EV : WS_EU) + (size_t)(erow & (NEXP - 1)) * EROW, (float*)(a.ws + WS_ESC) + erow, lane); }
#undef ER_LOAD
#undef ER_STORE
}

typedef float f32x2 __attribute__((ext_vector_type(2)));
__device__ __forceinline__ u32x4 bl128(__amdgpu_buffer_rsrc_t r, unsigned voff, unsigned soff) { return __builtin_amdgcn_raw_buffer_load_b128(r, voff, soff, 0); }
__device__ __forceinline__ u32x2 bl64(__amdgpu_buffer_rsrc_t r, unsigned voff, unsigned soff) { return __builtin_amdgcn_raw_buffer_load_b64(r, voff, soff, 0); }
__device__ __forceinline__ unsigned bl32(__amdgpu_buffer_rsrc_t r, unsigned voff, unsigned soff) { return __builtin_amdgcn_raw_buffer_load_b32(r, voff, soff, 0); }
__device__ __forceinline__ float wave_sum_dpp(float v) {
    v = dpp_add_f32<0xB1>(v); v = dpp_add_f32<0x4E>(v); v = dpp_add_f32<0x141>(v); v = dpp_add_f32<0x140>(v);
    v += __builtin_bit_cast(float, __builtin_amdgcn_update_dpp(0, __builtin_bit_cast(int, v), 0x142, 0xA, 0xF, false));
    v += __builtin_bit_cast(float, __builtin_amdgcn_update_dpp(0, __builtin_bit_cast(int, v), 0x143, 0xC, 0xF, false));
    return __builtin_bit_cast(float, __builtin_amdgcn_readlane(__builtin_bit_cast(int, v), 63));
}
__device__ __forceinline__ float wave_sum_fast(float v) {
    v = dpp_add_f32<0xB1>(v); v = dpp_add_f32<0x4E>(v); v = dpp_add_f32<0x141>(v); v = dpp_add_f32<0x140>(v);
    v += __shfl_xor(v, 16); v += __shfl_xor(v, 32); return v;
}
constexpr int TPW = 4, NSL = 8, SL_SHIFT = 11, RING = 10, SLOT = 1536;
#define P8_VMW 18
typedef __bf16 bf16x2_t __attribute__((ext_vector_type(2)));
__device__ __forceinline__ float dot2bf(unsigned a, unsigned b, float c) { return __builtin_amdgcn_fdot2_f32_bf16(__builtin_bit_cast(bf16x2_t, a), __builtin_bit_cast(bf16x2_t, b), c, false); }
constexpr int NROWS = TPW * 128;
#define P8_ISSUE(TBASE) do { const unsigned ro_ = (unsigned)__builtin_amdgcn_readlane(lch_, ii_ & 63) * (unsigned)EROW; \
        const char* sb_ = (const char*)a.ws + (TBASE) + ro_; const char* sb2_ = sb_ + 1024; const unsigned dl_ = ring_lo + (unsigned)is_ * SLOT; \
        asm volatile("s_mov_b32 m0, %3\n\ts_nop 0\n\tglobal_load_lds_dwordx4 %0, %1\n\ts_mov_b32 m0, %4\n\ts_mov_b64 exec, %5\n\tglobal_load_lds_dwordx4 %0, %2\n\ts_mov_b64 exec, -1" \
                     :: "v"(l16), "s"(sb_), "s"(sb2_), "s"(dl_), "s"(dl_ + 1024u), "s"(half_) : "memory"); \
        is_ = (is_ == RING - 1) ? 0 : is_ + 1; \
        ++ii_; if ((ii_ & 63) == 0) lch_ = (int)LST[ii_ + lane]; } while (0)
#define P8_RING_READ(r0, r1) do { r0 = *(const LAS u32x4*)(ring + cs_ * SLOT + l16); r1 = *(const LAS u32x2*)(ring + cs_ * SLOT + 1024 + l8); } while (0)
#define P8_DECODE(r0, r1) __builtin_amdgcn_cvt_scalef32_pk32_f32_fp6((u32x6){r0.x, r0.y, r0.z, r0.w, r1.x, r1.y}, 1.0f)
#define P8_STREAM_INIT(TBASE, r0, r1) int cs_ = 0, is_ = 0, ii_ = 0; int lch_ = (int)LST[lane]; \
        asm volatile("s_waitcnt vmcnt(0) lgkmcnt(0)" ::: "memory"); \
        _Pragma("unroll 1") for (int q_ = 0; q_ < RING; ++q_) P8_ISSUE(TBASE); \
        P8_WAIT_OLDEST(); P8_RING_READ(r0, r1)
#define P8_ROW_READY() asm volatile("s_waitcnt lgkmcnt(0)" ::: "memory")
#define P8_ROW_ADVANCE(TBASE, r0, r1) do { cs_ = (cs_ == RING - 1) ? 0 : cs_ + 1; P8_ISSUE(TBASE); P8_WAIT_OLDEST(); P8_RING_READ(r0, r1); } while (0)
#define P8_STREAM_END() asm volatile("s_waitcnt vmcnt(0) lgkmcnt(0)" ::: "memory")
#define P8_STR2(x) #x
#define P8_STR(x) P8_STR2(x)
#define P8_WAIT_OLDEST() asm volatile("s_waitcnt vmcnt(" P8_STR(P8_VMW) ")" ::: "memory")
static_assert(P8_VMW == 2 * (RING - 1) && RING * SLOT <= 16384, "the counted wait is vmcnt(2 * (RING - 1)); the ring is 16 KiB per wave");
__device__ __forceinline__ void p8_peer(const Args& a, LAS unsigned char* lds, float* dst, int vcu, int G, int wave, int lane_) {
    int lane = lane_; asm volatile("" : "+v"(lane));
    const __amdgpu_buffer_rsrc_t rws = __builtin_amdgcn_make_buffer_rsrc((void*)a.ws, (short)0, (int)WS_END, 0x00020000);
    const __amdgpu_buffer_rsrc_t rdst = __builtin_amdgcn_make_buffer_rsrc((void*)dst, (short)0, S * D * 4, 0x00020000);
    const __amdgpu_buffer_rsrc_t rfg = __builtin_amdgcn_make_buffer_rsrc((void*)a.in[17], (short)0, D * 4, 0x00020000);
    LAS unsigned char* ring = lds + wave * 16384;
    LAS unsigned* SLW = (LAS unsigned*)(lds + 132096 + wave * 1280);
    LAS unsigned short* LST = (LAS unsigned short*)SLW;
    const int gw = vcu * NWAVES + wave, NGW = G * NWAVES;
    const unsigned l16 = (unsigned)lane * 16u, l8 = (unsigned)lane * 8u, l4 = (unsigned)lane * 4u;
    const unsigned long long half_ = 0xffffffffull;
    const unsigned ring_lo = (unsigned)(size_t)(lds + wave * 16384);
#pragma unroll 1
    for (int tb = gw; tb < S; tb += TPW * NGW) {
        int sid[TPW][2], offv[TPW]; float act[TPW][2]; int cntv = 0;
#pragma unroll
        for (int k = 0; k < TPW; ++k) {
            const int t = (tb + k * NGW) < S ? (tb + k * NGW) : (S - 1);
            const unsigned oi = (unsigned)(WS_IDX + (size_t)t * 512);
            const int id0 = (int)bl32(rws, l4, oi), id1 = (int)bl32(rws, l4 + 256u, oi);
            const int sl0 = id0 >> SL_SHIFT, sl1 = id1 >> SL_SHIFT;
            int pos0 = 0, pos1 = 0, basec = 0, offacc = 0;
#pragma unroll
            for (int s = 0; s < NSL; ++s) {
                const unsigned long long m0 = __ballot(sl0 == s), m1 = __ballot(sl1 == s);
                const int c0 = __popcll(m0), c1 = __popcll(m1);
                const int b0 = (int)__builtin_amdgcn_mbcnt_hi((unsigned)(m0 >> 32), __builtin_amdgcn_mbcnt_lo((unsigned)m0, 0u));
                const int b1 = (int)__builtin_amdgcn_mbcnt_hi((unsigned)(m1 >> 32), __builtin_amdgcn_mbcnt_lo((unsigned)m1, 0u));
                pos0 = (sl0 == s) ? basec + b0 : pos0; pos1 = (sl1 == s) ? basec + c0 + b1 : pos1;
                basec += c0 + c1; offacc = (lane == s + 1) ? basec : offacc; cntv = (lane == s * TPW + k) ? (c0 + c1) : cntv;
            }
            offv[k] = offacc;
            SLW[pos0] = (unsigned)id0; SLW[pos1] = (unsigned)id1; SLW[128 + pos0] = (unsigned)lane; SLW[128 + pos1] = (unsigned)(64 + lane);
            asm volatile("s_waitcnt lgkmcnt(0)" ::: "memory");
            sid[k][0] = (int)SLW[lane]; sid[k][1] = (int)SLW[64 + lane];
            act[k][0] = __builtin_bit_cast(float, SLW[128 + lane]); act[k][1] = __builtin_bit_cast(float, SLW[192 + lane]);
            asm volatile("s_waitcnt lgkmcnt(0)" ::: "memory");
        }
        {
            int incl = cntv;
#pragma unroll
            for (int o = 1; o < 64; o <<= 1) { const int up = __shfl_up(incl, o); incl += (lane >= o) ? up : 0; }
            const int gb = incl - cntv;
            asm volatile("s_waitcnt lgkmcnt(0)" ::: "memory");
#pragma unroll
            for (int k = 0; k < TPW; ++k)
#pragma unroll
                for (int h = 0; h < 2; ++h) { const int sl = sid[k][h] >> SL_SHIFT;
                    const int p = __shfl(gb, sl * TPW + k) + (h * 64 + lane) - __shfl(offv[k], sl);
                    LST[p] = (unsigned short)sid[k][h]; }
            if (lane < RING) LST[NROWS + lane] = (unsigned short)0;
            asm volatile("s_waitcnt lgkmcnt(0)" ::: "memory");
        }
        int orig[TPW][2];
#pragma unroll
        for (int k = 0; k < TPW; ++k) { orig[k][0] = __builtin_bit_cast(int, act[k][0]); orig[k][1] = __builtin_bit_cast(int, act[k][1]); act[k][0] = 0.f; act[k][1] = 0.f; }
        {
            u32x2 hb[TPW][8];
#pragma unroll
            for (int k = 0; k < TPW; ++k) { const int t = (tb + k * NGW) < S ? (tb + k * NGW) : (S - 1);
#pragma unroll
                for (int kk = 0; kk < 8; ++kk) hb[k][kk] = bl64(rws, l8 + (unsigned)(kk * 512), (unsigned)(WS_XB + (size_t)t * (D * 2))); }
#pragma unroll
            for (int k = 0; k < TPW; ++k)
#pragma unroll
                for (int kk = 0; kk < 8; ++kk) asm volatile("" : "+v"(hb[k][kk]));
            float wd[4];
#pragma unroll
            for (int j = 0; j < 4; ++j) wd[j] = ((((lane & 15) >> 2) == (lane >> 4)) && ((lane & 3) == j)) ? 1.0f : 0.0f;
            u32x4 r0; u32x2 r1;
            P8_STREAM_INIT(WS_EU, r0, r1);
#pragma unroll 1
            for (int s = 0; s < NSL; ++s) {
#pragma unroll
                for (int k = 0; k < TPW; ++k) {
                    const int lo = __builtin_amdgcn_readlane(offv[k], s), hi = __builtin_amdgcn_readlane(offv[k], s + 1);
#pragma unroll 1
                    for (int e = lo; e < hi; ++e) {
                        P8_ROW_READY();
                        float tr;
                        { const u32x16 fb = __builtin_bit_cast(u32x16, __builtin_amdgcn_cvt_scalef32_pk32_bf16_fp6((u32x6){r0.x, r0.y, r0.z, r0.w, r1.x, r1.y}, 1.0f));
                          f32x4 dg = {0.f, 0.f, 0.f, 0.f};
#pragma unroll
                          for (int c = 0; c < 4; ++c) { const u32x4 av = {fb[4 * c], fb[4 * c + 1], fb[4 * c + 2], fb[4 * c + 3]};
                              const u32x4 bv = {hb[k][2 * c].x, hb[k][2 * c].y, hb[k][2 * c + 1].x, hb[k][2 * c + 1].y};
                              dg = __builtin_amdgcn_mfma_f32_16x16x32_bf16(__builtin_bit_cast(bf16x8, av), __builtin_bit_cast(bf16x8, bv), dg, 0, 0, 0); }
                          tr = (dg[0] * wd[0] + dg[1] * wd[1]) + (dg[2] * wd[2] + dg[3] * wd[3]); }
                        asm volatile("" : "+v"(tr));
                        P8_ROW_ADVANCE(WS_EU, r0, r1);
                        const float d = wave_sum_dpp(tr);
                        act[k][0] = (lane == e) ? d : act[k][0]; act[k][1] = (lane == e - 64) ? d : act[k][1];
                    }
                }
            }
            P8_STREAM_END();
        }
#pragma unroll
        for (int k = 0; k < TPW; ++k) {
            const int t = (tb + k * NGW) < S ? (tb + k * NGW) : (S - 1);
            const float ssp = lane < 32 ? __builtin_bit_cast(float, bl32(rws, l4, (unsigned)(WS_SS + (size_t)t * 128))) : 0.f;
            const float rstd2 = 1.0f / sqrtf(wave_sum(ssp) * (1.0f / D) + EPS);
            const unsigned og = (unsigned)(WS_GATE + (size_t)t * 512);
#pragma unroll
            for (int h = 0; h < 2; ++h) {
                const float gate = __builtin_bit_cast(float, bl32(rws, (unsigned)orig[k][h] * 4u, og));
                const float su = __builtin_bit_cast(float, bl32(rws, (unsigned)sid[k][h] * 4u, (unsigned)WS_ESC)) * rstd2;
                const float sv = __builtin_bit_cast(float, bl32(rws, (unsigned)sid[k][h] * 4u, (unsigned)(WS_ESC + NEXP * 4)));
                act[k][h] = gelu_tanh(act[k][h] * su) * gate * sv; }
        }
        {
            float acc[TPW][32];
#pragma unroll
            for (int k = 0; k < TPW; ++k)
#pragma unroll
                for (int i = 0; i < 32; ++i) acc[k][i] = 0.f;
            u32x4 r0; u32x2 r1;
            P8_STREAM_INIT(WS_EV, r0, r1);
#pragma unroll 1
            for (int s = 0; s < NSL; ++s) {
#pragma unroll
                for (int k = 0; k < TPW; ++k) {
                    const int lo = __builtin_amdgcn_readlane(offv[k], s), hi = __builtin_amdgcn_readlane(offv[k], s + 1);
#pragma unroll 1
                    for (int e = lo; e < hi; ++e) {
                        const int a0_ = __builtin_amdgcn_readlane(__builtin_bit_cast(int, act[k][0]), e & 63), a1_ = __builtin_amdgcn_readlane(__builtin_bit_cast(int, act[k][1]), e & 63);
                        const float aw = __builtin_bit_cast(float, e < 64 ? a0_ : a1_);
                        P8_ROW_READY();
                        { const f32x32 f = P8_DECODE(r0, r1);
#pragma unroll
                          for (int j = 0; j < 32; ++j) acc[k][j] += aw * f[j]; }
                        asm volatile("" : "+v"(acc[k][0]), "+v"(acc[k][16]));
                        P8_ROW_ADVANCE(WS_EV, r0, r1);
                    }
                }
            }
            P8_STREAM_END();
#pragma unroll
            for (int k = 0; k < TPW; ++k) { const int t = tb + k * NGW;
                if (t < S) {
                    float ss = 0.f; const unsigned ot = (unsigned)t * (unsigned)(D * 4);
#pragma unroll
                    for (int kk = 0; kk < 8; ++kk) { const u32x2 xw = bl64(rws, l8 + (unsigned)(kk * 512), (unsigned)(WS_XB + (size_t)t * (D * 2)));
                        acc[k][kk * 4 + 0] += bflo(xw.x); acc[k][kk * 4 + 1] += bfhi(xw.x); acc[k][kk * 4 + 2] += bflo(xw.y); acc[k][kk * 4 + 3] += bfhi(xw.y);
                        ss += (acc[k][kk * 4 + 0] * acc[k][kk * 4 + 0] + acc[k][kk * 4 + 1] * acc[k][kk * 4 + 1]) + (acc[k][kk * 4 + 2] * acc[k][kk * 4 + 2] + acc[k][kk * 4 + 3] * acc[k][kk * 4 + 3]); }
                    const float rstd = 1.0f / sqrtf(wave_sum(ss) * (1.0f / D) + EPS);
#pragma unroll
                    for (int kk = 0; kk < 8; ++kk) { const f32x4 f0 = __builtin_bit_cast(f32x4, bl128(rfg, l16 + (unsigned)((kk & 3) * 1024), (unsigned)((kk >> 2) * 4096)));
                        f32x4 o0; o0.x = acc[k][kk * 4 + 0] * rstd * f0.x; o0.y = acc[k][kk * 4 + 1] * rstd * f0.y; o0.z = acc[k][kk * 4 + 2] * rstd * f0.z; o0.w = acc[k][kk * 4 + 3] * rstd * f0.w;
                        __builtin_amdgcn_raw_buffer_store_b128(__builtin_bit_cast(u32x4, o0), rdst, l16 + (unsigned)((kk & 3) * 1024), ot + (unsigned)((kk >> 2) * 4096), 0); }
                }
            }
        }
    }
}

#define XB_TMO      128
#define XB_XCNT(j)  (256  + 64 * (j))
#define XB_XSUB(j)  (1280 + 64 * (j))
#define XB_XGEN(j)  (2304 + 64 * (j))
#define XB_TOP      3328
#define XB_TOPGEN   3392
#define XCD_BAR_WORDS 3456
#define XB_SPIN_CAP (1u << 22)
__device__ __forceinline__ unsigned xb_ld(unsigned* p)              { return __hip_atomic_load(p, __ATOMIC_RELAXED, __HIP_MEMORY_SCOPE_AGENT); }
__device__ __forceinline__ unsigned xb_add(unsigned* p, unsigned v) { return __hip_atomic_fetch_add(p, v, __ATOMIC_RELAXED, __HIP_MEMORY_SCOPE_AGENT); }
__device__ __forceinline__ unsigned xb_xcc_id() { return (unsigned)__builtin_amdgcn_s_getreg((3 << 11) | 20) & 0xFu; }
#define XB_SPIN(cond, bar) do { unsigned _sp = 0; while (cond) { __builtin_amdgcn_s_sleep(1); \
    if ((++_sp & 255u) == 0u) { if (xb_ld(&(bar)[XB_TMO])) break; if (_sp > XB_SPIN_CAP) { atomicAdd(&(bar)[XB_TMO], 1u); break; } } } } while (0)
struct XcdBarrier { unsigned* bar; unsigned x; volatile LAS unsigned* st; };
__device__ __forceinline__ XcdBarrier xcd_barrier_post(unsigned* bar, volatile LAS unsigned* st) {
    XcdBarrier b; b.bar = bar; b.x = xb_xcc_id(); b.st = st;
    if (threadIdx.x == 0) (void)xb_add(&bar[XB_XCNT(b.x)], 1u);
    return b;
}
__device__ __forceinline__ void xcd_barrier_complete(unsigned* bar, unsigned x, unsigned G, unsigned& nloc, unsigned& nx) {
    unsigned sum, cnt, mine, sp = 0u;
    for (;;) {
        sum = 0u; cnt = 0u; mine = 0u;
#pragma unroll
        for (unsigned j = 0; j < 16; ++j) { const unsigned c = xb_ld(&bar[XB_XCNT(j)]); sum += c; cnt += (c > 0u) ? 1u : 0u; mine = (j == x) ? c : mine; }
        if (sum == G) break;
        __builtin_amdgcn_s_sleep(1);
        if ((++sp & 255u) == 0u) { if (xb_ld(&bar[XB_TMO])) break; if (sp > XB_SPIN_CAP) { atomicAdd(&bar[XB_TMO], 1u); break; } }
    }
    nloc = mine > 0u ? mine : 1u; nx = cnt > 0u ? cnt : 1u;
}
__device__ __forceinline__ void xcd_barrier(const XcdBarrier& b, unsigned G) {
    asm volatile("s_waitcnt vmcnt(0)" ::: "memory");
    __syncthreads();
    if (threadIdx.x == 0) {
        unsigned* bar = b.bar;
        __builtin_amdgcn_s_waitcnt(0);
        unsigned nloc = b.st[0], nx = b.st[1];
        if (nloc == 0u) { xcd_barrier_complete(bar, b.x, G, nloc, nx); b.st[0] = nloc; b.st[1] = nx; }
        const unsigned old = xb_add(&bar[XB_XSUB(b.x)], 1u);
        const unsigned gen = old / nloc;
        if (old + 1u == (gen + 1u) * nloc) {
            __builtin_amdgcn_fence(__ATOMIC_RELEASE, "agent");
            asm volatile("s_waitcnt vmcnt(0)" ::: "memory");
            const unsigned og = xb_add(&bar[XB_TOP], 1u);
            const unsigned tg = og / nx;
            if (og + 1u == (tg + 1u) * nx) xb_add(&bar[XB_TOPGEN], 1u);
            else XB_SPIN(xb_ld(&bar[XB_TOPGEN]) == tg, bar);
            __builtin_amdgcn_fence(__ATOMIC_ACQUIRE, "agent");
            xb_add(&bar[XB_XGEN(b.x)], 1u);
            asm volatile("s_waitcnt vmcnt(0)" ::: "memory");
        } else {
            XB_SPIN(xb_ld(&bar[XB_XGEN(b.x)]) == gen, bar);
            __builtin_amdgcn_fence(__ATOMIC_ACQUIRE, "agent");
            asm volatile("s_waitcnt vmcnt(0)" ::: "memory");
        }
    }
    __syncthreads();
}

constexpr int N_PHASES = 9;
#ifndef DUP_MASK
#define DUP_MASK 0
#endif
#define REP(k) for (int rep_ = 0; rep_ < 1 + ((DUP_MASK >> (k)) & 1); ++rep_)
__global__ void __launch_bounds__(NTHR, 2) fwd(Args args) {
    extern __shared__ __attribute__((aligned(16))) unsigned char lds_raw[];
    LAS unsigned char* lds = (LAS unsigned char*)lds_raw;
    const int tid = threadIdx.x, lane = tid & 63, wave = __builtin_amdgcn_readfirstlane(tid >> 6);
    const int G = gridDim.x; const int bx = blockIdx.x; const int vcu = (G % 8 == 0) ? (bx % 8) * (G / 8) + bx / 8 : bx;
    unsigned char* ws = args.ws;
    const int lo = args.ph_lo, hi = args.ph_hi;
#define IN(k) (lo <= (k) && (k) < hi)
    volatile LAS unsigned* MISC = (volatile LAS unsigned*)(lds + MISC_OFF);
    if (tid < 32) MISC[tid] = 0u;
    __syncthreads();
#if USE_CG_SYNC
    if (IN(0) && bx * NTHR + tid < XCD_BAR_WORDS) __hip_atomic_store((unsigned*)(ws + WS_CTL) + bx * NTHR + tid, 0u, __ATOMIC_RELAXED, __HIP_MEMORY_SCOPE_AGENT);
    XcdBarrier bar; bar.bar = (unsigned*)(ws + WS_CTL); bar.x = 0; bar.st = MISC + 8;
#else
    XcdBarrier bar = xcd_barrier_post((unsigned*)(ws + WS_CTL), MISC + 8);
#endif
#if USE_CG_SYNC
    if (IN(0)) { cg::this_grid().sync(); bar = xcd_barrier_post((unsigned*)(ws + WS_CTL), MISC + 8); }
#define SEAM(k) do { if (IN(k) && IN((k) + ((k) == 4 ? 2 : 1))) { xcd_barrier(bar, (unsigned)G); } } while (0)
#else
#define SEAM(k) do { if (IN(k) && IN((k) + ((k) == 4 ? 2 : 1))) { xcd_barrier(bar, (unsigned)G); } } while (0)
#endif

    if (IN(0)) REP(0) { p0_prologue(args, lds, vcu, G, wave, lane, tid); }
    SEAM(0);
    if (IN(1)) REP(1) {
        { pg8::Gemm g{(const bf16_t*)(ws + WS_H), (const bf16_t*)(ws + WS_WIN), S, 12 * 256, D, D, D, 0}; pg8::StaticOrder so; so.init(S, 12 * 256, G, bx);
          pg8::EpiZ E{(bf16_t*)(ws + WS_Z), args.in[3], 1.0f};
          pg8::gemm_phase<pg8::EpiZ>(lds, g, so, E); }
        asm volatile("s_waitcnt vmcnt(0)" ::: "memory"); __syncthreads();
        { pg8::Gemm g{(const bf16_t*)(ws + WS_H8), (const bf16_t*)(ws + WS_W8), S, 16 * 256, D / 2, D / 2, D / 2, 0}; pg8::StaticOrder so; so.init(S, 16 * 256, G, bx, 12, 1);
          pg8::EpiZ E{(bf16_t*)(ws + WS_Z), args.in[3], 1.0f / (W8_SCALE * H8_SCALE)};
          pg8::gemm_phase<pg8::EpiZ, true, true>(lds, g, so, E); }
    }
    SEAM(1);
    if (IN(2)) REP(2) {
        for (int bi = bx; bi < 256; bi += G) p2_sgu(args, lds, bi * 2, bi * 2 + 2, 1, wave, lane, tid);
        p2_pool(args, vcu, G, tid);
    }
    SEAM(2);
    if (IN(3)) REP(3) {
        pg8::StaticOrder so; so.init(S, D, G, bx, 0, 0, 1);
        pg8::Gemm g{(const bf16_t*)(ws + WS_A2) + 1024, (const bf16_t*)(ws + WS_WG), S, D, GWD, D, GWD, 2, (const bf16_t*)(ws + WS_A2), (const bf16_t*)(ws + WS_WPOOL), 256};
        pg8::EpiChain E{(const bf16_t*)(ws + WS_Z), (bf16_t*)(ws + WS_MRG)};
        pg8::gemm_phase<pg8::EpiChain>(lds, g, so, E);
    }
    SEAM(3);
    if (IN(4)) REP(4) {
        pg8::Gemm g{(const bf16_t*)(ws + WS_MRG), (const bf16_t*)(ws + WS_WOUT), S, D, D, D, D, 0}; pg8::StaticOrder so; so.init(S, D, G, bx);
        pg8::EpiX1 E{args.in[0], (bf16_t*)(ws + WS_XB), (float*)(ws + WS_SS)};
        pg8::gemm_phase<pg8::EpiX1>(lds, g, so, E);
    }
    SEAM(4);
    if (IN(6)) REP(6) {
        pg8::Gemm g{(const bf16_t*)(ws + WS_XB), (const bf16_t*)(ws + WS_WQ), S, D, D, D, D, 0}; pg8::StaticOrder so; so.init(S, D, G, bx);
        pg8::EpiQ E{(bf16_t*)(ws + WS_Q), (const float*)(ws + WS_SS)};
        pg8::gemm_phase<pg8::EpiQ>(lds, g, so, E);
    }
    if (IN(6) && IN(7)) { asm volatile("s_waitcnt vmcnt(0)" ::: "memory"); __syncthreads(); }
    if (IN(7)) REP(7) { p7_topk(args, lds, vcu, G, wave, lane); }
    SEAM(7);
    if (IN(8)) REP(8) { float* dst8 = (rep_ < ((DUP_MASK >> 8) & 1)) ? (float*)(ws + WS_T) : args.out; p8_peer(args, lds, dst8, vcu, G, wave, lane); }
#undef IN
#undef SEAM
}

extern "C" void kernel_launch(void* const* d_in, const int* in_sizes, int n_in, void* d_out, int out_size, void* d_ws, size_t ws_size, hipStream_t stream) {
    static int grid = 0;
    if (grid == 0) {
        if (n_in != 18 || out_size != S * D || ws_size < WS_END) { fprintf(stderr, "kernel_launch: unexpected shapes (n_in %d, out %d, ws %zu)\n", n_in, out_size, ws_size); grid = -1; return; }
        int dev = 0, cus = 0, per_cu = 0;
        if (hipGetDevice(&dev) != hipSuccess || hipDeviceGetAttribute(&cus, hipDeviceAttributeMultiprocessorCount, dev) != hipSuccess) { grid = -1; return; }
        if (hipFuncSetAttribute((const void*)fwd, hipFuncAttributeMaxDynamicSharedMemorySize, LDS_BYTES) != hipSuccess) { fprintf(stderr, "kernel_launch: hipFuncSetAttribute failed\n"); grid = -1; return; }
        if (hipOccupancyMaxActiveBlocksPerMultiprocessor(&per_cu, (const void*)fwd, NTHR, LDS_BYTES) != hipSuccess || per_cu < 1) { fprintf(stderr, "kernel_launch: occupancy query says %d\n", per_cu); per_cu = 1; }
        (void)hipGetLastError();
        grid = cus;
    }
    if (grid < 0) return;
#if !USE_CG_SYNC
    if (hipMemsetAsync((char*)d_ws + WS_CTL, 0, 16384, stream) != hipSuccess) { fprintf(stderr, "kernel_launch: memset failed\n"); return; }
#endif
    Args a{};
    for (int i = 0; i < 18; ++i) a.in[i] = (const float*)d_in[i];
    a.out = (float*)d_out; a.ws = (unsigned char*)d_ws;
#if MK_N_LAUNCHES == 1
    a.ph_lo = 0; a.ph_hi = N_PHASES;
    void* kargs[] = {&a};
    hipError_t e = hipLaunchCooperativeKernel((const void*)fwd, dim3(grid), dim3(NTHR), kargs, LDS_BYTES, stream);
    if (e != hipSuccess) fprintf(stderr, "kernel_launch: cooperative launch failed: %s (grid %d)\n", hipGetErrorString(e), grid);
#else
    for (int p = 0; p < N_PHASES; ++p) {
        a.ph_lo = p; a.ph_hi = p + 1;
        hipLaunchKernelGGL(fwd, dim3(grid), dim3(NTHR), LDS_BYTES, stream, a);
    }
#endif
}
```

```cpp
#include <hip/hip_runtime.h>
#include <hip/hip_cooperative_groups.h>
#include <cstdio>
#include <cstdint>
namespace cg = cooperative_groups;

#ifndef USE_CG_SYNC
#define USE_CG_SYNC 1
#endif
#ifndef MK_N_LAUNCHES
#define MK_N_LAUNCHES 1
#endif

#define LAS __attribute__((address_space(3)))
typedef unsigned short bf16_t;
typedef short bf16x8 __attribute__((ext_vector_type(8)));
typedef float f32x4 __attribute__((ext_vector_type(4)));
typedef unsigned u32x4 __attribute__((ext_vector_type(4)));
typedef unsigned u32x2 __attribute__((ext_vector_type(2)));

constexpr int S = 8192, D = 2048, INW = 7168, PW = 1024, GWD = 1024;
constexpr int NEXP = 16384;
constexpr float EPS = 1e-6f;
constexpr int NWAVES = 8, NTHR = 512;

constexpr size_t MiB = 1u << 20;
constexpr size_t WS_CTL = 0;
constexpr size_t WS_WIN = 1 * MiB;
constexpr size_t WS_WPOOL = 21 * MiB;
constexpr size_t WS_WG = 31 * MiB;
constexpr size_t WS_WOUT = 35 * MiB;
constexpr size_t WS_WQ = 43 * MiB;
constexpr size_t WS_KEYS = 51 * MiB;
constexpr size_t WS_WSM = 52 * MiB;
constexpr size_t WS_H = 53 * MiB;
constexpr size_t WS_Z = 85 * MiB;
constexpr size_t WS_A2 = 197 * MiB;
constexpr size_t WS_T = 229 * MiB;
constexpr size_t WS_MRG = 293 * MiB;
constexpr size_t WS_Q = 325 * MiB;
constexpr size_t WS_IDX = 357 * MiB;
constexpr size_t WS_GATE = 361 * MiB;
constexpr size_t WS_SS = 365 * MiB;
constexpr size_t WS_ESC = 369 * MiB;
constexpr size_t WS_EU = 370 * MiB;
constexpr size_t WS_EV = 402 * MiB;
constexpr size_t WS_XB = 434 * MiB;
constexpr size_t WS_END = 466 * MiB;
constexpr size_t WS_W8 = WS_WIN + 6 * MiB;
constexpr size_t WS_H8 = WS_Q;
constexpr float W8_SCALE = 256.0f, H8_SCALE = 4.0f;

constexpr int LDS_BYTES = 147456;
constexpr int MISC_OFF = 131072 + 320;

__device__ __forceinline__ unsigned f2bf(float f) { unsigned u = __builtin_bit_cast(unsigned, f); return (u + 0x7fffu + ((u >> 16) & 1u)) >> 16; }
__device__ __forceinline__ unsigned pk2(float lo, float hi) { return f2bf(lo) | (f2bf(hi) << 16); }
__device__ __forceinline__ float bflo(unsigned w) { return __builtin_bit_cast(float, w << 16); }
__device__ __forceinline__ float bfhi(unsigned w) { return __builtin_bit_cast(float, w & 0xffff0000u); }
__device__ __forceinline__ float wave_sum(float v) {
#pragma unroll
    for (int o = 1; o < 64; o <<= 1) v += __shfl_xor(v, o);
    return v;
}
template <int CTRL> __device__ __forceinline__ float dpp_add_f32(float v) { return v + __builtin_bit_cast(float, __builtin_amdgcn_update_dpp(0, __builtin_bit_cast(int, v), CTRL, 0xF, 0xF, true)); }
__device__ __forceinline__ float row_sum_f32(float v) { v = dpp_add_f32<0xB1>(v); v = dpp_add_f32<0x4E>(v); v = dpp_add_f32<0x141>(v); v = dpp_add_f32<0x140>(v); return v; }
__device__ __forceinline__ float gelu_tanh(float x) {
    const float y = 1.5957691216057308f * (x + 0.044715f * x * x * x);
    const float e = __builtin_amdgcn_exp2f(-y * 1.4426950408889634f);
    return x * __builtin_amdgcn_rcpf(1.0f + e);
}
__device__ __forceinline__ float sigmoidf_(float x) { return __builtin_amdgcn_rcpf(1.0f + __builtin_amdgcn_exp2f(-x * 1.4426950408889634f)); }

namespace pg8 {
constexpr int BM = 256, BK = 64, HALF = 128, HTB = HALF * BK * 2, STAGE_BYTES = 8 * HTB, NXCD = 8, WGM = 1;
__host__ __device__ __forceinline__ int lds_byte(int r, int c) { const int st = (r >> 4) * 2 + (c >> 5), rr = r & 15, cc = c & 31, ob = rr * 64 + cc * 2; return st * 1024 + (ob ^ (((ob >> 9) & 1) << 5)); }
__host__ __device__ __forceinline__ void stage_rc(int b, int& R, int& C) { const int st = b / 1024, sb = b % 1024, swz = sb ^ (((sb >> 9) & 1) << 5); R = (st >> 1) * 16 + swz / 64; C = (st & 1) * 32 + (swz % 64) / 2; }
__host__ __device__ __forceinline__ int perm32(int rho) { const int n = rho >> 4, i = rho & 15; return 8 * (i >> 2) + 4 * n + (i & 3); }

struct Unit { int pm, pn, sub; };
struct Gemm { const bf16_t* A; const bf16_t* Bt; int M, N, K, lda, ldb, mode; const bf16_t* A0; const bf16_t* Bt0; int K0; };
__device__ __forceinline__ const char* a_ptr(const Gemm& g, const Unit& u) {
    const size_t off = (size_t)u.pm * BM * g.lda; if (g.mode == 2 && u.sub == 0) return (const char*)(g.A0 + off + (size_t)(u.pn >> 1) * 256); return (const char*)(g.A + off); }
__device__ __forceinline__ const char* b_ptr(const Gemm& g, const Unit& u) {
    const size_t off = (size_t)u.pn * BM * g.ldb; return (const char*)(((g.mode == 2 && u.sub == 0) ? g.Bt0 : g.Bt) + off); }

struct StaticOrder {
    int nM, nN, nwg, G, c, pn0, split, chain;
    __host__ __device__ void init(int M, int N, int G_, int c_, int pn0_ = 0, int split_ = 0, int chain_ = 0) { nM = M / BM; nN = N / BM; nwg = nM * nN; G = G_; c = c_; pn0 = pn0_; split = (split_ && nwg == 2 * G_ && (G_ & 1) == 0) ? 1 : 0; chain = chain_; }
    __host__ __device__ bool next(int i_, Unit& u) const {
        const int i = chain ? (i_ >> 1) : i_; u.sub = chain ? (i_ & 1) : 0;
        long L;
        if (split) { const int hG = G / 2; if (c < hG) { if (i > 0) return false; L = c; } else { if (i > 2) return false; L = (long)c + (long)hG * i; } }
        else L = (long)i * G + c;
        if (L >= nwg) return false;
        int wgid = (int)L; { const int q = nwg / NXCD, r = nwg % NXCD, xcd = wgid % NXCD, off = wgid / NXCD; wgid = (xcd < r ? xcd * (q + 1) : r * (q + 1) + (xcd - r) * q) + off; }
        const int nig = WGM * nN, gid = wgid / nig, fm = gid * WGM, gsz = (nM - fm) < WGM ? (nM - fm) : WGM;
        u.pm = fm + ((wgid % nig) % gsz); u.pn = pn0 + (wgid % nig) / gsz; return true;
    }
};

__device__ __forceinline__ unsigned cvt_pk_bf16(float lo, float hi) { unsigned r; asm volatile("v_cvt_pk_bf16_f32 %0, %1, %2" : "=v"(r) : "v"(lo), "v"(hi)); return r; }


struct EpiZ {
    static constexpr bool PERM = true;
    bf16_t* Z; const float* b_gate; float zs;
    __device__ __forceinline__ void operator()(const f32x4 (&acc)[2][2][4][2], const Unit& u, int wr, int wc, int fr, int fq) const {
        const int row0 = u.pm * BM + wr * 64 + fr, col0 = u.pn * BM + wc * 32 + 8 * fq;
        const int mode = u.pn < 4 ? 0 : (u.pn < 12 ? 1 : 2);
        f32x4 bv[2][2];
#pragma unroll
        for (int bj = 0; bj < 2; ++bj)
#pragma unroll
            for (int n = 0; n < 2; ++n) bv[bj][n] = (mode == 2) ? *(const f32x4*)(b_gate + (col0 - 3072) + bj * HALF + 4 * n) : (f32x4){0.f, 0.f, 0.f, 0.f};
#pragma unroll
        for (int ai = 0; ai < 2; ++ai)
#pragma unroll
            for (int m = 0; m < 4; ++m) { bf16_t* rowp = Z + (size_t)(row0 + ai * HALF + m * 16) * INW + col0;
#pragma unroll
                for (int bj = 0; bj < 2; ++bj) { f32x4 v0 = acc[ai][bj][m][0], v1 = acc[ai][bj][m][1];
                    if (mode == 1) {
#pragma unroll
                        for (int j = 0; j < 4; ++j) { v0[j] = gelu_tanh(v0[j]); v1[j] = gelu_tanh(v1[j]); } }
                    if (mode == 2) { v0 = v0 * zs + bv[bj][0]; v1 = v1 * zs + bv[bj][1];
#pragma unroll
                        for (int j = 0; j < 4; ++j) { v0[j] = sigmoidf_(v0[j]); v1[j] = sigmoidf_(v1[j]); } }
                    u32x4 w; w.x = cvt_pk_bf16(v0[0], v0[1]); w.y = cvt_pk_bf16(v0[2], v0[3]); w.z = cvt_pk_bf16(v1[0], v1[1]); w.w = cvt_pk_bf16(v1[2], v1[3]);
                    *(u32x4*)(rowp + bj * HALF) = w; } }
    }
};
struct EpiChain {
    static constexpr bool PERM = true;
    const bf16_t* Z; bf16_t* O;
    __device__ __forceinline__ void operator()(f32x4 (&acc)[2][2][4][2], const Unit& u, int wr, int wc, int fr, int fq) const {
        const int row0 = u.pm * BM + wr * 64 + fr, col0 = u.pn * BM + wc * 32 + 8 * fq;
        if (u.sub == 0) {
#pragma unroll
            for (int ai = 0; ai < 2; ++ai)
#pragma unroll
                for (int m = 0; m < 4; ++m) { const size_t row = (size_t)(row0 + ai * HALF + m * 16);
#pragma unroll
                    for (int bj = 0; bj < 2; ++bj) { const int c = col0 + bj * HALF;
                        const u32x4 ga = *(const u32x4*)(Z + row * INW + 3072 + c), gb = *(const u32x4*)(Z + row * INW + 5120 + c);
                        f32x4 r0, r1;
                        r0[0] = bflo(ga.x) * __builtin_amdgcn_rcpf(fmaxf(bflo(gb.x), 1.0e-30f)); r0[1] = bfhi(ga.x) * __builtin_amdgcn_rcpf(fmaxf(bfhi(gb.x), 1.0e-30f));
                        r0[2] = bflo(ga.y) * __builtin_amdgcn_rcpf(fmaxf(bflo(gb.y), 1.0e-30f)); r0[3] = bfhi(ga.y) * __builtin_amdgcn_rcpf(fmaxf(bfhi(gb.y), 1.0e-30f));
                        r1[0] = bflo(ga.z) * __builtin_amdgcn_rcpf(fmaxf(bflo(gb.z), 1.0e-30f)); r1[1] = bfhi(ga.z) * __builtin_amdgcn_rcpf(fmaxf(bfhi(gb.z), 1.0e-30f));
                        r1[2] = bflo(ga.w) * __builtin_amdgcn_rcpf(fmaxf(bflo(gb.w), 1.0e-30f)); r1[3] = bfhi(ga.w) * __builtin_amdgcn_rcpf(fmaxf(bfhi(gb.w), 1.0e-30f));
                        acc[ai][bj][m][0] *= r0; acc[ai][bj][m][1] *= r1; asm volatile("" ::: "memory"); } }
        } else {
#pragma unroll
            for (int ai = 0; ai < 2; ++ai)
#pragma unroll
                for (int m = 0; m < 4; ++m) { const size_t row = (size_t)(row0 + ai * HALF + m * 16);
#pragma unroll
                    for (int bj = 0; bj < 2; ++bj) { const int c = col0 + bj * HALF;
                        const u32x4 g = *(const u32x4*)(Z + row * INW + 5120 + c);
                        const f32x4 a0 = acc[ai][bj][m][0], a1 = acc[ai][bj][m][1];
                        u32x4 w; w.x = cvt_pk_bf16(fmaxf(bflo(g.x), 1.0e-30f) * a0[0], fmaxf(bfhi(g.x), 1.0e-30f) * a0[1]); w.y = cvt_pk_bf16(fmaxf(bflo(g.y), 1.0e-30f) * a0[2], fmaxf(bfhi(g.y), 1.0e-30f) * a0[3]);
                        w.z = cvt_pk_bf16(fmaxf(bflo(g.z), 1.0e-30f) * a1[0], fmaxf(bfhi(g.z), 1.0e-30f) * a1[1]); w.w = cvt_pk_bf16(fmaxf(bflo(g.w), 1.0e-30f) * a1[2], fmaxf(bfhi(g.w), 1.0e-30f) * a1[3]);
                        *(u32x4*)(O + row * D + c) = w; asm volatile("" ::: "memory"); } }
        }
    }
};
struct EpiX1 {
    static constexpr bool PERM = true;
    const float* X; bf16_t* XB; float* SS;
    __device__ __forceinline__ void operator()(const f32x4 (&acc)[2][2][4][2], const Unit& u, int wr, int wc, int fr, int fq) const {
        const int row0 = u.pm * BM + wr * 64 + fr, col0 = u.pn * BM + wc * 32 + 8 * fq;
#pragma unroll
        for (int ai = 0; ai < 2; ++ai)
#pragma unroll
            for (int m = 0; m < 4; ++m) { const size_t row = (size_t)(row0 + ai * HALF + m * 16); float ss = 0.f;
#pragma unroll
                for (int bj = 0; bj < 2; ++bj) { const size_t off = row * D + col0 + bj * HALF;
                    const f32x4 x0 = *(const f32x4*)(X + off) + acc[ai][bj][m][0], x1 = *(const f32x4*)(X + off + 4) + acc[ai][bj][m][1];
                    ss += (x0[0] * x0[0] + x0[1] * x0[1]) + (x0[2] * x0[2] + x0[3] * x0[3]) + (x1[0] * x1[0] + x1[1] * x1[1]) + (x1[2] * x1[2] + x1[3] * x1[3]);
                    u32x4 w; w.x = cvt_pk_bf16(x0[0], x0[1]); w.y = cvt_pk_bf16(x0[2], x0[3]); w.z = cvt_pk_bf16(x1[0], x1[1]); w.w = cvt_pk_bf16(x1[2], x1[3]);
                    *(u32x4*)(XB + off) = w; }
                ss += __shfl_xor(ss, 16); ss += __shfl_xor(ss, 32);
                if (fq == 0) SS[row * 32 + u.pn * 4 + wc] = ss;
                asm volatile("" ::: "memory"); }
    }
};
struct EpiQ {
    static constexpr bool PERM = true;
    bf16_t* O; const float* SS;
    __device__ __forceinline__ void operator()(const f32x4 (&acc)[2][2][4][2], const Unit& u, int wr, int wc, int fr, int fq) const {
        const int row0 = u.pm * BM + wr * 64 + fr, col0 = u.pn * BM + wc * 32 + 8 * fq;
#pragma unroll
        for (int ai = 0; ai < 2; ++ai)
#pragma unroll
            for (int m = 0; m < 4; ++m) { const size_t row = (size_t)(row0 + ai * HALF + m * 16);
                const f32x4 p0 = *(const f32x4*)(SS + row * 32 + fq * 8), p1 = *(const f32x4*)(SS + row * 32 + fq * 8 + 4);
                float ss = ((p0[0] + p0[1]) + (p0[2] + p0[3])) + ((p1[0] + p1[1]) + (p1[2] + p1[3]));
                ss += __shfl_xor(ss, 16); ss += __shfl_xor(ss, 32);
                const float rstd = 1.0f / sqrtf(ss * (1.0f / D) + EPS);
                bf16_t* rowp = O + row * D + col0;
#pragma unroll
                for (int bj = 0; bj < 2; ++bj) { const f32x4 v0 = acc[ai][bj][m][0] * rstd, v1 = acc[ai][bj][m][1] * rstd;
                    u32x4 w; w.x = cvt_pk_bf16(v0[0], v0[1]); w.y = cvt_pk_bf16(v0[2], v0[3]); w.z = cvt_pk_bf16(v1[0], v1[1]); w.w = cvt_pk_bf16(v1[2], v1[3]);
                    *(u32x4*)(rowp + bj * HALF) = w; } }
    }
};

typedef int i32x8 __attribute__((ext_vector_type(8)));
template <class Epi, bool ALIGN_EPI = true, bool FP8 = false>
__device__ __forceinline__ void gemm_phase(LAS unsigned char* lds, const Gemm g, const StaticOrder& S_, const Epi& E) {
    int tid_ = threadIdx.x; asm volatile("" : "+v"(tid_));
    const int tid = tid_, wid = __builtin_amdgcn_readfirstlane(tid >> 6), lane = tid & 63, wr = wid >> 2, wc = wid & 3, fr = lane & 15, fq = lane >> 4;
    const int K = g.K, nt1 = K / BK, nt0 = g.K0 / BK;
    unsigned voffA[2], voffB[2];
#pragma unroll
    for (int i = 0; i < 2; ++i) { int R, C; stage_rc(tid * 16 + i * 8192, R, C); const int Rb = Epi::PERM ? ((R & ~31) + perm32(R & 31)) : R;
        voffA[i] = (unsigned)(R * g.lda + C) * 2u; voffB[i] = (unsigned)(Rb * g.ldb + C) * 2u; }
    const size_t kstep = (size_t)(BK * 2);
    const size_t hstepA = (size_t)HALF * g.lda * 2, hstepB = (size_t)HALF * g.ldb * 2;
    const unsigned ldsw = (unsigned)wid * 1024u;
    const int aoff = lds_byte(wr * 64 + fr, fq * 8), boff = lds_byte(wc * 32 + fr, fq * 8);
#define PG8_SA(b, h) (((b) * 2 + (h)) * HTB)
#define PG8_SB(b, h) ((4 + (b) * 2 + (h)) * HTB)
#define PG8_STAGE(bufoff, gbase, voff) do { _Pragma("unroll") for (int _i = 0; _i < 2; ++_i) \
        __builtin_amdgcn_global_load_lds((const unsigned*)((const char*)(gbase) + (voff)[_i]), (LAS unsigned*)(lds + (bufoff) + ldsw + _i * 8192), 16, 0, 0); } while (0)
#define PG8_LDA(dst, b, h) do { _Pragma("unroll") for (int m = 0; m < 4; ++m) _Pragma("unroll") for (int k = 0; k < 2; ++k) dst[m][k] = *(const LAS bf16x8*)(lds + PG8_SA(b, h) + aoff + m * 2048 + k * 1024); } while (0)
#define PG8_LDB(dst, b, h) do { _Pragma("unroll") for (int n = 0; n < 2; ++n) _Pragma("unroll") for (int k = 0; k < 2; ++k) dst[n][k] = *(const LAS bf16x8*)(lds + PG8_SB(b, h) + boff + n * 2048 + k * 1024); } while (0)
#define PG8_CAT(x) __builtin_bit_cast(i32x8, __builtin_shufflevector(x[0], x[1], 0, 1, 2, 3, 4, 5, 6, 7, 8, 9, 10, 11, 12, 13, 14, 15))
#define PG8_MMA(ai, bj, At, Bt) do { __builtin_amdgcn_s_setprio(1); _Pragma("unroll") for (int m = 0; m < 4; ++m) _Pragma("unroll") for (int n = 0; n < 2; ++n) { \
        if constexpr (FP8) asm volatile("v_mfma_f32_16x16x128_f8f6f4 %0, %1, %2, %0" : "+v"(acc[ai][bj][m][n]) : "v"(PG8_CAT(Bt[n])), "v"(PG8_CAT(At[m])));   \
        else { _Pragma("unroll") for (int k = 0; k < 2; ++k) acc[ai][bj][m][n] = __builtin_amdgcn_mfma_f32_16x16x32_bf16(Bt[n][k], At[m][k], acc[ai][bj][m][n], 0, 0, 0); } } \
        __builtin_amdgcn_s_setprio(0); } while (0)
#define PG8_WAIT_V(n) asm volatile("s_waitcnt vmcnt(" #n ")" ::: "memory")
#define PG8_WAIT_L(n) asm volatile("s_waitcnt lgkmcnt(" #n ")" ::: "memory")
#define PG8_BAR __builtin_amdgcn_s_barrier()
#define PG8_SCHED __builtin_amdgcn_sched_barrier(0)
    Unit cur, nxt; int ui = 0;
    if (!S_.next(0, cur)) return;
    f32x4 acc[2][2][4][2];
#pragma unroll
    for (int a = 0; a < 2; ++a)
#pragma unroll
        for (int b = 0; b < 2; ++b)
#pragma unroll
            for (int m = 0; m < 4; ++m)
#pragma unroll
                for (int n = 0; n < 2; ++n) acc[a][b][m][n] = (f32x4){0.f, 0.f, 0.f, 0.f};
    bf16x8 At[4][2], B0[2][2], B1[2][2];
    const char* cA = a_ptr(g, cur); const char* cB = b_ptr(g, cur);
    PG8_STAGE(PG8_SB(0, 0), cB, voffB); PG8_STAGE(PG8_SB(0, 1), cB + hstepB, voffB); PG8_STAGE(PG8_SA(0, 0), cA, voffA); PG8_STAGE(PG8_SA(0, 1), cA + hstepA, voffA);
    if (wr == 1) PG8_BAR;
    PG8_WAIT_V(2); PG8_BAR;
    PG8_STAGE(PG8_SB(1, 0), cB + kstep, voffB); PG8_STAGE(PG8_SA(1, 0), cA + kstep, voffA); PG8_STAGE(PG8_SB(1, 1), cB + hstepB + kstep, voffB);
    PG8_WAIT_V(6); PG8_BAR;
    for (;;) {
        const bool has_next = S_.next(ui + 1, nxt);
        const char* nA = has_next ? a_ptr(g, nxt) : cA; const char* nB = has_next ? b_ptr(g, nxt) : cB;
        const int nt = (g.mode == 2 && cur.sub == 0) ? nt0 : nt1;
        for (int t = 0; t < nt; t += 2) {
            const bool last = (t == nt - 2);
            const char* a1 = cA + (size_t)(t + 1) * kstep;
            const char* a2 = last ? nA : cA + (size_t)(t + 2) * kstep; const char* b2 = last ? nB : cB + (size_t)(t + 2) * kstep;
            const char* a3 = a2 + kstep; const char* b3 = b2 + kstep;
            PG8_LDB(B0, 0, 0); PG8_LDB(B1, 0, 1); PG8_SCHED; PG8_LDA(At, 0, 0); PG8_STAGE(PG8_SA(1, 1), a1 + hstepA, voffA);
            PG8_WAIT_V(8); PG8_WAIT_L(0); PG8_BAR; PG8_MMA(0, 0, At, B0); PG8_MMA(0, 1, At, B1); PG8_BAR; PG8_SCHED;
            PG8_LDA(At, 0, 1); PG8_STAGE(PG8_SB(0, 0), b2, voffB); PG8_STAGE(PG8_SB(0, 1), b2 + hstepB, voffB); PG8_STAGE(PG8_SA(0, 0), a2, voffA);
            PG8_WAIT_V(8); PG8_WAIT_L(0); PG8_BAR; PG8_MMA(1, 0, At, B0); PG8_MMA(1, 1, At, B1); PG8_BAR; PG8_SCHED;
            PG8_LDB(B0, 1, 0); PG8_LDB(B1, 1, 1); PG8_SCHED; PG8_LDA(At, 1, 0); PG8_STAGE(PG8_SA(0, 1), a2 + hstepA, voffA);
            PG8_WAIT_V(8); PG8_WAIT_L(0); PG8_BAR; PG8_MMA(0, 0, At, B0); PG8_MMA(0, 1, At, B1); PG8_BAR; PG8_SCHED;
            PG8_LDA(At, 1, 1); PG8_STAGE(PG8_SB(1, 0), b3, voffB); PG8_STAGE(PG8_SB(1, 1), b3 + hstepB, voffB); PG8_STAGE(PG8_SA(1, 0), a3, voffA);
            PG8_WAIT_V(8); PG8_WAIT_L(0); PG8_BAR; PG8_MMA(1, 0, At, B0); PG8_MMA(1, 1, At, B1); PG8_BAR; PG8_SCHED;
        }
        if constexpr (ALIGN_EPI) { if (wr == 0) PG8_BAR; }
        if constexpr (FP8) asm volatile("s_nop 15\n\ts_nop 15" ::: "memory");
        { int ln_ = threadIdx.x & 63; asm volatile("" : "+v"(ln_));
          E(acc, cur, wr, wc, ln_ & 15, ln_ >> 4); }
        if (!has_next) break;
        if (!(g.mode == 2 && cur.sub == 0))
#pragma unroll
        for (int a = 0; a < 2; ++a)
#pragma unroll
            for (int b = 0; b < 2; ++b)
#pragma unroll
                for (int m = 0; m < 4; ++m)
#pragma unroll
                    for (int n = 0; n < 2; ++n) acc[a][b][m][n] = (f32x4){0.f, 0.f, 0.f, 0.f};
        cur = nxt; cA = nA; cB = nB; ++ui;
        if constexpr (ALIGN_EPI) { if (wr == 1) PG8_BAR; }
    }
    PG8_WAIT_V(0);
    if constexpr (!ALIGN_EPI) { if (wr == 0) PG8_BAR; }
    PG8_BAR;
#undef PG8_SA
#undef PG8_SB
#undef PG8_STAGE
#undef PG8_LDA
#undef PG8_LDB
#undef PG8_MMA
#undef PG8_CAT
#undef PG8_WAIT_V
#undef PG8_WAIT_L
#undef PG8_BAR
#undef PG8_SCHED
}
}

struct Args { const float* in[18]; float* out; unsigned char* ws; int ph_lo, ph_hi; };

__device__ __forceinline__ void p0_transpose_item(const float* W, int K, int N, bf16_t* WT, LAS float* scr, int item, int lane, const float* kgain = nullptr, unsigned char* W8 = nullptr, int n8 = 0, float s8 = 1.0f, int ldwt = 0) {
    const int nblk = N / 32, kb = item / nblk, nb = item % nblk, k0 = 64 * kb, n0 = 32 * nb;
    { f32x4 wv[8];
#pragma unroll
      for (int i = 0; i < 8; ++i) wv[i] = *(const f32x4*)(W + (size_t)(k0 + 8 * i + (lane >> 3)) * N + n0 + 4 * (lane & 7));
#pragma unroll
      for (int i = 0; i < 8; ++i) { const int kk = 8 * i + (lane >> 3); const float gk = kgain ? kgain[k0 + kk] : 1.0f; LAS float* sp = scr + kk * 33 + 4 * (lane & 7);
          sp[0] = gk * wv[i].x; sp[1] = gk * wv[i].y; sp[2] = gk * wv[i].z; sp[3] = gk * wv[i].w; } }
    asm volatile("s_waitcnt lgkmcnt(0)" ::: "memory");
    const int c = lane & 7;
    if (W8 != nullptr && n0 >= n8) {
#pragma unroll
        for (int j = 0; j < 4; ++j) { const int n = (lane >> 3) + 8 * j; const LAS float* s = scr + (8 * c) * 33 + n;
            int w0 = __builtin_amdgcn_cvt_pk_fp8_f32(s[0 * 33] * s8, s[1 * 33] * s8, 0, false); w0 = __builtin_amdgcn_cvt_pk_fp8_f32(s[2 * 33] * s8, s[3 * 33] * s8, w0, true);
            int w1 = __builtin_amdgcn_cvt_pk_fp8_f32(s[4 * 33] * s8, s[5 * 33] * s8, 0, false); w1 = __builtin_amdgcn_cvt_pk_fp8_f32(s[6 * 33] * s8, s[7 * 33] * s8, w1, true);
            u32x2 o; o.x = (unsigned)w0; o.y = (unsigned)w1; *(u32x2*)(W8 + (size_t)(n0 + n) * K + k0 + 8 * c) = o; }
    } else {
#pragma unroll
    for (int j = 0; j < 4; ++j) { const int n = (lane >> 3) + 8 * j; const LAS float* s = scr + (8 * c) * 33 + n;
        u32x4 o; o.x = pk2(s[0 * 33], s[1 * 33]); o.y = pk2(s[2 * 33], s[3 * 33]); o.z = pk2(s[4 * 33], s[5 * 33]); o.w = pk2(s[6 * 33], s[7 * 33]);
        *(u32x4*)(WT + (size_t)(n0 + n) * (ldwt ? ldwt : K) + k0 + 8 * c) = o; }
    }
    asm volatile("s_waitcnt lgkmcnt(0)" ::: "memory");
}
__device__ __forceinline__ void rms_row_to_bf16(const float* xrow, const float* g, bf16_t* orow, int lane, unsigned char* o8row = nullptr, float s8 = 1.0f) {
    const f32x4* xr = (const f32x4*)xrow + lane;
    f32x4 v[8]; float s = 0.f;
#pragma unroll
    for (int j = 0; j < 8; ++j) { v[j] = xr[64 * j]; s += (v[j].x * v[j].x + v[j].y * v[j].y) + (v[j].z * v[j].z + v[j].w * v[j].w); }
    const float rstd = 1.0f / sqrtf(wave_sum(s) * (1.0f / D) + EPS);
    const f32x4* gr = (const f32x4*)g + lane;
    u32x2* o8 = (u32x2*)orow + lane;
#pragma unroll
    for (int j = 0; j < 8; ++j) { const f32x4 gv = gr[64 * j]; const float h0 = v[j].x * rstd * gv.x, h1 = v[j].y * rstd * gv.y, h2 = v[j].z * rstd * gv.z, h3 = v[j].w * rstd * gv.w;
        u32x2 o; o.x = pk2(h0, h1); o.y = pk2(h2, h3); o8[64 * j] = o;
        if (o8row != nullptr) { int w = __builtin_amdgcn_cvt_pk_fp8_f32(h0 * s8, h1 * s8, 0, false); w = __builtin_amdgcn_cvt_pk_fp8_f32(h2 * s8, h3 * s8, w, true); ((unsigned*)o8row)[64 * j + lane] = (unsigned)w; } }
}
__device__ __forceinline__ void cvt_stream(const float* src, bf16_t* dst, size_t n8, size_t gtid, size_t nthr) {
    for (size_t i = gtid; i < n8; i += nthr) { const f32x4 a = ((const f32x4*)src)[2 * i], b = ((const f32x4*)src)[2 * i + 1];
        u32x4 o; o.x = pk2(a.x, a.y); o.y = pk2(a.z, a.w); o.z = pk2(b.x, b.y); o.w = pk2(b.z, b.w); ((u32x4*)dst)[i] = o; }
}

constexpr int EROW = 1536;
typedef unsigned u32x6 __attribute__((ext_vector_type(6)));
typedef float f32x16 __attribute__((ext_vector_type(16)));
typedef float f32x32 __attribute__((ext_vector_type(32)));
typedef unsigned u32x16 __attribute__((ext_vector_type(16)));
#ifndef FP6_ENC_INTERLEAVED
#define FP6_ENC_INTERLEAVED 1
#endif
__device__ __forceinline__ void expert_row_load(const float* src, f32x4 (&v)[8], int lane) {
    const f32x4* xr = (const f32x4*)src + lane;
#pragma unroll
    for (int k = 0; k < 8; ++k) v[k] = xr[64 * k];
}
__device__ __forceinline__ void expert_row_gain(f32x4 (&v)[8], const float* g, int lane) {
    const f32x4* gr = (const f32x4*)g + lane;
#pragma unroll
    for (int k = 0; k < 8; ++k) v[k] = v[k] * gr[64 * k];
}
__device__ __forceinline__ void expert_row_store(const f32x4 (&v)[8], unsigned char* dst, float* isc, int lane) {
    float am = 0.f;
#pragma unroll
    for (int k = 0; k < 8; ++k) am = fmaxf(am, fmaxf(fmaxf(fabsf(v[k].x), fabsf(v[k].y)), fmaxf(fabsf(v[k].z), fabsf(v[k].w))));
#pragma unroll
    for (int o = 1; o < 64; o <<= 1) am = fmaxf(am, __shfl_xor(am, o));
    float sc = 1.0f, inv = 1.0f;
    if (am > 0.f) { const float amc = fminf(fmaxf(am, 1.0e-30f), 1.0e30f); sc = 7.5f / amc; inv = amc * (1.0f / 7.5f); }
    f32x16 ea, eb;
#pragma unroll
    for (int j = 0; j < 16; ++j) {
#if FP6_ENC_INTERLEAVED
        const int ja = 2 * j, jb = 2 * j + 1;
#else
        const int ja = j, jb = 16 + j;
#endif
        ea[j] = v[ja >> 2][ja & 3] * sc; eb[j] = v[jb >> 2][jb & 3] * sc; }
    const u32x6 o = __builtin_amdgcn_cvt_scalef32_2xpk16_fp6_f32(ea, eb, 1.0f);
    u32x4 o0; o0.x = o[0]; o0.y = o[1]; o0.z = o[2]; o0.w = o[3]; u32x2 o1; o1.x = o[4]; o1.y = o[5];
    *(u32x4*)(dst + lane * 16) = o0; *(u32x2*)(dst + 1024 + lane * 8) = o1;
    if (lane == 0) *isc = inv;
}

__device__ __forceinline__ void p0_score_weights(const Args& a, int item, int lane) {
    const float* wq = a.in[13]; const float* g2 = a.in[12]; const float* keys = a.in[14]; bf16_t* M = (bf16_t*)(a.ws + WS_WQ);
    const int b = item >> 7, kt = item & 127, fr = lane & 15, fq = lane >> 4;
    const int k = kt * 16 + fr; const float gk = g2[k];
    bf16x8 wf[4];
#pragma unroll
    for (int ks = 0; ks < 4; ++ks) { const float* p = wq + (size_t)k * D + b * 128 + ks * 32 + fq * 8; const f32x4 x0 = *(const f32x4*)p, x1 = *(const f32x4*)(p + 4);
        u32x4 w; w.x = pk2(gk * x0.x, gk * x0.y); w.y = pk2(gk * x0.z, gk * x0.w); w.z = pk2(gk * x1.x, gk * x1.y); w.w = pk2(gk * x1.z, gk * x1.w); wf[ks] = __builtin_bit_cast(bf16x8, w); }
#pragma unroll 2
    for (int nb = 0; nb < 8; ++nb) {
        f32x4 acc = {0.f, 0.f, 0.f, 0.f};
#pragma unroll
        for (int ks = 0; ks < 4; ++ks) { const float* p = keys + (size_t)(b * 128 + nb * 16 + fr) * 128 + ks * 32 + fq * 8; const f32x4 x0 = *(const f32x4*)p, x1 = *(const f32x4*)(p + 4);
            u32x4 w; w.x = pk2(x0.x, x0.y); w.y = pk2(x0.z, x0.w); w.z = pk2(x1.x, x1.y); w.w = pk2(x1.z, x1.w);
            acc = __builtin_amdgcn_mfma_f32_16x16x32_bf16(wf[ks], __builtin_bit_cast(bf16x8, w), acc, 0, 0, 0); }
        u32x2 o; o.x = pk2(acc[0], acc[1]); o.y = pk2(acc[2], acc[3]);
        *(u32x2*)(M + (size_t)(b * 128 + nb * 16 + fr) * D + kt * 16 + fq * 4) = o;
    }
}

__device__ __forceinline__ void p0_prologue(const Args& a, LAS unsigned char* lds, int vcu, int G, int wave, int lane, int tid) {
    unsigned char* ws = a.ws;
    LAS float* scr = (LAS float*)(lds + wave * 16384);
    const int gw = vcu * NWAVES + wave, NGW = G * NWAVES;
    constexpr int I_IN = (D / 64) * (INW / 32), I_POOL1 = (256 / 64) * (512 / 32), I_G = (GWD / 64) * (D / 32), I_O = (D / 64) * (D / 32);
    constexpr int NITEMS = I_IN + 4 * I_POOL1 + I_G + I_O;
    for (int it = gw; it < NITEMS; it += NGW) {
        int r = it;
        if (r < I_IN) { p0_transpose_item(a.in[2], D, INW, (bf16_t*)(ws + WS_WIN), scr, r, lane, nullptr, ws + WS_W8, 3072, W8_SCALE); continue; } r -= I_IN;
        if (r < 4 * I_POOL1) { const int g = r / I_POOL1; p0_transpose_item(a.in[5] + (size_t)g * 256 * 512, 256, 512, (bf16_t*)(ws + WS_WPOOL) + (size_t)g * 512 * GWD, scr, r % I_POOL1, lane, nullptr, nullptr, 0, 1.0f, GWD); continue; } r -= 4 * I_POOL1;
        if (r < I_G) { p0_transpose_item(a.in[10], GWD, D, (bf16_t*)(ws + WS_WG), scr, r, lane); continue; } r -= I_G;
        p0_transpose_item(a.in[11], D, D, (bf16_t*)(ws + WS_WOUT), scr, r, lane);
    }
    for (int it = gw; it < 16 * (D / 16); it += NGW) p0_score_weights(a, it, lane);
    for (int m = gw; m < S; m += NGW) rms_row_to_bf16(a.in[0] + (size_t)m * D, a.in[1], (bf16_t*)(ws + WS_H) + (size_t)m * D, lane, ws + WS_H8 + (size_t)m * D, H8_SCALE);
    unsigned tq_ = (unsigned)tid; asm volatile("" : "+v"(tq_));
    const size_t gtid = (size_t)vcu * NTHR + tq_, nthr = (size_t)G * NTHR;
    {
        const float* src = a.in[8]; bf16_t* dst = (bf16_t*)(ws + WS_WSM);
        for (size_t i = gtid; i < (size_t)8 * 128 * 128 / 8; i += nthr) { const int s0 = (int)(i & 15) * 8, t = (int)(i >> 4) & 127;
            const f32x4 x0 = ((const f32x4*)src)[2 * i], x1 = ((const f32x4*)src)[2 * i + 1];
            float v[8] = {x0.x, x0.y, x0.z, x0.w, x1.x, x1.y, x1.z, x1.w};
#pragma unroll
            for (int j = 0; j < 8; ++j) v[j] = (s0 + j <= t) ? v[j] : 0.f;
            u32x4 o; o.x = pk2(v[0], v[1]); o.y = pk2(v[2], v[3]); o.z = pk2(v[4], v[5]); o.w = pk2(v[6], v[7]); ((u32x4*)dst)[i] = o; }
    }
}

__device__ __forceinline__ void p2_pool(const Args& a, int vcu, int G, int tid) {
    const bf16_t* Z = (const bf16_t*)(a.ws + WS_Z); bf16_t* A2 = (bf16_t*)(a.ws + WS_A2); const float* psc = a.in[4];
    unsigned tq_ = (unsigned)tid; asm volatile("" : "+v"(tq_));
    const size_t gtid = (size_t)vcu * NTHR + tq_, nthr = (size_t)G * NTHR;
    for (size_t id = gtid; id < (size_t)(S / 8) * 128; id += nthr) {
        const int c8 = (int)(id & 127), t0 = (int)(id >> 7) * 8, g = c8 >> 5, w = 2 << g;
        u32x4 row[23];
#pragma unroll
        for (int r = 0; r < 23; ++r) { const int t = t0 - 15 + r; const bool need = (r >= 16 - w) && (t >= 0);
            row[r] = need ? *(const u32x4*)(Z + (size_t)t * INW + c8 * 8) : (u32x4){0u, 0u, 0u, 0u}; }
        const f32x4 p0 = *(const f32x4*)(psc + c8 * 8), p1 = *(const f32x4*)(psc + c8 * 8 + 4);
        const float ps[8] = {p0.x, p0.y, p0.z, p0.w, p1.x, p1.y, p1.z, p1.w};
        float s[8] = {0.f, 0.f, 0.f, 0.f, 0.f, 0.f, 0.f, 0.f};
#pragma unroll
        for (int r = 0; r < 15; ++r) { const u32x4 q = row[r];
            s[0] += bflo(q.x); s[1] += bfhi(q.x); s[2] += bflo(q.y); s[3] += bfhi(q.y); s[4] += bflo(q.z); s[5] += bfhi(q.z); s[6] += bflo(q.w); s[7] += bfhi(q.w); }
#pragma unroll
        for (int i = 0; i < 8; ++i) {
            const u32x4 q = row[15 + i];
            const float at[8] = {bflo(q.x), bfhi(q.x), bflo(q.y), bfhi(q.y), bflo(q.z), bfhi(q.z), bflo(q.w), bfhi(q.w)};
#pragma unroll
            for (int c = 0; c < 8; ++c) s[c] += at[c];
            const int t = t0 + i; const int cnt = (t + 1) < w ? (t + 1) : w; const float inv = 1.0f / (float)cnt;
            float o[8];
#pragma unroll
            for (int c = 0; c < 8; ++c) o[c] = (s[c] * inv - at[c]) * ps[c];
            u32x4 w4; w4.x = pk2(o[0], o[1]); w4.y = pk2(o[2], o[3]); w4.z = pk2(o[4], o[5]); w4.w = pk2(o[6], o[7]);
            *(u32x4*)(A2 + (size_t)t * D + c8 * 8) = w4;
            const u32x4 d2 = row[15 + i - 1], d4 = row[15 + i - 3], d8 = row[15 + i - 7], d16 = row[15 + i - 15];
            const u32x4 dq = g == 0 ? d2 : (g == 1 ? d4 : (g == 2 ? d8 : d16));
            s[0] -= bflo(dq.x); s[1] -= bfhi(dq.x); s[2] -= bflo(dq.y); s[3] -= bfhi(dq.y); s[4] -= bflo(dq.z); s[5] -= bfhi(dq.z); s[6] -= bflo(dq.w); s[7] -= bfhi(dq.w);
        }
    }
}
constexpr int VT_LD = 136;
__device__ __forceinline__ void p2_sgu(const Args& a, LAS unsigned char* lds, int item0, int item1, int istep, int wave, int lane, int tid) {
    const bf16_t* Z = (const bf16_t*)(a.ws + WS_Z); bf16_t* A2 = (bf16_t*)(a.ws + WS_A2); const bf16_t* WSM = (const bf16_t*)(a.ws + WS_WSM);
    const float* lng = a.in[6]; const float* lnb = a.in[7]; const float* bs = a.in[9];
    LAS float* st = (LAS float*)lds; LAS bf16_t* Vt = (LAS bf16_t*)(lds + 1024);
    const int fr = lane & 15, fq = lane >> 4;
    int prev_c = -1;
    for (int item = item0; item < item1; item += istep) {
        const int c = item >> 3, h = item & 7, t0 = c * 128; const bool need_stats = (c != prev_c); prev_c = c;
        u32x4 raw[4][8];
        if (need_stats) {
#pragma unroll
        for (int p = 0; p < 4; ++p) { const bf16_t* rp = Z + (size_t)(t0 + wave * 16 + p * 4 + fq) * INW + 2048 + fr * 8;
#pragma unroll
            for (int j = 0; j < 8; ++j) raw[p][j] = *(const u32x4*)(rp + j * 128); } }
        u32x4 rawB[4];
#pragma unroll
        for (int q = 0; q < 4; ++q) { const int id = tid + q * NTHR, sr = id & 127, dc = id >> 7; rawB[q] = *(const u32x4*)(Z + (size_t)(t0 + sr) * INW + 2048 + h * 128 + dc * 8); }
        bf16x8 bW[4];
#pragma unroll
        for (int ks = 0; ks < 4; ++ks) bW[ks] = *(const bf16x8*)(WSM + (size_t)(h * 128 + wave * 16 + fr) * 128 + ks * 32 + fq * 8);
        u32x2 ur[8];
#pragma unroll
        for (int db = 0; db < 8; ++db) ur[db] = *(const u32x2*)(Z + (size_t)(t0 + wave * 16 + fr) * INW + 1024 + h * 128 + db * 16 + fq * 4);
        const float bias = bs[h * 128 + wave * 16 + fr];
        if (need_stats) {
#pragma unroll
        for (int p = 0; p < 4; ++p) { float s = 0.f, q = 0.f;
#pragma unroll
            for (int j = 0; j < 8; ++j)
#pragma unroll
                for (int w = 0; w < 4; ++w) { const float a0 = bflo(raw[p][j][w]), a1 = bfhi(raw[p][j][w]); s += a0 + a1; q += a0 * a0 + a1 * a1; }
            s = row_sum_f32(s); q = row_sum_f32(q);
            if (fr == 0) { const float mean = s * (1.0f / 1024.0f); const float var = fmaxf(q * (1.0f / 1024.0f) - mean * mean, 0.f);
                const int sr = wave * 16 + p * 4 + fq; st[2 * sr] = mean; st[2 * sr + 1] = 1.0f / sqrtf(var + EPS); } }
        __syncthreads();
        }
#pragma unroll
        for (int q = 0; q < 4; ++q) { const int id = tid + q * NTHR, sr = id & 127, dc = id >> 7;
            const u32x4 rw = rawB[q];
            const float mean = st[2 * sr], rstd = st[2 * sr + 1];
            const float v[8] = {bflo(rw.x), bfhi(rw.x), bflo(rw.y), bfhi(rw.y), bflo(rw.z), bfhi(rw.z), bflo(rw.w), bfhi(rw.w)};
            const f32x4 g0 = *(const f32x4*)(lng + h * 128 + dc * 8), g1 = *(const f32x4*)(lng + h * 128 + dc * 8 + 4), b0 = *(const f32x4*)(lnb + h * 128 + dc * 8), b1 = *(const f32x4*)(lnb + h * 128 + dc * 8 + 4);
            const float gg[8] = {g0.x, g0.y, g0.z, g0.w, g1.x, g1.y, g1.z, g1.w}, bb[8] = {b0.x, b0.y, b0.z, b0.w, b1.x, b1.y, b1.z, b1.w};
#pragma unroll
            for (int i = 0; i < 8; ++i) { const int d = dc * 8 + i; const float y = (v[i] - mean) * rstd * gg[i] + bb[i]; Vt[d * VT_LD + sr] = (bf16_t)f2bf(y); } }
        __syncthreads();
        f32x4 acc[8];
#pragma unroll
        for (int db = 0; db < 8; ++db) acc[db] = (f32x4){0.f, 0.f, 0.f, 0.f};
        const int nks = (wave * 16 + 15) / 32 + 1;
#pragma unroll
        for (int ks = 0; ks < 4; ++ks) if (ks < nks) {
#pragma unroll
            for (int db = 0; db < 8; ++db) { const bf16x8 aV = *(const LAS bf16x8*)(Vt + (db * 16 + fr) * VT_LD + ks * 32 + fq * 8);
                acc[db] = __builtin_amdgcn_mfma_f32_16x16x32_bf16(aV, bW[ks], acc[db], 0, 0, 0); }
        }
        { const int t = t0 + wave * 16 + fr;
#pragma unroll
          for (int db = 0; db < 8; ++db) { const int col = h * 128 + db * 16 + fq * 4;
              u32x2 o; o.x = pk2(bflo(ur[db].x) * (acc[db][0] + bias), bfhi(ur[db].x) * (acc[db][1] + bias)); o.y = pk2(bflo(ur[db].y) * (acc[db][2] + bias), bfhi(ur[db].y) * (acc[db][3] + bias));
              *(u32x2*)(A2 + (size_t)t * D + 1024 + col) = o; } }
        __syncthreads();
    }
}

__device__ __forceinline__ unsigned f2key(float f) { const unsigned b = __builtin_bit_cast(unsigned, f); return (b & 0x80000000u) ? ~b : (b | 0x80000000u); }
__device__ __forceinline__ float key2f(unsigned k) { const unsigned b = (k & 0x80000000u) ? (k ^ 0x80000000u) : ~k; return __builtin_bit_cast(float, b); }
template <int CTRL> __device__ __forceinline__ unsigned dpp_max_u32(unsigned v) { const unsigned o = (unsigned)__builtin_amdgcn_update_dpp(0, (int)v, CTRL, 0xF, 0xF, true); return v > o ? v : o; }
__device__ __forceinline__ unsigned row_max_u32(unsigned v) { v = dpp_max_u32<0xB1>(v); v = dpp_max_u32<0x4E>(v); v = dpp_max_u32<0x141>(v); v = dpp_max_u32<0x140>(v); return v; }
__device__ __forceinline__ void ce_desc(unsigned& a, unsigned& b) { const unsigned hi = a > b ? a : b, lo = a > b ? b : a; a = hi; b = lo; }
__device__ __forceinline__ void sort8_desc(unsigned (&k)[8]) {
    ce_desc(k[0], k[1]); ce_desc(k[2], k[3]); ce_desc(k[4], k[5]); ce_desc(k[6], k[7]);
    ce_desc(k[0], k[2]); ce_desc(k[1], k[3]); ce_desc(k[4], k[6]); ce_desc(k[5], k[7]);
    ce_desc(k[1], k[2]); ce_desc(k[5], k[6]);
    ce_desc(k[0], k[4]); ce_desc(k[1], k[5]); ce_desc(k[2], k[6]); ce_desc(k[3], k[7]);
    ce_desc(k[2], k[4]); ce_desc(k[3], k[5]);
    ce_desc(k[1], k[2]); ce_desc(k[3], k[4]); ce_desc(k[5], k[6]);
}
__device__ __forceinline__ void sort4_desc(unsigned (&k)[4]) { ce_desc(k[0], k[1]); ce_desc(k[2], k[3]); ce_desc(k[0], k[2]); ce_desc(k[1], k[3]); ce_desc(k[1], k[2]); }
template <int NV> __device__ __forceinline__ unsigned row_top16_sorted(unsigned (&k)[NV], int fr) {
    unsigned tk = 0u;
    for (int it = 0; it < 16; ++it) {
        const unsigned m = row_max_u32(k[0]);
        const unsigned wm = (k[0] == m) ? 0xffffffffu : 0u;
#pragma unroll
        for (int i = 0; i + 1 < NV; ++i) k[i] = (k[i + 1] & wm) | (k[i] & ~wm);
        k[NV - 1] = k[NV - 1] & ~wm;
        tk = (fr == it) ? m : tk;
    }
    return tk;
}
__device__ __forceinline__ unsigned cand_table(int fr) {
    constexpr unsigned T[16] = {0x03020100u, 0x07060504u, 0x0b0a0908u, 0x0f0e0d0cu, 0x13121110u, 0x17161514u, 0x23222120u, 0x32313024u, 0x42414033u, 0x61605150u, 0x90807170u, 0xd0c0b0a0u, 0xfffff0e0u, 0xffffffffu, 0xffffffffu, 0xffffffffu};
    unsigned w = T[0];
#pragma unroll
    for (int i = 1; i < 16; ++i) w = (fr == i) ? T[i] : w;
    return w;
}
constexpr int SC_LD = 132;
__device__ __forceinline__ void p7_topk(const Args& a, LAS unsigned char* lds, int vcu, int G, int wave, int lane_) {
    int lane = lane_; asm volatile("" : "+v"(lane));
    const bf16_t* Q = (const bf16_t*)(a.ws + WS_Q);
    int* IDX = (int*)(a.ws + WS_IDX); float* GATE = (float*)(a.ws + WS_GATE);
    LAS float* SL = (LAS float*)(lds + wave * (16 * SC_LD * 4));
    const int gw = vcu * NWAVES + wave, NGW = G * NWAVES; const int fr = lane & 15, fq = lane >> 4;
    const unsigned ctab = cand_table(fr);
    int erow = gw;
    f32x4 er0[8], er1[8]; int e0 = 2 * NEXP, e1 = 2 * NEXP;
#define ER_LOAD() do { e0 = erow; e1 = erow + NGW; erow += 2 * NGW; \
        if (e0 < 2 * NEXP) expert_row_load(a.in[15 + (e0 >= NEXP)] + (size_t)(e0 & (NEXP - 1)) * D, er0, lane); \
        if (e1 < 2 * NEXP) expert_row_load(a.in[15 + (e1 >= NEXP)] + (size_t)(e1 & (NEXP - 1)) * D, er1, lane); } while (0)
#define ER_STORE() do { \
        if (e0 < NEXP) expert_row_gain(er0, a.in[12], lane); if (e1 < NEXP) expert_row_gain(er1, a.in[12], lane); \
        if (e0 < 2 * NEXP) expert_row_store(er0, a.ws + ((e0 >= NEXP) ? WS_EV : WS_EU) + (size_t)(e0 & (NEXP - 1)) * EROW, (float*)(a.ws + WS_ESC) + e0, lane); \
        if (e1 < 2 * NEXP) expert_row_store(er1, a.ws + ((e1 >= NEXP) ? WS_EV : WS_EU) + (size_t)(e1 & (NEXP - 1)) * EROW, (float*)(a.ws + WS_ESC) + e1, lane); } while (0)
    pg8::StaticOrder so7; so7.init(S, D, G, (int)blockIdx.x); pg8::Unit u7;
    for (int ui = 0; so7.next(ui >> 1, u7); ++ui) {
        const int h = u7.pn, t0 = u7.pm * 256 + ((ui & 1) * 8 + wave) * 16;
        unsigned tk[8];
#pragma unroll
        for (int i = 0; i < 8; ++i) tk[i] = 0u;
#pragma unroll 1
        for (int p = 0; p < 2; ++p) {
            {
                u32x4 sc[4];
#pragma unroll
                for (int i = 0; i < 4; ++i) sc[i] = *(const u32x4*)(Q + (size_t)(t0 + i * 4 + fq) * D + h * 256 + p * 128 + fr * 8);
#pragma unroll
                for (int i = 0; i < 4; ++i) { LAS float* d = SL + (i * 4 + fq) * SC_LD + fr * 8;
                    *(LAS f32x4*)d = (f32x4){bflo(sc[i].x), bfhi(sc[i].x), bflo(sc[i].y), bfhi(sc[i].y)}; *(LAS f32x4*)(d + 4) = (f32x4){bflo(sc[i].z), bfhi(sc[i].z), bflo(sc[i].w), bfhi(sc[i].w)}; }
                asm volatile("" ::: "memory");
            }
            ER_LOAD();
#pragma unroll 1
            for (int j = 0; j < 4; ++j) {
                unsigned k[8];
#pragma unroll
                for (int nb = 0; nb < 8; ++nb) k[nb] = (f2key(SL[(fq * 4 + j) * SC_LD + nb * 16 + fr]) & ~127u) | (127u - (unsigned)(nb * 16 + fr));
                sort8_desc(k);
                const unsigned r = row_top16_sorted<8>(k, fr);
#pragma unroll
                for (int i = 0; i < 8; ++i) tk[i] = (i == p * 4 + j) ? r : tk[i];
            }
            ER_STORE();
        }
#pragma unroll 1
        for (int j = 0; j < 4; ++j) {
            if ((j & 1) == 0) ER_LOAD();
            const unsigned tk1 = j == 0 ? tk[0] : (j == 1 ? tk[1] : (j == 2 ? tk[2] : tk[3])), tk2 = j == 0 ? tk[4] : (j == 1 ? tk[5] : (j == 2 ? tk[6] : tk[7]));
            const float t1 = key2f(tk1 & ~127u), t2 = key2f(tk2 & ~127u); const int i1 = 127 - (int)(tk1 & 127u), i2 = 127 - (int)(tk2 & 127u);
            unsigned kc[4];
#pragma unroll
            for (int e = 0; e < 4; ++e) { const unsigned ab = (ctab >> (8 * e)) & 255u; const int ca = (int)(ab >> 4), cb = (int)(ab & 15u);
                const float c = __shfl(t1, (lane & 48) + ca) + __shfl(t2, (lane & 48) + cb);
                kc[e] = (ab == 255u) ? 0u : ((f2key(c) & ~255u) | (255u - ab)); }
            sort4_desc(kc);
            const unsigned tkc = row_top16_sorted<4>(kc, fr);
            const float ts = key2f(tkc & ~255u); const int ci = 255 - (int)(tkc & 255u);
            const int ia = __shfl(i1, (lane & 48) + (ci >> 4)), ib = __shfl(i2, (lane & 48) + (ci & 15));
            const float tmax = __shfl(ts, lane & 48);
            const float e = __expf(ts - tmax); float sum = e;
            sum += __shfl_xor(sum, 1); sum += __shfl_xor(sum, 2); sum += __shfl_xor(sum, 4); sum += __shfl_xor(sum, 8);
            const int t = t0 + fq * 4 + j;
            IDX[(size_t)t * 128 + h * 16 + fr] = ia * 128 + ib;
            GATE[(size_t)t * 128 + h * 16 + fr] = e / sum;
            if ((j & 1) == 1) ER_STORE();
        }
    }
    for (; erow < 2 * NEXP; erow += NGW) { expert_row_load(a.in[15 + (erow >= NEXP)] + (size_t)(erow & (NEXP - 1)) * D, er0, lane); if (erow < NEXP) expert_row_gain(er0, a.in[12], lane);
        expert_row_store(er0, a.ws + ((erow >= NEXP) ? WS_EV : WS_EU) + (size_t)(erow & (NEXP - 1)) * EROW, (float*)(a.ws + WS_ESC) + erow, lane); }
#undef ER_LOAD
#undef ER_STORE
}

typedef float f32x2 __attribute__((ext_vector_type(2)));
__device__ __forceinline__ u32x4 bl128(__amdgpu_buffer_rsrc_t r, unsigned voff, unsigned soff) { return __builtin_amdgcn_raw_buffer_load_b128(r, voff, soff, 0); }
__device__ __forceinline__ u32x2 bl64(__amdgpu_buffer_rsrc_t r, unsigned voff, unsigned soff) { return __builtin_amdgcn_raw_buffer_load_b64(r, voff, soff, 0); }
__device__ __forceinline__ unsigned bl32(__amdgpu_buffer_rsrc_t r, unsigned voff, unsigned soff) { return __builtin_amdgcn_raw_buffer_load_b32(r, voff, soff, 0); }
__device__ __forceinline__ float wave_sum_dpp(float v) {
    v = dpp_add_f32<0xB1>(v); v = dpp_add_f32<0x4E>(v); v = dpp_add_f32<0x141>(v); v = dpp_add_f32<0x140>(v);
    v += __builtin_bit_cast(float, __builtin_amdgcn_update_dpp(0, __builtin_bit_cast(int, v), 0x142, 0xA, 0xF, false));
    v += __builtin_bit_cast(float, __builtin_amdgcn_update_dpp(0, __builtin_bit_cast(int, v), 0x143, 0xC, 0xF, false));
    return __builtin_bit_cast(float, __builtin_amdgcn_readlane(__builtin_bit_cast(int, v), 63));
}
__device__ __forceinline__ float wave_sum_fast(float v) {
    v = dpp_add_f32<0xB1>(v); v = dpp_add_f32<0x4E>(v); v = dpp_add_f32<0x141>(v); v = dpp_add_f32<0x140>(v);
    v += __shfl_xor(v, 16); v += __shfl_xor(v, 32); return v;
}
constexpr int TPW = 4, NSL = 8, SL_SHIFT = 11, RING = 10, SLOT = 1536;
#define P8_VMW 18
typedef __bf16 bf16x2_t __attribute__((ext_vector_type(2)));
__device__ __forceinline__ float dot2bf(unsigned a, unsigned b, float c) { return __builtin_amdgcn_fdot2_f32_bf16(__builtin_bit_cast(bf16x2_t, a), __builtin_bit_cast(bf16x2_t, b), c, false); }
constexpr int NROWS = TPW * 128;
#define P8_ISSUE(TBASE) do { const unsigned ro_ = (unsigned)__builtin_amdgcn_readlane(lch_, ii_ & 63) * (unsigned)EROW; \
        const char* sb_ = (const char*)a.ws + (TBASE) + ro_; const char* sb2_ = sb_ + 1024; const unsigned dl_ = ring_lo + (unsigned)is_ * SLOT; \
        asm volatile("s_mov_b32 m0, %3\n\ts_nop 0\n\tglobal_load_lds_dwordx4 %0, %1\n\ts_mov_b32 m0, %4\n\ts_mov_b64 exec, %5\n\tglobal_load_lds_dwordx4 %0, %2\n\ts_mov_b64 exec, -1" \
                     :: "v"(l16), "s"(sb_), "s"(sb2_), "s"(dl_), "s"(dl_ + 1024u), "s"(half_) : "memory"); \
        is_ = (is_ == RING - 1) ? 0 : is_ + 1; \
        ++ii_; if ((ii_ & 63) == 0) lch_ = (int)LST[ii_ + lane]; } while (0)
#define P8_RING_READ(r0, r1) do { r0 = *(const LAS u32x4*)(ring + cs_ * SLOT + l16); r1 = *(const LAS u32x2*)(ring + cs_ * SLOT + 1024 + l8); } while (0)
#define P8_DECODE(r0, r1) __builtin_amdgcn_cvt_scalef32_pk32_f32_fp6((u32x6){r0.x, r0.y, r0.z, r0.w, r1.x, r1.y}, 1.0f)
#define P8_STREAM_INIT(TBASE, r0, r1) int cs_ = 0, is_ = 0, ii_ = 0; int lch_ = (int)LST[lane]; \
        asm volatile("s_waitcnt vmcnt(0) lgkmcnt(0)" ::: "memory"); \
        _Pragma("unroll 1") for (int q_ = 0; q_ < RING; ++q_) P8_ISSUE(TBASE); \
        P8_WAIT_OLDEST(); P8_RING_READ(r0, r1)
#define P8_ROW_READY() asm volatile("s_waitcnt lgkmcnt(0)" ::: "memory")
#define P8_ROW_ADVANCE(TBASE, r0, r1) do { cs_ = (cs_ == RING - 1) ? 0 : cs_ + 1; P8_ISSUE(TBASE); P8_WAIT_OLDEST(); P8_RING_READ(r0, r1); } while (0)
#define P8_STREAM_END() asm volatile("s_waitcnt vmcnt(0) lgkmcnt(0)" ::: "memory")
#define P8_STR2(x) #x
#define P8_STR(x) P8_STR2(x)
#define P8_WAIT_OLDEST() asm volatile("s_waitcnt vmcnt(" P8_STR(P8_VMW) ")" ::: "memory")
static_assert(P8_VMW == 2 * (RING - 1) && RING * SLOT <= 16384, "the counted wait is vmcnt(2 * (RING - 1)); the ring is 16 KiB per wave");
__device__ __forceinline__ void p8_peer(const Args& a, LAS unsigned char* lds, float* dst, int vcu, int G, int wave, int lane_) {
    int lane = lane_; asm volatile("" : "+v"(lane));
    const __amdgpu_buffer_rsrc_t rws = __builtin_amdgcn_make_buffer_rsrc((void*)a.ws, (short)0, (int)WS_END, 0x00020000);
    const __amdgpu_buffer_rsrc_t rdst = __builtin_amdgcn_make_buffer_rsrc((void*)dst, (short)0, S * D * 4, 0x00020000);
    const __amdgpu_buffer_rsrc_t rfg = __builtin_amdgcn_make_buffer_rsrc((void*)a.in[17], (short)0, D * 4, 0x00020000);
    LAS unsigned char* ring = lds + wave * 16384;
    LAS unsigned* SLW = (LAS unsigned*)(lds + 132096 + wave * 1280);
    LAS unsigned short* LST = (LAS unsigned short*)SLW;
    const int gw = vcu * NWAVES + wave, NGW = G * NWAVES;
    const unsigned l16 = (unsigned)lane * 16u, l8 = (unsigned)lane * 8u, l4 = (unsigned)lane * 4u;
    const unsigned long long half_ = 0xffffffffull;
    const unsigned ring_lo = (unsigned)(size_t)(lds + wave * 16384);
#pragma unroll 1
    for (int tb = gw; tb < S; tb += TPW * NGW) {
        int sid[TPW][2], offv[TPW]; float act[TPW][2]; int cntv = 0;
#pragma unroll
        for (int k = 0; k < TPW; ++k) {
            const int t = (tb + k * NGW) < S ? (tb + k * NGW) : (S - 1);
            const unsigned oi = (unsigned)(WS_IDX + (size_t)t * 512);
            const int id0 = (int)bl32(rws, l4, oi), id1 = (int)bl32(rws, l4 + 256u, oi);
            const int sl0 = id0 >> SL_SHIFT, sl1 = id1 >> SL_SHIFT;
            int pos0 = 0, pos1 = 0, basec = 0, offacc = 0;
#pragma unroll
            for (int s = 0; s < NSL; ++s) {
                const unsigned long long m0 = __ballot(sl0 == s), m1 = __ballot(sl1 == s);
                const int c0 = __popcll(m0), c1 = __popcll(m1);
                const int b0 = (int)__builtin_amdgcn_mbcnt_hi((unsigned)(m0 >> 32), __builtin_amdgcn_mbcnt_lo((unsigned)m0, 0u));
                const int b1 = (int)__builtin_amdgcn_mbcnt_hi((unsigned)(m1 >> 32), __builtin_amdgcn_mbcnt_lo((unsigned)m1, 0u));
                pos0 = (sl0 == s) ? basec + b0 : pos0; pos1 = (sl1 == s) ? basec + c0 + b1 : pos1;
                basec += c0 + c1; offacc = (lane == s + 1) ? basec : offacc; cntv = (lane == s * TPW + k) ? (c0 + c1) : cntv;
            }
            offv[k] = offacc;
            SLW[pos0] = (unsigned)id0; SLW[pos1] = (unsigned)id1; SLW[128 + pos0] = (unsigned)lane; SLW[128 + pos1] = (unsigned)(64 + lane);
            asm volatile("s_waitcnt lgkmcnt(0)" ::: "memory");
            sid[k][0] = (int)SLW[lane]; sid[k][1] = (int)SLW[64 + lane];
            act[k][0] = __builtin_bit_cast(float, SLW[128 + lane]); act[k][1] = __builtin_bit_cast(float, SLW[192 + lane]);
            asm volatile("s_waitcnt lgkmcnt(0)" ::: "memory");
        }
        {
            int incl = cntv;
#pragma unroll
            for (int o = 1; o < 64; o <<= 1) { const int up = __shfl_up(incl, o); incl += (lane >= o) ? up : 0; }
            const int gb = incl - cntv;
            asm volatile("s_waitcnt lgkmcnt(0)" ::: "memory");
#pragma unroll
            for (int k = 0; k < TPW; ++k)
#pragma unroll
                for (int h = 0; h < 2; ++h) { const int sl = sid[k][h] >> SL_SHIFT;
                    const int p = __shfl(gb, sl * TPW + k) + (h * 64 + lane) - __shfl(offv[k], sl);
                    LST[p] = (unsigned short)sid[k][h]; }
            if (lane < RING) LST[NROWS + lane] = (unsigned short)0;
            asm volatile("s_waitcnt lgkmcnt(0)" ::: "memory");
        }
        int orig[TPW][2];
#pragma unroll
        for (int k = 0; k < TPW; ++k) { orig[k][0] = __builtin_bit_cast(int, act[k][0]); orig[k][1] = __builtin_bit_cast(int, act[k][1]); act[k][0] = 0.f; act[k][1] = 0.f; }
        {
            u32x2 hb[TPW][8];
#pragma unroll
            for (int k = 0; k < TPW; ++k) { const int t = (tb + k * NGW) < S ? (tb + k * NGW) : (S - 1);
#pragma unroll
                for (int kk = 0; kk < 8; ++kk) hb[k][kk] = bl64(rws, l8 + (unsigned)(kk * 512), (unsigned)(WS_XB + (size_t)t * (D * 2))); }
#pragma unroll
            for (int k = 0; k < TPW; ++k)
#pragma unroll
                for (int kk = 0; kk < 8; ++kk) asm volatile("" : "+v"(hb[k][kk]));
            float wd[4];
#pragma unroll
            for (int j = 0; j < 4; ++j) wd[j] = ((((lane & 15) >> 2) == (lane >> 4)) && ((lane & 3) == j)) ? 1.0f : 0.0f;
            u32x4 r0; u32x2 r1;
            P8_STREAM_INIT(WS_EU, r0, r1);
#pragma unroll 1
            for (int s = 0; s < NSL; ++s) {
#pragma unroll
                for (int k = 0; k < TPW; ++k) {
                    const int lo = __builtin_amdgcn_readlane(offv[k], s), hi = __builtin_amdgcn_readlane(offv[k], s + 1);
#pragma unroll 1
                    for (int e = lo; e < hi; ++e) {
                        P8_ROW_READY();
                        u32x16 fb = __builtin_bit_cast(u32x16, __builtin_amdgcn_cvt_scalef32_pk32_bf16_fp6((u32x6){r0.x, r0.y, r0.z, r0.w, r1.x, r1.y}, 1.0f));
                        asm volatile("" : "+v"(fb));
                        P8_ROW_ADVANCE(WS_EU, r0, r1);
                        float tr;
                        { f32x4 dg0 = {0.f, 0.f, 0.f, 0.f}, dg1 = {0.f, 0.f, 0.f, 0.f};
#pragma unroll
                          for (int c = 0; c < 4; ++c) { const u32x4 av = {fb[4 * c], fb[4 * c + 1], fb[4 * c + 2], fb[4 * c + 3]};
                              const u32x4 bv = {hb[k][2 * c].x, hb[k][2 * c].y, hb[k][2 * c + 1].x, hb[k][2 * c + 1].y};
                              if (c & 1) dg1 = __builtin_amdgcn_mfma_f32_16x16x32_bf16(__builtin_bit_cast(bf16x8, av), __builtin_bit_cast(bf16x8, bv), dg1, 0, 0, 0);
                              else       dg0 = __builtin_amdgcn_mfma_f32_16x16x32_bf16(__builtin_bit_cast(bf16x8, av), __builtin_bit_cast(bf16x8, bv), dg0, 0, 0, 0); }
                          const f32x4 dg = dg0 + dg1;
                          tr = (dg[0] * wd[0] + dg[1] * wd[1]) + (dg[2] * wd[2] + dg[3] * wd[3]); }
                        const float d = wave_sum_dpp(tr);
                        act[k][0] = (lane == e) ? d : act[k][0]; act[k][1] = (lane == e - 64) ? d : act[k][1];
                    }
                }
            }
            P8_STREAM_END();
        }
#pragma unroll
        for (int k = 0; k < TPW; ++k) {
            const int t = (tb + k * NGW) < S ? (tb + k * NGW) : (S - 1);
            const float ssp = lane < 32 ? __builtin_bit_cast(float, bl32(rws, l4, (unsigned)(WS_SS + (size_t)t * 128))) : 0.f;
            const float rstd2 = 1.0f / sqrtf(wave_sum(ssp) * (1.0f / D) + EPS);
            const unsigned og = (unsigned)(WS_GATE + (size_t)t * 512);
#pragma unroll
            for (int h = 0; h < 2; ++h) {
                const float gate = __builtin_bit_cast(float, bl32(rws, (unsigned)orig[k][h] * 4u, og));
                const float su = __builtin_bit_cast(float, bl32(rws, (unsigned)sid[k][h] * 4u, (unsigned)WS_ESC)) * rstd2;
                const float sv = __builtin_bit_cast(float, bl32(rws, (unsigned)sid[k][h] * 4u, (unsigned)(WS_ESC + NEXP * 4)));
                act[k][h] = gelu_tanh(act[k][h] * su) * gate * sv; }
        }
        {
            float acc[TPW][32];
#pragma unroll
            for (int k = 0; k < TPW; ++k)
#pragma unroll
                for (int i = 0; i < 32; ++i) acc[k][i] = 0.f;
            u32x4 r0; u32x2 r1;
            P8_STREAM_INIT(WS_EV, r0, r1);
#pragma unroll 1
            for (int s = 0; s < NSL; ++s) {
#pragma unroll
                for (int k = 0; k < TPW; ++k) {
                    const int lo = __builtin_amdgcn_readlane(offv[k], s), hi = __builtin_amdgcn_readlane(offv[k], s + 1);
#pragma unroll 1
                    for (int e = lo; e < hi; ++e) {
                        const int a0_ = __builtin_amdgcn_readlane(__builtin_bit_cast(int, act[k][0]), e & 63), a1_ = __builtin_amdgcn_readlane(__builtin_bit_cast(int, act[k][1]), e & 63);
                        const float aw = __builtin_bit_cast(float, e < 64 ? a0_ : a1_);
                        P8_ROW_READY();
                        { f32x32 f = P8_DECODE(r0, r1);
                          asm volatile("" : "+v"(f));
                          P8_ROW_ADVANCE(WS_EV, r0, r1);
#pragma unroll
                          for (int j = 0; j < 32; ++j) acc[k][j] += aw * f[j]; }
                    }
                }
            }
            P8_STREAM_END();
#pragma unroll
            for (int k = 0; k < TPW; ++k) { const int t = tb + k * NGW;
                if (t < S) {
                    float ss = 0.f; const unsigned ot = (unsigned)t * (unsigned)(D * 4);
#pragma unroll
                    for (int kk = 0; kk < 8; ++kk) { const u32x2 xw = bl64(rws, l8 + (unsigned)(kk * 512), (unsigned)(WS_XB + (size_t)t * (D * 2)));
                        acc[k][kk * 4 + 0] += bflo(xw.x); acc[k][kk * 4 + 1] += bfhi(xw.x); acc[k][kk * 4 + 2] += bflo(xw.y); acc[k][kk * 4 + 3] += bfhi(xw.y);
                        ss += (acc[k][kk * 4 + 0] * acc[k][kk * 4 + 0] + acc[k][kk * 4 + 1] * acc[k][kk * 4 + 1]) + (acc[k][kk * 4 + 2] * acc[k][kk * 4 + 2] + acc[k][kk * 4 + 3] * acc[k][kk * 4 + 3]); }
                    const float rstd = 1.0f / sqrtf(wave_sum(ss) * (1.0f / D) + EPS);
#pragma unroll
                    for (int kk = 0; kk < 8; ++kk) { const f32x4 f0 = __builtin_bit_cast(f32x4, bl128(rfg, l16 + (unsigned)((kk & 3) * 1024), (unsigned)((kk >> 2) * 4096)));
                        f32x4 o0; o0.x = acc[k][kk * 4 + 0] * rstd * f0.x; o0.y = acc[k][kk * 4 + 1] * rstd * f0.y; o0.z = acc[k][kk * 4 + 2] * rstd * f0.z; o0.w = acc[k][kk * 4 + 3] * rstd * f0.w;
                        __builtin_amdgcn_raw_buffer_store_b128(__builtin_bit_cast(u32x4, o0), rdst, l16 + (unsigned)((kk & 3) * 1024), ot + (unsigned)((kk >> 2) * 4096), 0); }
                }
            }
        }
    }
}

#define XB_TMO      128
#define XB_XCNT(j)  (256  + 64 * (j))
#define XB_XSUB(j)  (1280 + 64 * (j))
#define XB_XGEN(j)  (2304 + 64 * (j))
#define XB_TOP      3328
#define XB_TOPGEN   3392
#define XCD_BAR_WORDS 3456
#define XB_SPIN_CAP (1u << 22)
__device__ __forceinline__ unsigned xb_ld(unsigned* p)              { return __hip_atomic_load(p, __ATOMIC_RELAXED, __HIP_MEMORY_SCOPE_AGENT); }
__device__ __forceinline__ unsigned xb_add(unsigned* p, unsigned v) { return __hip_atomic_fetch_add(p, v, __ATOMIC_RELAXED, __HIP_MEMORY_SCOPE_AGENT); }
__device__ __forceinline__ unsigned xb_xcc_id() { return (unsigned)__builtin_amdgcn_s_getreg((3 << 11) | 20) & 0xFu; }
#define XB_SPIN(cond, bar) do { unsigned _sp = 0; while (cond) { __builtin_amdgcn_s_sleep(1); \
    if ((++_sp & 255u) == 0u) { if (xb_ld(&(bar)[XB_TMO])) break; if (_sp > XB_SPIN_CAP) { atomicAdd(&(bar)[XB_TMO], 1u); break; } } } } while (0)
struct XcdBarrier { unsigned* bar; unsigned x; volatile LAS unsigned* st; };
__device__ __forceinline__ XcdBarrier xcd_barrier_post(unsigned* bar, volatile LAS unsigned* st) {
    XcdBarrier b; b.bar = bar; b.x = xb_xcc_id(); b.st = st;
    if (threadIdx.x == 0) (void)xb_add(&bar[XB_XCNT(b.x)], 1u);
    return b;
}
__device__ __forceinline__ void xcd_barrier_complete(unsigned* bar, unsigned x, unsigned G, unsigned& nloc, unsigned& nx) {
    unsigned sum, cnt, mine, sp = 0u;
    for (;;) {
        sum = 0u; cnt = 0u; mine = 0u;
#pragma unroll
        for (unsigned j = 0; j < 16; ++j) { const unsigned c = xb_ld(&bar[XB_XCNT(j)]); sum += c; cnt += (c > 0u) ? 1u : 0u; mine = (j == x) ? c : mine; }
        if (sum == G) break;
        __builtin_amdgcn_s_sleep(1);
        if ((++sp & 255u) == 0u) { if (xb_ld(&bar[XB_TMO])) break; if (sp > XB_SPIN_CAP) { atomicAdd(&bar[XB_TMO], 1u); break; } }
    }
    nloc = mine > 0u ? mine : 1u; nx = cnt > 0u ? cnt : 1u;
}
__device__ __forceinline__ void xcd_barrier(const XcdBarrier& b, unsigned G) {
    asm volatile("s_waitcnt vmcnt(0)" ::: "memory");
    __syncthreads();
    if (threadIdx.x == 0) {
        unsigned* bar = b.bar;
        __builtin_amdgcn_s_waitcnt(0);
        unsigned nloc = b.st[0], nx = b.st[1];
        if (nloc == 0u) { xcd_barrier_complete(bar, b.x, G, nloc, nx); b.st[0] = nloc; b.st[1] = nx; }
        const unsigned old = xb_add(&bar[XB_XSUB(b.x)], 1u);
        const unsigned gen = old / nloc;
        if (old + 1u == (gen + 1u) * nloc) {
            __builtin_amdgcn_fence(__ATOMIC_RELEASE, "agent");
            asm volatile("s_waitcnt vmcnt(0)" ::: "memory");
            const unsigned og = xb_add(&bar[XB_TOP], 1u);
            const unsigned tg = og / nx;
            if (og + 1u == (tg + 1u) * nx) xb_add(&bar[XB_TOPGEN], 1u);
            else XB_SPIN(xb_ld(&bar[XB_TOPGEN]) == tg, bar);
            __builtin_amdgcn_fence(__ATOMIC_ACQUIRE, "agent");
            xb_add(&bar[XB_XGEN(b.x)], 1u);
            asm volatile("s_waitcnt vmcnt(0)" ::: "memory");
        } else {
            XB_SPIN(xb_ld(&bar[XB_XGEN(b.x)]) == gen, bar);
            __builtin_amdgcn_fence(__ATOMIC_ACQUIRE, "agent");
            asm volatile("s_waitcnt vmcnt(0)" ::: "memory");
        }
    }
    __syncthreads();
}

constexpr int N_PHASES = 9;
#ifndef DUP_MASK
#define DUP_MASK 0
#endif
#define REP(k) for (int rep_ = 0; rep_ < 1 + ((DUP_MASK >> (k)) & 1); ++rep_)
__global__ void __launch_bounds__(NTHR, 2) fwd(Args args) {
    extern __shared__ __attribute__((aligned(16))) unsigned char lds_raw[];
    LAS unsigned char* lds = (LAS unsigned char*)lds_raw;
    const int tid = threadIdx.x, lane = tid & 63, wave = __builtin_amdgcn_readfirstlane(tid >> 6);
    const int G = gridDim.x; const int bx = blockIdx.x; const int vcu = (G % 8 == 0) ? (bx % 8) * (G / 8) + bx / 8 : bx;
    unsigned char* ws = args.ws;
    const int lo = args.ph_lo, hi = args.ph_hi;
#define IN(k) (lo <= (k) && (k) < hi)
    volatile LAS unsigned* MISC = (volatile LAS unsigned*)(lds + MISC_OFF);
    if (tid < 32) MISC[tid] = 0u;
    __syncthreads();
#if USE_CG_SYNC
    if (IN(0) && bx * NTHR + tid < XCD_BAR_WORDS) __hip_atomic_store((unsigned*)(ws + WS_CTL) + bx * NTHR + tid, 0u, __ATOMIC_RELAXED, __HIP_MEMORY_SCOPE_AGENT);
    XcdBarrier bar; bar.bar = (unsigned*)(ws + WS_CTL); bar.x = 0; bar.st = MISC + 8;
#else
    XcdBarrier bar = xcd_barrier_post((unsigned*)(ws + WS_CTL), MISC + 8);
#endif
#if USE_CG_SYNC
    if (IN(0)) { cg::this_grid().sync(); bar = xcd_barrier_post((unsigned*)(ws + WS_CTL), MISC + 8); }
#define SEAM(k) do { if (IN(k) && IN((k) + ((k) == 4 ? 2 : 1))) { xcd_barrier(bar, (unsigned)G); } } while (0)
#else
#define SEAM(k) do { if (IN(k) && IN((k) + ((k) == 4 ? 2 : 1))) { xcd_barrier(bar, (unsigned)G); } } while (0)
#endif

    if (IN(0)) REP(0) { p0_prologue(args, lds, vcu, G, wave, lane, tid); }
    SEAM(0);
    if (IN(1)) REP(1) {
        { pg8::Gemm g{(const bf16_t*)(ws + WS_H), (const bf16_t*)(ws + WS_WIN), S, 12 * 256, D, D, D, 0}; pg8::StaticOrder so; so.init(S, 12 * 256, G, bx);
          pg8::EpiZ E{(bf16_t*)(ws + WS_Z), args.in[3], 1.0f};
          pg8::gemm_phase<pg8::EpiZ>(lds, g, so, E); }
        asm volatile("s_waitcnt vmcnt(0)" ::: "memory"); __syncthreads();
        { pg8::Gemm g{(const bf16_t*)(ws + WS_H8), (const bf16_t*)(ws + WS_W8), S, 16 * 256, D / 2, D / 2, D / 2, 0}; pg8::StaticOrder so; so.init(S, 16 * 256, G, bx, 12, 1);
          pg8::EpiZ E{(bf16_t*)(ws + WS_Z), args.in[3], 1.0f / (W8_SCALE * H8_SCALE)};
          pg8::gemm_phase<pg8::EpiZ, true, true>(lds, g, so, E); }
    }
    SEAM(1);
    if (IN(2)) REP(2) {
        for (int bi = bx; bi < 256; bi += G) p2_sgu(args, lds, bi * 2, bi * 2 + 2, 1, wave, lane, tid);
        p2_pool(args, vcu, G, tid);
    }
    SEAM(2);
    if (IN(3)) REP(3) {
        pg8::StaticOrder so; so.init(S, D, G, bx, 0, 0, 1);
        pg8::Gemm g{(const bf16_t*)(ws + WS_A2) + 1024, (const bf16_t*)(ws + WS_WG), S, D, GWD, D, GWD, 2, (const bf16_t*)(ws + WS_A2), (const bf16_t*)(ws + WS_WPOOL), 256};
        pg8::EpiChain E{(const bf16_t*)(ws + WS_Z), (bf16_t*)(ws + WS_MRG)};
        pg8::gemm_phase<pg8::EpiChain>(lds, g, so, E);
    }
    SEAM(3);
    if (IN(4)) REP(4) {
        pg8::Gemm g{(const bf16_t*)(ws + WS_MRG), (const bf16_t*)(ws + WS_WOUT), S, D, D, D, D, 0}; pg8::StaticOrder so; so.init(S, D, G, bx);
        pg8::EpiX1 E{args.in[0], (bf16_t*)(ws + WS_XB), (float*)(ws + WS_SS)};
        pg8::gemm_phase<pg8::EpiX1>(lds, g, so, E);
    }
    SEAM(4);
    if (IN(6)) REP(6) {
        pg8::Gemm g{(const bf16_t*)(ws + WS_XB), (const bf16_t*)(ws + WS_WQ), S, D, D, D, D, 0}; pg8::StaticOrder so; so.init(S, D, G, bx);
        pg8::EpiQ E{(bf16_t*)(ws + WS_Q), (const float*)(ws + WS_SS)};
        pg8::gemm_phase<pg8::EpiQ>(lds, g, so, E);
    }
    if (IN(6) && IN(7)) { asm volatile("s_waitcnt vmcnt(0)" ::: "memory"); __syncthreads(); }
    if (IN(7)) REP(7) { p7_topk(args, lds, vcu, G, wave, lane); }
    SEAM(7);
    if (IN(8)) REP(8) { float* dst8 = (rep_ < ((DUP_MASK >> 8) & 1)) ? (float*)(ws + WS_T) : args.out; p8_peer(args, lds, dst8, vcu, G, wave, lane); }
#undef IN
#undef SEAM
}

extern "C" void kernel_launch(void* const* d_in, const int* in_sizes, int n_in, void* d_out, int out_size, void* d_ws, size_t ws_size, hipStream_t stream) {
    static int grid = 0;
    if (grid == 0) {
        if (n_in != 18 || out_size != S * D || ws_size < WS_END) { fprintf(stderr, "kernel_launch: unexpected shapes (n_in %d, out %d, ws %zu)\n", n_in, out_size, ws_size); grid = -1; return; }
        int dev = 0, cus = 0, per_cu = 0;
        if (hipGetDevice(&dev) != hipSuccess || hipDeviceGetAttribute(&cus, hipDeviceAttributeMultiprocessorCount, dev) != hipSuccess) { grid = -1; return; }
        if (hipFuncSetAttribute((const void*)fwd, hipFuncAttributeMaxDynamicSharedMemorySize, LDS_BYTES) != hipSuccess) { fprintf(stderr, "kernel_launch: hipFuncSetAttribute failed\n"); grid = -1; return; }
        if (hipOccupancyMaxActiveBlocksPerMultiprocessor(&per_cu, (const void*)fwd, NTHR, LDS_BYTES) != hipSuccess || per_cu < 1) { fprintf(stderr, "kernel_launch: occupancy query says %d\n", per_cu); per_cu = 1; }
        (void)hipGetLastError();
        grid = cus;
    }
    if (grid < 0) return;
#if !USE_CG_SYNC
    if (hipMemsetAsync((char*)d_ws + WS_CTL, 0, 16384, stream) != hipSuccess) { fprintf(stderr, "kernel_launch: memset failed\n"); return; }
#endif
    Args a{};
    for (int i = 0; i < 18; ++i) a.in[i] = (const float*)d_in[i];
    a.out = (float*)d_out; a.ws = (unsigned char*)d_ws;
#if MK_N_LAUNCHES == 1
    a.ph_lo = 0; a.ph_hi = N_PHASES;
    void* kargs[] = {&a};
    hipError_t e = hipLaunchCooperativeKernel((const void*)fwd, dim3(grid), dim3(NTHR), kargs, LDS_BYTES, stream);
    if (e != hipSuccess) fprintf(stderr, "kernel_launch: cooperative launch failed: %s (grid %d)\n", hipGetErrorString(e), grid);
#else
    for (int p = 0; p < N_PHASES; ++p) {
        a.ph_lo = p; a.ph_hi = p + 1;
        hipLaunchKernelGGL(fwd, dim3(grid), dim3(NTHR), LDS_BYTES, stream, a);
    }
#endif
}
```
